# Optimizing an MI355X kernel written in HIP

```python
import math
import jax, jax.numpy as jnp
from jax import lax
import numpy as np

D_MODEL = 1024
BATCH = 2
SEQ = 8192
DEPTH = 1

D_CONV = D_MODEL
CONV_WIDTH = 3
HEAD_DIM = 64
N_Q_HEADS = D_MODEL // HEAD_DIM
N_KV_HEADS = 4
GQA_GROUP = N_Q_HEADS // N_KV_HEADS
WINDOW = 128
BLOCK = 128
N_EXPERTS = 32
TOP_K = 4
D_EXPERT = D_MODEL
SWIGLU_LIMIT = 7.0
SWIGLU_ALPHA = 1.702
EXPERT_CHUNK = 256
D_PLE = 256
DN_ALPHA = (2.0 * DEPTH) ** 0.25
DN_BETA = (8.0 * DEPTH) ** -0.25
LN_EPS = 1e-5

IN_SIZES = [D_CONV, D_CONV, D_CONV,
            N_Q_HEADS * HEAD_DIM, N_KV_HEADS * HEAD_DIM, N_KV_HEADS * HEAD_DIM,
            D_MODEL, D_MODEL]
IN_TOTAL = sum(IN_SIZES)
IN_SPLITS = [int(s) for s in np.cumsum(IN_SIZES)[:-1]]
V_START = 3 * D_CONV + N_Q_HEADS * HEAD_DIM + N_KV_HEADS * HEAD_DIM
V_END = V_START + N_KV_HEADS * HEAD_DIM

kernel_name = "hybrid_conv_swa_moe_deepnorm"


def layer_norm(x, g, b):
    xf = x.astype(jnp.float32)
    mu = jnp.mean(xf, axis=-1, keepdims=True)
    var = jnp.mean(jnp.square(xf - mu), axis=-1, keepdims=True)
    y = (xf - mu) * lax.rsqrt(var + LN_EPS) * g.astype(jnp.float32) + b.astype(jnp.float32)
    return y.astype(x.dtype)


def short_conv_mixer(b_gate, c_gate, h, conv_w):
    u = c_gate * h
    S = u.shape[1]
    up = jnp.pad(u, ((0, 0), (CONV_WIDTH - 1, 0), (0, 0)))
    y = sum(conv_w[k] * up[:, k:k + S] for k in range(CONV_WIDTH))
    return b_gate * y


def sliding_window_attention(q, k, v, sinks):
    B, S, _ = q.shape
    nb = S // BLOCK
    qb = q.reshape(B, nb, BLOCK, N_KV_HEADS, GQA_GROUP, HEAD_DIM)
    k4 = k.reshape(B, S, N_KV_HEADS, HEAD_DIM)
    v4 = v.reshape(B, S, N_KV_HEADS, HEAD_DIM)
    pad = ((0, 0), (BLOCK, 0), (0, 0), (0, 0))
    kp = jnp.pad(k4, pad)[:, :S].reshape(B, nb, BLOCK, N_KV_HEADS, HEAD_DIM)
    vp = jnp.pad(v4, pad)[:, :S].reshape(B, nb, BLOCK, N_KV_HEADS, HEAD_DIM)
    kb = jnp.concatenate([kp, k4.reshape(B, nb, BLOCK, N_KV_HEADS, HEAD_DIM)], axis=2)
    vb = jnp.concatenate([vp, v4.reshape(B, nb, BLOCK, N_KV_HEADS, HEAD_DIM)], axis=2)
    scale = 1.0 / math.sqrt(HEAD_DIM)
    s = jnp.einsum('bnqhgd,bnkhd->bnhgqk', qb, kb).astype(jnp.float32) * scale
    qi = jnp.arange(BLOCK)[:, None] + BLOCK
    kj = jnp.arange(2 * BLOCK)[None, :]
    rel = qi - kj
    band = (rel >= 0) & (rel < WINDOW)
    valid_key = (jnp.arange(nb)[:, None] * BLOCK - BLOCK + kj) >= 0
    mask = band[None] & valid_key[:, None, :]
    s = jnp.where(mask[None, :, None, None], s, -jnp.inf)
    sink = sinks.astype(jnp.float32).reshape(1, 1, N_KV_HEADS, GQA_GROUP, 1, 1)
    m = jnp.maximum(jnp.max(s, axis=-1, keepdims=True), sink)
    e = jnp.exp(s - m)
    denom = jnp.sum(e, axis=-1, keepdims=True) + jnp.exp(sink - m)
    probs = (e / denom).astype(q.dtype)
    o = jnp.einsum('bnhgqk,bnkhd->bnqhgd', probs, vb)
    return o.reshape(B, S, N_Q_HEADS * HEAD_DIM)


def routed_experts(x, w_router, b_router, w_gu, b_gu, w_down, b_down):
    B, S, D = x.shape
    N = B * S
    t = x.reshape(N, D)
    logits = (t @ w_router + b_router).astype(jnp.float32)
    top_vals, top_idx = lax.top_k(logits, TOP_K)
    top_w = jax.nn.softmax(top_vals, axis=-1)
    A = N * TOP_K
    flat_e = top_idx.reshape(A)
    flat_tok = jnp.repeat(jnp.arange(N, dtype=jnp.int32), TOP_K)
    flat_w = top_w.reshape(A)
    order = jnp.argsort(flat_e, stable=True)
    sorted_e = flat_e[order]
    counts = jnp.bincount(flat_e, length=N_EXPERTS)
    padded = ((counts + EXPERT_CHUNK - 1) // EXPERT_CHUNK) * EXPERT_CHUNK
    start_sorted = jnp.cumsum(counts) - counts
    end_padded = jnp.cumsum(padded)
    start_padded = end_padded - padded
    rank = jnp.arange(A) - start_sorted[sorted_e]
    dest = start_padded[sorted_e] + rank
    P = A + N_EXPERTS * EXPERT_CHUNK
    P = ((P + EXPERT_CHUNK - 1) // EXPERT_CHUNK) * EXPERT_CHUNK
    n_chunks = P // EXPERT_CHUNK
    tok_buf = jnp.full((P,), N, dtype=jnp.int32).at[dest].set(flat_tok[order])
    w_buf = jnp.zeros((P,), jnp.float32).at[dest].set(flat_w[order])
    chunk_start = jnp.arange(n_chunks) * EXPERT_CHUNK
    chunk_e = jnp.clip(jnp.searchsorted(end_padded, chunk_start, side='right'), 0, N_EXPERTS - 1)
    t_pad = jnp.concatenate([t, jnp.zeros((1, D), t.dtype)], axis=0)
    xs = t_pad[tok_buf].reshape(n_chunks, EXPERT_CHUNK, D)

    def expert_chunk(args):
        xc, e = args
        gu = xc @ w_gu[e] + b_gu[e]
        gate, up = gu[:, :D_EXPERT], gu[:, D_EXPERT:]
        gate = jnp.minimum(gate, SWIGLU_LIMIT)
        up = jnp.clip(up, -SWIGLU_LIMIT, SWIGLU_LIMIT)
        h = (up + 1.0) * gate * jax.nn.sigmoid(SWIGLU_ALPHA * gate)
        return h @ w_down[e] + b_down[e]

    ys = lax.map(expert_chunk, (xs, chunk_e)).reshape(P, D)
    ys = ys * w_buf[:, None].astype(ys.dtype)
    out = jnp.zeros((N + 1, D), ys.dtype).at[tok_buf].add(ys)[:N]
    return out.reshape(B, S, D).astype(x.dtype)


def setup_inputs(seed: int = 0) -> dict:
    key = jax.random.key(seed)
    ks = jax.random.split(key, 24)
    f32 = jnp.float32
    nrm = lambda k, shape, s: jax.random.normal(k, shape, f32) * s
    L = DEPTH
    w_in = nrm(ks[2], (L, D_MODEL, IN_TOTAL), D_MODEL ** -0.5)
    w_in = w_in.at[:, :, V_START:V_END].multiply(DN_BETA)
    return {
        "x": nrm(ks[0], (BATCH, SEQ, D_MODEL), 1.0),
        "p": nrm(ks[1], (DEPTH, BATCH, SEQ, D_PLE), 1.0),
        "w_in": w_in,
        "conv_w": nrm(ks[3], (L, CONV_WIDTH, D_CONV), CONV_WIDTH ** -0.5),
        "w_br_conv": nrm(ks[4], (L, D_CONV, D_MODEL), D_CONV ** -0.5 * DN_BETA),
        "w_br_attn": nrm(ks[5], (L, N_Q_HEADS * HEAD_DIM, D_MODEL), (N_Q_HEADS * HEAD_DIM) ** -0.5 * DN_BETA),
        "attn_sinks": nrm(ks[6], (L, N_Q_HEADS), 0.5),
        "w_out": nrm(ks[7], (L, D_MODEL, D_MODEL), D_MODEL ** -0.5 * DN_BETA),
        "ln1_g": 1.0 + nrm(ks[8], (L, D_MODEL), 0.02),
        "ln1_b": nrm(ks[9], (L, D_MODEL), 0.02),
        "w_router": nrm(ks[10], (L, D_MODEL, N_EXPERTS), D_MODEL ** -0.5),
        "b_router": nrm(ks[11], (L, N_EXPERTS), 0.01),
        "w_gu": nrm(ks[12], (L, N_EXPERTS, D_MODEL, 2 * D_EXPERT), D_MODEL ** -0.5 * DN_BETA),
        "b_gu": nrm(ks[13], (L, N_EXPERTS, 2 * D_EXPERT), 0.01),
        "w_down": nrm(ks[14], (L, N_EXPERTS, D_EXPERT, D_MODEL), D_EXPERT ** -0.5 * DN_BETA),
        "b_down": nrm(ks[15], (L, N_EXPERTS, D_MODEL), 0.01),
        "w_ple_proj": nrm(ks[16], (L, D_PLE, D_MODEL), D_PLE ** -0.5 * DN_BETA),
        "w_ple_gate": nrm(ks[17], (L, D_MODEL, D_MODEL), D_MODEL ** -0.5),
        "ln2_g": 1.0 + nrm(ks[18], (L, D_MODEL), 0.02),
        "ln2_b": nrm(ks[19], (L, D_MODEL), 0.02),
    }


def reference(x, p, w_in, conv_w, w_br_conv, w_br_attn, attn_sinks, w_out, ln1_g, ln1_b,
              w_router, b_router, w_gu, b_gu, w_down, b_down, w_ple_proj, w_ple_gate,
              ln2_g, ln2_b):
    B, S, D = x.shape
    for i in range(DEPTH):
        proj = x @ w_in[i]
        b_gate, c_gate, h, q, k, v, g_conv, g_attn = jnp.split(proj, IN_SPLITS, axis=-1)
        y_conv = short_conv_mixer(b_gate, c_gate, h, conv_w[i]) @ w_br_conv[i]
        y_attn = sliding_window_attention(q, k, v, attn_sinks[i]) @ w_br_attn[i]
        merged = jax.nn.sigmoid(g_conv) * y_conv + jax.nn.sigmoid(g_attn) * y_attn
        x1 = layer_norm(DN_ALPHA * x + merged @ w_out[i], ln1_g[i], ln1_b[i])
        moe_out = routed_experts(x1, w_router[i], b_router[i], w_gu[i], b_gu[i], w_down[i], b_down[i])
        ple = jax.nn.sigmoid(x1 @ w_ple_gate[i]) * (p[i] @ w_ple_proj[i])
        x = layer_norm(DN_ALPHA * x1 + moe_out + ple, ln2_g[i], ln2_b[i])
    return x
```

```cpp
#include <hip/hip_runtime.h>
#include <cstdio>
#include <cstdint>

constexpr int BATCH = 2, SEQ = 8192, M = BATCH * SEQ, D = 1024, NIN = 6656, NE = 32, TOPK = 4, DPLE = 256, NH = 16, HD = 64;
constexpr int C_B = 0, C_C = 1024, C_H = 2048, C_Q = 3072, C_K = 4096, C_V = 4352, C_GC = 4608, C_GA = 5632;
constexpr float DN_ALPHA = 1.189207115002721f;
constexpr float LN_EPS = 1e-5f;
constexpr int PADROWS = 65536 + NE * 128;
constexpr int NTILES = PADROWS / 128;

struct GemmP { const float* A; const int* rowidx; const float* B; int lda; int ldb; int K; int pad; };

template <class Epi>
__device__ __forceinline__ void gemm_tile(const GemmP g, int m0, int nb0, int nb1, const Epi& epi) {
    __shared__ float As[16][132];
    __shared__ float Bs[16][132];
    const int tid = threadIdx.x, ty = tid >> 4, tx = tid & 15;
    const int arow = tid >> 1, akq = (tid & 1) * 8;
    int grow = m0 + arow;
    if (g.rowidx) { grow = g.rowidx[grow]; if (grow < 0) grow = 0; }
    const float* ap = g.A + (size_t)grow * g.lda + akq;
    const int bk = tid >> 4, bc = (tid & 15) * 8;
    const int bcol = (bc < 64) ? (nb0 + bc) : (nb1 + bc - 64);
    const float* bp = g.B + (size_t)bk * g.ldb + bcol;
    float acc[8][8];
#pragma unroll
    for (int i = 0; i < 8; ++i)
#pragma unroll
        for (int j = 0; j < 8; ++j) acc[i][j] = 0.f;
    for (int k0 = 0; k0 < g.K; k0 += 16) {
        const float4 a0 = *(const float4*)(ap + k0), a1 = *(const float4*)(ap + k0 + 4);
        const float4 b0 = *(const float4*)(bp + (size_t)k0 * g.ldb), b1 = *(const float4*)(bp + (size_t)k0 * g.ldb + 4);
        __syncthreads();
        As[akq + 0][arow] = a0.x; As[akq + 1][arow] = a0.y; As[akq + 2][arow] = a0.z; As[akq + 3][arow] = a0.w;
        As[akq + 4][arow] = a1.x; As[akq + 5][arow] = a1.y; As[akq + 6][arow] = a1.z; As[akq + 7][arow] = a1.w;
        *(float4*)&Bs[bk][bc] = b0; *(float4*)&Bs[bk][bc + 4] = b1;
        __syncthreads();
#pragma unroll
        for (int k = 0; k < 16; ++k) {
            float a[8], b[8];
            const float4 x0 = *(const float4*)&As[k][ty * 8], x1 = *(const float4*)&As[k][ty * 8 + 4];
            a[0] = x0.x; a[1] = x0.y; a[2] = x0.z; a[3] = x0.w; a[4] = x1.x; a[5] = x1.y; a[6] = x1.z; a[7] = x1.w;
            const float4 y0 = *(const float4*)&Bs[k][tx * 4], y1 = *(const float4*)&Bs[k][64 + tx * 4];
            b[0] = y0.x; b[1] = y0.y; b[2] = y0.z; b[3] = y0.w; b[4] = y1.x; b[5] = y1.y; b[6] = y1.z; b[7] = y1.w;
#pragma unroll
            for (int i = 0; i < 8; ++i)
#pragma unroll
                for (int j = 0; j < 8; ++j) acc[i][j] = fmaf(a[i], b[j], acc[i][j]);
        }
    }
#pragma unroll
    for (int i = 0; i < 8; ++i) {
        const int r = m0 + ty * 8 + i;
        float va[4] = {acc[i][0], acc[i][1], acc[i][2], acc[i][3]}, vb[4] = {acc[i][4], acc[i][5], acc[i][6], acc[i][7]};
        epi(r, nb0 + tx * 4, nb1 + tx * 4, va, vb);
    }
}

__device__ __forceinline__ float sigmoidf_(float v) { return 1.0f / (1.0f + expf(-v)); }

struct EpiStore { float* C; int ldc; int pad;
    __device__ void operator()(int r, int c0, int c1, const float (&a)[4], const float (&b)[4]) const {
        *(float4*)(C + (size_t)r * ldc + c0) = make_float4(a[0], a[1], a[2], a[3]);
        *(float4*)(C + (size_t)r * ldc + c1) = make_float4(b[0], b[1], b[2], b[3]); } };
struct EpiGate { float* C; const float* G; int gcol; int accumulate;
    __device__ void operator()(int r, int c0, int c1, const float (&a)[4], const float (&b)[4]) const {
#pragma unroll
        for (int j = 0; j < 4; ++j) {
            float v0 = sigmoidf_(G[(size_t)r * NIN + gcol + c0 + j]) * a[j], v1 = sigmoidf_(G[(size_t)r * NIN + gcol + c1 + j]) * b[j];
            float* p0 = C + (size_t)r * D + c0 + j; float* p1 = C + (size_t)r * D + c1 + j;
            if (accumulate) { v0 += *p0; v1 += *p1; }
            *p0 = v0; *p1 = v1; } } };
struct EpiResid { float* C; const float* X;
    __device__ void operator()(int r, int c0, int c1, const float (&a)[4], const float (&b)[4]) const {
#pragma unroll
        for (int j = 0; j < 4; ++j) { C[(size_t)r * D + c0 + j] = DN_ALPHA * X[(size_t)r * D + c0 + j] + a[j]; C[(size_t)r * D + c1 + j] = DN_ALPHA * X[(size_t)r * D + c1 + j] + b[j]; } } };
struct EpiPle { float* C; const float* P2;
    __device__ void operator()(int r, int c0, int c1, const float (&a)[4], const float (&b)[4]) const {
#pragma unroll
        for (int j = 0; j < 4; ++j) { C[(size_t)r * D + c0 + j] = sigmoidf_(a[j]) * P2[(size_t)r * D + c0 + j]; C[(size_t)r * D + c1 + j] = sigmoidf_(b[j]) * P2[(size_t)r * D + c1 + j]; } } };

template <class Epi>
__global__ void __launch_bounds__(256) gemm_kernel(GemmP g, Epi epi) { gemm_tile(g, blockIdx.y * 128, blockIdx.x * 128, blockIdx.x * 128 + 64, epi); }

struct MoeP { const float* x1; const int* sorted_tok; const float* sorted_w; const int* tile_e; const float* w_gu; const float* b_gu; const float* w_down; const float* b_down; float* H; float* Y; };
struct EpiSwiglu { float* H; const float* bg; const int* sorted_tok;
    __device__ void operator()(int r, int c0, int c1, const float (&a)[4], const float (&b)[4]) const {
        if (sorted_tok[r] < 0) return;
#pragma unroll
        for (int j = 0; j < 4; ++j) {
            float gate = a[j] + bg[c0 + j], up = b[j] + bg[c1 + j];
            gate = fminf(gate, 7.0f); up = fminf(fmaxf(up, -7.0f), 7.0f);
            H[(size_t)r * D + c0 + j] = (up + 1.0f) * gate * sigmoidf_(1.702f * gate); } } };
struct EpiDown { float* Y; const float* bd; const int* sorted_tok; const float* sorted_w;
    __device__ void operator()(int r, int c0, int c1, const float (&a)[4], const float (&b)[4]) const {
        if (sorted_tok[r] < 0) return;
        const float w = sorted_w[r];
#pragma unroll
        for (int j = 0; j < 4; ++j) { Y[(size_t)r * D + c0 + j] = w * (a[j] + bd[c0 + j]); Y[(size_t)r * D + c1 + j] = w * (b[j] + bd[c1 + j]); } } };

__global__ void __launch_bounds__(256) moe_gu_kernel(MoeP p) {
    const int e = p.tile_e[blockIdx.y]; if (e < 0) return;
    GemmP g{p.x1, p.sorted_tok, p.w_gu + (size_t)e * D * 2048, D, 2048, D, 0};
    EpiSwiglu epi{p.H, p.b_gu + e * 2048, p.sorted_tok};
    gemm_tile(g, blockIdx.y * 128, blockIdx.x * 64, 1024 + blockIdx.x * 64, epi);
}
__global__ void __launch_bounds__(256) moe_down_kernel(MoeP p) {
    const int e = p.tile_e[blockIdx.y]; if (e < 0) return;
    GemmP g{p.H, nullptr, p.w_down + (size_t)e * D * D, D, D, D, 0};
    EpiDown epi{p.Y, p.b_down + e * D, p.sorted_tok, p.sorted_w};
    gemm_tile(g, blockIdx.y * 128, blockIdx.x * 128, blockIdx.x * 128 + 64, epi);
}

__global__ void conv_kernel(const float* PROJ, const float* cw, float* Z) {
    const size_t i = (size_t)blockIdx.x * blockDim.x + threadIdx.x; if (i >= (size_t)M * D) return;
    const int t = (int)(i / D), c = (int)(i % D), tl = t % SEQ;
    float y = 0.f;
#pragma unroll
    for (int k = 0; k < 3; ++k) { const int dt = k - 2; if (tl + dt >= 0) { const float* r = PROJ + (size_t)(t + dt) * NIN; y += cw[k * D + c] * (r[C_C + c] * r[C_H + c]); } }
    Z[i] = PROJ[(size_t)t * NIN + C_B + c] * y;
}

__global__ void __launch_bounds__(256) attn_kernel(const float* PROJ, const float* sinks, float* O) {
    const int lane = threadIdx.x & 63, wave = threadIdx.x >> 6;
    const int gw = blockIdx.x * 4 + wave, nw = gridDim.x * 4;
    for (int it = gw; it < M * NH; it += nw) {
        const int t = it / NH, h = it % NH, kvh = h / 4, tl = t % SEQ;
        const int slo = tl - 127 < 0 ? 0 : tl - 127, n = tl - slo + 1;
        const float* qp = PROJ + (size_t)t * NIN + C_Q + h * HD;
        float sc[2];
#pragma unroll
        for (int u = 0; u < 2; ++u) {
            const int j = lane + 64 * u; float dot = -INFINITY;
            if (j < n) { const float* kp = PROJ + (size_t)(t - tl + slo + j) * NIN + C_K + kvh * HD; dot = 0.f;
                for (int d = 0; d < HD; ++d) dot = fmaf(qp[d], kp[d], dot);
                dot *= 0.125f; }
            sc[u] = dot;
        }
        const float sink = sinks[h];
        float m = fmaxf(sc[0], sc[1]);
        for (int o = 1; o < 64; o <<= 1) m = fmaxf(m, __shfl_xor(m, o));
        m = fmaxf(m, sink);
        float e0 = (lane < n) ? expf(sc[0] - m) : 0.f, e1 = (lane + 64 < n) ? expf(sc[1] - m) : 0.f;
        float s = e0 + e1;
        for (int o = 1; o < 64; o <<= 1) s += __shfl_xor(s, o);
        const float denom = s + expf(sink - m);
        e0 /= denom; e1 /= denom;
        float acc = 0.f;
        for (int j = 0; j < n; ++j) {
            const float pj = __shfl(j < 64 ? e0 : e1, j & 63);
            acc = fmaf(pj, PROJ[(size_t)(t - tl + slo + j) * NIN + C_V + kvh * HD + lane], acc);
        }
        O[(size_t)t * D + h * HD + lane] = acc;
    }
}

__device__ __forceinline__ float wave_sum(float v) {
#pragma unroll
    for (int o = 1; o < 64; o <<= 1) v += __shfl_xor(v, o);
    return v;
}
__global__ void __launch_bounds__(256) ln1_route_kernel(const float* PRE, const float* g1, const float* b1, const float* wr, const float* br,
                                                         float* X1, int* tk_e, float* tk_w, int* tk_rank, int* cnt) {
    const int lane = threadIdx.x & 63, wave = threadIdx.x >> 6;
    const int t = blockIdx.x * 4 + wave; if (t >= M) return;
    float v[16]; float s = 0.f;
#pragma unroll
    for (int j = 0; j < 16; ++j) { v[j] = PRE[(size_t)t * D + j * 64 + lane]; s += v[j]; }
    const float mean = wave_sum(s) * (1.0f / D); float q = 0.f;
#pragma unroll
    for (int j = 0; j < 16; ++j) { v[j] -= mean; q += v[j] * v[j]; }
    const float rstd = rsqrtf(wave_sum(q) * (1.0f / D) + LN_EPS);
#pragma unroll
    for (int j = 0; j < 16; ++j) { const int c = j * 64 + lane; v[j] = v[j] * rstd * g1[c] + b1[c]; X1[(size_t)t * D + c] = v[j]; }
    float mylogit = -INFINITY;
    for (int e = 0; e < NE; ++e) {
        float part = 0.f;
#pragma unroll
        for (int j = 0; j < 16; ++j) part = fmaf(v[j], wr[(size_t)(j * 64 + lane) * NE + e], part);
        part = wave_sum(part) + br[e];
        if (lane == e) mylogit = part;
    }
    int se[4]; float sv[4];
#pragma unroll
    for (int k = 0; k < 4; ++k) {
        float bv = mylogit; int bi = lane < NE ? lane : 1 << 20;
        for (int o = 1; o < 64; o <<= 1) { const float ov = __shfl_xor(bv, o); const int oi = __shfl_xor(bi, o); if (ov > bv || (ov == bv && oi < bi)) { bv = ov; bi = oi; } }
        se[k] = bi; sv[k] = bv; if (lane == bi) mylogit = -INFINITY;
    }
    const float e0 = 1.0f, e1 = expf(sv[1] - sv[0]), e2 = expf(sv[2] - sv[0]), e3 = expf(sv[3] - sv[0]);
    const float inv = 1.0f / (e0 + e1 + e2 + e3);
    if (lane < 4) {
        const int e = lane == 0 ? se[0] : lane == 1 ? se[1] : lane == 2 ? se[2] : se[3];
        const float w = (lane == 0 ? e0 : lane == 1 ? e1 : lane == 2 ? e2 : e3) * inv;
        const int rank = atomicAdd(&cnt[e], 1);
        tk_e[t * 4 + lane] = e; tk_w[t * 4 + lane] = w; tk_rank[t * 4 + lane] = rank;
    }
}
__global__ void __launch_bounds__(1024) route_offsets_kernel(const int* cnt, int* poff, int* tile_e, int* sorted_tok) {
    __shared__ int so[NE + 1];
    if (threadIdx.x == 0) { int a = 0; for (int e = 0; e < NE; ++e) { so[e] = a; a += (cnt[e] + 127) / 128 * 128; } so[NE] = a; }
    __syncthreads();
    if (threadIdx.x < NE) poff[threadIdx.x] = so[threadIdx.x];
    for (int i = threadIdx.x; i < NTILES; i += 1024) { int e = -1; for (int k = 0; k < NE; ++k) if (i * 128 >= so[k] && i * 128 < so[k + 1]) e = k; tile_e[i] = e; }
    for (int i = threadIdx.x; i < PADROWS; i += 1024) sorted_tok[i] = -1;
}
__global__ void route_scatter_kernel(const int* tk_e, const float* tk_w, const int* tk_rank, const int* poff, int* sorted_tok, float* sorted_w) {
    const int i = blockIdx.x * blockDim.x + threadIdx.x; if (i >= M * 4) return;
    const int pos = poff[tk_e[i]] + tk_rank[i];
    sorted_tok[pos] = i / 4; sorted_w[pos] = tk_w[i];
}
__global__ void __launch_bounds__(256) final_kernel(const float* X1, const float* PLE, const float* Y, const int* tk_e, const int* tk_rank, const int* poff,
                                                     const float* g2, const float* b2, float* out) {
    const int lane = threadIdx.x & 63, wave = threadIdx.x >> 6;
    const int t = blockIdx.x * 4 + wave; if (t >= M) return;
    int pos[4];
#pragma unroll
    for (int k = 0; k < 4; ++k) pos[k] = poff[tk_e[t * 4 + k]] + tk_rank[t * 4 + k];
    float v[16]; float s = 0.f;
#pragma unroll
    for (int j = 0; j < 16; ++j) { const int c = j * 64 + lane; float moe = 0.f;
#pragma unroll
        for (int k = 0; k < 4; ++k) moe += Y[(size_t)pos[k] * D + c];
        v[j] = DN_ALPHA * X1[(size_t)t * D + c] + moe + PLE[(size_t)t * D + c]; s += v[j]; }
    const float mean = wave_sum(s) * (1.0f / D); float q = 0.f;
#pragma unroll
    for (int j = 0; j < 16; ++j) { v[j] -= mean; q += v[j] * v[j]; }
    const float rstd = rsqrtf(wave_sum(q) * (1.0f / D) + LN_EPS);
#pragma unroll
    for (int j = 0; j < 16; ++j) { const int c = j * 64 + lane; out[(size_t)t * D + c] = v[j] * rstd * g2[c] + b2[c]; }
}

extern "C" void kernel_launch(void* const* d_in, const int* in_sizes, int n_in, void* d_out, int out_size, void* d_ws, size_t ws_size, hipStream_t stream) {
    const float* x = (const float*)d_in[0]; const float* p = (const float*)d_in[1]; const float* w_in = (const float*)d_in[2]; const float* conv_w = (const float*)d_in[3];
    const float* w_brc = (const float*)d_in[4]; const float* w_bra = (const float*)d_in[5]; const float* sinks = (const float*)d_in[6]; const float* w_out = (const float*)d_in[7];
    const float* ln1g = (const float*)d_in[8]; const float* ln1b = (const float*)d_in[9]; const float* w_r = (const float*)d_in[10]; const float* b_r = (const float*)d_in[11];
    const float* w_gu = (const float*)d_in[12]; const float* b_gu = (const float*)d_in[13]; const float* w_dn = (const float*)d_in[14]; const float* b_dn = (const float*)d_in[15];
    const float* w_pp = (const float*)d_in[16]; const float* w_pg = (const float*)d_in[17]; const float* ln2g = (const float*)d_in[18]; const float* ln2b = (const float*)d_in[19];
    float* out = (float*)d_out;
    const size_t MiB = 1u << 20;
    if (ws_size < 960 * MiB || n_in != 20 || out_size != M * D) { fprintf(stderr, "kernel_launch: unexpected sizes ws %zu n_in %d out %d\n", ws_size, n_in, out_size); return; }
    char* ws = (char*)d_ws;
    int* cnt = (int*)(ws + 0); int* poff = (int*)(ws + 4096); int* tile_e = (int*)(ws + 8192);
    int* tk_e = (int*)(ws + 1 * MiB); float* tk_w = (float*)(ws + 2 * MiB); int* tk_rank = (int*)(ws + 3 * MiB);
    int* sorted_tok = (int*)(ws + 4 * MiB); float* sorted_w = (float*)(ws + 5 * MiB);
    float* X1 = (float*)(ws + 16 * MiB); float* PLE = (float*)(ws + 80 * MiB); float* PRE = (float*)(ws + 144 * MiB);
    float* PROJ = (float*)(ws + 208 * MiB); float* Z = (float*)(ws + 624 * MiB); float* O = (float*)(ws + 688 * MiB); float* MG = (float*)(ws + 752 * MiB);
    float* H = (float*)(ws + 208 * MiB); float* Y = (float*)(ws + 496 * MiB);
    hipMemsetAsync(cnt, 0, 4096, stream);
    { GemmP g{x, nullptr, w_in, D, NIN, D, 0}; EpiStore e{PROJ, NIN, 0}; gemm_kernel<<<dim3(NIN / 128, M / 128), 256, 0, stream>>>(g, e); }
    conv_kernel<<<(M * D) / 256, 256, 0, stream>>>(PROJ, conv_w, Z);
    attn_kernel<<<2048, 256, 0, stream>>>(PROJ, sinks, O);
    { GemmP g{Z, nullptr, w_brc, D, D, D, 0}; EpiGate e{MG, PROJ, C_GC, 0}; gemm_kernel<<<dim3(D / 128, M / 128), 256, 0, stream>>>(g, e); }
    { GemmP g{O, nullptr, w_bra, D, D, D, 0}; EpiGate e{MG, PROJ, C_GA, 1}; gemm_kernel<<<dim3(D / 128, M / 128), 256, 0, stream>>>(g, e); }
    { GemmP g{MG, nullptr, w_out, D, D, D, 0}; EpiResid e{PRE, x}; gemm_kernel<<<dim3(D / 128, M / 128), 256, 0, stream>>>(g, e); }
    ln1_route_kernel<<<M / 4, 256, 0, stream>>>(PRE, ln1g, ln1b, w_r, b_r, X1, tk_e, tk_w, tk_rank, cnt);
    route_offsets_kernel<<<1, 1024, 0, stream>>>(cnt, poff, tile_e, sorted_tok);
    route_scatter_kernel<<<(M * 4) / 256, 256, 0, stream>>>(tk_e, tk_w, tk_rank, poff, sorted_tok, sorted_w);
    MoeP mp{X1, sorted_tok, sorted_w, tile_e, w_gu, b_gu, w_dn, b_dn, H, Y};
    moe_gu_kernel<<<dim3(16, NTILES), 256, 0, stream>>>(mp);
    moe_down_kernel<<<dim3(8, NTILES), 256, 0, stream>>>(mp);
    { GemmP g{p, nullptr, w_pp, DPLE, D, DPLE, 0}; EpiStore e{PRE, D, 0}; gemm_kernel<<<dim3(D / 128, M / 128), 256, 0, stream>>>(g, e); }
    { GemmP g{X1, nullptr, w_pg, D, D, D, 0}; EpiPle e{PLE, PRE}; gemm_kernel<<<dim3(D / 128, M / 128), 256, 0, stream>>>(g, e); }
    final_kernel<<<M / 4, 256, 0, stream>>>(X1, PLE, Y, tk_e, tk_rank, poff, ln2g, ln2b, out);
}
```

```cpp
#include <hip/hip_runtime.h>
#include <hip/hip_cooperative_groups.h>
#include <cstdio>
#include <cstdint>
namespace cg = cooperative_groups;

#define LAS __attribute__((address_space(3)))
typedef unsigned short bf16_t;
typedef short bf16x8 __attribute__((ext_vector_type(8)));
typedef short s16x4 __attribute__((ext_vector_type(4)));
typedef float f32x4 __attribute__((ext_vector_type(4)));
typedef float f32x16 __attribute__((ext_vector_type(16)));
typedef unsigned u32x4 __attribute__((ext_vector_type(4)));
typedef unsigned u32x2 __attribute__((ext_vector_type(2)));

constexpr int BATCH = 2, SEQ = 8192, M = BATCH * SEQ, D = 1024, NIN = 6656, NE = 32, DPLE = 256, NH = 16, HD = 64, NKV = 4;
constexpr float DN_ALPHA = 1.189207115002721f, LN_EPS = 1e-5f, LOG2E = 1.4426950408889634f;
constexpr float QSCALE = 0.125f * LOG2E;
constexpr int LISTCAP = M;
constexpr int MAXTILES = (M * 4) / 256 + NE;
constexpr int NWAVES = 8, NTHREADS = 512;

constexpr size_t MiB = 1u << 20;
constexpr size_t WS_CTL = 0;
constexpr size_t WS_TKE = 1 * MiB, WS_TKR = 2 * MiB, WS_TKW = 3 * MiB;
constexpr size_t WS_LTOK = 4 * MiB, WS_LW = 6 * MiB;
constexpr size_t WS_WIN = 8 * MiB;
constexpr size_t WS_WBR = 22 * MiB;
constexpr size_t WS_WOUT = 26 * MiB, WS_WPG = 28 * MiB;
constexpr size_t WS_WPP = 30 * MiB;
constexpr size_t WS_WGU = 32 * MiB;
constexpr size_t WS_WDN = 160 * MiB;
constexpr size_t WS_XB = 224 * MiB;
constexpr size_t WS_PB = 256 * MiB;
constexpr size_t WS_X1F = 264 * MiB;
constexpr size_t WS_X1B = 328 * MiB;
constexpr size_t WS_P2 = 360 * MiB;
constexpr size_t WS_PLE = 424 * MiB;
constexpr size_t WS_R = 456 * MiB;
constexpr size_t WS_BG = WS_R, WS_U = WS_R + 32 * MiB, WS_Q = WS_R + 64 * MiB, WS_K = WS_R + 96 * MiB, WS_V = WS_R + 104 * MiB;
constexpr size_t WS_GC = WS_R + 112 * MiB, WS_GA = WS_R + 144 * MiB;
constexpr size_t WS_ZO = WS_R + 176 * MiB;
constexpr size_t WS_T1 = WS_R + 240 * MiB;
constexpr size_t WS_MG = WS_R + 304 * MiB;
constexpr size_t WS_H = WS_R;
constexpr size_t WS_Y = WS_R + 144 * MiB;
constexpr size_t WS_END = WS_R + 336 * MiB;

constexpr int LDS_BYTES = 147456;
constexpr int MISC_OFF = 135168;

__device__ __forceinline__ unsigned f2bf(float f) { unsigned u = __builtin_bit_cast(unsigned, f); return (u + 0x7fffu + ((u >> 16) & 1u)) >> 16; }
__device__ __forceinline__ unsigned pk2(float lo, float hi) { return f2bf(lo) | (f2bf(hi) << 16); }
__device__ __forceinline__ float bflo(unsigned w) { return __builtin_bit_cast(float, w << 16); }
__device__ __forceinline__ float bfhi(unsigned w) { return __builtin_bit_cast(float, w & 0xffff0000u); }
__device__ __forceinline__ float fast_sigmoid(float v) { return __builtin_amdgcn_rcpf(1.0f + __builtin_amdgcn_exp2f(-LOG2E * v)); }
__device__ __forceinline__ float wave_sum(float v) {
#pragma unroll
    for (int o = 1; o < 64; o <<= 1) v += __shfl_xor(v, o);
    return v;
}
namespace pg8 {
constexpr int BM = 256, BK = 64, HALF = 128, HTB = HALF * BK * 2  , STAGE_BYTES = 8 * HTB, NXCD = 8, WGM = 8;
__host__ __device__ __forceinline__ int lds_byte(int r, int c) { const int st = (r >> 4) * 2 + (c >> 5), rr = r & 15, cc = c & 31, ob = rr * 64 + cc * 2; return st * 1024 + (ob ^ (((ob >> 9) & 1) << 5)); }
__host__ __device__ __forceinline__ void stage_rc(int b, int& R, int& C) { const int st = b / 1024, sb = b % 1024, swz = sb ^ (((sb >> 9) & 1) << 5); R = (st >> 1) * 16 + swz / 64; C = (st & 1) * 32 + (swz % 64) / 2; }
__host__ __device__ __forceinline__ int perm32(int rho) { const int n = rho >> 4, i = rho & 15; return 8 * (i >> 2) + 4 * n + (i & 3); }

struct Unit { int pm, pn, om, on, e, mt; };
struct Gemm { const bf16_t* A; const bf16_t* Bt; int K; };

__device__ __forceinline__ int xcd_remap(int L, int nwg) { const int q = nwg / NXCD, r = nwg % NXCD, xcd = L % NXCD, off = L / NXCD; return (xcd < r ? xcd * (q + 1) : r * (q + 1) + (xcd - r) * q) + off; }

__device__ __forceinline__ void plain_a_off(int pm, int tid, int K, unsigned (&o)[2][2]) {
#pragma unroll
    for (int i = 0; i < 2; ++i) { int R, C; stage_rc(tid * 16 + i * 8192, R, C);
#pragma unroll
        for (int h = 0; h < 2; ++h) o[h][i] = (unsigned)((pm * BM + h * HALF + R) * K + C) * 2u; }
}
struct StaticOrder {
    int nM, nN, nwg, G, c;
    __device__ void init(int nM_, int nN_, int G_, int c_) { nM = nM_; nN = nN_; nwg = nM * nN; G = G_; c = c_; }
    __device__ __forceinline__ bool tile(int i, int& pm, int& pn) const {
        const long L = (long)i * G + c; if (L >= nwg) return false;
        const int wgid = xcd_remap((int)L, nwg);
        const int nig = WGM * nN, gid = wgid / nig, fm = gid * WGM, gsz = (nM - fm) < WGM ? (nM - fm) : WGM;
        pm = fm + ((wgid % nig) % gsz); pn = (wgid % nig) / gsz; return true;
    }
    __device__ __forceinline__ bool next(int i, Unit& u) const { int pm, pn; if (!tile(i, pm, pn)) return false; u.pm = pm; u.pn = pn; u.om = pm; u.on = pn; u.e = 0; u.mt = 0; return true; }
    __device__ __forceinline__ void a_off(const Unit& u, int tid, int K, unsigned (&o)[2][2]) const { plain_a_off(u.pm, tid, K, o); }
};

__device__ __forceinline__ unsigned cvt_pk_bf16(float lo, float hi) { unsigned r; asm volatile("v_cvt_pk_bf16_f32 %0, %1, %2" : "=v"(r) : "v"(lo), "v"(hi)); return r; }

template <class Epi, class Sched, bool ALIGN_EPI>
__device__ __forceinline__ void gemm_phase(LAS unsigned char* lds, const Gemm g, const Sched& S, const Epi& E) {
    int tid_ = threadIdx.x; asm volatile("" : "+v"(tid_));
    const int tid = tid_, wid = __builtin_amdgcn_readfirstlane(tid >> 6), lane = tid & 63, wr = wid >> 2, wc = wid & 3, fr = lane & 15, fq = lane >> 4;
    const int K = g.K, nt = K / BK;
    unsigned voffB[2];
#pragma unroll
    for (int i = 0; i < 2; ++i) { int R, C; stage_rc(tid * 16 + i * 8192, R, C); const int Rb = Epi::PERM ? ((R & ~31) + perm32(R & 31)) : R;
        voffB[i] = (unsigned)(Rb * K + C) * 2u; }
    constexpr unsigned kstep = BK * 2;
    const unsigned hstep = (unsigned)HALF * K * 2;
    const unsigned tstep = 2 * hstep;
    const unsigned ldsw = (unsigned)wid * 1024u;
    const int aoff = lds_byte(wr * 64 + fr, fq * 8), boff = lds_byte(wc * 32 + fr, fq * 8);
#define PG8_SA(b, h) (((b) * 2 + (h)) * HTB)
#define PG8_SB(b, h) ((4 + (b) * 2 + (h)) * HTB)
#define PG8_STAGE(bufoff, gbase, voff) do { _Pragma("unroll") for (int _i = 0; _i < 2; ++_i) \
        __builtin_amdgcn_global_load_lds((const unsigned*)((const char*)(gbase) + (voff)[_i]), (LAS unsigned*)(lds + (bufoff) + ldsw + _i * 8192), 16, 0, 0); } while (0)
#define PG8_LDA(dst, b, h) do { _Pragma("unroll") for (int m = 0; m < 4; ++m) _Pragma("unroll") for (int k = 0; k < 2; ++k) dst[m][k] = *(const LAS bf16x8*)(lds + PG8_SA(b, h) + aoff + m * 2048 + k * 1024); } while (0)
#define PG8_LDB(dst, b, h) do { _Pragma("unroll") for (int n = 0; n < 2; ++n) _Pragma("unroll") for (int k = 0; k < 2; ++k) dst[n][k] = *(const LAS bf16x8*)(lds + PG8_SB(b, h) + boff + n * 2048 + k * 1024); } while (0)
#define PG8_MMA(ai, bj, At, Bt) do { __builtin_amdgcn_s_setprio(1); _Pragma("unroll") for (int m = 0; m < 4; ++m) _Pragma("unroll") for (int n = 0; n < 2; ++n) _Pragma("unroll") for (int k = 0; k < 2; ++k) \
        acc[ai][bj][m][n] = __builtin_amdgcn_mfma_f32_16x16x32_bf16(Bt[n][k], At[m][k], acc[ai][bj][m][n], 0, 0, 0); __builtin_amdgcn_s_setprio(0); } while (0)
#define PG8_WAIT_V(n) asm volatile("s_waitcnt vmcnt(" #n ")" ::: "memory")
#define PG8_WAIT_L(n) asm volatile("s_waitcnt lgkmcnt(" #n ")" ::: "memory")
#define PG8_BAR __builtin_amdgcn_s_barrier()
#define PG8_SCHED __builtin_amdgcn_sched_barrier(0)
    Unit cur, nxt; int ui = 0;
    if (!S.next(0, cur)) return;
    f32x4 acc[2][2][4][2];
#pragma unroll
    for (int a = 0; a < 2; ++a)
#pragma unroll
        for (int b = 0; b < 2; ++b)
#pragma unroll
            for (int m = 0; m < 4; ++m)
#pragma unroll
                for (int n = 0; n < 2; ++n) acc[a][b][m][n] = (f32x4){0.f, 0.f, 0.f, 0.f};
    bf16x8 At[4][2], B0[2][2], B1[2][2];
    unsigned aC[2][2], aN[2][2];
    S.a_off(cur, tid, K, aC);
    const char* const Ab = (const char*)g.A;
    const char* cB = (const char*)g.Bt + (size_t)cur.pn * tstep;
    PG8_STAGE(PG8_SB(0, 0), cB, voffB); PG8_STAGE(PG8_SB(0, 1), cB + hstep, voffB); PG8_STAGE(PG8_SA(0, 0), Ab, aC[0]); PG8_STAGE(PG8_SA(0, 1), Ab, aC[1]);
    if (wr == 1) PG8_BAR;
    PG8_WAIT_V(2); PG8_BAR;
    PG8_STAGE(PG8_SB(1, 0), cB + kstep, voffB); PG8_STAGE(PG8_SA(1, 0), Ab + kstep, aC[0]); PG8_STAGE(PG8_SB(1, 1), cB + hstep + kstep, voffB);
    PG8_WAIT_V(6); PG8_BAR;
    for (;;) {
        const bool has_next = S.next(ui + 1, nxt);
        const char* nB = has_next ? (const char*)g.Bt + (size_t)nxt.pn * tstep : cB;
        if (has_next) S.a_off(nxt, tid, K, aN);
        else {
#pragma unroll
            for (int h = 0; h < 2; ++h)
#pragma unroll
                for (int i = 0; i < 2; ++i) aN[h][i] = aC[h][i]; }
        for (int t = 0; t < nt; t += 2) {
            const bool last = (t == nt - 2);
            const char* a1 = Ab + (size_t)(t + 1) * kstep;
            const char* a2 = last ? Ab : Ab + (size_t)(t + 2) * kstep; const char* b2 = last ? nB : cB + (size_t)(t + 2) * kstep;
            const char* a3 = a2 + kstep; const char* b3 = b2 + kstep;
            PG8_LDB(B0, 0, 0); PG8_LDB(B1, 0, 1); PG8_SCHED; PG8_LDA(At, 0, 0); PG8_STAGE(PG8_SA(1, 1), a1, aC[1]);
            if (last) {
#pragma unroll
                for (int h = 0; h < 2; ++h)
#pragma unroll
                    for (int i = 0; i < 2; ++i) aC[h][i] = aN[h][i]; }
            PG8_WAIT_V(8); PG8_WAIT_L(0); PG8_BAR; PG8_MMA(0, 0, At, B0); PG8_MMA(0, 1, At, B1); PG8_BAR; PG8_SCHED;
            PG8_LDA(At, 0, 1); PG8_STAGE(PG8_SB(0, 0), b2, voffB); PG8_STAGE(PG8_SB(0, 1), b2 + hstep, voffB); PG8_STAGE(PG8_SA(0, 0), a2, aC[0]);
            PG8_WAIT_V(8); PG8_WAIT_L(0); PG8_BAR; PG8_MMA(1, 0, At, B0); PG8_MMA(1, 1, At, B1); PG8_BAR; PG8_SCHED;
            PG8_LDB(B0, 1, 0); PG8_LDB(B1, 1, 1); PG8_SCHED; PG8_LDA(At, 1, 0); PG8_STAGE(PG8_SA(0, 1), a2, aC[1]);
            PG8_WAIT_V(8); PG8_WAIT_L(0); PG8_BAR; PG8_MMA(0, 0, At, B0); PG8_MMA(0, 1, At, B1); PG8_BAR; PG8_SCHED;
            PG8_LDA(At, 1, 1); PG8_STAGE(PG8_SB(1, 0), b3, voffB); PG8_STAGE(PG8_SB(1, 1), b3 + hstep, voffB); PG8_STAGE(PG8_SA(1, 0), a3, aC[0]);
            PG8_WAIT_V(8); PG8_WAIT_L(0); PG8_BAR; PG8_MMA(1, 0, At, B0); PG8_MMA(1, 1, At, B1); PG8_BAR; PG8_SCHED;
        }
        if constexpr (ALIGN_EPI) { if (wr == 0) PG8_BAR; }
        E(acc, cur, wr, wc, fr, fq);
        if (!has_next) break;
#pragma unroll
        for (int a = 0; a < 2; ++a)
#pragma unroll
            for (int b = 0; b < 2; ++b)
#pragma unroll
                for (int m = 0; m < 4; ++m)
#pragma unroll
                    for (int n = 0; n < 2; ++n) acc[a][b][m][n] = (f32x4){0.f, 0.f, 0.f, 0.f};
        cur = nxt; cB = nB; ++ui;
        if constexpr (ALIGN_EPI) { if (wr == 1) PG8_BAR; }
    }
    PG8_WAIT_V(0);
    if constexpr (!ALIGN_EPI) { if (wr == 0) PG8_BAR; }
    PG8_BAR;
#undef PG8_SA
#undef PG8_SB
#undef PG8_STAGE
#undef PG8_LDA
#undef PG8_LDB
#undef PG8_MMA
#undef PG8_WAIT_V
#undef PG8_WAIT_L
#undef PG8_BAR
#undef PG8_SCHED
}
}
namespace pg8 {
typedef const f32x4 (&AccRef)[2][2][4][2];

struct EpiInProj {
    static constexpr bool PERM = true;
    unsigned char* ws;
    __device__ __forceinline__ void operator()(AccRef acc, const Unit& u, int wr, int wc, int fr, int fq) const {
        const int pn = u.on, row0 = u.om * BM + wr * 64 + fr, cw = wc * 32 + 8 * fq;
        if (pn >= 4 && pn < 12) {
#pragma unroll
            for (int ai = 0; ai < 2; ++ai)
#pragma unroll
                for (int m = 0; m < 4; ++m) { const f32x4 v0 = acc[ai][0][m][0] * acc[ai][1][m][0], v1 = acc[ai][0][m][1] * acc[ai][1][m][1];
                    u32x4 w; w.x = cvt_pk_bf16(v0[0], v0[1]); w.y = cvt_pk_bf16(v0[2], v0[3]); w.z = cvt_pk_bf16(v1[0], v1[1]); w.w = cvt_pk_bf16(v1[2], v1[3]);
                    *(u32x4*)((bf16_t*)(ws + WS_U) + (size_t)(row0 + ai * HALF + m * 16) * D + (pn - 4) * 128 + cw) = w; }
            return;
        }
        size_t doff; int ldc = D, cb, mode = 0;
        if (pn < 4) { doff = WS_BG; cb = pn * 256; }
        else if (pn < 16) { doff = WS_Q; cb = (pn - 12) * 256; mode = 1; }
        else if (pn == 16) { doff = WS_K; cb = 0; ldc = 256; }
        else if (pn == 17) { doff = WS_V; cb = 0; ldc = 256; }
        else if (pn < 22) { doff = WS_GC; cb = (pn - 18) * 256; mode = 2; }
        else { doff = WS_GA; cb = (pn - 22) * 256; mode = 2; }
        bf16_t* dst = (bf16_t*)(ws + doff);
#pragma unroll
        for (int ai = 0; ai < 2; ++ai)
#pragma unroll
            for (int m = 0; m < 4; ++m) { bf16_t* rowp = dst + (size_t)(row0 + ai * HALF + m * 16) * ldc + cb + cw;
#pragma unroll
                for (int bj = 0; bj < 2; ++bj) { f32x4 v0 = acc[ai][bj][m][0], v1 = acc[ai][bj][m][1];
                    if (mode == 1) { v0 = v0 * QSCALE; v1 = v1 * QSCALE; }
                    if (mode == 2) {
#pragma unroll
                        for (int j = 0; j < 4; ++j) { v0[j] = fast_sigmoid(v0[j]); v1[j] = fast_sigmoid(v1[j]); } }
                    u32x4 w; w.x = cvt_pk_bf16(v0[0], v0[1]); w.y = cvt_pk_bf16(v0[2], v0[3]); w.z = cvt_pk_bf16(v1[0], v1[1]); w.w = cvt_pk_bf16(v1[2], v1[3]);
                    *(u32x4*)(rowp + bj * HALF) = w; } }
    }
};

struct EpiDual {
    static constexpr bool PERM = true;
    unsigned char* ws;
    __device__ __forceinline__ void operator()(AccRef acc, const Unit& u, int wr, int wc, int fr, int fq) const {
        const int row0 = u.om * BM + wr * 64 + fr, col0 = u.on * BM + wc * 32 + 8 * fq;
        const bf16_t* G = (const bf16_t*)(ws + (u.e == 0 ? WS_GC : WS_GA)); float* T1 = (float*)(ws + WS_T1); bf16_t* MG = (bf16_t*)(ws + WS_MG);
#pragma unroll
        for (int ai = 0; ai < 2; ++ai)
#pragma unroll
            for (int m = 0; m < 4; ++m) { const size_t ro = (size_t)(row0 + ai * HALF + m * 16) * D + col0;
#pragma unroll
                for (int bj = 0; bj < 2; ++bj) { const size_t o = ro + bj * HALF;
                    const u32x4 gw = *(const u32x4*)(G + o);
                    f32x4 g0 = {bflo(gw.x), bfhi(gw.x), bflo(gw.y), bfhi(gw.y)}, g1 = {bflo(gw.z), bfhi(gw.z), bflo(gw.w), bfhi(gw.w)};
                    f32x4 v0 = g0 * acc[ai][bj][m][0], v1 = g1 * acc[ai][bj][m][1];
                    if (u.e == 0) { *(f32x4*)(T1 + o) = v0; *(f32x4*)(T1 + o + 4) = v1; }
                    else { v0 = v0 + *(const f32x4*)(T1 + o); v1 = v1 + *(const f32x4*)(T1 + o + 4);
                        u32x4 w; w.x = cvt_pk_bf16(v0[0], v0[1]); w.y = cvt_pk_bf16(v0[2], v0[3]); w.z = cvt_pk_bf16(v1[0], v1[1]); w.w = cvt_pk_bf16(v1[2], v1[3]);
                        *(u32x4*)(MG + o) = w; } } }
    }
};

struct EpiResid {
    static constexpr bool PERM = false;
    const float* X; float* C;
    __device__ __forceinline__ void operator()(AccRef acc, const Unit& u, int wr, int wc, int fr, int fq) const {
        const int row0 = u.om * BM + wr * 64 + fr, col0 = u.on * BM + wc * 32 + 4 * fq;
#pragma unroll
        for (int ai = 0; ai < 2; ++ai)
#pragma unroll
            for (int m = 0; m < 4; ++m) { const size_t ro = (size_t)(row0 + ai * HALF + m * 16) * D + col0;
#pragma unroll
                for (int bj = 0; bj < 2; ++bj)
#pragma unroll
                    for (int n = 0; n < 2; ++n) { const size_t o = ro + bj * HALF + n * 16; *(f32x4*)(C + o) = *(const f32x4*)(X + o) * DN_ALPHA + acc[ai][bj][m][n]; } }
    }
};

struct EpiF32 {
    static constexpr bool PERM = false;
    float* C;
    __device__ __forceinline__ void operator()(AccRef acc, const Unit& u, int wr, int wc, int fr, int fq) const {
        const int row0 = u.om * BM + wr * 64 + fr, col0 = u.on * BM + wc * 32 + 4 * fq;
#pragma unroll
        for (int ai = 0; ai < 2; ++ai)
#pragma unroll
            for (int m = 0; m < 4; ++m) { const size_t ro = (size_t)(row0 + ai * HALF + m * 16) * D + col0;
#pragma unroll
                for (int bj = 0; bj < 2; ++bj)
#pragma unroll
                    for (int n = 0; n < 2; ++n) *(f32x4*)(C + ro + bj * HALF + n * 16) = acc[ai][bj][m][n]; }
    }
};
struct EpiPle {
    static constexpr bool PERM = false;
    const float* P2; bf16_t* PLE;
    __device__ __forceinline__ void operator()(AccRef acc, const Unit& u, int wr, int wc, int fr, int fq) const {
        const int row0 = u.om * BM + wr * 64 + fr, col0 = u.on * BM + wc * 32 + 4 * fq;
#pragma unroll
        for (int ai = 0; ai < 2; ++ai)
#pragma unroll
            for (int m = 0; m < 4; ++m) { const size_t ro = (size_t)(row0 + ai * HALF + m * 16) * D + col0;
#pragma unroll
                for (int bj = 0; bj < 2; ++bj)
#pragma unroll
                    for (int n = 0; n < 2; ++n) { const size_t o = ro + bj * HALF + n * 16; const f32x4 p2 = *(const f32x4*)(P2 + o); const f32x4 a = acc[ai][bj][m][n];
                        u32x2 w; w.x = cvt_pk_bf16(fast_sigmoid(a[0]) * p2[0], fast_sigmoid(a[1]) * p2[1]); w.y = cvt_pk_bf16(fast_sigmoid(a[2]) * p2[2], fast_sigmoid(a[3]) * p2[3]);
                        *(u32x2*)(PLE + o) = w; } }
    }
};

struct EpiSwiglu {
    static constexpr bool PERM = true;
    bf16_t* H; const float* b_gu;
    __device__ __forceinline__ void operator()(AccRef acc, const Unit& u, int wr, int wc, int fr, int fq) const {
        const int row0 = u.om * BM + wr * 64 + fr, cw = wc * 32 + 8 * fq, col0 = u.on * 128 + cw;
        const float* bg = b_gu + (size_t)u.e * 2048 + col0;
        const f32x4 bg0 = *(const f32x4*)(bg), bg1 = *(const f32x4*)(bg + 4), bu0 = *(const f32x4*)(bg + 1024), bu1 = *(const f32x4*)(bg + 1028);
#pragma unroll
        for (int ai = 0; ai < 2; ++ai)
#pragma unroll
            for (int m = 0; m < 4; ++m) { f32x4 hv[2];
#pragma unroll
                for (int n = 0; n < 2; ++n) { const f32x4 gt = acc[ai][0][m][n] + (n == 0 ? bg0 : bg1), up = acc[ai][1][m][n] + (n == 0 ? bu0 : bu1);
#pragma unroll
                    for (int j = 0; j < 4; ++j) { const float gv = fminf(gt[j], 7.0f), uv = fminf(fmaxf(up[j], -7.0f), 7.0f); hv[n][j] = (uv + 1.0f) * gv * fast_sigmoid(1.702f * gv); } }
                u32x4 w; w.x = cvt_pk_bf16(hv[0][0], hv[0][1]); w.y = cvt_pk_bf16(hv[0][2], hv[0][3]); w.z = cvt_pk_bf16(hv[1][0], hv[1][1]); w.w = cvt_pk_bf16(hv[1][2], hv[1][3]);
                *(u32x4*)(H + (size_t)(row0 + ai * HALF + m * 16) * D + col0) = w; }
    }
};
struct EpiDown {
    static constexpr bool PERM = true;
    bf16_t* Y; const float* list_w; const LAS int* cntL;
    __device__ __forceinline__ void operator()(AccRef acc, const Unit& u, int wr, int wc, int fr, int fq) const {
        const int trow0 = wr * 64 + fr, col0 = u.on * BM + wc * 32 + 8 * fq;
        const int cnt = cntL[u.e], li0 = u.mt * BM + trow0;
        const float* lw = list_w + (size_t)u.e * LISTCAP + li0;
        bf16_t* yp = Y + (size_t)(u.om * BM + trow0) * D + col0;
#pragma unroll
        for (int ai = 0; ai < 2; ++ai)
#pragma unroll
            for (int m = 0; m < 4; ++m) { const int dr = ai * HALF + m * 16;
                const float w = (li0 + dr) < cnt ? lw[dr] : 0.f;
#pragma unroll
                for (int bj = 0; bj < 2; ++bj) { const f32x4 v0 = acc[ai][bj][m][0] * w, v1 = acc[ai][bj][m][1] * w;
                    u32x4 o; o.x = cvt_pk_bf16(v0[0], v0[1]); o.y = cvt_pk_bf16(v0[2], v0[3]); o.z = cvt_pk_bf16(v1[0], v1[1]); o.w = cvt_pk_bf16(v1[2], v1[3]);
                    *(u32x4*)(yp + (size_t)dr * D + bj * HALF) = o; }
                if (m & 1) asm volatile("" ::: "memory"); }
    }
};

struct DualOrder {
    StaticOrder so;
    __device__ __forceinline__ bool next(int i, Unit& u) const {
        int pm, pn; if (!so.tile(i >> 1, pm, pn)) return false;
        const int e = i & 1; u.pm = e * (M / BM) + pm; u.pn = e * 4 + pn; u.om = pm; u.on = pn; u.e = e; u.mt = 0; return true;
    }
    __device__ __forceinline__ void a_off(const Unit& u, int tid, int K, unsigned (&o)[2][2]) const { plain_a_off(u.pm, tid, K, o); }
};
struct MoeOrder {
    const LAS int* cntL; const LAS int* tsL; const int* list_tok; int NT, G, c, gather;
    __device__ __forceinline__ bool next(int i, Unit& u) const {
        const int total = __builtin_amdgcn_readfirstlane(tsL[NE]) * NT;
        const long L = (long)i * G + c; if (L >= total) return false;
        const int wgid = xcd_remap((int)L, total);
        int e = 0;
        for (int k = 1; k < NE; ++k) e += (wgid >= __builtin_amdgcn_readfirstlane(tsL[k]) * NT) ? 1 : 0;
        const int ts = __builtin_amdgcn_readfirstlane(tsL[e]), ntl = __builtin_amdgcn_readfirstlane(tsL[e + 1]) - ts, r = wgid - ts * NT;
        const int nt = r / ntl, mt = r - nt * ntl;
        u.pm = ts + mt; u.pn = e * NT + nt; u.om = ts + mt; u.on = nt; u.e = e; u.mt = mt; return true;
    }
    __device__ __forceinline__ void a_off(const Unit& u, int tid, int K, unsigned (&o)[2][2]) const {
        if (!gather) { plain_a_off(u.pm, tid, K, o); return; }
        const int cnt = cntL[u.e];
#pragma unroll
        for (int i = 0; i < 2; ++i) { int R, C; stage_rc(tid * 16 + i * 8192, R, C);
#pragma unroll
            for (int h = 0; h < 2; ++h) { const int li = u.mt * BM + h * HALF + R; const int tok = li < cnt ? list_tok[(size_t)u.e * LISTCAP + li] : 0;
                o[h][i] = (unsigned)(tok * K + C) * 2u; } }
    }
};
}
__device__ __forceinline__ int dst_row(int n, int map) {
    if (map == 1) { if (n >= 1024 && n < 3072) { const int hsel = n >= 2048, c = n - 1024 - hsel * 1024; return 1024 + (c >> 7) * 256 + hsel * 128 + (c & 127); } return n; }
    if (map == 2) { const int hsel = n >= 1024, c = n - hsel * 1024; return (c >> 7) * 256 + hsel * 128 + (c & 127); }
    return n;
}
__device__ __forceinline__ void p0_item(const float* W, int K, int N, bf16_t* WT, int map, LAS float* scr, int item, int lane) {
    const int nblk = N / 64, kb = item / nblk, nb = item - kb * nblk, k0 = 64 * kb, n0 = 64 * nb;
    const int lr = lane >> 4, lc = (lane & 15) * 4;
    f32x4 v[16];
#pragma unroll
    for (int i = 0; i < 16; ++i) v[i] = *(const f32x4*)(W + (size_t)(k0 + 4 * i + lr) * N + n0 + lc);
#pragma unroll
    for (int i = 0; i < 16; ++i) { LAS float* s = scr + (4 * i + lr) * 65 + lc; s[0] = v[i][0]; s[1] = v[i][1]; s[2] = v[i][2]; s[3] = v[i][3]; }
    asm volatile("s_waitcnt lgkmcnt(0)" ::: "memory");
    const int c = lane & 7;
    const int drow0 = dst_row(n0, map);
#pragma unroll
    for (int j = 0; j < 8; ++j) { const int n = (lane >> 3) + 8 * j; const LAS float* s = scr + (8 * c) * 65 + n;
        u32x4 o; o.x = pk2(s[0 * 65], s[1 * 65]); o.y = pk2(s[2 * 65], s[3 * 65]); o.z = pk2(s[4 * 65], s[5 * 65]); o.w = pk2(s[6 * 65], s[7 * 65]);
        *(u32x4*)(WT + (size_t)(drow0 + n) * K + k0 + 8 * c) = o; }
    asm volatile("s_waitcnt lgkmcnt(0)" ::: "memory");
}
struct P0Args { const float *x, *p, *w_in, *w_brc, *w_bra, *w_out, *w_pg, *w_pp, *w_gu, *w_dn; unsigned char* ws; };
__device__ __forceinline__ void p0_phase(const P0Args& a, LAS unsigned char* lds, int vcu, int G) {
    int tid_ = threadIdx.x; asm volatile("" : "+v"(tid_));
    const int tid = tid_, lane = tid & 63, wave = __builtin_amdgcn_readfirstlane(tid >> 6);
    LAS float* scr = (LAS float*)(lds + wave * 16640);
    const int gw = vcu * NWAVES + wave, NGW = G * NWAVES;
    constexpr int I_IN = 16 * (NIN / 64), I_SQ = 16 * 16, I_PP = 4 * 16, I_GU = 16 * 32, I_DN = 16 * 16;
    constexpr int NITEMS = I_IN + 4 * I_SQ + I_PP + NE * I_GU + NE * I_DN;
    for (int it = gw; it < NITEMS; it += NGW) {
        int r = it;
        if (r < I_IN) { p0_item(a.w_in, D, NIN, (bf16_t*)(a.ws + WS_WIN), 1, scr, r, lane); continue; } r -= I_IN;
        if (r < I_SQ) { p0_item(a.w_brc, D, D, (bf16_t*)(a.ws + WS_WBR), 0, scr, r, lane); continue; } r -= I_SQ;
        if (r < I_SQ) { p0_item(a.w_bra, D, D, (bf16_t*)(a.ws + WS_WBR) + (size_t)D * D, 0, scr, r, lane); continue; } r -= I_SQ;
        if (r < I_SQ) { p0_item(a.w_out, D, D, (bf16_t*)(a.ws + WS_WOUT), 0, scr, r, lane); continue; } r -= I_SQ;
        if (r < I_SQ) { p0_item(a.w_pg, D, D, (bf16_t*)(a.ws + WS_WPG), 0, scr, r, lane); continue; } r -= I_SQ;
        if (r < I_PP) { p0_item(a.w_pp, DPLE, D, (bf16_t*)(a.ws + WS_WPP), 0, scr, r, lane); continue; } r -= I_PP;
        if (r < NE * I_GU) { const int e = r / I_GU; p0_item(a.w_gu + (size_t)e * D * 2048, D, 2048, (bf16_t*)(a.ws + WS_WGU) + (size_t)e * 2048 * D, 2, scr, r - e * I_GU, lane); continue; } r -= NE * I_GU;
        { const int e = r / I_DN; p0_item(a.w_dn + (size_t)e * D * D, D, D, (bf16_t*)(a.ws + WS_WDN) + (size_t)e * D * D, 0, scr, r - e * I_DN, lane); }
    }
    const int gt = vcu * NTHREADS + tid, NGT = G * NTHREADS;
    for (int i = gt; i < M * D / 8; i += NGT) { const f32x4 v0 = *(const f32x4*)(a.x + (size_t)i * 8), v1 = *(const f32x4*)(a.x + (size_t)i * 8 + 4);
        u32x4 o; o.x = pk2(v0[0], v0[1]); o.y = pk2(v0[2], v0[3]); o.z = pk2(v1[0], v1[1]); o.w = pk2(v1[2], v1[3]); *(u32x4*)((bf16_t*)(a.ws + WS_XB) + (size_t)i * 8) = o; }
    for (int i = gt; i < M * DPLE / 8; i += NGT) { const f32x4 v0 = *(const f32x4*)(a.p + (size_t)i * 8), v1 = *(const f32x4*)(a.p + (size_t)i * 8 + 4);
        u32x4 o; o.x = pk2(v0[0], v0[1]); o.y = pk2(v0[2], v0[3]); o.z = pk2(v1[0], v1[1]); o.w = pk2(v1[2], v1[3]); *(u32x4*)((bf16_t*)(a.ws + WS_PB) + (size_t)i * 8) = o; }
}

__device__ __forceinline__ int crow(int r, int hi) { return (r & 3) + 8 * (r >> 2) + 4 * hi; }
typedef short v4i16_t __attribute__((ext_vector_type(4)));
__device__ __forceinline__ s16x4 vtr(const LAS unsigned char* p) { return __builtin_bit_cast(s16x4, __builtin_amdgcn_ds_read_tr16_b64_v4i16((LAS v4i16_t*)p)); }
__device__ __forceinline__ void attn_unit(LAS unsigned char* lds, const bf16_t* Q, const bf16_t* Kg, const bf16_t* Vg, const float* sinks, bf16_t* O, int b, int kvh, int nb) {
    int tid_ = threadIdx.x; asm volatile("" : "+v"(tid_));
    const int tid = tid_, lane = tid & 63, r32 = lane & 31, hi = lane >> 5; const int wid = __builtin_amdgcn_readfirstlane(tid >> 6);
    const int t0 = b * SEQ + nb * 128;
#pragma unroll
    for (int it = 0; it < 4; ++it) { const int idx = tid + it * NTHREADS, key = idx >> 3, c = idx & 7;
        int row = t0 - 128 + key; if (row < b * SEQ) row = b * SEQ;
        const u32x4 kv = *(const u32x4*)(Kg + (size_t)row * 256 + kvh * HD + c * 8);
        const u32x4 vv = *(const u32x4*)(Vg + (size_t)row * 256 + kvh * HD + c * 8);
        *(LAS u32x4*)(lds + c * 4096 + key * 16) = kv;
        *(LAS u32x4*)(lds + 32768 + (c >> 2) * 16384 + (key >> 4) * 1024 + (key & 15) * 64 + (c & 3) * 16) = vv; }
    __syncthreads();
    const int g = wid >> 1, half = wid & 1, h = kvh * 4 + g;
    const float sink2 = sinks[h] * LOG2E;
    const LAS unsigned char* vbase = lds + 32768 + ((lane >> 4) & 1) * 32 + (lane & 3) * 8 + (4 * hi + ((lane & 15) >> 2)) * 64;
#pragma unroll 1
    for (int qq = 0; qq < 2; ++qq) {
        const int qt = half * 2 + qq;
        const bf16_t* qp = Q + (size_t)(t0 + 32 * qt + r32) * D + h * HD + hi * 8;
        bf16x8 qr[4];
#pragma unroll
        for (int d0 = 0; d0 < 4; ++d0) qr[d0] = *(const bf16x8*)(qp + d0 * 16);
        f32x16 s[5];
#pragma unroll
        for (int j = 0; j < 5; ++j) { const LAS unsigned char* kp = lds + hi * 4096 + ((qt + j) * 32 + r32) * 16; f32x16 a = {};
#pragma unroll
            for (int d0 = 0; d0 < 4; ++d0) a = __builtin_amdgcn_mfma_f32_32x32x16_bf16(*(const LAS bf16x8*)(kp + d0 * 8192), qr[d0], a, 0, 0, 0);
            s[j] = a; }
#pragma unroll
        for (int r = 0; r < 16; ++r) { const int cr = crow(r, hi); if (cr <= r32) s[0][r] = -INFINITY; if (cr > r32) s[4][r] = -INFINITY; }
        if (nb == 0) {
#pragma unroll
            for (int j = 0; j < 4; ++j) if (qt + j < 4) {
#pragma unroll
                for (int r = 0; r < 16; ++r) s[j][r] = -INFINITY; } }
        float mx = -INFINITY;
#pragma unroll
        for (int j = 0; j < 5; ++j)
#pragma unroll
            for (int r = 0; r < 16; ++r) mx = fmaxf(mx, s[j][r]);
        mx = fmaxf(mx, __shfl_xor(mx, 32)); mx = fmaxf(mx, sink2);
        float ls = 0.f;
#pragma unroll
        for (int j = 0; j < 5; ++j)
#pragma unroll
            for (int r = 0; r < 16; ++r) { s[j][r] = __builtin_amdgcn_exp2f(s[j][r] - mx); ls += s[j][r]; }
        ls += __shfl_xor(ls, 32); ls += __builtin_amdgcn_exp2f(sink2 - mx);
        const float linv = 1.0f / ls;
        f32x16 o[2]; o[0] = f32x16{}; o[1] = f32x16{};
#pragma unroll
        for (int j = 0; j < 5; ++j)
#pragma unroll
            for (int ks = 0; ks < 2; ++ks) {
                u32x4 pw; pw.x = pk2(s[j][8 * ks + 0], s[j][8 * ks + 1]); pw.y = pk2(s[j][8 * ks + 2], s[j][8 * ks + 3]); pw.z = pk2(s[j][8 * ks + 4], s[j][8 * ks + 5]); pw.w = pk2(s[j][8 * ks + 6], s[j][8 * ks + 7]);
                const bf16x8 pa = __builtin_bit_cast(bf16x8, pw);
                const LAS unsigned char* vp = vbase + ((qt + j) * 2 + ks) * 1024;
#pragma unroll
                for (int dh = 0; dh < 2; ++dh) { const s16x4 lo = vtr(vp + dh * 16384), hi4 = vtr(vp + dh * 16384 + 512);
                    const bf16x8 vf = {lo[0], lo[1], lo[2], lo[3], hi4[0], hi4[1], hi4[2], hi4[3]};
                    o[dh] = __builtin_amdgcn_mfma_f32_32x32x16_bf16(pa, vf, o[dh], 0, 0, 0); } }
        bf16_t* op = O + (size_t)(t0 + 32 * qt) * D + h * HD + r32;
#pragma unroll
        for (int r = 0; r < 16; ++r) { const int q = crow(r, hi); const float sc = __shfl(linv, q);
            op[(size_t)q * D] = (bf16_t)f2bf(o[0][r] * sc); op[(size_t)q * D + 32] = (bf16_t)f2bf(o[1][r] * sc); }
    }
    __syncthreads();
}
__device__ __forceinline__ void conv_phase(const bf16_t* Bg, const bf16_t* U, const float* cw, bf16_t* Z, int vcu, int G) {
    int tid_ = threadIdx.x; asm volatile("" : "+v"(tid_));
    const int gt = vcu * NTHREADS + tid_, NGT = G * NTHREADS;
    for (int i = gt; i < M * (D / 8); i += NGT) {
        const int t = i >> 7, c = (i & 127) * 8, tl = t & (SEQ - 1);
        float y[8];
#pragma unroll
        for (int j = 0; j < 8; ++j) y[j] = 0.f;
#pragma unroll
        for (int k = 0; k < 3; ++k) { const int dt = k - 2; if (tl + dt >= 0) { const u32x4 uw = *(const u32x4*)(U + (size_t)(t + dt) * D + c);
            const f32x4 w0 = *(const f32x4*)(cw + k * D + c), w1 = *(const f32x4*)(cw + k * D + c + 4);
            y[0] += w0[0] * bflo(uw.x); y[1] += w0[1] * bfhi(uw.x); y[2] += w0[2] * bflo(uw.y); y[3] += w0[3] * bfhi(uw.y);
            y[4] += w1[0] * bflo(uw.z); y[5] += w1[1] * bfhi(uw.z); y[6] += w1[2] * bflo(uw.w); y[7] += w1[3] * bfhi(uw.w); } }
        const u32x4 bw = *(const u32x4*)(Bg + (size_t)t * D + c);
        u32x4 o; o.x = pk2(y[0] * bflo(bw.x), y[1] * bfhi(bw.x)); o.y = pk2(y[2] * bflo(bw.y), y[3] * bfhi(bw.y)); o.z = pk2(y[4] * bflo(bw.z), y[5] * bfhi(bw.z)); o.w = pk2(y[6] * bflo(bw.w), y[7] * bfhi(bw.w));
        *(u32x4*)(Z + (size_t)t * D + c) = o;
    }
}
constexpr int WR_STRIDE = 1028;
struct RouteArgs { float* X1F; bf16_t* X1B; const float *g1, *b1, *w_r, *b_r; int* gcnt; int* list_tok; float* list_w; int* tk_e; int* tk_rank; float* tk_w; };
__device__ __forceinline__ void route_phase(const RouteArgs& a, LAS unsigned char* lds, int vcu, int G) {
    int tid_ = threadIdx.x; asm volatile("" : "+v"(tid_));
    const int tid = tid_, lane = tid & 63, wave = __builtin_amdgcn_readfirstlane(tid >> 6);
    LAS float* wrt = (LAS float*)lds;
    LAS int* misc = (LAS int*)(lds + MISC_OFF);
    LAS int* lcnt = misc + 96; LAS int* gbase = misc + 128; LAS int* rowe = misc + 160; LAS float* roww = (LAS float*)(misc + 416); LAS int* lrank = misc + 672;
    for (int i = tid; i < D * NE; i += NTHREADS) { const int c = i >> 5, e = i & 31; wrt[e * WR_STRIDE + c] = a.w_r[i]; }
    if (tid < NE) lcnt[tid] = 0;
    __syncthreads();
    const int rows_per_wg = M / G;
    for (int rr = wave; rr < rows_per_wg; rr += NWAVES) {
        const int t = vcu * rows_per_wg + rr;
        f32x4 v[4]; float s = 0.f;
#pragma unroll
        for (int j = 0; j < 4; ++j) { v[j] = *(const f32x4*)(a.X1F + (size_t)t * D + 256 * j + 4 * lane); s += (v[j][0] + v[j][1]) + (v[j][2] + v[j][3]); }
        const float mean = wave_sum(s) * (1.0f / D); float q = 0.f;
#pragma unroll
        for (int j = 0; j < 4; ++j) { v[j] = v[j] - mean; q += (v[j][0] * v[j][0] + v[j][1] * v[j][1]) + (v[j][2] * v[j][2] + v[j][3] * v[j][3]); }
        const float rstd = 1.0f / sqrtf(wave_sum(q) * (1.0f / D) + LN_EPS);
#pragma unroll
        for (int j = 0; j < 4; ++j) { const f32x4 gg = *(const f32x4*)(a.g1 + 256 * j + 4 * lane), bb = *(const f32x4*)(a.b1 + 256 * j + 4 * lane);
            v[j] = v[j] * rstd * gg + bb;
            *(f32x4*)(a.X1F + (size_t)t * D + 256 * j + 4 * lane) = v[j];
            u32x2 w; w.x = pk2(v[j][0], v[j][1]); w.y = pk2(v[j][2], v[j][3]); *(u32x2*)(a.X1B + (size_t)t * D + 256 * j + 4 * lane) = w; }
        float pl[32];
#pragma unroll
        for (int e = 0; e < 32; ++e) { float acc = 0.f;
#pragma unroll
            for (int j = 0; j < 4; ++j) { const f32x4 w = *(const LAS f32x4*)(wrt + e * WR_STRIDE + 256 * j + 4 * lane); acc += (v[j][0] * w[0] + v[j][1] * w[1]) + (v[j][2] * w[2] + v[j][3] * w[3]); }
            pl[e] = acc; }
#pragma unroll
        for (int o = 32, n = 16; o >= 2; o >>= 1, n >>= 1) { const bool up = (lane & o) != 0;
#pragma unroll
            for (int i = 0; i < 16; ++i) if (i < n) { const float send = up ? pl[i] : pl[i + n], keep = up ? pl[i + n] : pl[i]; pl[i] = keep + __shfl_xor(send, o); } }
        float logit = pl[0] + __shfl_xor(pl[0], 1);
        const int myexp = lane >> 1;
        logit += a.b_r[myexp];
        int se[4]; float sv[4];
#pragma unroll
        for (int k = 0; k < 4; ++k) { float bv = logit; int bi = myexp;
#pragma unroll
            for (int o = 1; o < 64; o <<= 1) { const float ov = __shfl_xor(bv, o); const int oi = __shfl_xor(bi, o); if (ov > bv || (ov == bv && oi < bi)) { bv = ov; bi = oi; } }
            se[k] = bi; sv[k] = bv; if (myexp == bi) logit = -INFINITY; }
        const float e1 = __expf(sv[1] - sv[0]), e2 = __expf(sv[2] - sv[0]), e3 = __expf(sv[3] - sv[0]);
        const float inv = 1.0f / (1.0f + e1 + e2 + e3);
        if (lane < 4) { const int e = lane == 0 ? se[0] : lane == 1 ? se[1] : lane == 2 ? se[2] : se[3];
            const float w = (lane == 0 ? 1.0f : lane == 1 ? e1 : lane == 2 ? e2 : e3) * inv;
            rowe[rr * 4 + lane] = e; roww[rr * 4 + lane] = w; }
    }
    __syncthreads();
    const int nent = rows_per_wg * 4;
    int my_e = 0, my_lr = 0;
    if (tid < nent) { my_e = rowe[tid]; my_lr = atomicAdd((int*)(lcnt + my_e), 1); }
    __syncthreads();
    if (tid < NE) gbase[tid] = atomicAdd(a.gcnt + tid, lcnt[tid]);
    __syncthreads();
    if (tid < nent) { const int t = vcu * rows_per_wg + (tid >> 2), rank = gbase[my_e] + my_lr;
        a.list_tok[(size_t)my_e * LISTCAP + rank] = t; a.list_w[(size_t)my_e * LISTCAP + rank] = roww[tid];
        a.tk_e[t * 4 + (tid & 3)] = my_e; a.tk_rank[t * 4 + (tid & 3)] = rank; a.tk_w[t * 4 + (tid & 3)] = roww[tid]; }
    __syncthreads();
}
__device__ __forceinline__ void build_tables(const int* gcnt, LAS unsigned char* lds) {
    LAS int* misc = (LAS int*)(lds + MISC_OFF);
    if (threadIdx.x == 0) { int a = 0; for (int e = 0; e < NE; ++e) { const int c = __hip_atomic_load(gcnt + e, __ATOMIC_RELAXED, __HIP_MEMORY_SCOPE_AGENT); misc[e] = c; misc[32 + e] = a; a += (c + 255) >> 8; } misc[32 + NE] = a; }
    __syncthreads();
}
struct FinalArgs { const float* X1F; const bf16_t* PLE; const bf16_t* Y; const int* tk_e; const int* tk_rank; const float* tk_w; const float* b_down; const float *g2, *b2; float* out; };
__device__ __forceinline__ void final_phase(const FinalArgs& a, LAS unsigned char* lds, int vcu, int G) {
    int tid_ = threadIdx.x; asm volatile("" : "+v"(tid_));
    const int tid = tid_, lane = tid & 63, wave = __builtin_amdgcn_readfirstlane(tid >> 6);
    const LAS int* ts = (const LAS int*)(lds + MISC_OFF) + 32;
    const int gw = vcu * NWAVES + wave, NGW = G * NWAVES;
    for (int t = gw; t < M; t += NGW) {
        size_t pos[4]; int ek[4]; float wk[4];
#pragma unroll
        for (int k = 0; k < 4; ++k) { const int e = a.tk_e[t * 4 + k], rk = a.tk_rank[t * 4 + k]; pos[k] = ((size_t)ts[e] * 256 + rk) * D; ek[k] = e * D; wk[k] = a.tk_w[t * 4 + k]; }
        f32x4 v[4]; float s = 0.f;
#pragma unroll
        for (int j = 0; j < 4; ++j) { const int c = 256 * j + 4 * lane;
            f32x4 x = *(const f32x4*)(a.X1F + (size_t)t * D + c) * DN_ALPHA;
            const u32x2 pw = *(const u32x2*)(a.PLE + (size_t)t * D + c);
            x[0] += bflo(pw.x); x[1] += bfhi(pw.x); x[2] += bflo(pw.y); x[3] += bfhi(pw.y);
#pragma unroll
            for (int k = 0; k < 4; ++k) { const u32x2 yw = *(const u32x2*)(a.Y + pos[k] + c); const f32x4 bd = *(const f32x4*)(a.b_down + ek[k] + c);
                x[0] += bflo(yw.x) + wk[k] * bd[0]; x[1] += bfhi(yw.x) + wk[k] * bd[1]; x[2] += bflo(yw.y) + wk[k] * bd[2]; x[3] += bfhi(yw.y) + wk[k] * bd[3]; }
            v[j] = x; s += (x[0] + x[1]) + (x[2] + x[3]); }
        const float mean = wave_sum(s) * (1.0f / D); float q = 0.f;
#pragma unroll
        for (int j = 0; j < 4; ++j) { v[j] = v[j] - mean; q += (v[j][0] * v[j][0] + v[j][1] * v[j][1]) + (v[j][2] * v[j][2] + v[j][3] * v[j][3]); }
        const float rstd = 1.0f / sqrtf(wave_sum(q) * (1.0f / D) + LN_EPS);
#pragma unroll
        for (int j = 0; j < 4; ++j) { const int c = 256 * j + 4 * lane; const f32x4 gg = *(const f32x4*)(a.g2 + c), bb = *(const f32x4*)(a.b2 + c);
            *(f32x4*)(a.out + (size_t)t * D + c) = v[j] * rstd * gg + bb; }
    }
}

#ifndef PHASES
#define PHASES 0xfff
#endif
struct Args { const float* in[20]; float* out; unsigned char* ws; };
__global__ void __launch_bounds__(NTHREADS, 2) mega_fwd(Args args) {
    extern __shared__ __attribute__((aligned(16))) unsigned char lds_raw[];
    LAS unsigned char* lds = (LAS unsigned char*)lds_raw;
    cg::grid_group grid = cg::this_grid();
    const int G = gridDim.x, bx = blockIdx.x;
    const int vcu = (G % 8 == 0) ? (bx % 8) * (G / 8) + bx / 8 : bx;
    unsigned char* ws = args.ws;
    const float* x = args.in[0];
    bf16_t* XB = (bf16_t*)(ws + WS_XB); bf16_t* PB = (bf16_t*)(ws + WS_PB);
    bf16_t* Bg = (bf16_t*)(ws + WS_BG); bf16_t* U = (bf16_t*)(ws + WS_U); bf16_t* Q = (bf16_t*)(ws + WS_Q); bf16_t* Kb = (bf16_t*)(ws + WS_K); bf16_t* Vb = (bf16_t*)(ws + WS_V);
    bf16_t* Gc = (bf16_t*)(ws + WS_GC); bf16_t* Ga = (bf16_t*)(ws + WS_GA); bf16_t* ZO = (bf16_t*)(ws + WS_ZO); float* T1 = (float*)(ws + WS_T1); bf16_t* MG = (bf16_t*)(ws + WS_MG);
    float* X1F = (float*)(ws + WS_X1F); bf16_t* X1B = (bf16_t*)(ws + WS_X1B); float* P2 = (float*)(ws + WS_P2); bf16_t* PLE = (bf16_t*)(ws + WS_PLE);
    bf16_t* H = (bf16_t*)(ws + WS_H); bf16_t* Y = (bf16_t*)(ws + WS_Y);
    int* gcnt = (int*)(ws + WS_CTL); int* tk_e = (int*)(ws + WS_TKE); int* tk_rank = (int*)(ws + WS_TKR); float* tk_w = (float*)(ws + WS_TKW); int* list_tok = (int*)(ws + WS_LTOK); float* list_w = (float*)(ws + WS_LW);
    const LAS int* cntL = (const LAS int*)(lds + MISC_OFF); const LAS int* tsL = cntL + 32;

    if (PHASES & 1) { P0Args a{args.in[0], args.in[1], args.in[2], args.in[4], args.in[5], args.in[7], args.in[17], args.in[16], args.in[12], args.in[14], ws}; p0_phase(a, lds, vcu, G); }
    grid.sync();
    if (PHASES & 2) { pg8::Gemm g{XB, (const bf16_t*)(ws + WS_WIN), D}; pg8::StaticOrder S; S.init(M / 256, NIN / 256, G, bx);
      pg8::EpiInProj E{ws};
      pg8::gemm_phase<pg8::EpiInProj, pg8::StaticOrder, true>(lds, g, S, E); }
    grid.sync();
    if (PHASES & 4) for (int it = vcu; it < BATCH * NKV * (SEQ / 128); it += G) { const int nb = it & 63, kvh = (it >> 6) & 3, b = it >> 8;
        attn_unit(lds, Q, Kb, Vb, args.in[6], ZO + (size_t)M * D, b, kvh, nb); }
    if (PHASES & 8) conv_phase(Bg, U, args.in[3], ZO, vcu, G);
    grid.sync();
    if (PHASES & 16) { pg8::Gemm g{ZO, (const bf16_t*)(ws + WS_WBR), D}; pg8::DualOrder S; S.so.init(M / 256, D / 256, G, bx);
      pg8::EpiDual E{ws};
      pg8::gemm_phase<pg8::EpiDual, pg8::DualOrder, false>(lds, g, S, E); }
    grid.sync();
    if (PHASES & 32) { pg8::Gemm g{MG, (const bf16_t*)(ws + WS_WOUT), D}; pg8::StaticOrder S; S.init(M / 256, D / 256, G, bx);
      pg8::EpiResid E{x, X1F};
      pg8::gemm_phase<pg8::EpiResid, pg8::StaticOrder, false>(lds, g, S, E); }
    grid.sync();
    if (PHASES & 64) { RouteArgs a{X1F, X1B, args.in[8], args.in[9], args.in[10], args.in[11], gcnt, list_tok, list_w, tk_e, tk_rank, tk_w}; route_phase(a, lds, vcu, G); }
    grid.sync();
    build_tables(gcnt, lds);
    if (PHASES & 128) { pg8::Gemm g{X1B, (const bf16_t*)(ws + WS_WGU), D}; pg8::MoeOrder S{cntL, tsL, list_tok, 8, G, bx, 1};
      pg8::EpiSwiglu E{H, args.in[13]};
      pg8::gemm_phase<pg8::EpiSwiglu, pg8::MoeOrder, true>(lds, g, S, E); }
    if (PHASES & 256) { pg8::Gemm g{PB, (const bf16_t*)(ws + WS_WPP), DPLE}; pg8::StaticOrder S; S.init(M / 256, D / 256, G, bx);
      pg8::EpiF32 E{P2};
      pg8::gemm_phase<pg8::EpiF32, pg8::StaticOrder, false>(lds, g, S, E); }
    if (PHASES & 512) { pg8::Gemm g{X1B, (const bf16_t*)(ws + WS_WPG), D}; pg8::StaticOrder S; S.init(M / 256, D / 256, G, bx);
      pg8::EpiPle E{P2, PLE};
      pg8::gemm_phase<pg8::EpiPle, pg8::StaticOrder, false>(lds, g, S, E); }
    grid.sync();
    if (PHASES & 1024) { pg8::Gemm g{H, (const bf16_t*)(ws + WS_WDN), D}; pg8::MoeOrder S{cntL, tsL, list_tok, 4, G, bx, 0};
      pg8::EpiDown E{Y, list_w, cntL};
      pg8::gemm_phase<pg8::EpiDown, pg8::MoeOrder, true>(lds, g, S, E); }
    grid.sync();
    if (PHASES & 2048) { FinalArgs a{X1F, PLE, Y, tk_e, tk_rank, tk_w, args.in[15], args.in[18], args.in[19], args.out}; final_phase(a, lds, vcu, G); }
}

extern "C" void kernel_launch(void* const* d_in, const int* in_sizes, int n_in, void* d_out, int out_size, void* d_ws, size_t ws_size, hipStream_t stream) {
    static int grid = 0;
    if (grid == 0) {
        if (n_in != 20 || out_size != M * D || ws_size < WS_END) { fprintf(stderr, "kernel_launch: unexpected sizes (n_in %d, out %d, ws %zu < %zu)\n", n_in, out_size, ws_size, (size_t)WS_END); grid = -1; return; }
        int dev = 0, cus = 0, per_cu = 0;
        if (hipGetDevice(&dev) != hipSuccess || hipDeviceGetAttribute(&cus, hipDeviceAttributeMultiprocessorCount, dev) != hipSuccess) { grid = -1; return; }
        if (hipFuncSetAttribute((const void*)mega_fwd, hipFuncAttributeMaxDynamicSharedMemorySize, LDS_BYTES) != hipSuccess) { fprintf(stderr, "kernel_launch: hipFuncSetAttribute failed\n"); grid = -1; return; }
        if (hipOccupancyMaxActiveBlocksPerMultiprocessor(&per_cu, (const void*)mega_fwd, NTHREADS, LDS_BYTES) != hipSuccess || per_cu < 1) { fprintf(stderr, "kernel_launch: occupancy query says %d blocks per CU\n", per_cu); grid = -1; return; }
        grid = cus;
        if (grid != 256) fprintf(stderr, "kernel_launch: note: %d CUs (built and tuned for 256)\n", grid);
    }
    if (grid < 0) return;
    if (hipMemsetAsync((char*)d_ws + WS_CTL, 0, 4096, stream) != hipSuccess) return;
    Args a{};
    for (int i = 0; i < 20; ++i) a.in[i] = (const float*)d_in[i];
    a.out = (float*)d_out; a.ws = (unsigned char*)d_ws;
    void* kargs[] = {&a};
    const hipError_t e = hipLaunchCooperativeKernel((const void*)mega_fwd, dim3(grid), dim3(NTHREADS), kargs, LDS_BYTES, stream);
    if (e != hipSuccess) fprintf(stderr, "kernel_launch: cooperative launch failed: %s (grid %d)\n", hipGetErrorString(e), grid);
}
```

```cpp
#include <hip/hip_runtime.h>
#include <hip/hip_cooperative_groups.h>
#include <cstdio>
#include <cstdint>
namespace cg = cooperative_groups;

#define LAS __attribute__((address_space(3)))
typedef unsigned short bf16_t;
typedef short bf16x8 __attribute__((ext_vector_type(8)));
typedef short s16x4 __attribute__((ext_vector_type(4)));
typedef float f32x4 __attribute__((ext_vector_type(4)));
typedef float f32x16 __attribute__((ext_vector_type(16)));
typedef unsigned u32x4 __attribute__((ext_vector_type(4)));
typedef unsigned u32x2 __attribute__((ext_vector_type(2)));

constexpr int BATCH = 2, SEQ = 8192, M = BATCH * SEQ, D = 1024, NIN = 6656, NE = 32, DPLE = 256, NH = 16, HD = 64, NKV = 4;
constexpr float DN_ALPHA = 1.189207115002721f, LN_EPS = 1e-5f, LOG2E = 1.4426950408889634f;
constexpr float QSCALE = 0.125f * LOG2E;
constexpr int LISTCAP = M;
constexpr int MAXTILES = (M * 4) / 256 + NE;
constexpr int NWAVES = 8, NTHREADS = 512;

constexpr size_t MiB = 1u << 20;
constexpr size_t WS_CTL = 0;
constexpr size_t WS_BAR = 16384, CTL_ZERO_BYTES = 65536;
constexpr size_t WS_TKE = 1 * MiB, WS_TKR = 2 * MiB, WS_TKW = 3 * MiB;
constexpr size_t WS_LTOK = 4 * MiB, WS_LW = 6 * MiB;
constexpr size_t WS_WIN = 8 * MiB;
constexpr size_t WS_WBR = 22 * MiB;
constexpr size_t WS_WOUT = 26 * MiB, WS_WPG = 28 * MiB;
constexpr size_t WS_WPP = 30 * MiB;
constexpr size_t WS_WGU = 32 * MiB;
constexpr size_t WS_WDN = 160 * MiB;
constexpr size_t WS_XB = 224 * MiB;
constexpr size_t WS_PB = 256 * MiB;
constexpr size_t WS_X1F = 264 * MiB;
constexpr size_t WS_X1B = 328 * MiB;
constexpr size_t WS_P2 = 360 * MiB;
constexpr size_t WS_PLE = 424 * MiB;
constexpr size_t WS_R = 456 * MiB;
constexpr size_t WS_BG = WS_R, WS_U = WS_R + 32 * MiB, WS_Q = WS_R + 64 * MiB, WS_K = WS_R + 96 * MiB, WS_V = WS_R + 104 * MiB;
constexpr size_t WS_GC = WS_R + 112 * MiB, WS_GA = WS_R + 144 * MiB;
constexpr size_t WS_ZO = WS_R + 176 * MiB;
constexpr size_t WS_T1 = WS_R + 240 * MiB;
constexpr size_t WS_MG = WS_R + 304 * MiB;
constexpr size_t WS_H = WS_R;
constexpr size_t WS_Y = WS_R + 144 * MiB;
constexpr size_t WS_END = WS_R + 336 * MiB;

constexpr int LDS_BYTES = 147456;
constexpr int MISC_OFF = 135168;

__device__ __forceinline__ unsigned f2bf(float f) { unsigned u = __builtin_bit_cast(unsigned, f); return (u + 0x7fffu + ((u >> 16) & 1u)) >> 16; }
__device__ __forceinline__ unsigned pk2(float lo, float hi) { return f2bf(lo) | (f2bf(hi) << 16); }
__device__ __forceinline__ float bflo(unsigned w) { return __builtin_bit_cast(float, w << 16); }
__device__ __forceinline__ float bfhi(unsigned w) { return __builtin_bit_cast(float, w & 0xffff0000u); }
__device__ __forceinline__ float fast_sigmoid(float v) { return __builtin_amdgcn_rcpf(1.0f + __builtin_amdgcn_exp2f(-LOG2E * v)); }
__device__ __forceinline__ float wave_sum(float v) {
#pragma unroll
    for (int o = 1; o < 64; o <<= 1) v += __shfl_xor(v, o);
    return v;
}

#define XB_TMO      128
#define XB_XCNT(j)  (256  + 64 * (j))
#define XB_XSUB(j)  (1280 + 64 * (j))
#define XB_XGEN(j)  (2304 + 64 * (j))
#define XB_TOP      3328
#define XB_TOPGEN   3392
#define XCD_BAR_WORDS 3456
#define XB_SPIN_CAP (1u << 18)

__device__ __forceinline__ unsigned xb_ld(unsigned* p)              { return __hip_atomic_load(p, __ATOMIC_RELAXED, __HIP_MEMORY_SCOPE_AGENT); }
__device__ __forceinline__ unsigned xb_add(unsigned* p, unsigned v) { return __hip_atomic_fetch_add(p, v, __ATOMIC_RELAXED, __HIP_MEMORY_SCOPE_AGENT); }
__device__ __forceinline__ unsigned xb_xcc_id() { return (unsigned)__builtin_amdgcn_s_getreg((3 << 11) | 20) & 0xFu; }
#define XB_SPIN(cond, bar) do { unsigned _sp = 0; while (cond) { __builtin_amdgcn_s_sleep(1); \
    if ((++_sp & 255u) == 0u) { if (xb_ld(&(bar)[XB_TMO])) break; if (_sp > XB_SPIN_CAP) { atomicAdd(&(bar)[XB_TMO], 1u); break; } } } } while (0)

struct XcdBarrier {
    unsigned* bar; unsigned x;
    volatile LAS unsigned* st;
};

__device__ __forceinline__ XcdBarrier xcd_barrier_post(unsigned* bar, volatile LAS unsigned* st) {
    XcdBarrier b; b.bar = bar; b.x = xb_xcc_id(); b.st = st;
    if (threadIdx.x == 0) (void)xb_add(&bar[XB_XCNT(b.x)], 1u);
    return b;
}
__device__ __forceinline__ void xcd_barrier_complete(unsigned* bar, unsigned x, unsigned& nloc, unsigned& nx) {
    const unsigned G = gridDim.x * gridDim.y * gridDim.z;
    unsigned sum, cnt, mine, sp = 0u;
    for (;;) {
        sum = 0u; cnt = 0u; mine = 0u;
#pragma unroll
        for (unsigned j = 0; j < 16; ++j) { const unsigned c = xb_ld(&bar[XB_XCNT(j)]); sum += c; cnt += (c > 0u) ? 1u : 0u; mine = (j == x) ? c : mine; }
        if (sum == G) break;
        __builtin_amdgcn_s_sleep(1);
        if ((++sp & 255u) == 0u) { if (xb_ld(&bar[XB_TMO])) break; if (sp > XB_SPIN_CAP) { atomicAdd(&bar[XB_TMO], 1u); break; } }
    }
    nloc = mine > 0u ? mine : 1u; nx = cnt > 0u ? cnt : 1u;
}

__device__ __forceinline__ void xcd_barrier(const XcdBarrier& b) {
    asm volatile("s_waitcnt vmcnt(0)" ::: "memory");
    __syncthreads();
    if (threadIdx.x == 0) {
        unsigned* bar = b.bar;
        __builtin_amdgcn_s_waitcnt(0);
        unsigned nloc = b.st[0], nx = b.st[1];
        if (nloc == 0u) { xcd_barrier_complete(bar, b.x, nloc, nx); b.st[0] = nloc; b.st[1] = nx; }
        const unsigned old = xb_add(&bar[XB_XSUB(b.x)], 1u);
        const unsigned gen = old / nloc;
        if (old + 1u == (gen + 1u) * nloc) {
            __builtin_amdgcn_fence(__ATOMIC_RELEASE, "agent");
            asm volatile("s_waitcnt vmcnt(0)" ::: "memory");
            const unsigned og = xb_add(&bar[XB_TOP], 1u);
            const unsigned tg = og / nx;
            if (og + 1u == (tg + 1u) * nx) xb_add(&bar[XB_TOPGEN], 1u);
            else XB_SPIN(xb_ld(&bar[XB_TOPGEN]) == tg, bar);
            __builtin_amdgcn_fence(__ATOMIC_ACQUIRE, "agent");
            xb_add(&bar[XB_XGEN(b.x)], 1u);
            asm volatile("s_waitcnt vmcnt(0)" ::: "memory");
        } else {
            XB_SPIN(xb_ld(&bar[XB_XGEN(b.x)]) == gen, bar);
            __builtin_amdgcn_fence(__ATOMIC_ACQUIRE, "agent");
            asm volatile("s_waitcnt vmcnt(0)" ::: "memory");
        }
    }
    __syncthreads();
}

namespace pg8 {
constexpr int BM = 256, BK = 64, HALF = 128, HTB = HALF * BK * 2  , STAGE_BYTES = 8 * HTB, NXCD = 8, WGM = 8;
__host__ __device__ __forceinline__ int lds_byte(int r, int c) { const int st = (r >> 4) * 2 + (c >> 5), rr = r & 15, cc = c & 31, ob = rr * 64 + cc * 2; return st * 1024 + (ob ^ (((ob >> 9) & 1) << 5)); }
__host__ __device__ __forceinline__ void stage_rc(int b, int& R, int& C) { const int st = b / 1024, sb = b % 1024, swz = sb ^ (((sb >> 9) & 1) << 5); R = (st >> 1) * 16 + swz / 64; C = (st & 1) * 32 + (swz % 64) / 2; }
__host__ __device__ __forceinline__ int perm32(int rho) { const int n = rho >> 4, i = rho & 15; return 8 * (i >> 2) + 4 * n + (i & 3); }

struct Unit { int pm, pn, om, on, e, mt; };
struct Gemm { const bf16_t* A; const bf16_t* Bt; int K; };

__device__ __forceinline__ int xcd_remap(int L, int nwg) { const int q = nwg / NXCD, r = nwg % NXCD, xcd = L % NXCD, off = L / NXCD; return (xcd < r ? xcd * (q + 1) : r * (q + 1) + (xcd - r) * q) + off; }

__device__ __forceinline__ void plain_a_off(int pm, int tid, int K, unsigned (&o)[2][2]) {
#pragma unroll
    for (int i = 0; i < 2; ++i) { int R, C; stage_rc(tid * 16 + i * 8192, R, C);
#pragma unroll
        for (int h = 0; h < 2; ++h) o[h][i] = (unsigned)((pm * BM + h * HALF + R) * K + C) * 2u; }
}
struct StaticOrder {
    int nM, nN, nwg, G, c;
    __device__ void init(int nM_, int nN_, int G_, int c_) { nM = nM_; nN = nN_; nwg = nM * nN; G = G_; c = c_; }
    __device__ __forceinline__ bool tile(int i, int& pm, int& pn) const {
        const long L = (long)i * G + c; if (L >= nwg) return false;
        const int wgid = xcd_remap((int)L, nwg);
        const int nig = WGM * nN, gid = wgid / nig, fm = gid * WGM, gsz = (nM - fm) < WGM ? (nM - fm) : WGM;
        pm = fm + ((wgid % nig) % gsz); pn = (wgid % nig) / gsz; return true;
    }
    __device__ __forceinline__ bool next(int i, Unit& u) const { int pm, pn; if (!tile(i, pm, pn)) return false; u.pm = pm; u.pn = pn; u.om = pm; u.on = pn; u.e = 0; u.mt = 0; return true; }
    __device__ __forceinline__ void a_off(const Unit& u, int tid, int K, unsigned (&o)[2][2]) const { plain_a_off(u.pm, tid, K, o); }
};

__device__ __forceinline__ unsigned cvt_pk_bf16(float lo, float hi) { unsigned r; asm volatile("v_cvt_pk_bf16_f32 %0, %1, %2" : "=v"(r) : "v"(lo), "v"(hi)); return r; }

template <class Epi, class Sched, bool ALIGN_EPI>
__device__ __forceinline__ void gemm_phase(LAS unsigned char* lds, const Gemm g, const Sched& S, const Epi& E) {
    int tid_ = threadIdx.x; asm volatile("" : "+v"(tid_));
    const int tid = tid_, wid = __builtin_amdgcn_readfirstlane(tid >> 6), lane = tid & 63, wr = wid >> 2, wc = wid & 3, fr = lane & 15, fq = lane >> 4;
    const int K = g.K, nt = K / BK;
    unsigned voffB[2];
#pragma unroll
    for (int i = 0; i < 2; ++i) { int R, C; stage_rc(tid * 16 + i * 8192, R, C); const int Rb = Epi::PERM ? ((R & ~31) + perm32(R & 31)) : R;
        voffB[i] = (unsigned)(Rb * K + C) * 2u; }
    constexpr unsigned kstep = BK * 2;
    const unsigned hstep = (unsigned)HALF * K * 2;
    const unsigned tstep = 2 * hstep;
    const unsigned ldsw = (unsigned)wid * 1024u;
    const int aoff = lds_byte(wr * 64 + fr, fq * 8), boff = lds_byte(wc * 32 + fr, fq * 8);
#define PG8_SA(b, h) (((b) * 2 + (h)) * HTB)
#define PG8_SB(b, h) ((4 + (b) * 2 + (h)) * HTB)
#define PG8_STAGE(bufoff, gbase, voff) do { _Pragma("unroll") for (int _i = 0; _i < 2; ++_i) \
        __builtin_amdgcn_global_load_lds((const unsigned*)((const char*)(gbase) + (voff)[_i]), (LAS unsigned*)(lds + (bufoff) + ldsw + _i * 8192), 16, 0, 0); } while (0)
#define PG8_LDA(dst, b, h) do { _Pragma("unroll") for (int m = 0; m < 4; ++m) _Pragma("unroll") for (int k = 0; k < 2; ++k) dst[m][k] = *(const LAS bf16x8*)(lds + PG8_SA(b, h) + aoff + m * 2048 + k * 1024); } while (0)
#define PG8_LDB(dst, b, h) do { _Pragma("unroll") for (int n = 0; n < 2; ++n) _Pragma("unroll") for (int k = 0; k < 2; ++k) dst[n][k] = *(const LAS bf16x8*)(lds + PG8_SB(b, h) + boff + n * 2048 + k * 1024); } while (0)
#define PG8_MMA(ai, bj, At, Bt) do { __builtin_amdgcn_s_setprio(1); _Pragma("unroll") for (int m = 0; m < 4; ++m) _Pragma("unroll") for (int n = 0; n < 2; ++n) _Pragma("unroll") for (int k = 0; k < 2; ++k) \
        acc[ai][bj][m][n] = __builtin_amdgcn_mfma_f32_16x16x32_bf16(Bt[n][k], At[m][k], acc[ai][bj][m][n], 0, 0, 0); __builtin_amdgcn_s_setprio(0); } while (0)
#define PG8_WAIT_V(n) asm volatile("s_waitcnt vmcnt(" #n ")" ::: "memory")
#define PG8_WAIT_L(n) asm volatile("s_waitcnt lgkmcnt(" #n ")" ::: "memory")
#define PG8_BAR __builtin_amdgcn_s_barrier()
#define PG8_SCHED __builtin_amdgcn_sched_barrier(0)
    Unit cur, nxt; int ui = 0;
    if (!S.next(0, cur)) return;
    f32x4 acc[2][2][4][2];
#pragma unroll
    for (int a = 0; a < 2; ++a)
#pragma unroll
        for (int b = 0; b < 2; ++b)
#pragma unroll
            for (int m = 0; m < 4; ++m)
#pragma unroll
                for (int n = 0; n < 2; ++n) acc[a][b][m][n] = (f32x4){0.f, 0.f, 0.f, 0.f};
    bf16x8 At[4][2], B0[2][2], B1[2][2];
    unsigned aC[2][2], aN[2][2];
    S.a_off(cur, tid, K, aC);
    const char* const Ab = (const char*)g.A;
    const char* cB = (const char*)g.Bt + (size_t)cur.pn * tstep;
    PG8_STAGE(PG8_SB(0, 0), cB, voffB); PG8_STAGE(PG8_SB(0, 1), cB + hstep, voffB); PG8_STAGE(PG8_SA(0, 0), Ab, aC[0]); PG8_STAGE(PG8_SA(0, 1), Ab, aC[1]);
    if (wr == 1) PG8_BAR;
    PG8_WAIT_V(2); PG8_BAR;
    PG8_STAGE(PG8_SB(1, 0), cB + kstep, voffB); PG8_STAGE(PG8_SA(1, 0), Ab + kstep, aC[0]); PG8_STAGE(PG8_SB(1, 1), cB + hstep + kstep, voffB);
    PG8_WAIT_V(6); PG8_BAR;
    for (;;) {
        const bool has_next = S.next(ui + 1, nxt);
        const char* nB = has_next ? (const char*)g.Bt + (size_t)nxt.pn * tstep : cB;
        if (has_next) S.a_off(nxt, tid, K, aN);
        else {
#pragma unroll
            for (int h = 0; h < 2; ++h)
#pragma unroll
                for (int i = 0; i < 2; ++i) aN[h][i] = aC[h][i]; }
        for (int t = 0; t < nt; t += 2) {
            const bool last = (t == nt - 2);
            const char* a1 = Ab + (size_t)(t + 1) * kstep;
            const char* a2 = last ? Ab : Ab + (size_t)(t + 2) * kstep; const char* b2 = last ? nB : cB + (size_t)(t + 2) * kstep;
            const char* a3 = a2 + kstep; const char* b3 = b2 + kstep;
            PG8_LDB(B0, 0, 0); PG8_LDB(B1, 0, 1); PG8_SCHED; PG8_LDA(At, 0, 0); PG8_STAGE(PG8_SA(1, 1), a1, aC[1]);
            if (last) {
#pragma unroll
                for (int h = 0; h < 2; ++h)
#pragma unroll
                    for (int i = 0; i < 2; ++i) aC[h][i] = aN[h][i]; }
            PG8_WAIT_V(8); PG8_WAIT_L(0); PG8_BAR; PG8_MMA(0, 0, At, B0); PG8_MMA(0, 1, At, B1); PG8_BAR; PG8_SCHED;
            PG8_LDA(At, 0, 1); PG8_STAGE(PG8_SB(0, 0), b2, voffB); PG8_STAGE(PG8_SB(0, 1), b2 + hstep, voffB); PG8_STAGE(PG8_SA(0, 0), a2, aC[0]);
            PG8_WAIT_V(8); PG8_WAIT_L(0); PG8_BAR; PG8_MMA(1, 0, At, B0); PG8_MMA(1, 1, At, B1); PG8_BAR; PG8_SCHED;
            PG8_LDB(B0, 1, 0); PG8_LDB(B1, 1, 1); PG8_SCHED; PG8_LDA(At, 1, 0); PG8_STAGE(PG8_SA(0, 1), a2, aC[1]);
            PG8_WAIT_V(8); PG8_WAIT_L(0); PG8_BAR; PG8_MMA(0, 0, At, B0); PG8_MMA(0, 1, At, B1); PG8_BAR; PG8_SCHED;
            PG8_LDA(At, 1, 1); PG8_STAGE(PG8_SB(1, 0), b3, voffB); PG8_STAGE(PG8_SB(1, 1), b3 + hstep, voffB); PG8_STAGE(PG8_SA(1, 0), a3, aC[0]);
            PG8_WAIT_V(8); PG8_WAIT_L(0); PG8_BAR; PG8_MMA(1, 0, At, B0); PG8_MMA(1, 1, At, B1); PG8_BAR; PG8_SCHED;
        }
        if constexpr (ALIGN_EPI) { if (wr == 0) PG8_BAR; }
        E(acc, cur, wr, wc, fr, fq);
        if (!has_next) break;
#pragma unroll
        for (int a = 0; a < 2; ++a)
#pragma unroll
            for (int b = 0; b < 2; ++b)
#pragma unroll
                for (int m = 0; m < 4; ++m)
#pragma unroll
                    for (int n = 0; n < 2; ++n) acc[a][b][m][n] = (f32x4){0.f, 0.f, 0.f, 0.f};
        cur = nxt; cB = nB; ++ui;
        if constexpr (ALIGN_EPI) { if (wr == 1) PG8_BAR; }
    }
    PG8_WAIT_V(0);
    if constexpr (!ALIGN_EPI) { if (wr == 0) PG8_BAR; }
    PG8_BAR;
#undef PG8_SA
#undef PG8_SB
#undef PG8_STAGE
#undef PG8_LDA
#undef PG8_LDB
#undef PG8_MMA
#undef PG8_WAIT_V
#undef PG8_WAIT_L
#undef PG8_BAR
#undef PG8_SCHED
}
}
namespace pg8 {
typedef const f32x4 (&AccRef)[2][2][4][2];

struct EpiInProj {
    static constexpr bool PERM = true;
    unsigned char* ws;
    __device__ __forceinline__ void operator()(AccRef acc, const Unit& u, int wr, int wc, int fr, int fq) const {
        const int pn = u.on, row0 = u.om * BM + wr * 64 + fr, cw = wc * 32 + 8 * fq;
        if (pn >= 4 && pn < 12) {
#pragma unroll
            for (int ai = 0; ai < 2; ++ai)
#pragma unroll
                for (int m = 0; m < 4; ++m) { const f32x4 v0 = acc[ai][0][m][0] * acc[ai][1][m][0], v1 = acc[ai][0][m][1] * acc[ai][1][m][1];
                    u32x4 w; w.x = cvt_pk_bf16(v0[0], v0[1]); w.y = cvt_pk_bf16(v0[2], v0[3]); w.z = cvt_pk_bf16(v1[0], v1[1]); w.w = cvt_pk_bf16(v1[2], v1[3]);
                    *(u32x4*)((bf16_t*)(ws + WS_U) + (size_t)(row0 + ai * HALF + m * 16) * D + (pn - 4) * 128 + cw) = w; }
            return;
        }
        size_t doff; int ldc = D, cb, mode = 0;
        if (pn < 4) { doff = WS_BG; cb = pn * 256; }
        else if (pn < 16) { doff = WS_Q; cb = (pn - 12) * 256; mode = 1; }
        else if (pn == 16) { doff = WS_K; cb = 0; ldc = 256; }
        else if (pn == 17) { doff = WS_V; cb = 0; ldc = 256; }
        else if (pn < 22) { doff = WS_GC; cb = (pn - 18) * 256; mode = 2; }
        else { doff = WS_GA; cb = (pn - 22) * 256; mode = 2; }
        bf16_t* dst = (bf16_t*)(ws + doff);
#pragma unroll
        for (int ai = 0; ai < 2; ++ai)
#pragma unroll
            for (int m = 0; m < 4; ++m) { bf16_t* rowp = dst + (size_t)(row0 + ai * HALF + m * 16) * ldc + cb + cw;
#pragma unroll
                for (int bj = 0; bj < 2; ++bj) { f32x4 v0 = acc[ai][bj][m][0], v1 = acc[ai][bj][m][1];
                    if (mode == 1) { v0 = v0 * QSCALE; v1 = v1 * QSCALE; }
                    if (mode == 2) {
#pragma unroll
                        for (int j = 0; j < 4; ++j) { v0[j] = fast_sigmoid(v0[j]); v1[j] = fast_sigmoid(v1[j]); } }
                    u32x4 w; w.x = cvt_pk_bf16(v0[0], v0[1]); w.y = cvt_pk_bf16(v0[2], v0[3]); w.z = cvt_pk_bf16(v1[0], v1[1]); w.w = cvt_pk_bf16(v1[2], v1[3]);
                    *(u32x4*)(rowp + bj * HALF) = w; } }
    }
};

struct EpiDual {
    static constexpr bool PERM = true;
    unsigned char* ws;
    __device__ __forceinline__ void operator()(AccRef acc, const Unit& u, int wr, int wc, int fr, int fq) const {
        const int row0 = u.om * BM + wr * 64 + fr, col0 = u.on * BM + wc * 32 + 8 * fq;
        const bf16_t* G = (const bf16_t*)(ws + (u.e == 0 ? WS_GC : WS_GA)); float* T1 = (float*)(ws + WS_T1); bf16_t* MG = (bf16_t*)(ws + WS_MG);
#pragma unroll
        for (int ai = 0; ai < 2; ++ai)
#pragma unroll
            for (int m = 0; m < 4; ++m) { const size_t ro = (size_t)(row0 + ai * HALF + m * 16) * D + col0;
#pragma unroll
                for (int bj = 0; bj < 2; ++bj) { const size_t o = ro + bj * HALF;
                    const u32x4 gw = *(const u32x4*)(G + o);
                    f32x4 g0 = {bflo(gw.x), bfhi(gw.x), bflo(gw.y), bfhi(gw.y)}, g1 = {bflo(gw.z), bfhi(gw.z), bflo(gw.w), bfhi(gw.w)};
                    f32x4 v0 = g0 * acc[ai][bj][m][0], v1 = g1 * acc[ai][bj][m][1];
                    if (u.e == 0) { *(f32x4*)(T1 + o) = v0; *(f32x4*)(T1 + o + 4) = v1; }
                    else { v0 = v0 + *(const f32x4*)(T1 + o); v1 = v1 + *(const f32x4*)(T1 + o + 4);
                        u32x4 w; w.x = cvt_pk_bf16(v0[0], v0[1]); w.y = cvt_pk_bf16(v0[2], v0[3]); w.z = cvt_pk_bf16(v1[0], v1[1]); w.w = cvt_pk_bf16(v1[2], v1[3]);
                        *(u32x4*)(MG + o) = w; } } }
    }
};

struct EpiResid {
    static constexpr bool PERM = false;
    const float* X; float* C;
    __device__ __forceinline__ void operator()(AccRef acc, const Unit& u, int wr, int wc, int fr, int fq) const {
        const int row0 = u.om * BM + wr * 64 + fr, col0 = u.on * BM + wc * 32 + 4 * fq;
#pragma unroll
        for (int ai = 0; ai < 2; ++ai)
#pragma unroll
            for (int m = 0; m < 4; ++m) { const size_t ro = (size_t)(row0 + ai * HALF + m * 16) * D + col0;
#pragma unroll
                for (int bj = 0; bj < 2; ++bj)
#pragma unroll
                    for (int n = 0; n < 2; ++n) { const size_t o = ro + bj * HALF + n * 16; *(f32x4*)(C + o) = *(const f32x4*)(X + o) * DN_ALPHA + acc[ai][bj][m][n]; } }
    }
};

struct EpiF32 {
    static constexpr bool PERM = false;
    float* C;
    __device__ __forceinline__ void operator()(AccRef acc, const Unit& u, int wr, int wc, int fr, int fq) const {
        const int row0 = u.om * BM + wr * 64 + fr, col0 = u.on * BM + wc * 32 + 4 * fq;
#pragma unroll
        for (int ai = 0; ai < 2; ++ai)
#pragma unroll
            for (int m = 0; m < 4; ++m) { const size_t ro = (size_t)(row0 + ai * HALF + m * 16) * D + col0;
#pragma unroll
                for (int bj = 0; bj < 2; ++bj)
#pragma unroll
                    for (int n = 0; n < 2; ++n) *(f32x4*)(C + ro + bj * HALF + n * 16) = acc[ai][bj][m][n]; }
    }
};
struct EpiPle {
    static constexpr bool PERM = false;
    const float* P2; bf16_t* PLE;
    __device__ __forceinline__ void operator()(AccRef acc, const Unit& u, int wr, int wc, int fr, int fq) const {
        const int row0 = u.om * BM + wr * 64 + fr, col0 = u.on * BM + wc * 32 + 4 * fq;
#pragma unroll
        for (int ai = 0; ai < 2; ++ai)
#pragma unroll
            for (int m = 0; m < 4; ++m) { const size_t ro = (size_t)(row0 + ai * HALF + m * 16) * D + col0;
#pragma unroll
                for (int bj = 0; bj < 2; ++bj)
#pragma unroll
                    for (int n = 0; n < 2; ++n) { const size_t o = ro + bj * HALF + n * 16; const f32x4 p2 = *(const f32x4*)(P2 + o); const f32x4 a = acc[ai][bj][m][n];
                        u32x2 w; w.x = cvt_pk_bf16(fast_sigmoid(a[0]) * p2[0], fast_sigmoid(a[1]) * p2[1]); w.y = cvt_pk_bf16(fast_sigmoid(a[2]) * p2[2], fast_sigmoid(a[3]) * p2[3]);
                        *(u32x2*)(PLE + o) = w; } }
    }
};

struct EpiSwiglu {
    static constexpr bool PERM = true;
    bf16_t* H; const float* b_gu;
    __device__ __forceinline__ void operator()(AccRef acc, const Unit& u, int wr, int wc, int fr, int fq) const {
        const int row0 = u.om * BM + wr * 64 + fr, cw = wc * 32 + 8 * fq, col0 = u.on * 128 + cw;
        const float* bg = b_gu + (size_t)u.e * 2048 + col0;
        const f32x4 bg0 = *(const f32x4*)(bg), bg1 = *(const f32x4*)(bg + 4), bu0 = *(const f32x4*)(bg + 1024), bu1 = *(const f32x4*)(bg + 1028);
#pragma unroll
        for (int ai = 0; ai < 2; ++ai)
#pragma unroll
            for (int m = 0; m < 4; ++m) { f32x4 hv[2];
#pragma unroll
                for (int n = 0; n < 2; ++n) { const f32x4 gt = acc[ai][0][m][n] + (n == 0 ? bg0 : bg1), up = acc[ai][1][m][n] + (n == 0 ? bu0 : bu1);
#pragma unroll
                    for (int j = 0; j < 4; ++j) { const float gv = fminf(gt[j], 7.0f), uv = fminf(fmaxf(up[j], -7.0f), 7.0f); hv[n][j] = (uv + 1.0f) * gv * fast_sigmoid(1.702f * gv); } }
                u32x4 w; w.x = cvt_pk_bf16(hv[0][0], hv[0][1]); w.y = cvt_pk_bf16(hv[0][2], hv[0][3]); w.z = cvt_pk_bf16(hv[1][0], hv[1][1]); w.w = cvt_pk_bf16(hv[1][2], hv[1][3]);
                *(u32x4*)(H + (size_t)(row0 + ai * HALF + m * 16) * D + col0) = w; }
    }
};
struct EpiDown {
    static constexpr bool PERM = true;
    bf16_t* Y; const float* list_w; const LAS int* cntL;
    __device__ __forceinline__ void operator()(AccRef acc, const Unit& u, int wr, int wc, int fr, int fq) const {
        const int trow0 = wr * 64 + fr, col0 = u.on * BM + wc * 32 + 8 * fq;
        const int cnt = cntL[u.e], li0 = u.mt * BM + trow0;
        const float* lw = list_w + (size_t)u.e * LISTCAP + li0;
        bf16_t* yp = Y + (size_t)(u.om * BM + trow0) * D + col0;
#pragma unroll
        for (int ai = 0; ai < 2; ++ai)
#pragma unroll
            for (int m = 0; m < 4; ++m) { const int dr = ai * HALF + m * 16;
                const float w = (li0 + dr) < cnt ? lw[dr] : 0.f;
#pragma unroll
                for (int bj = 0; bj < 2; ++bj) { const f32x4 v0 = acc[ai][bj][m][0] * w, v1 = acc[ai][bj][m][1] * w;
                    u32x4 o; o.x = cvt_pk_bf16(v0[0], v0[1]); o.y = cvt_pk_bf16(v0[2], v0[3]); o.z = cvt_pk_bf16(v1[0], v1[1]); o.w = cvt_pk_bf16(v1[2], v1[3]);
                    *(u32x4*)(yp + (size_t)dr * D + bj * HALF) = o; }
                if (m & 1) asm volatile("" ::: "memory"); }
    }
};

struct DualOrder {
    StaticOrder so;
    __device__ __forceinline__ bool next(int i, Unit& u) const {
        int pm, pn; if (!so.tile(i >> 1, pm, pn)) return false;
        const int e = i & 1; u.pm = e * (M / BM) + pm; u.pn = e * 4 + pn; u.om = pm; u.on = pn; u.e = e; u.mt = 0; return true;
    }
    __device__ __forceinline__ void a_off(const Unit& u, int tid, int K, unsigned (&o)[2][2]) const { plain_a_off(u.pm, tid, K, o); }
};
struct MoeOrder {
    const LAS int* cntL; const LAS int* tsL; const int* list_tok; int NT, G, c, gather;
    __device__ __forceinline__ bool next(int i, Unit& u) const {
        const int total = __builtin_amdgcn_readfirstlane(tsL[NE]) * NT;
        const long L = (long)i * G + c; if (L >= total) return false;
        const int wgid = xcd_remap((int)L, total);
        int e = 0;
        for (int k = 1; k < NE; ++k) e += (wgid >= __builtin_amdgcn_readfirstlane(tsL[k]) * NT) ? 1 : 0;
        const int ts = __builtin_amdgcn_readfirstlane(tsL[e]), ntl = __builtin_amdgcn_readfirstlane(tsL[e + 1]) - ts, r = wgid - ts * NT;
        const int nt = r / ntl, mt = r - nt * ntl;
        u.pm = ts + mt; u.pn = e * NT + nt; u.om = ts + mt; u.on = nt; u.e = e; u.mt = mt; return true;
    }
    __device__ __forceinline__ void a_off(const Unit& u, int tid, int K, unsigned (&o)[2][2]) const {
        if (!gather) { plain_a_off(u.pm, tid, K, o); return; }
        const int cnt = cntL[u.e];
#pragma unroll
        for (int i = 0; i < 2; ++i) { int R, C; stage_rc(tid * 16 + i * 8192, R, C);
#pragma unroll
            for (int h = 0; h < 2; ++h) { const int li = u.mt * BM + h * HALF + R; const int tok = li < cnt ? list_tok[(size_t)u.e * LISTCAP + li] : 0;
                o[h][i] = (unsigned)(tok * K + C) * 2u; } }
    }
};
}
__device__ __forceinline__ int dst_row(int n, int map) {
    if (map == 1) { if (n >= 1024 && n < 3072) { const int hsel = n >= 2048, c = n - 1024 - hsel * 1024; return 1024 + (c >> 7) * 256 + hsel * 128 + (c & 127); } return n; }
    if (map == 2) { const int hsel = n >= 1024, c = n - hsel * 1024; return (c >> 7) * 256 + hsel * 128 + (c & 127); }
    return n;
}
__device__ __forceinline__ void p0_item(const float* W, int K, int N, bf16_t* WT, int map, LAS float* scr, int item, int lane) {
    const int nblk = N / 64, kb = item / nblk, nb = item - kb * nblk, k0 = 64 * kb, n0 = 64 * nb;
    const int lr = lane >> 4, lc = (lane & 15) * 4;
    f32x4 v[16];
#pragma unroll
    for (int i = 0; i < 16; ++i) v[i] = *(const f32x4*)(W + (size_t)(k0 + 4 * i + lr) * N + n0 + lc);
#pragma unroll
    for (int i = 0; i < 16; ++i) { LAS float* s = scr + (4 * i + lr) * 65 + lc; s[0] = v[i][0]; s[1] = v[i][1]; s[2] = v[i][2]; s[3] = v[i][3]; }
    asm volatile("s_waitcnt lgkmcnt(0)" ::: "memory");
    const int c = lane & 7;
    const int drow0 = dst_row(n0, map);
#pragma unroll
    for (int j = 0; j < 8; ++j) { const int n = (lane >> 3) + 8 * j; const LAS float* s = scr + (8 * c) * 65 + n;
        u32x4 o; o.x = pk2(s[0 * 65], s[1 * 65]); o.y = pk2(s[2 * 65], s[3 * 65]); o.z = pk2(s[4 * 65], s[5 * 65]); o.w = pk2(s[6 * 65], s[7 * 65]);
        *(u32x4*)(WT + (size_t)(drow0 + n) * K + k0 + 8 * c) = o; }
    asm volatile("s_waitcnt lgkmcnt(0)" ::: "memory");
}
struct P0Args { const float *x, *p, *w_in, *w_brc, *w_bra, *w_out, *w_pg, *w_pp, *w_gu, *w_dn; unsigned char* ws; };
__device__ __forceinline__ void p0_phase(const P0Args& a, LAS unsigned char* lds, int vcu, int G) {
    int tid_ = threadIdx.x; asm volatile("" : "+v"(tid_));
    const int tid = tid_, lane = tid & 63, wave = __builtin_amdgcn_readfirstlane(tid >> 6);
    LAS float* scr = (LAS float*)(lds + wave * 16640);
    const int gw = vcu * NWAVES + wave, NGW = G * NWAVES;
    constexpr int I_IN = 16 * (NIN / 64), I_SQ = 16 * 16, I_PP = 4 * 16, I_GU = 16 * 32, I_DN = 16 * 16;
    constexpr int NITEMS = I_IN + 4 * I_SQ + I_PP + NE * I_GU + NE * I_DN;
    for (int it = gw; it < NITEMS; it += NGW) {
        int r = it;
        if (r < I_IN) { p0_item(a.w_in, D, NIN, (bf16_t*)(a.ws + WS_WIN), 1, scr, r, lane); continue; } r -= I_IN;
        if (r < I_SQ) { p0_item(a.w_brc, D, D, (bf16_t*)(a.ws + WS_WBR), 0, scr, r, lane); continue; } r -= I_SQ;
        if (r < I_SQ) { p0_item(a.w_bra, D, D, (bf16_t*)(a.ws + WS_WBR) + (size_t)D * D, 0, scr, r, lane); continue; } r -= I_SQ;
        if (r < I_SQ) { p0_item(a.w_out, D, D, (bf16_t*)(a.ws + WS_WOUT), 0, scr, r, lane); continue; } r -= I_SQ;
        if (r < I_SQ) { p0_item(a.w_pg, D, D, (bf16_t*)(a.ws + WS_WPG), 0, scr, r, lane); continue; } r -= I_SQ;
        if (r < I_PP) { p0_item(a.w_pp, DPLE, D, (bf16_t*)(a.ws + WS_WPP), 0, scr, r, lane); continue; } r -= I_PP;
        if (r < NE * I_GU) { const int e = r / I_GU; p0_item(a.w_gu + (size_t)e * D * 2048, D, 2048, (bf16_t*)(a.ws + WS_WGU) + (size_t)e * 2048 * D, 2, scr, r - e * I_GU, lane); continue; } r -= NE * I_GU;
        { const int e = r / I_DN; p0_item(a.w_dn + (size_t)e * D * D, D, D, (bf16_t*)(a.ws + WS_WDN) + (size_t)e * D * D, 0, scr, r - e * I_DN, lane); }
    }
    const int gt = vcu * NTHREADS + tid, NGT = G * NTHREADS;
    for (int i = gt; i < M * D / 8; i += NGT) { const f32x4 v0 = *(const f32x4*)(a.x + (size_t)i * 8), v1 = *(const f32x4*)(a.x + (size_t)i * 8 + 4);
        u32x4 o; o.x = pk2(v0[0], v0[1]); o.y = pk2(v0[2], v0[3]); o.z = pk2(v1[0], v1[1]); o.w = pk2(v1[2], v1[3]); *(u32x4*)((bf16_t*)(a.ws + WS_XB) + (size_t)i * 8) = o; }
    for (int i = gt; i < M * DPLE / 8; i += NGT) { const f32x4 v0 = *(const f32x4*)(a.p + (size_t)i * 8), v1 = *(const f32x4*)(a.p + (size_t)i * 8 + 4);
        u32x4 o; o.x = pk2(v0[0], v0[1]); o.y = pk2(v0[2], v0[3]); o.z = pk2(v1[0], v1[1]); o.w = pk2(v1[2], v1[3]); *(u32x4*)((bf16_t*)(a.ws + WS_PB) + (size_t)i * 8) = o; }
}

__device__ __forceinline__ int crow(int r, int hi) { return (r & 3) + 8 * (r >> 2) + 4 * hi; }
typedef short v4i16_t __attribute__((ext_vector_type(4)));
__device__ __forceinline__ s16x4 vtr(const LAS unsigned char* p) { return __builtin_bit_cast(s16x4, __builtin_amdgcn_ds_read_tr16_b64_v4i16((LAS v4i16_t*)p)); }
__device__ __forceinline__ void attn_unit(LAS unsigned char* lds, const bf16_t* Q, const bf16_t* Kg, const bf16_t* Vg, const float* sinks, bf16_t* O, int b, int kvh, int nb) {
    int tid_ = threadIdx.x; asm volatile("" : "+v"(tid_));
    const int tid = tid_, lane = tid & 63, r32 = lane & 31, hi = lane >> 5; const int wid = __builtin_amdgcn_readfirstlane(tid >> 6);
    const int t0 = b * SEQ + nb * 128;
#pragma unroll
    for (int it = 0; it < 4; ++it) { const int idx = tid + it * NTHREADS, key = idx >> 3, c = idx & 7;
        int row = t0 - 128 + key; if (row < b * SEQ) row = b * SEQ;
        const u32x4 kv = *(const u32x4*)(Kg + (size_t)row * 256 + kvh * HD + c * 8);
        const u32x4 vv = *(const u32x4*)(Vg + (size_t)row * 256 + kvh * HD + c * 8);
        *(LAS u32x4*)(lds + c * 4096 + key * 16) = kv;
        *(LAS u32x4*)(lds + 32768 + (c >> 2) * 16384 + (key >> 4) * 1024 + (key & 15) * 64 + (c & 3) * 16) = vv; }
    __syncthreads();
    const int g = wid >> 1, half = wid & 1, h = kvh * 4 + g;
    const float sink2 = sinks[h] * LOG2E;
    const LAS unsigned char* vbase = lds + 32768 + ((lane >> 4) & 1) * 32 + (lane & 3) * 8 + (4 * hi + ((lane & 15) >> 2)) * 64;
#pragma unroll 1
    for (int qq = 0; qq < 2; ++qq) {
        const int qt = half * 2 + qq;
        const bf16_t* qp = Q + (size_t)(t0 + 32 * qt + r32) * D + h * HD + hi * 8;
        bf16x8 qr[4];
#pragma unroll
        for (int d0 = 0; d0 < 4; ++d0) qr[d0] = *(const bf16x8*)(qp + d0 * 16);
        f32x16 s[5];
#pragma unroll
        for (int j = 0; j < 5; ++j) { const LAS unsigned char* kp = lds + hi * 4096 + ((qt + j) * 32 + r32) * 16; f32x16 a = {};
#pragma unroll
            for (int d0 = 0; d0 < 4; ++d0) a = __builtin_amdgcn_mfma_f32_32x32x16_bf16(*(const LAS bf16x8*)(kp + d0 * 8192), qr[d0], a, 0, 0, 0);
            s[j] = a; }
#pragma unroll
        for (int r = 0; r < 16; ++r) { const int cr = crow(r, hi); if (cr <= r32) s[0][r] = -INFINITY; if (cr > r32) s[4][r] = -INFINITY; }
        if (nb == 0) {
#pragma unroll
            for (int j = 0; j < 4; ++j) if (qt + j < 4) {
#pragma unroll
                for (int r = 0; r < 16; ++r) s[j][r] = -INFINITY; } }
        float mx = -INFINITY;
#pragma unroll
        for (int j = 0; j < 5; ++j)
#pragma unroll
            for (int r = 0; r < 16; ++r) mx = fmaxf(mx, s[j][r]);
        mx = fmaxf(mx, __shfl_xor(mx, 32)); mx = fmaxf(mx, sink2);
        float ls = 0.f;
#pragma unroll
        for (int j = 0; j < 5; ++j)
#pragma unroll
            for (int r = 0; r < 16; ++r) { s[j][r] = __builtin_amdgcn_exp2f(s[j][r] - mx); ls += s[j][r]; }
        ls += __shfl_xor(ls, 32); ls += __builtin_amdgcn_exp2f(sink2 - mx);
        const float linv = 1.0f / ls;
        f32x16 o[2]; o[0] = f32x16{}; o[1] = f32x16{};
#pragma unroll
        for (int j = 0; j < 5; ++j)
#pragma unroll
            for (int ks = 0; ks < 2; ++ks) {
                u32x4 pw; pw.x = pk2(s[j][8 * ks + 0], s[j][8 * ks + 1]); pw.y = pk2(s[j][8 * ks + 2], s[j][8 * ks + 3]); pw.z = pk2(s[j][8 * ks + 4], s[j][8 * ks + 5]); pw.w = pk2(s[j][8 * ks + 6], s[j][8 * ks + 7]);
                const bf16x8 pa = __builtin_bit_cast(bf16x8, pw);
                const LAS unsigned char* vp = vbase + ((qt + j) * 2 + ks) * 1024;
#pragma unroll
                for (int dh = 0; dh < 2; ++dh) { const s16x4 lo = vtr(vp + dh * 16384), hi4 = vtr(vp + dh * 16384 + 512);
                    const bf16x8 vf = {lo[0], lo[1], lo[2], lo[3], hi4[0], hi4[1], hi4[2], hi4[3]};
                    o[dh] = __builtin_amdgcn_mfma_f32_32x32x16_bf16(pa, vf, o[dh], 0, 0, 0); } }
        bf16_t* op = O + (size_t)(t0 + 32 * qt) * D + h * HD + r32;
#pragma unroll
        for (int r = 0; r < 16; ++r) { const int q = crow(r, hi); const float sc = __shfl(linv, q);
            op[(size_t)q * D] = (bf16_t)f2bf(o[0][r] * sc); op[(size_t)q * D + 32] = (bf16_t)f2bf(o[1][r] * sc); }
    }
    __syncthreads();
}
__device__ __forceinline__ void conv_phase(const bf16_t* Bg, const bf16_t* U, const float* cw, bf16_t* Z, int vcu, int G) {
    int tid_ = threadIdx.x; asm volatile("" : "+v"(tid_));
    const int gt = vcu * NTHREADS + tid_, NGT = G * NTHREADS;
    for (int i = gt; i < M * (D / 8); i += NGT) {
        const int t = i >> 7, c = (i & 127) * 8, tl = t & (SEQ - 1);
        float y[8];
#pragma unroll
        for (int j = 0; j < 8; ++j) y[j] = 0.f;
#pragma unroll
        for (int k = 0; k < 3; ++k) { const int dt = k - 2; if (tl + dt >= 0) { const u32x4 uw = *(const u32x4*)(U + (size_t)(t + dt) * D + c);
            const f32x4 w0 = *(const f32x4*)(cw + k * D + c), w1 = *(const f32x4*)(cw + k * D + c + 4);
            y[0] += w0[0] * bflo(uw.x); y[1] += w0[1] * bfhi(uw.x); y[2] += w0[2] * bflo(uw.y); y[3] += w0[3] * bfhi(uw.y);
            y[4] += w1[0] * bflo(uw.z); y[5] += w1[1] * bfhi(uw.z); y[6] += w1[2] * bflo(uw.w); y[7] += w1[3] * bfhi(uw.w); } }
        const u32x4 bw = *(const u32x4*)(Bg + (size_t)t * D + c);
        u32x4 o; o.x = pk2(y[0] * bflo(bw.x), y[1] * bfhi(bw.x)); o.y = pk2(y[2] * bflo(bw.y), y[3] * bfhi(bw.y)); o.z = pk2(y[4] * bflo(bw.z), y[5] * bfhi(bw.z)); o.w = pk2(y[6] * bflo(bw.w), y[7] * bfhi(bw.w));
        *(u32x4*)(Z + (size_t)t * D + c) = o;
    }
}
constexpr int WR_STRIDE = 1028;
struct RouteArgs { float* X1F; bf16_t* X1B; const float *g1, *b1, *w_r, *b_r; int* gcnt; int* list_tok; float* list_w; int* tk_e; int* tk_rank; float* tk_w; };
__device__ __forceinline__ void route_phase(const RouteArgs& a, LAS unsigned char* lds, int vcu, int G) {
    int tid_ = threadIdx.x; asm volatile("" : "+v"(tid_));
    const int tid = tid_, lane = tid & 63, wave = __builtin_amdgcn_readfirstlane(tid >> 6);
    LAS float* wrt = (LAS float*)lds;
    LAS int* misc = (LAS int*)(lds + MISC_OFF);
    LAS int* lcnt = misc + 96; LAS int* gbase = misc + 128; LAS int* rowe = misc + 160; LAS float* roww = (LAS float*)(misc + 416); LAS int* lrank = misc + 672;
    for (int i = tid; i < D * NE; i += NTHREADS) { const int c = i >> 5, e = i & 31; wrt[e * WR_STRIDE + c] = a.w_r[i]; }
    if (tid < NE) lcnt[tid] = 0;
    __syncthreads();
    const int rows_per_wg = M / G;
    for (int rr = wave; rr < rows_per_wg; rr += NWAVES) {
        const int t = vcu * rows_per_wg + rr;
        f32x4 v[4]; float s = 0.f;
#pragma unroll
        for (int j = 0; j < 4; ++j) { v[j] = *(const f32x4*)(a.X1F + (size_t)t * D + 256 * j + 4 * lane); s += (v[j][0] + v[j][1]) + (v[j][2] + v[j][3]); }
        const float mean = wave_sum(s) * (1.0f / D); float q = 0.f;
#pragma unroll
        for (int j = 0; j < 4; ++j) { v[j] = v[j] - mean; q += (v[j][0] * v[j][0] + v[j][1] * v[j][1]) + (v[j][2] * v[j][2] + v[j][3] * v[j][3]); }
        const float rstd = 1.0f / sqrtf(wave_sum(q) * (1.0f / D) + LN_EPS);
#pragma unroll
        for (int j = 0; j < 4; ++j) { const f32x4 gg = *(const f32x4*)(a.g1 + 256 * j + 4 * lane), bb = *(const f32x4*)(a.b1 + 256 * j + 4 * lane);
            v[j] = v[j] * rstd * gg + bb;
            *(f32x4*)(a.X1F + (size_t)t * D + 256 * j + 4 * lane) = v[j];
            u32x2 w; w.x = pk2(v[j][0], v[j][1]); w.y = pk2(v[j][2], v[j][3]); *(u32x2*)(a.X1B + (size_t)t * D + 256 * j + 4 * lane) = w; }
        float pl[32];
#pragma unroll
        for (int e = 0; e < 32; ++e) { float acc = 0.f;
#pragma unroll
            for (int j = 0; j < 4; ++j) { const f32x4 w = *(const LAS f32x4*)(wrt + e * WR_STRIDE + 256 * j + 4 * lane); acc += (v[j][0] * w[0] + v[j][1] * w[1]) + (v[j][2] * w[2] + v[j][3] * w[3]); }
            pl[e] = acc; }
#pragma unroll
        for (int o = 32, n = 16; o >= 2; o >>= 1, n >>= 1) { const bool up = (lane & o) != 0;
#pragma unroll
            for (int i = 0; i < 16; ++i) if (i < n) { const float send = up ? pl[i] : pl[i + n], keep = up ? pl[i + n] : pl[i]; pl[i] = keep + __shfl_xor(send, o); } }
        float logit = pl[0] + __shfl_xor(pl[0], 1);
        const int myexp = lane >> 1;
        logit += a.b_r[myexp];
        int se[4]; float sv[4];
#pragma unroll
        for (int k = 0; k < 4; ++k) { float bv = logit; int bi = myexp;
#pragma unroll
            for (int o = 1; o < 64; o <<= 1) { const float ov = __shfl_xor(bv, o); const int oi = __shfl_xor(bi, o); if (ov > bv || (ov == bv && oi < bi)) { bv = ov; bi = oi; } }
            se[k] = bi; sv[k] = bv; if (myexp == bi) logit = -INFINITY; }
        const float e1 = __expf(sv[1] - sv[0]), e2 = __expf(sv[2] - sv[0]), e3 = __expf(sv[3] - sv[0]);
        const float inv = 1.0f / (1.0f + e1 + e2 + e3);
        if (lane < 4) { const int e = lane == 0 ? se[0] : lane == 1 ? se[1] : lane == 2 ? se[2] : se[3];
            const float w = (lane == 0 ? 1.0f : lane == 1 ? e1 : lane == 2 ? e2 : e3) * inv;
            rowe[rr * 4 + lane] = e; roww[rr * 4 + lane] = w; }
    }
    __syncthreads();
    const int nent = rows_per_wg * 4;
    int my_e = 0, my_lr = 0;
    if (tid < nent) { my_e = rowe[tid]; my_lr = atomicAdd((int*)(lcnt + my_e), 1); }
    __syncthreads();
    if (tid < NE) gbase[tid] = atomicAdd(a.gcnt + tid, lcnt[tid]);
    __syncthreads();
    if (tid < nent) { const int t = vcu * rows_per_wg + (tid >> 2), rank = gbase[my_e] + my_lr;
        a.list_tok[(size_t)my_e * LISTCAP + rank] = t; a.list_w[(size_t)my_e * LISTCAP + rank] = roww[tid];
        a.tk_e[t * 4 + (tid & 3)] = my_e; a.tk_rank[t * 4 + (tid & 3)] = rank; a.tk_w[t * 4 + (tid & 3)] = roww[tid]; }
    __syncthreads();
}
__device__ __forceinline__ void build_tables(const int* gcnt, LAS unsigned char* lds) {
    LAS int* misc = (LAS int*)(lds + MISC_OFF);
    if (threadIdx.x == 0) { int a = 0; for (int e = 0; e < NE; ++e) { const int c = __hip_atomic_load(gcnt + e, __ATOMIC_RELAXED, __HIP_MEMORY_SCOPE_AGENT); misc[e] = c; misc[32 + e] = a; a += (c + 255) >> 8; } misc[32 + NE] = a; }
    __syncthreads();
}
struct FinalArgs { const float* X1F; const bf16_t* PLE; const bf16_t* Y; const int* tk_e; const int* tk_rank; const float* tk_w; const float* b_down; const float *g2, *b2; float* out; };
__device__ __forceinline__ void final_phase(const FinalArgs& a, LAS unsigned char* lds, int vcu, int G) {
    int tid_ = threadIdx.x; asm volatile("" : "+v"(tid_));
    const int tid = tid_, lane = tid & 63, wave = __builtin_amdgcn_readfirstlane(tid >> 6);
    const LAS int* ts = (const LAS int*)(lds + MISC_OFF) + 32;
    const int gw = vcu * NWAVES + wave, NGW = G * NWAVES;
    for (int t = gw; t < M; t += NGW) {
        size_t pos[4]; int ek[4]; float wk[4];
#pragma unroll
        for (int k = 0; k < 4; ++k) { const int e = a.tk_e[t * 4 + k], rk = a.tk_rank[t * 4 + k]; pos[k] = ((size_t)ts[e] * 256 + rk) * D; ek[k] = e * D; wk[k] = a.tk_w[t * 4 + k]; }
        f32x4 v[4]; float s = 0.f;
#pragma unroll
        for (int j = 0; j < 4; ++j) { const int c = 256 * j + 4 * lane;
            f32x4 x = *(const f32x4*)(a.X1F + (size_t)t * D + c) * DN_ALPHA;
            const u32x2 pw = *(const u32x2*)(a.PLE + (size_t)t * D + c);
            x[0] += bflo(pw.x); x[1] += bfhi(pw.x); x[2] += bflo(pw.y); x[3] += bfhi(pw.y);
#pragma unroll
            for (int k = 0; k < 4; ++k) { const u32x2 yw = *(const u32x2*)(a.Y + pos[k] + c); const f32x4 bd = *(const f32x4*)(a.b_down + ek[k] + c);
                x[0] += bflo(yw.x) + wk[k] * bd[0]; x[1] += bfhi(yw.x) + wk[k] * bd[1]; x[2] += bflo(yw.y) + wk[k] * bd[2]; x[3] += bfhi(yw.y) + wk[k] * bd[3]; }
            v[j] = x; s += (x[0] + x[1]) + (x[2] + x[3]); }
        const float mean = wave_sum(s) * (1.0f / D); float q = 0.f;
#pragma unroll
        for (int j = 0; j < 4; ++j) { v[j] = v[j] - mean; q += (v[j][0] * v[j][0] + v[j][1] * v[j][1]) + (v[j][2] * v[j][2] + v[j][3] * v[j][3]); }
        const float rstd = 1.0f / sqrtf(wave_sum(q) * (1.0f / D) + LN_EPS);
#pragma unroll
        for (int j = 0; j < 4; ++j) { const int c = 256 * j + 4 * lane; const f32x4 gg = *(const f32x4*)(a.g2 + c), bb = *(const f32x4*)(a.b2 + c);
            *(f32x4*)(a.out + (size_t)t * D + c) = v[j] * rstd * gg + bb; }
    }
}

#ifndef PHASES
#define PHASES 0xfff
#endif
struct Args { const float* in[20]; float* out; unsigned char* ws; };
__global__ void __launch_bounds__(NTHREADS, 2) mega_fwd(Args args) {
    extern __shared__ __attribute__((aligned(16))) unsigned char lds_raw[];
    LAS unsigned char* lds = (LAS unsigned char*)lds_raw;
    cg::grid_group grid = cg::this_grid();
    const int G = gridDim.x, bx = blockIdx.x;
    const int vcu = (G % 8 == 0) ? (bx % 8) * (G / 8) + bx / 8 : bx;
    unsigned char* ws = args.ws;
    const float* x = args.in[0];
    bf16_t* XB = (bf16_t*)(ws + WS_XB); bf16_t* PB = (bf16_t*)(ws + WS_PB);
    bf16_t* Bg = (bf16_t*)(ws + WS_BG); bf16_t* U = (bf16_t*)(ws + WS_U); bf16_t* Q = (bf16_t*)(ws + WS_Q); bf16_t* Kb = (bf16_t*)(ws + WS_K); bf16_t* Vb = (bf16_t*)(ws + WS_V);
    bf16_t* Gc = (bf16_t*)(ws + WS_GC); bf16_t* Ga = (bf16_t*)(ws + WS_GA); bf16_t* ZO = (bf16_t*)(ws + WS_ZO); float* T1 = (float*)(ws + WS_T1); bf16_t* MG = (bf16_t*)(ws + WS_MG);
    float* X1F = (float*)(ws + WS_X1F); bf16_t* X1B = (bf16_t*)(ws + WS_X1B); float* P2 = (float*)(ws + WS_P2); bf16_t* PLE = (bf16_t*)(ws + WS_PLE);
    bf16_t* H = (bf16_t*)(ws + WS_H); bf16_t* Y = (bf16_t*)(ws + WS_Y);
    int* gcnt = (int*)(ws + WS_CTL); int* tk_e = (int*)(ws + WS_TKE); int* tk_rank = (int*)(ws + WS_TKR); float* tk_w = (float*)(ws + WS_TKW); int* list_tok = (int*)(ws + WS_LTOK); float* list_w = (float*)(ws + WS_LW);
    const LAS int* cntL = (const LAS int*)(lds + MISC_OFF); const LAS int* tsL = cntL + 32;
    volatile LAS unsigned* bst = (volatile LAS unsigned*)(lds + MISC_OFF) + 1000;
    if (threadIdx.x < 2) bst[threadIdx.x] = 0u;
    __syncthreads();
    const XcdBarrier bar = xcd_barrier_post((unsigned*)(ws + WS_BAR), bst);

    if (PHASES & 1) { P0Args a{args.in[0], args.in[1], args.in[2], args.in[4], args.in[5], args.in[7], args.in[17], args.in[16], args.in[12], args.in[14], ws}; p0_phase(a, lds, vcu, G); }
    grid.sync();
    if (PHASES & 2) { pg8::Gemm g{XB, (const bf16_t*)(ws + WS_WIN), D}; pg8::StaticOrder S; S.init(M / 256, NIN / 256, G, bx);
      pg8::EpiInProj E{ws};
      pg8::gemm_phase<pg8::EpiInProj, pg8::StaticOrder, true>(lds, g, S, E); }
    xcd_barrier(bar);
    if (PHASES & 4) for (int it = vcu; it < BATCH * NKV * (SEQ / 128); it += G) { const int nb = it & 63, kvh = (it >> 6) & 3, b = it >> 8;
        attn_unit(lds, Q, Kb, Vb, args.in[6], ZO + (size_t)M * D, b, kvh, nb); }
    if (PHASES & 8) conv_phase(Bg, U, args.in[3], ZO, vcu, G);
    xcd_barrier(bar);
    if (PHASES & 16) { pg8::Gemm g{ZO, (const bf16_t*)(ws + WS_WBR), D}; pg8::DualOrder S; S.so.init(M / 256, D / 256, G, bx);
      pg8::EpiDual E{ws};
      pg8::gemm_phase<pg8::EpiDual, pg8::DualOrder, false>(lds, g, S, E); }
    xcd_barrier(bar);
    if (PHASES & 32) { pg8::Gemm g{MG, (const bf16_t*)(ws + WS_WOUT), D}; pg8::StaticOrder S; S.init(M / 256, D / 256, G, bx);
      pg8::EpiResid E{x, X1F};
      pg8::gemm_phase<pg8::EpiResid, pg8::StaticOrder, false>(lds, g, S, E); }
    xcd_barrier(bar);
    if (PHASES & 64) { RouteArgs a{X1F, X1B, args.in[8], args.in[9], args.in[10], args.in[11], gcnt, list_tok, list_w, tk_e, tk_rank, tk_w}; route_phase(a, lds, vcu, G); }
    xcd_barrier(bar);
    build_tables(gcnt, lds);
    if (PHASES & 128) { pg8::Gemm g{X1B, (const bf16_t*)(ws + WS_WGU), D}; pg8::MoeOrder S{cntL, tsL, list_tok, 8, G, bx, 1};
      pg8::EpiSwiglu E{H, args.in[13]};
      pg8::gemm_phase<pg8::EpiSwiglu, pg8::MoeOrder, true>(lds, g, S, E); }
    if (PHASES & 256) { pg8::Gemm g{PB, (const bf16_t*)(ws + WS_WPP), DPLE}; pg8::StaticOrder S; S.init(M / 256, D / 256, G, bx);
      pg8::EpiF32 E{P2};
      pg8::gemm_phase<pg8::EpiF32, pg8::StaticOrder, false>(lds, g, S, E); }
    if (PHASES & 512) { pg8::Gemm g{X1B, (const bf16_t*)(ws + WS_WPG), D}; pg8::StaticOrder S; S.init(M / 256, D / 256, G, bx);
      pg8::EpiPle E{P2, PLE};
      pg8::gemm_phase<pg8::EpiPle, pg8::StaticOrder, false>(lds, g, S, E); }
    xcd_barrier(bar);
    if (PHASES & 1024) { pg8::Gemm g{H, (const bf16_t*)(ws + WS_WDN), D}; pg8::MoeOrder S{cntL, tsL, list_tok, 4, G, bx, 0};
      pg8::EpiDown E{Y, list_w, cntL};
      pg8::gemm_phase<pg8::EpiDown, pg8::MoeOrder, true>(lds, g, S, E); }
    xcd_barrier(bar);
    if (PHASES & 2048) { FinalArgs a{X1F, PLE, Y, tk_e, tk_rank, tk_w, args.in[15], args.in[18], args.in[19], args.out}; final_phase(a, lds, vcu, G); }
}

extern "C" void kernel_launch(void* const* d_in, const int* in_sizes, int n_in, void* d_out, int out_size, void* d_ws, size_t ws_size, hipStream_t stream) {
    static int grid = 0;
    if (grid == 0) {
        if (n_in != 20 || out_size != M * D || ws_size < WS_END) { fprintf(stderr, "kernel_launch: unexpected sizes (n_in %d, out %d, ws %zu < %zu)\n", n_in, out_size, ws_size, (size_t)WS_END); grid = -1; return; }
        int dev = 0, cus = 0, per_cu = 0;
        if (hipGetDevice(&dev) != hipSuccess || hipDeviceGetAttribute(&cus, hipDeviceAttributeMultiprocessorCount, dev) != hipSuccess) { grid = -1; return; }
        if (hipFuncSetAttribute((const void*)mega_fwd, hipFuncAttributeMaxDynamicSharedMemorySize, LDS_BYTES) != hipSuccess) { fprintf(stderr, "kernel_launch: hipFuncSetAttribute failed\n"); grid = -1; return; }
        if (hipOccupancyMaxActiveBlocksPerMultiprocessor(&per_cu, (const void*)mega_fwd, NTHREADS, LDS_BYTES) != hipSuccess || per_cu < 1) { fprintf(stderr, "kernel_launch: occupancy query says %d blocks per CU\n", per_cu); grid = -1; return; }
        grid = cus;
        if (grid != 256) fprintf(stderr, "kernel_launch: note: %d CUs (built and tuned for 256)\n", grid);
    }
    if (grid < 0) return;
    if (hipMemsetAsync((char*)d_ws + WS_CTL, 0, CTL_ZERO_BYTES, stream) != hipSuccess) return;
    Args a{};
    for (int i = 0; i < 20; ++i) a.in[i] = (const float*)d_in[i];
    a.out = (float*)d_out; a.ws = (unsigned char*)d_ws;
    void* kargs[] = {&a};
    const hipError_t e = hipLaunchCooperativeKernel((const void*)mega_fwd, dim3(grid), dim3(NTHREADS), kargs, LDS_BYTES, stream);
    if (e != hipSuccess) fprintf(stderr, "kernel_launch: cooperative launch failed: %s (grid %d)\n", hipGetErrorString(e), grid);
}
```

```cpp
#include <hip/hip_runtime.h>
#include <hip/hip_cooperative_groups.h>
#include <cstdio>
#include <cstdint>
namespace cg = cooperative_groups;

#define LAS __attribute__((address_space(3)))
typedef unsigned short bf16_t;
typedef short bf16x8 __attribute__((ext_vector_type(8)));
typedef short s16x4 __attribute__((ext_vector_type(4)));
typedef float f32x4 __attribute__((ext_vector_type(4)));
typedef float f32x16 __attribute__((ext_vector_type(16)));
typedef unsigned u32x4 __attribute__((ext_vector_type(4)));
typedef unsigned u32x2 __attribute__((ext_vector_type(2)));

constexpr int BATCH = 2, SEQ = 8192, M = BATCH * SEQ, D = 1024, NIN = 6656, NE = 32, DPLE = 256, NH = 16, HD = 64, NKV = 4;
constexpr float DN_ALPHA = 1.189207115002721f, LN_EPS = 1e-5f, LOG2E = 1.4426950408889634f;
constexpr float QSCALE = 0.125f * LOG2E;
constexpr int LISTCAP = M;
constexpr int MAXTILES = (M * 4) / 256 + NE;
constexpr int NWAVES = 8, NTHREADS = 512;

constexpr size_t MiB = 1u << 20;
constexpr size_t WS_CTL = 0;
constexpr size_t WS_BAR = 16384, CTL_ZERO_BYTES = 65536;
constexpr size_t WS_TKE = 1 * MiB, WS_TKR = 2 * MiB, WS_TKW = 3 * MiB;
constexpr size_t WS_LTOK = 4 * MiB, WS_LW = 6 * MiB;
constexpr size_t WS_WIN = 8 * MiB;
constexpr size_t WS_WBR = 22 * MiB;
constexpr size_t WS_WOUT = 26 * MiB, WS_WPG = 28 * MiB;
constexpr size_t WS_WPP = 30 * MiB;
constexpr size_t WS_WGU = 32 * MiB;
constexpr size_t WS_WDN = 160 * MiB;
constexpr size_t WS_XB = 224 * MiB;
constexpr size_t WS_PB = 256 * MiB;
constexpr size_t WS_X1F = 264 * MiB;
constexpr size_t WS_X1B = 328 * MiB;
constexpr size_t WS_P2 = 360 * MiB;
constexpr size_t WS_PLE = 424 * MiB;
constexpr size_t WS_R = 456 * MiB;
constexpr size_t WS_BG = WS_R, WS_U = WS_R + 32 * MiB, WS_Q = WS_R + 64 * MiB, WS_K = WS_R + 96 * MiB, WS_V = WS_R + 104 * MiB;
constexpr size_t WS_GC = WS_R + 112 * MiB, WS_GA = WS_R + 144 * MiB;
constexpr size_t WS_ZO = WS_R + 176 * MiB;
constexpr size_t WS_T1 = WS_R + 240 * MiB;
constexpr size_t WS_MG = WS_R + 304 * MiB;
constexpr size_t WS_H = WS_R;
constexpr size_t WS_Y = WS_R + 144 * MiB;
constexpr size_t WS_END = WS_R + 336 * MiB;

constexpr int LDS_BYTES = 147456;
constexpr int MISC_OFF = 135168;
constexpr int BST_IDX = 66, TW_OFF = MISC_OFF + 512;

__device__ __forceinline__ unsigned f2bf(float f) { unsigned u = __builtin_bit_cast(unsigned, f); return (u + 0x7fffu + ((u >> 16) & 1u)) >> 16; }
__device__ __forceinline__ unsigned pk2(float lo, float hi) { return f2bf(lo) | (f2bf(hi) << 16); }
__device__ __forceinline__ float bflo(unsigned w) { return __builtin_bit_cast(float, w << 16); }
__device__ __forceinline__ float bfhi(unsigned w) { return __builtin_bit_cast(float, w & 0xffff0000u); }
__device__ __forceinline__ float fast_sigmoid(float v) { return __builtin_amdgcn_rcpf(1.0f + __builtin_amdgcn_exp2f(-LOG2E * v)); }
__device__ __forceinline__ float wave_sum(float v) {
#pragma unroll
    for (int o = 1; o < 64; o <<= 1) v += __shfl_xor(v, o);
    return v;
}

#define XB_TMO      128
#define XB_XCNT(j)  (256  + 64 * (j))
#define XB_XSUB(j)  (1280 + 64 * (j))
#define XB_XGEN(j)  (2304 + 64 * (j))
#define XB_TOP      3328
#define XB_TOPGEN   3392
#define XCD_BAR_WORDS 3456
#define XB_SPIN_CAP (1u << 18)

__device__ __forceinline__ unsigned xb_ld(unsigned* p)              { return __hip_atomic_load(p, __ATOMIC_RELAXED, __HIP_MEMORY_SCOPE_AGENT); }
__device__ __forceinline__ unsigned xb_add(unsigned* p, unsigned v) { return __hip_atomic_fetch_add(p, v, __ATOMIC_RELAXED, __HIP_MEMORY_SCOPE_AGENT); }
__device__ __forceinline__ unsigned xb_xcc_id() { return (unsigned)__builtin_amdgcn_s_getreg((3 << 11) | 20) & 0xFu; }
#define XB_SPIN(cond, bar) do { unsigned _sp = 0; while (cond) { __builtin_amdgcn_s_sleep(1); \
    if ((++_sp & 255u) == 0u) { if (xb_ld(&(bar)[XB_TMO])) break; if (_sp > XB_SPIN_CAP) { atomicAdd(&(bar)[XB_TMO], 1u); break; } } } } while (0)

struct XcdBarrier {
    unsigned* bar; unsigned x;
    volatile LAS unsigned* st;
};

__device__ __forceinline__ XcdBarrier xcd_barrier_post(unsigned* bar, volatile LAS unsigned* st) {
    XcdBarrier b; b.bar = bar; b.x = xb_xcc_id(); b.st = st;
    if (threadIdx.x == 0) (void)xb_add(&bar[XB_XCNT(b.x)], 1u);
    return b;
}
__device__ __forceinline__ void xcd_barrier_complete(unsigned* bar, unsigned x, unsigned& nloc, unsigned& nx) {
    const unsigned G = gridDim.x * gridDim.y * gridDim.z;
    unsigned sum, cnt, mine, sp = 0u;
    for (;;) {
        sum = 0u; cnt = 0u; mine = 0u;
#pragma unroll
        for (unsigned j = 0; j < 16; ++j) { const unsigned c = xb_ld(&bar[XB_XCNT(j)]); sum += c; cnt += (c > 0u) ? 1u : 0u; mine = (j == x) ? c : mine; }
        if (sum == G) break;
        __builtin_amdgcn_s_sleep(1);
        if ((++sp & 255u) == 0u) { if (xb_ld(&bar[XB_TMO])) break; if (sp > XB_SPIN_CAP) { atomicAdd(&bar[XB_TMO], 1u); break; } }
    }
    nloc = mine > 0u ? mine : 1u; nx = cnt > 0u ? cnt : 1u;
}

__device__ __forceinline__ void xcd_barrier(const XcdBarrier& b) {
    asm volatile("s_waitcnt vmcnt(0)" ::: "memory");
    __syncthreads();
    if (threadIdx.x == 0) {
        unsigned* bar = b.bar;
        __builtin_amdgcn_s_waitcnt(0);
        unsigned nloc = b.st[0], nx = b.st[1];
        if (nloc == 0u) { xcd_barrier_complete(bar, b.x, nloc, nx); b.st[0] = nloc; b.st[1] = nx; }
        const unsigned old = xb_add(&bar[XB_XSUB(b.x)], 1u);
        const unsigned gen = old / nloc;
        if (old + 1u == (gen + 1u) * nloc) {
            __builtin_amdgcn_fence(__ATOMIC_RELEASE, "agent");
            asm volatile("s_waitcnt vmcnt(0)" ::: "memory");
            const unsigned og = xb_add(&bar[XB_TOP], 1u);
            const unsigned tg = og / nx;
            if (og + 1u == (tg + 1u) * nx) xb_add(&bar[XB_TOPGEN], 1u);
            else XB_SPIN(xb_ld(&bar[XB_TOPGEN]) == tg, bar);
            __builtin_amdgcn_fence(__ATOMIC_ACQUIRE, "agent");
            xb_add(&bar[XB_XGEN(b.x)], 1u);
            asm volatile("s_waitcnt vmcnt(0)" ::: "memory");
        } else {
            XB_SPIN(xb_ld(&bar[XB_XGEN(b.x)]) == gen, bar);
            __builtin_amdgcn_fence(__ATOMIC_ACQUIRE, "agent");
            asm volatile("s_waitcnt vmcnt(0)" ::: "memory");
        }
    }
    __syncthreads();
}

namespace pg8 {
constexpr int BM = 256, BK = 64, HALF = 128, HTB = HALF * BK * 2  , STAGE_BYTES = 8 * HTB, NXCD = 8, WGM = 8;
__host__ __device__ __forceinline__ int lds_byte(int r, int c) { const int st = (r >> 4) * 2 + (c >> 5), rr = r & 15, cc = c & 31, ob = rr * 64 + cc * 2; return st * 1024 + (ob ^ (((ob >> 9) & 1) << 5)); }
__host__ __device__ __forceinline__ void stage_rc(int b, int& R, int& C) { const int st = b / 1024, sb = b % 1024, swz = sb ^ (((sb >> 9) & 1) << 5); R = (st >> 1) * 16 + swz / 64; C = (st & 1) * 32 + (swz % 64) / 2; }
__host__ __device__ __forceinline__ int perm32(int rho) { const int n = rho >> 4, i = rho & 15; return 8 * (i >> 2) + 4 * n + (i & 3); }

struct Unit { int pm, pn, om, on, e, mt, slot; };
struct Gemm { const bf16_t* A; const bf16_t* Bt; int K; };

__device__ __forceinline__ int xcd_remap(int L, int nwg) { const int q = nwg / NXCD, r = nwg % NXCD, xcd = L % NXCD, off = L / NXCD; return (xcd < r ? xcd * (q + 1) : r * (q + 1) + (xcd - r) * q) + off; }

__device__ __forceinline__ void plain_a_off(int pm, int tid, int K, unsigned (&o)[2][2]) {
#pragma unroll
    for (int i = 0; i < 2; ++i) { int R, C; stage_rc(tid * 16 + i * 8192, R, C);
#pragma unroll
        for (int h = 0; h < 2; ++h) o[h][i] = (unsigned)((pm * BM + h * HALF + R) * K + C) * 2u; }
}
struct TailSplit {
    int U, G, c, rounds, R, s;
    __device__ __forceinline__ void init(int U_, int G_, int c_, int smax) { U = U_; G = G_; c = c_; rounds = U / G; R = U - rounds * G; s = (smax >= 4 && R * 4 <= G) ? 4 : ((smax >= 2 && R * 2 <= G) ? 2 : 1); }
    __device__ __forceinline__ bool map(int i, int& L, int& q) const {
        if (i < rounds) { L = i * G + c; q = 0xF; return true; }
        if (i == rounds && c < R * s) { L = rounds * G + c / s; const int piece = c % s; q = s == 1 ? 0xF : (s == 2 ? (piece ? 0xC : 0x3) : (1 << piece)); return true; }
        return false;
    }
};
struct StaticOrder {
    int nM, nN, nwg; TailSplit ts;
    __device__ void init(int nM_, int nN_, int G_, int c_, int smax = 1) { nM = nM_; nN = nN_; nwg = nM * nN; ts.init(nwg, G_, c_, smax); }
    __device__ __forceinline__ bool tile(int i, int& pm, int& pn, int& q) const {
        int L; if (!ts.map(i, L, q)) return false;
        const int wgid = xcd_remap(L, nwg);
        const int nig = WGM * nN, gid = wgid / nig, fm = gid * WGM, gsz = (nM - fm) < WGM ? (nM - fm) : WGM;
        pm = fm + ((wgid % nig) % gsz); pn = (wgid % nig) / gsz; return true;
    }
    __device__ __forceinline__ bool next(int i, Unit& u) const { int pm, pn, q; if (!tile(i, pm, pn, q)) return false; u.pm = pm; u.pn = pn; u.om = pm; u.on = pn; u.e = 0; u.mt = 0; u.slot = 0; return true; }
    __device__ __forceinline__ void a_off(const Unit& u, int tid, int K, unsigned (&o)[2][2]) const { plain_a_off(u.pm, tid, K, o); }
};

__device__ __forceinline__ unsigned cvt_pk_bf16(float lo, float hi) { unsigned r; asm volatile("v_cvt_pk_bf16_f32 %0, %1, %2" : "=v"(r) : "v"(lo), "v"(hi)); return r; }

template <class Epi, class Sched, bool ALIGN_EPI>
__device__ __forceinline__ void gemm_phase(LAS unsigned char* lds, const Gemm g, const Sched& S, const Epi& E) {
    int tid_ = threadIdx.x; asm volatile("" : "+v"(tid_));
    const int tid = tid_, wid = __builtin_amdgcn_readfirstlane(tid >> 6), lane = tid & 63, wr = wid >> 2, wc = wid & 3, fr = lane & 15, fq = lane >> 4;
    const int K = g.K, nt = K / BK;
    unsigned voffB[2];
#pragma unroll
    for (int i = 0; i < 2; ++i) { int R, C; stage_rc(tid * 16 + i * 8192, R, C); const int Rb = Epi::PERM ? ((R & ~31) + perm32(R & 31)) : R;
        voffB[i] = (unsigned)(Rb * K + C) * 2u; }
    constexpr unsigned kstep = BK * 2;
    const unsigned hstep = (unsigned)HALF * K * 2;
    const unsigned tstep = 2 * hstep;
    const unsigned ldsw = (unsigned)wid * 1024u;
    const int aoff = lds_byte(wr * 64 + fr, fq * 8), boff = lds_byte(wc * 32 + fr, fq * 8);
#define PG8_SA(b, h) (((b) * 2 + (h)) * HTB)
#define PG8_SB(b, h) ((4 + (b) * 2 + (h)) * HTB)
#define PG8_STAGE(bufoff, gbase, voff) do { _Pragma("unroll") for (int _i = 0; _i < 2; ++_i) \
        __builtin_amdgcn_global_load_lds((const unsigned*)((const char*)(gbase) + (voff)[_i]), (LAS unsigned*)(lds + (bufoff) + ldsw + _i * 8192), 16, 0, 0); } while (0)
#define PG8_LDA(dst, b, h) do { _Pragma("unroll") for (int m = 0; m < 4; ++m) _Pragma("unroll") for (int k = 0; k < 2; ++k) dst[m][k] = *(const LAS bf16x8*)(lds + PG8_SA(b, h) + aoff + m * 2048 + k * 1024); } while (0)
#define PG8_LDB(dst, b, h) do { _Pragma("unroll") for (int n = 0; n < 2; ++n) _Pragma("unroll") for (int k = 0; k < 2; ++k) dst[n][k] = *(const LAS bf16x8*)(lds + PG8_SB(b, h) + boff + n * 2048 + k * 1024); } while (0)
#define PG8_MMA(ai, bj, At, Bt) do { __builtin_amdgcn_s_setprio(1); _Pragma("unroll") for (int m = 0; m < 4; ++m) _Pragma("unroll") for (int n = 0; n < 2; ++n) _Pragma("unroll") for (int k = 0; k < 2; ++k) \
        acc[ai][bj][m][n] = __builtin_amdgcn_mfma_f32_16x16x32_bf16(Bt[n][k], At[m][k], acc[ai][bj][m][n], 0, 0, 0); __builtin_amdgcn_s_setprio(0); } while (0)
#define PG8_WAIT_V(n) asm volatile("s_waitcnt vmcnt(" #n ")" ::: "memory")
#define PG8_WAIT_L(n) asm volatile("s_waitcnt lgkmcnt(" #n ")" ::: "memory")
#define PG8_BAR __builtin_amdgcn_s_barrier()
#define PG8_SCHED __builtin_amdgcn_sched_barrier(0)
    Unit cur, nxt; int ui = 0;
    if (!S.next(0, cur)) return;
    f32x4 acc[2][2][4][2];
#pragma unroll
    for (int a = 0; a < 2; ++a)
#pragma unroll
        for (int b = 0; b < 2; ++b)
#pragma unroll
            for (int m = 0; m < 4; ++m)
#pragma unroll
                for (int n = 0; n < 2; ++n) acc[a][b][m][n] = (f32x4){0.f, 0.f, 0.f, 0.f};
    bf16x8 At[4][2], B0[2][2], B1[2][2];
    unsigned aC[2][2];
    S.a_off(cur, tid, K, aC);
    const char* const Ab = (const char*)g.A;
    const char* cB = (const char*)g.Bt + (size_t)cur.pn * tstep;
    PG8_STAGE(PG8_SB(0, 0), cB, voffB); PG8_STAGE(PG8_SB(0, 1), cB + hstep, voffB); PG8_STAGE(PG8_SA(0, 0), Ab, aC[0]); PG8_STAGE(PG8_SA(0, 1), Ab, aC[1]);
    if (wr == 1) PG8_BAR;
    PG8_WAIT_V(2); PG8_BAR;
    PG8_STAGE(PG8_SB(1, 0), cB + kstep, voffB); PG8_STAGE(PG8_SA(1, 0), Ab + kstep, aC[0]); PG8_STAGE(PG8_SB(1, 1), cB + hstep + kstep, voffB);
    PG8_WAIT_V(6); PG8_BAR;
    for (;;) {
        const bool has_next = S.next(ui + 1, nxt);
        const char* nB = has_next ? (const char*)g.Bt + (size_t)nxt.pn * tstep : cB;
        for (int t = 0; t < nt; t += 2) {
            const bool last = (t == nt - 2);
            const char* a1 = Ab + (size_t)(t + 1) * kstep;
            const char* a2 = last ? Ab : Ab + (size_t)(t + 2) * kstep; const char* b2 = last ? nB : cB + (size_t)(t + 2) * kstep;
            const char* a3 = a2 + kstep; const char* b3 = b2 + kstep;
            PG8_LDB(B0, 0, 0); PG8_LDB(B1, 0, 1); PG8_SCHED; PG8_LDA(At, 0, 0); PG8_STAGE(PG8_SA(1, 1), a1, aC[1]);
            if (last && has_next) S.a_off(nxt, tid, K, aC);
            PG8_WAIT_V(8); PG8_WAIT_L(0); PG8_BAR; PG8_MMA(0, 0, At, B0); PG8_MMA(0, 1, At, B1); PG8_BAR; PG8_SCHED;
            PG8_LDA(At, 0, 1); PG8_STAGE(PG8_SB(0, 0), b2, voffB); PG8_STAGE(PG8_SB(0, 1), b2 + hstep, voffB); PG8_STAGE(PG8_SA(0, 0), a2, aC[0]);
            PG8_WAIT_V(8); PG8_WAIT_L(0); PG8_BAR; PG8_MMA(1, 0, At, B0); PG8_MMA(1, 1, At, B1); PG8_BAR; PG8_SCHED;
            PG8_LDB(B0, 1, 0); PG8_LDB(B1, 1, 1); PG8_SCHED; PG8_LDA(At, 1, 0); PG8_STAGE(PG8_SA(0, 1), a2, aC[1]);
            PG8_WAIT_V(8); PG8_WAIT_L(0); PG8_BAR; PG8_MMA(0, 0, At, B0); PG8_MMA(0, 1, At, B1); PG8_BAR; PG8_SCHED;
            PG8_LDA(At, 1, 1); PG8_STAGE(PG8_SB(1, 0), b3, voffB); PG8_STAGE(PG8_SB(1, 1), b3 + hstep, voffB); PG8_STAGE(PG8_SA(1, 0), a3, aC[0]);
            PG8_WAIT_V(8); PG8_WAIT_L(0); PG8_BAR; PG8_MMA(1, 0, At, B0); PG8_MMA(1, 1, At, B1); PG8_BAR; PG8_SCHED;
        }
        if constexpr (ALIGN_EPI) { if (wr == 0) PG8_BAR; }
        E(acc, cur, wr, wc, fr, fq);
        if (!has_next) break;
#pragma unroll
        for (int a = 0; a < 2; ++a)
#pragma unroll
            for (int b = 0; b < 2; ++b)
#pragma unroll
                for (int m = 0; m < 4; ++m)
#pragma unroll
                    for (int n = 0; n < 2; ++n) acc[a][b][m][n] = (f32x4){0.f, 0.f, 0.f, 0.f};
        cur = nxt; cB = nB; ++ui;
        if constexpr (ALIGN_EPI) { if (wr == 1) PG8_BAR; }
    }
    PG8_WAIT_V(0);
    if constexpr (!ALIGN_EPI) { if (wr == 0) PG8_BAR; }
    PG8_BAR;
#undef PG8_SA
#undef PG8_SB
#undef PG8_STAGE
#undef PG8_LDA
#undef PG8_LDB
#undef PG8_MMA
#undef PG8_WAIT_V
#undef PG8_WAIT_L
#undef PG8_BAR
#undef PG8_SCHED
}
}
namespace pg8 {
typedef const f32x4 (&AccRef)[2][2][4][2];

struct EpiInProj {
    static constexpr bool PERM = true;
    unsigned char* ws;
    __device__ __forceinline__ void operator()(AccRef acc, const Unit& u, int wr, int wc, int fr, int fq) const {
        const int pn = u.on, row0 = u.om * BM + wr * 64 + fr, cw = wc * 32 + 8 * fq;
        if (pn >= 4 && pn < 12) {
#pragma unroll
            for (int ai = 0; ai < 2; ++ai)
#pragma unroll
                for (int m = 0; m < 4; ++m) { const f32x4 v0 = acc[ai][0][m][0] * acc[ai][1][m][0], v1 = acc[ai][0][m][1] * acc[ai][1][m][1];
                    u32x4 w; w.x = cvt_pk_bf16(v0[0], v0[1]); w.y = cvt_pk_bf16(v0[2], v0[3]); w.z = cvt_pk_bf16(v1[0], v1[1]); w.w = cvt_pk_bf16(v1[2], v1[3]);
                    *(u32x4*)((bf16_t*)(ws + WS_U) + (size_t)(row0 + ai * HALF + m * 16) * D + (pn - 4) * 128 + cw) = w; }
            return;
        }
        size_t doff; int ldc = D, cb, mode = 0;
        if (pn < 4) { doff = WS_BG; cb = pn * 256; }
        else if (pn < 16) { doff = WS_Q; cb = (pn - 12) * 256; mode = 1; }
        else if (pn == 16) { doff = WS_K; cb = 0; ldc = 256; }
        else if (pn == 17) { doff = WS_V; cb = 0; ldc = 256; }
        else if (pn < 22) { doff = WS_GC; cb = (pn - 18) * 256; mode = 2; }
        else { doff = WS_GA; cb = (pn - 22) * 256; mode = 2; }
        bf16_t* dst = (bf16_t*)(ws + doff);
#pragma unroll
        for (int ai = 0; ai < 2; ++ai)
#pragma unroll
            for (int m = 0; m < 4; ++m) { bf16_t* rowp = dst + (size_t)(row0 + ai * HALF + m * 16) * ldc + cb + cw;
#pragma unroll
                for (int bj = 0; bj < 2; ++bj) { f32x4 v0 = acc[ai][bj][m][0], v1 = acc[ai][bj][m][1];
                    if (mode == 1) { v0 = v0 * QSCALE; v1 = v1 * QSCALE; }
                    if (mode == 2) {
#pragma unroll
                        for (int j = 0; j < 4; ++j) { v0[j] = fast_sigmoid(v0[j]); v1[j] = fast_sigmoid(v1[j]); } }
                    u32x4 w; w.x = cvt_pk_bf16(v0[0], v0[1]); w.y = cvt_pk_bf16(v0[2], v0[3]); w.z = cvt_pk_bf16(v1[0], v1[1]); w.w = cvt_pk_bf16(v1[2], v1[3]);
                    *(u32x4*)(rowp + bj * HALF) = w; } }
    }
};

struct EpiDual {
    static constexpr bool PERM = true;
    unsigned char* ws;
    __device__ __forceinline__ void operator()(AccRef acc, const Unit& u, int wr, int wc, int fr, int fq) const {
        const int row0 = u.om * BM + wr * 64 + fr, col0 = u.on * BM + wc * 32 + 8 * fq;
        const bf16_t* G = (const bf16_t*)(ws + (u.e == 0 ? WS_GC : WS_GA)); float* T1 = (float*)(ws + WS_T1); bf16_t* MG = (bf16_t*)(ws + WS_MG);
#pragma unroll
        for (int ai = 0; ai < 2; ++ai)
#pragma unroll
            for (int m = 0; m < 4; ++m) { const size_t ro = (size_t)(row0 + ai * HALF + m * 16) * D + col0;
#pragma unroll
                for (int bj = 0; bj < 2; ++bj) { const size_t o = ro + bj * HALF;
                    const u32x4 gw = *(const u32x4*)(G + o);
                    f32x4 g0 = {bflo(gw.x), bfhi(gw.x), bflo(gw.y), bfhi(gw.y)}, g1 = {bflo(gw.z), bfhi(gw.z), bflo(gw.w), bfhi(gw.w)};
                    f32x4 v0 = g0 * acc[ai][bj][m][0], v1 = g1 * acc[ai][bj][m][1];
                    if (u.e == 0) { *(f32x4*)(T1 + o) = v0; *(f32x4*)(T1 + o + 4) = v1; }
                    else { v0 = v0 + *(const f32x4*)(T1 + o); v1 = v1 + *(const f32x4*)(T1 + o + 4);
                        u32x4 w; w.x = cvt_pk_bf16(v0[0], v0[1]); w.y = cvt_pk_bf16(v0[2], v0[3]); w.z = cvt_pk_bf16(v1[0], v1[1]); w.w = cvt_pk_bf16(v1[2], v1[3]);
                        *(u32x4*)(MG + o) = w; } } }
    }
};

struct EpiResid {
    static constexpr bool PERM = false;
    const float* X; float* C;
    __device__ __forceinline__ void operator()(AccRef acc, const Unit& u, int wr, int wc, int fr, int fq) const {
        const int row0 = u.om * BM + wr * 64 + fr, col0 = u.on * BM + wc * 32 + 4 * fq;
#pragma unroll
        for (int ai = 0; ai < 2; ++ai)
#pragma unroll
            for (int m = 0; m < 4; ++m) { const size_t ro = (size_t)(row0 + ai * HALF + m * 16) * D + col0;
#pragma unroll
                for (int bj = 0; bj < 2; ++bj)
#pragma unroll
                    for (int n = 0; n < 2; ++n) { const size_t o = ro + bj * HALF + n * 16; *(f32x4*)(C + o) = *(const f32x4*)(X + o) * DN_ALPHA + acc[ai][bj][m][n]; } }
    }
};

struct EpiF32 {
    static constexpr bool PERM = false;
    float* C;
    __device__ __forceinline__ void operator()(AccRef acc, const Unit& u, int wr, int wc, int fr, int fq) const {
        const int row0 = u.om * BM + wr * 64 + fr, col0 = u.on * BM + wc * 32 + 4 * fq;
#pragma unroll
        for (int ai = 0; ai < 2; ++ai)
#pragma unroll
            for (int m = 0; m < 4; ++m) { const size_t ro = (size_t)(row0 + ai * HALF + m * 16) * D + col0;
#pragma unroll
                for (int bj = 0; bj < 2; ++bj)
#pragma unroll
                    for (int n = 0; n < 2; ++n) *(f32x4*)(C + ro + bj * HALF + n * 16) = acc[ai][bj][m][n]; }
    }
};
__device__ __forceinline__ void ple_epilogue(AccRef acc, const Unit& u, int wr, int wc, int fr, int fq, const float* P2, bf16_t* PLE) {
    const int row0 = u.om * BM + wr * 64 + fr, col0 = u.on * BM + wc * 32 + 8 * fq;
#pragma unroll
    for (int ai = 0; ai < 2; ++ai)
#pragma unroll
        for (int m = 0; m < 4; ++m) { const size_t ro = (size_t)(row0 + ai * HALF + m * 16) * D + col0;
#pragma unroll
            for (int bj = 0; bj < 2; ++bj) { const size_t o = ro + bj * HALF; const f32x4 p0 = *(const f32x4*)(P2 + o), p1 = *(const f32x4*)(P2 + o + 4); const f32x4 a0 = acc[ai][bj][m][0], a1 = acc[ai][bj][m][1];
                u32x4 w; w.x = cvt_pk_bf16(fast_sigmoid(a0[0]) * p0[0], fast_sigmoid(a0[1]) * p0[1]); w.y = cvt_pk_bf16(fast_sigmoid(a0[2]) * p0[2], fast_sigmoid(a0[3]) * p0[3]);
                w.z = cvt_pk_bf16(fast_sigmoid(a1[0]) * p1[0], fast_sigmoid(a1[1]) * p1[1]); w.w = cvt_pk_bf16(fast_sigmoid(a1[2]) * p1[2], fast_sigmoid(a1[3]) * p1[3]);
                *(u32x4*)(PLE + o) = w; }
            if (m & 1) asm volatile("" ::: "memory"); }
}

struct EpiSwiglu {
    static constexpr bool PERM = true;
    bf16_t* H; const float* b_gu; const LAS unsigned* tw; unsigned char* ws;
    __device__ __forceinline__ void operator()(AccRef acc, const Unit& u, int wr, int wc, int fr, int fq) const {
        if (u.e < 0) { ple_epilogue(acc, u, wr, wc, fr, fq, (const float*)(ws + WS_P2), (bf16_t*)(ws + WS_PLE)); return; }
        const int trow0 = wr * 64 + fr, row0 = u.om * BM + trow0, cw = wc * 32 + 8 * fq, col0 = u.on * 128 + cw;
        const float* bg = b_gu + (size_t)u.e * 2048 + col0;
#pragma unroll
        for (int n = 0; n < 2; ++n) { const f32x4 bgn = *(const f32x4*)(bg + 4 * n), bun = *(const f32x4*)(bg + 1024 + 4 * n);
#pragma unroll
            for (int ai = 0; ai < 2; ++ai)
#pragma unroll
                for (int m = 0; m < 4; ++m) { const float w = bfhi(tw[u.slot * BM + trow0 + ai * HALF + m * 16]);
                    const f32x4 gt = acc[ai][0][m][n] + bgn, up = acc[ai][1][m][n] + bun; f32x4 hv;
#pragma unroll
                    for (int j = 0; j < 4; ++j) { const float gv = fminf(gt[j], 7.0f), uv = fminf(fmaxf(up[j], -7.0f), 7.0f); hv[j] = (uv + 1.0f) * gv * fast_sigmoid(1.702f * gv) * w; }
                    u32x2 o; o.x = cvt_pk_bf16(hv[0], hv[1]); o.y = cvt_pk_bf16(hv[2], hv[3]);
                    *(u32x2*)(H + (size_t)(row0 + ai * HALF + m * 16) * D + col0 + 4 * n) = o; } }
    }
};
struct EpiDown {
    static constexpr bool PERM = true;
    bf16_t* Y; unsigned char* ws;
    __device__ __forceinline__ void operator()(AccRef acc, const Unit& u, int wr, int wc, int fr, int fq) const {
        if (u.e < 0) { ple_epilogue(acc, u, wr, wc, fr, fq, (const float*)(ws + WS_P2), (bf16_t*)(ws + WS_PLE)); return; }
        bf16_t* yp = Y + (size_t)(u.om * BM + wr * 64 + fr) * D + u.on * BM + wc * 32 + 8 * fq;
#pragma unroll
        for (int ai = 0; ai < 2; ++ai)
#pragma unroll
            for (int m = 0; m < 4; ++m)
#pragma unroll
                for (int bj = 0; bj < 2; ++bj) { const f32x4 v0 = acc[ai][bj][m][0], v1 = acc[ai][bj][m][1];
                    u32x4 o; o.x = cvt_pk_bf16(v0[0], v0[1]); o.y = cvt_pk_bf16(v0[2], v0[3]); o.z = cvt_pk_bf16(v1[0], v1[1]); o.w = cvt_pk_bf16(v1[2], v1[3]);
                    *(u32x4*)(yp + (size_t)(ai * HALF + m * 16) * D + bj * HALF) = o; }
    }
};

struct DualOrder {
    StaticOrder so;
    __device__ __forceinline__ bool next(int i, Unit& u) const {
        int pm, pn, q; if (!so.tile(i >> 1, pm, pn, q)) return false;
        const int e = i & 1; u.pm = e * (M / BM) + pm; u.pn = e * 4 + pn; u.om = pm; u.on = pn; u.e = e; u.mt = 0; u.slot = 0; return true;
    }
    __device__ __forceinline__ void a_off(const Unit& u, int tid, int K, unsigned (&o)[2][2]) const { plain_a_off(u.pm, tid, K, o); }
};
struct MoeOrder {
    const LAS int* cntL; const LAS int* tsL; const LAS unsigned* tw; int NT, gather, btile0, n_extra, extra_first; unsigned abase; TailSplit ts; int U;
    __device__ __forceinline__ void init(const LAS int* cntL_, const LAS int* tsL_, const LAS unsigned* tw_, int NT_, int G_, int c_, int gather_, size_t aoff_, size_t boff_, int n_extra_, int extra_first_) {
        cntL = cntL_; tsL = tsL_; tw = tw_; NT = NT_; gather = gather_; abase = (unsigned)aoff_; btile0 = (int)(boff_ >> 19); n_extra = n_extra_; extra_first = extra_first_;
        U = __builtin_amdgcn_readfirstlane(tsL_[NE]) * NT_; ts.init(U + n_extra_, G_, c_, 1); }
    __device__ __forceinline__ bool next(int i, Unit& u) const {
        int L, q; if (!ts.map(i, L, q)) return false;
        if (L >= U) { const int j = extra_first + (L - U), pm = (j >> 5) * 8 + (j & 7), pn = (j & 31) >> 3;
            u.pm = pm; u.pn = (int)(WS_WPG >> 19) + pn; u.om = pm; u.on = pn; u.e = -1; u.mt = 0; u.slot = 0; return true; }
        const int wgid = xcd_remap(L, U);
        int e = 0;
        for (int k = 1; k < NE; ++k) e += (wgid >= __builtin_amdgcn_readfirstlane(tsL[k]) * NT) ? 1 : 0;
        const int t0 = __builtin_amdgcn_readfirstlane(tsL[e]), ntl = __builtin_amdgcn_readfirstlane(tsL[e + 1]) - t0, r = wgid - t0 * NT;
        const int nt = r / ntl, mt = r - nt * ntl;
        u.pm = t0 + mt; u.pn = btile0 + e * NT + nt; u.om = t0 + mt; u.on = nt; u.e = e; u.mt = mt; u.slot = i; return true;
    }
    __device__ __forceinline__ void a_off(const Unit& u, int tid, int K, unsigned (&o)[2][2]) const {
        if (u.e < 0 || !gather) { plain_a_off(u.pm, tid, K, o); const unsigned base = u.e < 0 ? (unsigned)WS_X1B : abase;
#pragma unroll
            for (int h = 0; h < 2; ++h)
#pragma unroll
                for (int i = 0; i < 2; ++i) o[h][i] += base;
            return; }
#pragma unroll
        for (int i = 0; i < 2; ++i) { int R, C; stage_rc(tid * 16 + i * 8192, R, C);
#pragma unroll
            for (int h = 0; h < 2; ++h) { const int tok = (int)(tw[u.slot * BM + h * HALF + R] & 0xffffu);
                o[h][i] = (unsigned)(tok * K + C) * 2u + abase; } }
    }
};
constexpr int MOE_MAXU = 10;
__device__ __forceinline__ void moe_preload(const MoeOrder& S, const LAS int* cntL, const int* list_tok, const float* list_w, LAS unsigned* tw) {
    Unit u;
    for (int i = 0; i < MOE_MAXU && S.next(i, u); ++i)
        if (u.e >= 0 && threadIdx.x < BM) { const int li = u.mt * BM + (int)threadIdx.x; unsigned v = 0u;
            if (li < cntL[u.e]) v = (unsigned)list_tok[(size_t)u.e * LISTCAP + li] | (f2bf(list_w[(size_t)u.e * LISTCAP + li]) << 16);
            tw[i * BM + threadIdx.x] = v; }
    __syncthreads();
}
struct Ple1Order {
    int first, n;
    __device__ __forceinline__ bool next(int i, Unit& u) const { if (i >= n) return false; const int j = first + i, pm = (j >> 5) * 8 + (j & 7), pn = (j & 31) >> 3;
        u.pm = pm; u.pn = pn; u.om = pm; u.on = pn; u.e = 0; u.mt = 0; u.slot = 0; return true; }
    __device__ __forceinline__ void a_off(const Unit& u, int tid, int K, unsigned (&o)[2][2]) const { plain_a_off(u.pm, tid, K, o); }
};
}
__device__ __forceinline__ int dst_row(int n, int map) {
    if (map == 1) { if (n >= 1024 && n < 3072) { const int hsel = n >= 2048, c = n - 1024 - hsel * 1024; return 1024 + (c >> 7) * 256 + hsel * 128 + (c & 127); } return n; }
    if (map == 2) { const int hsel = n >= 1024, c = n - hsel * 1024; return (c >> 7) * 256 + hsel * 128 + (c & 127); }
    return n;
}
__device__ __forceinline__ void p0_item(const float* W, int K, int N, bf16_t* WT, int map, LAS float* scr, int item, int lane) {
    const int nblk = N / 64, kb = item / nblk, nb = item - kb * nblk, k0 = 64 * kb, n0 = 64 * nb;
    const int lr = lane >> 4, lc = (lane & 15) * 4;
    f32x4 v[16];
#pragma unroll
    for (int i = 0; i < 16; ++i) v[i] = *(const f32x4*)(W + (size_t)(k0 + 4 * i + lr) * N + n0 + lc);
#pragma unroll
    for (int i = 0; i < 16; ++i) { LAS float* s = scr + (4 * i + lr) * 65 + lc; s[0] = v[i][0]; s[1] = v[i][1]; s[2] = v[i][2]; s[3] = v[i][3]; }
    asm volatile("s_waitcnt lgkmcnt(0)" ::: "memory");
    const int c = lane & 7;
    const int drow0 = dst_row(n0, map);
#pragma unroll
    for (int j = 0; j < 8; ++j) { const int n = (lane >> 3) + 8 * j; const LAS float* s = scr + (8 * c) * 65 + n;
        u32x4 o; o.x = pk2(s[0 * 65], s[1 * 65]); o.y = pk2(s[2 * 65], s[3 * 65]); o.z = pk2(s[4 * 65], s[5 * 65]); o.w = pk2(s[6 * 65], s[7 * 65]);
        *(u32x4*)(WT + (size_t)(drow0 + n) * K + k0 + 8 * c) = o; }
    asm volatile("s_waitcnt lgkmcnt(0)" ::: "memory");
}
struct P0Args { const float *x, *p, *w_in, *w_brc, *w_bra, *w_out, *w_pg, *w_pp, *w_gu, *w_dn; unsigned char* ws; };
__device__ __forceinline__ void p0_phase(const P0Args& a, LAS unsigned char* lds, int vcu, int G) {
    int tid_ = threadIdx.x; asm volatile("" : "+v"(tid_));
    const int tid = tid_, lane = tid & 63, wave = __builtin_amdgcn_readfirstlane(tid >> 6);
    LAS float* scr = (LAS float*)(lds + wave * 16640);
    const int gw = vcu * NWAVES + wave, NGW = G * NWAVES;
    constexpr int I_IN = 16 * (NIN / 64), I_SQ = 16 * 16, I_PP = 4 * 16, I_GU = 16 * 32, I_DN = 16 * 16;
    constexpr int NITEMS = I_IN + 4 * I_SQ + I_PP + NE * I_GU + NE * I_DN;
    for (int it = gw; it < NITEMS; it += NGW) {
        int r = it;
        if (r < I_IN) { p0_item(a.w_in, D, NIN, (bf16_t*)(a.ws + WS_WIN), 1, scr, r, lane); continue; } r -= I_IN;
        if (r < I_SQ) { p0_item(a.w_brc, D, D, (bf16_t*)(a.ws + WS_WBR), 0, scr, r, lane); continue; } r -= I_SQ;
        if (r < I_SQ) { p0_item(a.w_bra, D, D, (bf16_t*)(a.ws + WS_WBR) + (size_t)D * D, 0, scr, r, lane); continue; } r -= I_SQ;
        if (r < I_SQ) { p0_item(a.w_out, D, D, (bf16_t*)(a.ws + WS_WOUT), 0, scr, r, lane); continue; } r -= I_SQ;
        if (r < I_SQ) { p0_item(a.w_pg, D, D, (bf16_t*)(a.ws + WS_WPG), 0, scr, r, lane); continue; } r -= I_SQ;
        if (r < I_PP) { p0_item(a.w_pp, DPLE, D, (bf16_t*)(a.ws + WS_WPP), 0, scr, r, lane); continue; } r -= I_PP;
        if (r < NE * I_GU) { const int e = r / I_GU; p0_item(a.w_gu + (size_t)e * D * 2048, D, 2048, (bf16_t*)(a.ws + WS_WGU) + (size_t)e * 2048 * D, 2, scr, r - e * I_GU, lane); continue; } r -= NE * I_GU;
        { const int e = r / I_DN; p0_item(a.w_dn + (size_t)e * D * D, D, D, (bf16_t*)(a.ws + WS_WDN) + (size_t)e * D * D, 0, scr, r - e * I_DN, lane); }
    }
    const int gt = vcu * NTHREADS + tid, NGT = G * NTHREADS;
    for (int i = gt; i < M * D / 8; i += NGT) { const f32x4 v0 = *(const f32x4*)(a.x + (size_t)i * 8), v1 = *(const f32x4*)(a.x + (size_t)i * 8 + 4);
        u32x4 o; o.x = pk2(v0[0], v0[1]); o.y = pk2(v0[2], v0[3]); o.z = pk2(v1[0], v1[1]); o.w = pk2(v1[2], v1[3]); *(u32x4*)((bf16_t*)(a.ws + WS_XB) + (size_t)i * 8) = o; }
    for (int i = gt; i < M * DPLE / 8; i += NGT) { const f32x4 v0 = *(const f32x4*)(a.p + (size_t)i * 8), v1 = *(const f32x4*)(a.p + (size_t)i * 8 + 4);
        u32x4 o; o.x = pk2(v0[0], v0[1]); o.y = pk2(v0[2], v0[3]); o.z = pk2(v1[0], v1[1]); o.w = pk2(v1[2], v1[3]); *(u32x4*)((bf16_t*)(a.ws + WS_PB) + (size_t)i * 8) = o; }
}

__device__ __forceinline__ int crow(int r, int hi) { return (r & 3) + 8 * (r >> 2) + 4 * hi; }
typedef short v4i16_t __attribute__((ext_vector_type(4)));
__device__ __forceinline__ s16x4 vtr(const LAS unsigned char* p) { return __builtin_bit_cast(s16x4, __builtin_amdgcn_ds_read_tr16_b64_v4i16((LAS v4i16_t*)p)); }
__device__ __forceinline__ void attn_unit(LAS unsigned char* lds, const bf16_t* Q, const bf16_t* Kg, const bf16_t* Vg, const float* sinks, bf16_t* O, int b, int kvh, int nb) {
    int tid_ = threadIdx.x; asm volatile("" : "+v"(tid_));
    const int tid = tid_, lane = tid & 63, r32 = lane & 31, hi = lane >> 5; const int wid = __builtin_amdgcn_readfirstlane(tid >> 6);
    const int t0 = b * SEQ + nb * 128;
#pragma unroll
    for (int it = 0; it < 4; ++it) { const int idx = tid + it * NTHREADS, key = idx >> 3, c = idx & 7;
        int row = t0 - 128 + key; if (row < b * SEQ) row = b * SEQ;
        const u32x4 kv = *(const u32x4*)(Kg + (size_t)row * 256 + kvh * HD + c * 8);
        const u32x4 vv = *(const u32x4*)(Vg + (size_t)row * 256 + kvh * HD + c * 8);
        *(LAS u32x4*)(lds + c * 4096 + key * 16) = kv;
        *(LAS u32x4*)(lds + 32768 + (c >> 2) * 16384 + (key >> 4) * 1024 + (key & 15) * 64 + (c & 3) * 16) = vv; }
    __syncthreads();
    const int g = wid >> 1, half = wid & 1, h = kvh * 4 + g;
    const float sink2 = sinks[h] * LOG2E;
    const LAS unsigned char* vbase = lds + 32768 + ((lane >> 4) & 1) * 32 + (lane & 3) * 8 + (4 * hi + ((lane & 15) >> 2)) * 64;
#pragma unroll 1
    for (int qq = 0; qq < 2; ++qq) {
        const int qt = half * 2 + qq;
        const bf16_t* qp = Q + (size_t)(t0 + 32 * qt + r32) * D + h * HD + hi * 8;
        bf16x8 qr[4];
#pragma unroll
        for (int d0 = 0; d0 < 4; ++d0) qr[d0] = *(const bf16x8*)(qp + d0 * 16);
        f32x16 s[5];
#pragma unroll
        for (int j = 0; j < 5; ++j) { const LAS unsigned char* kp = lds + hi * 4096 + ((qt + j) * 32 + r32) * 16; f32x16 a = {};
#pragma unroll
            for (int d0 = 0; d0 < 4; ++d0) a = __builtin_amdgcn_mfma_f32_32x32x16_bf16(*(const LAS bf16x8*)(kp + d0 * 8192), qr[d0], a, 0, 0, 0);
            s[j] = a; }
#pragma unroll
        for (int r = 0; r < 16; ++r) { const int cr = crow(r, hi); if (cr <= r32) s[0][r] = -INFINITY; if (cr > r32) s[4][r] = -INFINITY; }
        if (nb == 0) {
#pragma unroll
            for (int j = 0; j < 4; ++j) if (qt + j < 4) {
#pragma unroll
                for (int r = 0; r < 16; ++r) s[j][r] = -INFINITY; } }
        float mx = -INFINITY;
#pragma unroll
        for (int j = 0; j < 5; ++j)
#pragma unroll
            for (int r = 0; r < 16; ++r) mx = fmaxf(mx, s[j][r]);
        mx = fmaxf(mx, __shfl_xor(mx, 32)); mx = fmaxf(mx, sink2);
        float ls = 0.f;
#pragma unroll
        for (int j = 0; j < 5; ++j)
#pragma unroll
            for (int r = 0; r < 16; ++r) { s[j][r] = __builtin_amdgcn_exp2f(s[j][r] - mx); ls += s[j][r]; }
        ls += __shfl_xor(ls, 32); ls += __builtin_amdgcn_exp2f(sink2 - mx);
        const float linv = 1.0f / ls;
        f32x16 o[2]; o[0] = f32x16{}; o[1] = f32x16{};
#pragma unroll
        for (int j = 0; j < 5; ++j)
#pragma unroll
            for (int ks = 0; ks < 2; ++ks) {
                u32x4 pw; pw.x = pk2(s[j][8 * ks + 0], s[j][8 * ks + 1]); pw.y = pk2(s[j][8 * ks + 2], s[j][8 * ks + 3]); pw.z = pk2(s[j][8 * ks + 4], s[j][8 * ks + 5]); pw.w = pk2(s[j][8 * ks + 6], s[j][8 * ks + 7]);
                const bf16x8 pa = __builtin_bit_cast(bf16x8, pw);
                const LAS unsigned char* vp = vbase + ((qt + j) * 2 + ks) * 1024;
#pragma unroll
                for (int dh = 0; dh < 2; ++dh) { const s16x4 lo = vtr(vp + dh * 16384), hi4 = vtr(vp + dh * 16384 + 512);
                    const bf16x8 vf = {lo[0], lo[1], lo[2], lo[3], hi4[0], hi4[1], hi4[2], hi4[3]};
                    o[dh] = __builtin_amdgcn_mfma_f32_32x32x16_bf16(pa, vf, o[dh], 0, 0, 0); } }
        bf16_t* op = O + (size_t)(t0 + 32 * qt) * D + h * HD + r32;
#pragma unroll
        for (int r = 0; r < 16; ++r) { const int q = crow(r, hi); const float sc = __shfl(linv, q);
            op[(size_t)q * D] = (bf16_t)f2bf(o[0][r] * sc); op[(size_t)q * D + 32] = (bf16_t)f2bf(o[1][r] * sc); }
    }
    __syncthreads();
}
__device__ __forceinline__ void conv_phase(const bf16_t* Bg, const bf16_t* U, const float* cw, bf16_t* Z, int vcu, int G) {
    int tid_ = threadIdx.x; asm volatile("" : "+v"(tid_));
    const int gt = vcu * NTHREADS + tid_, NGT = G * NTHREADS;
    for (int i = gt; i < M * (D / 8); i += NGT) {
        const int t = i >> 7, c = (i & 127) * 8, tl = t & (SEQ - 1);
        float y[8];
#pragma unroll
        for (int j = 0; j < 8; ++j) y[j] = 0.f;
#pragma unroll
        for (int k = 0; k < 3; ++k) { const int dt = k - 2; if (tl + dt >= 0) { const u32x4 uw = *(const u32x4*)(U + (size_t)(t + dt) * D + c);
            const f32x4 w0 = *(const f32x4*)(cw + k * D + c), w1 = *(const f32x4*)(cw + k * D + c + 4);
            y[0] += w0[0] * bflo(uw.x); y[1] += w0[1] * bfhi(uw.x); y[2] += w0[2] * bflo(uw.y); y[3] += w0[3] * bfhi(uw.y);
            y[4] += w1[0] * bflo(uw.z); y[5] += w1[1] * bfhi(uw.z); y[6] += w1[2] * bflo(uw.w); y[7] += w1[3] * bfhi(uw.w); } }
        const u32x4 bw = *(const u32x4*)(Bg + (size_t)t * D + c);
        u32x4 o; o.x = pk2(y[0] * bflo(bw.x), y[1] * bfhi(bw.x)); o.y = pk2(y[2] * bflo(bw.y), y[3] * bfhi(bw.y)); o.z = pk2(y[4] * bflo(bw.z), y[5] * bfhi(bw.z)); o.w = pk2(y[6] * bflo(bw.w), y[7] * bfhi(bw.w));
        *(u32x4*)(Z + (size_t)t * D + c) = o;
    }
}

#ifndef DBG_ATTN
#define DBG_ATTN 0
#endif
#if DBG_ATTN
__device__ __forceinline__ void dbg_attn_check(const bf16_t* Q, const bf16_t* Kg, const bf16_t* Vg, const float* sinks, const bf16_t* O, float* acc3, int vcu, int G) {
    const int lane = threadIdx.x & 63, wave = threadIdx.x >> 6;
    const int gw = vcu * NWAVES + wave, nw = G * NWAVES;
    float lnum = 0.f, lden = 0.f, lmax = 0.f;
    for (int it = gw; it < M * NH; it += nw) {
        const int t = it / NH, h = it % NH, kvh = h / 4, tl = t % SEQ;
        const int slo = tl - 127 < 0 ? 0 : tl - 127, n = tl - slo + 1;
        const bf16_t* qp = Q + (size_t)t * D + h * HD;
        float sc[2];
#pragma unroll
        for (int u = 0; u < 2; ++u) { const int j = lane + 64 * u; float dot = -INFINITY;
            if (j < n) { const bf16_t* kp = Kg + (size_t)(t - tl + slo + j) * 256 + kvh * HD; dot = 0.f;
                for (int d = 0; d < HD; ++d) dot = fmaf(bflo((unsigned)qp[d]), bflo((unsigned)kp[d]), dot);
                dot *= (1.0f / LOG2E); }
            sc[u] = dot; }
        const float sink = sinks[h];
        float m = fmaxf(sc[0], sc[1]);
        for (int o = 1; o < 64; o <<= 1) m = fmaxf(m, __shfl_xor(m, o));
        m = fmaxf(m, sink);
        float e0 = (lane < n) ? expf(sc[0] - m) : 0.f, e1 = (lane + 64 < n) ? expf(sc[1] - m) : 0.f;
        float s = e0 + e1;
        for (int o = 1; o < 64; o <<= 1) s += __shfl_xor(s, o);
        const float denom = s + expf(sink - m);
        e0 /= denom; e1 /= denom;
        float a = 0.f;
        for (int j = 0; j < n; ++j) { const float pj = __shfl(j < 64 ? e0 : e1, j & 63); a = fmaf(pj, bflo((unsigned)Vg[(size_t)(t - tl + slo + j) * 256 + kvh * HD + lane]), a); }
        const float o = bflo((unsigned)O[(size_t)t * D + h * HD + lane]);
        const float rn = wave_sum((o - a) * (o - a)), rd = wave_sum(a * a);
        lnum += rn; lden += rd; lmax = fmaxf(lmax, rn / fmaxf(rd, 1e-20f));
    }
    if (lane == 0) { atomicAdd(acc3, lnum); atomicAdd(acc3 + 1, lden); atomicMax((unsigned*)(acc3 + 2), __float_as_uint(lmax)); }
}
#endif
constexpr int WR_STRIDE = 1028;
struct RouteArgs { float* X1F; bf16_t* X1B; const float *g1, *b1, *w_r, *b_r; int* gcnt; int* list_tok; float* list_w; int* tk_e; int* tk_rank; float* tk_w; };
__device__ __forceinline__ void route_phase(const RouteArgs& a, LAS unsigned char* lds, int vcu, int G, bool dry) {
    int tid_ = threadIdx.x; asm volatile("" : "+v"(tid_));
    const int tid = tid_, lane = tid & 63, wave = __builtin_amdgcn_readfirstlane(tid >> 6);
    LAS float* wrt = (LAS float*)lds;
    LAS int* misc = (LAS int*)(lds + MISC_OFF);
    LAS int* lcnt = misc + 96; LAS int* gbase = misc + 128; LAS int* rowe = misc + 160; LAS float* roww = (LAS float*)(misc + 416); LAS int* lrank = misc + 672;
    for (int i = tid; i < D * NE; i += NTHREADS) { const int c = i >> 5, e = i & 31; wrt[e * WR_STRIDE + c] = a.w_r[i]; }
    if (tid < NE) lcnt[tid] = 0;
    __syncthreads();
    const int rows_per_wg = M / G;
    for (int rr = wave; rr < rows_per_wg; rr += NWAVES) {
        const int t = vcu * rows_per_wg + rr;
        f32x4 v[4]; float s = 0.f;
#pragma unroll
        for (int j = 0; j < 4; ++j) { v[j] = *(const f32x4*)(a.X1F + (size_t)t * D + 256 * j + 4 * lane); s += (v[j][0] + v[j][1]) + (v[j][2] + v[j][3]); }
        const float mean = wave_sum(s) * (1.0f / D); float q = 0.f;
#pragma unroll
        for (int j = 0; j < 4; ++j) { v[j] = v[j] - mean; q += (v[j][0] * v[j][0] + v[j][1] * v[j][1]) + (v[j][2] * v[j][2] + v[j][3] * v[j][3]); }
        const float rstd = 1.0f / sqrtf(wave_sum(q) * (1.0f / D) + LN_EPS);
#pragma unroll
        for (int j = 0; j < 4; ++j) { const f32x4 gg = *(const f32x4*)(a.g1 + 256 * j + 4 * lane), bb = *(const f32x4*)(a.b1 + 256 * j + 4 * lane);
            v[j] = v[j] * rstd * gg + bb;
            if (!dry) { *(f32x4*)(a.X1F + (size_t)t * D + 256 * j + 4 * lane) = v[j];
            u32x2 w; w.x = pk2(v[j][0], v[j][1]); w.y = pk2(v[j][2], v[j][3]); *(u32x2*)(a.X1B + (size_t)t * D + 256 * j + 4 * lane) = w; } }
        float pl[32];
#pragma unroll
        for (int e = 0; e < 32; ++e) { float acc = 0.f;
#pragma unroll
            for (int j = 0; j < 4; ++j) { const f32x4 w = *(const LAS f32x4*)(wrt + e * WR_STRIDE + 256 * j + 4 * lane); acc += (v[j][0] * w[0] + v[j][1] * w[1]) + (v[j][2] * w[2] + v[j][3] * w[3]); }
            pl[e] = acc; }
#pragma unroll
        for (int o = 32, n = 16; o >= 2; o >>= 1, n >>= 1) { const bool up = (lane & o) != 0;
#pragma unroll
            for (int i = 0; i < 16; ++i) if (i < n) { const float send = up ? pl[i] : pl[i + n], keep = up ? pl[i + n] : pl[i]; pl[i] = keep + __shfl_xor(send, o); } }
        float logit = pl[0] + __shfl_xor(pl[0], 1);
        const int myexp = lane >> 1;
        logit += a.b_r[myexp];
        int se[4]; float sv[4];
#pragma unroll
        for (int k = 0; k < 4; ++k) { float bv = logit; int bi = myexp;
#pragma unroll
            for (int o = 1; o < 64; o <<= 1) { const float ov = __shfl_xor(bv, o); const int oi = __shfl_xor(bi, o); if (ov > bv || (ov == bv && oi < bi)) { bv = ov; bi = oi; } }
            se[k] = bi; sv[k] = bv; if (myexp == bi) logit = -INFINITY; }
        const float e1 = __expf(sv[1] - sv[0]), e2 = __expf(sv[2] - sv[0]), e3 = __expf(sv[3] - sv[0]);
        const float inv = 1.0f / (1.0f + e1 + e2 + e3);
        if (lane < 4) { const int e = lane == 0 ? se[0] : lane == 1 ? se[1] : lane == 2 ? se[2] : se[3];
            const float w = (lane == 0 ? 1.0f : lane == 1 ? e1 : lane == 2 ? e2 : e3) * inv;
            rowe[rr * 4 + lane] = e; roww[rr * 4 + lane] = w; }
    }
    __syncthreads();
    if (dry) return;
    const int nent = rows_per_wg * 4;
    int my_e = 0, my_lr = 0;
    if (tid < nent) { my_e = rowe[tid]; my_lr = atomicAdd((int*)(lcnt + my_e), 1); }
    __syncthreads();
    if (tid < NE) gbase[tid] = atomicAdd(a.gcnt + tid, lcnt[tid]);
    __syncthreads();
    if (tid < nent) { const int t = vcu * rows_per_wg + (tid >> 2), rank = gbase[my_e] + my_lr;
        a.list_tok[(size_t)my_e * LISTCAP + rank] = t; a.list_w[(size_t)my_e * LISTCAP + rank] = roww[tid];
        a.tk_e[t * 4 + (tid & 3)] = my_e; a.tk_rank[t * 4 + (tid & 3)] = rank; a.tk_w[t * 4 + (tid & 3)] = roww[tid]; }
    __syncthreads();
}
__device__ __forceinline__ void build_tables(const int* gcnt, LAS unsigned char* lds) {
    LAS int* misc = (LAS int*)(lds + MISC_OFF);
    if (threadIdx.x == 0) { int a = 0; for (int e = 0; e < NE; ++e) { const int c = __hip_atomic_load(gcnt + e, __ATOMIC_RELAXED, __HIP_MEMORY_SCOPE_AGENT); misc[e] = c; misc[32 + e] = a; a += (c + 255) >> 8; } misc[32 + NE] = a; }
    __syncthreads();
}
struct FinalArgs { float dbg_scale; int pad_; const float* X1F; const bf16_t* PLE; const bf16_t* Y; const int* tk_e; const int* tk_rank; const float* tk_w; const float* b_down; const float *g2, *b2; float* out; };
__device__ __forceinline__ void final_phase(const FinalArgs& a, LAS unsigned char* lds, int vcu, int G) {
    int tid_ = threadIdx.x; asm volatile("" : "+v"(tid_));
    const int tid = tid_, lane = tid & 63, wave = __builtin_amdgcn_readfirstlane(tid >> 6);
    const LAS int* ts = (const LAS int*)(lds + MISC_OFF) + 32;
    const int gw = vcu * NWAVES + wave, NGW = G * NWAVES;
    for (int t = gw; t < M; t += NGW) {
        size_t pos[4]; int ek[4]; float wk[4];
#pragma unroll
        for (int k = 0; k < 4; ++k) { const int e = a.tk_e[t * 4 + k], rk = a.tk_rank[t * 4 + k]; pos[k] = ((size_t)ts[e] * 256 + rk) * D; ek[k] = e * D; wk[k] = a.tk_w[t * 4 + k]; }
        f32x4 v[4]; float s = 0.f;
#pragma unroll
        for (int j = 0; j < 4; ++j) { const int c = 256 * j + 4 * lane;
            f32x4 x = *(const f32x4*)(a.X1F + (size_t)t * D + c) * DN_ALPHA;
            const u32x2 pw = *(const u32x2*)(a.PLE + (size_t)t * D + c);
            x[0] += bflo(pw.x); x[1] += bfhi(pw.x); x[2] += bflo(pw.y); x[3] += bfhi(pw.y);
#pragma unroll
            for (int k = 0; k < 4; ++k) { const u32x2 yw = *(const u32x2*)(a.Y + pos[k] + c); const f32x4 bd = *(const f32x4*)(a.b_down + ek[k] + c);
                x[0] += bflo(yw.x) + wk[k] * bd[0]; x[1] += bfhi(yw.x) + wk[k] * bd[1]; x[2] += bflo(yw.y) + wk[k] * bd[2]; x[3] += bfhi(yw.y) + wk[k] * bd[3]; }
            v[j] = x; s += (x[0] + x[1]) + (x[2] + x[3]); }
        const float mean = wave_sum(s) * (1.0f / D); float q = 0.f;
#pragma unroll
        for (int j = 0; j < 4; ++j) { v[j] = v[j] - mean; q += (v[j][0] * v[j][0] + v[j][1] * v[j][1]) + (v[j][2] * v[j][2] + v[j][3] * v[j][3]); }
        const float rstd = 1.0f / sqrtf(wave_sum(q) * (1.0f / D) + LN_EPS);
#pragma unroll
        for (int j = 0; j < 4; ++j) { const int c = 256 * j + 4 * lane; const f32x4 gg = *(const f32x4*)(a.g2 + c), bb = *(const f32x4*)(a.b2 + c);
            *(f32x4*)(a.out + (size_t)t * D + c) = (v[j] * rstd * gg + bb) * a.dbg_scale; }
    }
}

#ifndef PROBE_REP
#define PROBE_REP 0
#endif
struct Args { const float* in[20]; float* out; unsigned char* ws; };
__global__ void __launch_bounds__(NTHREADS, 2) mega_fwd(Args args) {
    extern __shared__ __attribute__((aligned(16))) unsigned char lds_raw[];
    LAS unsigned char* lds = (LAS unsigned char*)lds_raw;
    cg::grid_group grid = cg::this_grid();
    const int G = gridDim.x, bx = blockIdx.x;
    const int vcu = (G % 8 == 0) ? (bx % 8) * (G / 8) + bx / 8 : bx;
    unsigned char* const ws = args.ws;
    const LAS int* cntL = (const LAS int*)(lds + MISC_OFF); const LAS int* tsL = cntL + 32;
    { volatile LAS unsigned* bst = (volatile LAS unsigned*)(lds + MISC_OFF) + BST_IDX;
      if (threadIdx.x < 2) bst[threadIdx.x] = 0u;
      __syncthreads();
      (void)xcd_barrier_post((unsigned*)(ws + WS_BAR), bst); }
#define GRID_BAR() do { XcdBarrier b_; b_.bar = (unsigned*)(ws + WS_BAR); b_.x = xb_xcc_id(); b_.st = (volatile LAS unsigned*)(lds + MISC_OFF) + BST_IDX; xcd_barrier(b_); } while (0)
#define WSP(T, off) ((T*)(ws + (off)))

    _Pragma("unroll 1") for (int rep_ = 0; rep_ < ((PROBE_REP & 1) ? 2 : 1); ++rep_) { P0Args a{args.in[0], args.in[1], args.in[2], args.in[4], args.in[5], args.in[7], args.in[17], args.in[16], args.in[12], args.in[14], ws}; p0_phase(a, lds, vcu, G); }
    grid.sync();
    _Pragma("unroll 1") for (int rep_ = 0; rep_ < ((PROBE_REP & 2) ? 2 : 1); ++rep_) { pg8::Gemm g{WSP(bf16_t, WS_XB), (const bf16_t*)(ws + WS_WIN), D}; pg8::StaticOrder S; S.init(M / 256, NIN / 256, G, bx, 1);
      pg8::EpiInProj E{ws};
      pg8::gemm_phase<pg8::EpiInProj, pg8::StaticOrder, true>(lds, g, S, E); }
    { constexpr int U1 = (M / 256) * (NIN / 256); const int R1 = U1 % G, nidle = R1 ? G - R1 : G, per = 256 / nidle;
      if (R1 == 0 || bx >= R1) {
        pg8::Gemm g{WSP(bf16_t, WS_PB), (const bf16_t*)(ws + WS_WPP), DPLE}; pg8::Ple1Order S{(bx - R1) * per, per};
        pg8::EpiF32 E{WSP(float, WS_P2)};
        pg8::gemm_phase<pg8::EpiF32, pg8::Ple1Order, false>(lds, g, S, E); } }
    GRID_BAR();
    if (PROBE_REP & 4096) { _Pragma("unroll 1") for (int k_ = 0; k_ < 8; ++k_) GRID_BAR(); }
    _Pragma("unroll 1") for (int rep_ = 0; rep_ < ((PROBE_REP & 4) ? 2 : 1); ++rep_) for (int it = vcu; it < BATCH * NKV * (SEQ / 128); it += G) { const int nb = it & 63, kvh = (it >> 6) & 3, b = it >> 8;
        attn_unit(lds, WSP(bf16_t, WS_Q), WSP(bf16_t, WS_K), WSP(bf16_t, WS_V), args.in[6], WSP(bf16_t, WS_ZO) + (size_t)M * D, b, kvh, nb); }
    _Pragma("unroll 1") for (int rep_ = 0; rep_ < ((PROBE_REP & 8) ? 2 : 1); ++rep_) conv_phase(WSP(bf16_t, WS_BG), WSP(bf16_t, WS_U), args.in[3], WSP(bf16_t, WS_ZO), vcu, G);
    GRID_BAR();
#if DBG_ATTN
    dbg_attn_check(WSP(bf16_t, WS_Q), WSP(bf16_t, WS_K), WSP(bf16_t, WS_V), args.in[6], WSP(bf16_t, WS_ZO) + (size_t)M * D, WSP(float, WS_CTL) + 64, vcu, G);
#endif
    _Pragma("unroll 1") for (int rep_ = 0; rep_ < ((PROBE_REP & 16) ? 2 : 1); ++rep_) { pg8::Gemm g{WSP(bf16_t, WS_ZO), (const bf16_t*)(ws + WS_WBR), D}; pg8::DualOrder S; S.so.init(M / 256, D / 256, G, bx);
      pg8::EpiDual E{ws};
      pg8::gemm_phase<pg8::EpiDual, pg8::DualOrder, false>(lds, g, S, E); }
    GRID_BAR();
    _Pragma("unroll 1") for (int rep_ = 0; rep_ < ((PROBE_REP & 32) ? 2 : 1); ++rep_) { pg8::Gemm g{WSP(bf16_t, WS_MG), (const bf16_t*)(ws + WS_WOUT), D}; pg8::StaticOrder S; S.init(M / 256, D / 256, G, bx);
      pg8::EpiResid E{args.in[0], WSP(float, WS_X1F)};
      pg8::gemm_phase<pg8::EpiResid, pg8::StaticOrder, false>(lds, g, S, E); }
    GRID_BAR();
    _Pragma("unroll 1") for (int rep_ = ((PROBE_REP & 64) ? 0 : 1); rep_ < 2; ++rep_) { RouteArgs a{WSP(float, WS_X1F), WSP(bf16_t, WS_X1B), args.in[8], args.in[9], args.in[10], args.in[11], WSP(int, WS_CTL), WSP(int, WS_LTOK), WSP(float, WS_LW), WSP(int, WS_TKE), WSP(int, WS_TKR), WSP(float, WS_TKW)}; route_phase(a, lds, vcu, G, rep_ == 0); }
    GRID_BAR();
    build_tables(WSP(int, WS_CTL), lds);
    const int U5_ = __builtin_amdgcn_readfirstlane(tsL[NE]) * 8, idle5_ = (G - U5_ % G) % G, nx5_ = idle5_ < 256 ? idle5_ : 256;
    { pg8::MoeOrder S; S.init(cntL, tsL, (const LAS unsigned*)(lds + TW_OFF), 8, G, bx, 1, WS_X1B, WS_WGU, nx5_, 0);
      pg8::moe_preload(S, cntL, WSP(int, WS_LTOK), WSP(float, WS_LW), (LAS unsigned*)(lds + TW_OFF));
      _Pragma("unroll 1") for (int rep_ = 0; rep_ < ((PROBE_REP & 128) ? 2 : 1); ++rep_) { pg8::Gemm g{(const bf16_t*)ws, (const bf16_t*)ws, D};
        pg8::EpiSwiglu E{WSP(bf16_t, WS_H), args.in[13], (const LAS unsigned*)(lds + TW_OFF), ws};
        pg8::gemm_phase<pg8::EpiSwiglu, pg8::MoeOrder, true>(lds, g, S, E); } }
    GRID_BAR();
    _Pragma("unroll 1") for (int rep_ = 0; rep_ < ((PROBE_REP & 1024) ? 2 : 1); ++rep_) { pg8::Gemm g{(const bf16_t*)ws, (const bf16_t*)ws, D};
      pg8::MoeOrder S; S.init(cntL, tsL, (const LAS unsigned*)(lds + TW_OFF), 4, G, bx, 0, WS_H, WS_WDN, 256 - nx5_, nx5_);
      pg8::EpiDown E{WSP(bf16_t, WS_Y), ws};
      pg8::gemm_phase<pg8::EpiDown, pg8::MoeOrder, true>(lds, g, S, E); }
    GRID_BAR();
    _Pragma("unroll 1") for (int rep_ = 0; rep_ < ((PROBE_REP & 2048) ? 2 : 1); ++rep_) { float dbgs_ = 1.0f;
#if DBG_ATTN
      { const float* a3 = WSP(float, WS_CTL) + 64; const float num = __hip_atomic_load(a3, __ATOMIC_RELAXED, __HIP_MEMORY_SCOPE_AGENT), den = __hip_atomic_load(a3 + 1, __ATOMIC_RELAXED, __HIP_MEMORY_SCOPE_AGENT), mx = __hip_atomic_load(a3 + 2, __ATOMIC_RELAXED, __HIP_MEMORY_SCOPE_AGENT);
        dbgs_ = 1.0f + sqrtf(100.0f * (DBG_ATTN == 1 ? num / den : mx)); }
#endif
      FinalArgs a{dbgs_, 0, WSP(float, WS_X1F), WSP(bf16_t, WS_PLE), WSP(bf16_t, WS_Y), WSP(int, WS_TKE), WSP(int, WS_TKR), WSP(float, WS_TKW), args.in[15], args.in[18], args.in[19], args.out}; final_phase(a, lds, vcu, G); }
}

extern "C" void kernel_launch(void* const* d_in, const int* in_sizes, int n_in, void* d_out, int out_size, void* d_ws, size_t ws_size, hipStream_t stream) {
    static int grid = 0;
    if (grid == 0) {
        if (n_in != 20 || out_size != M * D || ws_size < WS_END) { fprintf(stderr, "kernel_launch: unexpected sizes (n_in %d, out %d, ws %zu < %zu)\n", n_in, out_size, ws_size, (size_t)WS_END); grid = -1; return; }
        int dev = 0, cus = 0, per_cu = 0;
        if (hipGetDevice(&dev) != hipSuccess || hipDeviceGetAttribute(&cus, hipDeviceAttributeMultiprocessorCount, dev) != hipSuccess) { grid = -1; return; }
        if (hipFuncSetAttribute((const void*)mega_fwd, hipFuncAttributeMaxDynamicSharedMemorySize, LDS_BYTES) != hipSuccess) { fprintf(stderr, "kernel_launch: hipFuncSetAttribute failed\n"); grid = -1; return; }
        if (hipOccupancyMaxActiveBlocksPerMultiprocessor(&per_cu, (const void*)mega_fwd, NTHREADS, LDS_BYTES) != hipSuccess || per_cu < 1) { fprintf(stderr, "kernel_launch: occupancy query says %d blocks per CU\n", per_cu); grid = -1; return; }
        grid = cus;
        if (grid != 256) fprintf(stderr, "kernel_launch: note: %d CUs (built and tuned for 256)\n", grid);
    }
    if (grid < 0) return;
    if (hipMemsetAsync((char*)d_ws + WS_CTL, 0, CTL_ZERO_BYTES, stream) != hipSuccess) return;
    Args a{};
    for (int i = 0; i < 20; ++i) a.in[i] = (const float*)d_in[i];
    a.out = (float*)d_out; a.ws = (unsigned char*)d_ws;
    void* kargs[] = {&a};
    const hipError_t e = hipLaunchCooperativeKernel((const void*)mega_fwd, dim3(grid), dim3(NTHREADS), kargs, LDS_BYTES, stream);
    if (e != hipSuccess) fprintf(stderr, "kernel_launch: cooperative launch failed: %s (grid %d)\n", hipGetErrorString(e), grid);
}
```

```cpp
#include <hip/hip_runtime.h>
#include <hip/hip_cooperative_groups.h>
#include <cstdio>
#include <cstdint>
namespace cg = cooperative_groups;

#define LAS __attribute__((address_space(3)))
typedef unsigned short bf16_t;
typedef short bf16x8 __attribute__((ext_vector_type(8)));
typedef short s16x4 __attribute__((ext_vector_type(4)));
typedef float f32x4 __attribute__((ext_vector_type(4)));
typedef float f32x16 __attribute__((ext_vector_type(16)));
typedef unsigned u32x4 __attribute__((ext_vector_type(4)));
typedef unsigned u32x2 __attribute__((ext_vector_type(2)));

constexpr int BATCH = 2, SEQ = 8192, M = BATCH * SEQ, D = 1024, NIN = 6656, NE = 32, DPLE = 256, NH = 16, HD = 64, NKV = 4;
constexpr float DN_ALPHA = 1.189207115002721f, LN_EPS = 1e-5f, LOG2E = 1.4426950408889634f;
constexpr float QSCALE = 0.125f * LOG2E;
constexpr int LISTCAP = M;
constexpr int MAXTILES = (M * 4) / 256 + NE;
constexpr int NWAVES = 8, NTHREADS = 512;

constexpr size_t MiB = 1u << 20;
constexpr size_t WS_CTL = 0;
constexpr size_t WS_BAR = 16384, CTL_ZERO_BYTES = 65536;
constexpr size_t WS_TKE = 1 * MiB, WS_TKR = 2 * MiB, WS_TKW = 3 * MiB;
constexpr size_t WS_LTOK = 4 * MiB, WS_LW = 6 * MiB;
constexpr size_t WS_WIN = 8 * MiB;
constexpr size_t WS_WBR = 22 * MiB;
constexpr size_t WS_WOUT = 26 * MiB, WS_WPG = 28 * MiB;
constexpr size_t WS_WPP = 30 * MiB;
constexpr size_t WS_WGU = 32 * MiB;
constexpr size_t WS_WDN = 160 * MiB;
constexpr size_t WS_XB = 224 * MiB;
constexpr size_t WS_PB = 256 * MiB;
constexpr size_t WS_X1F = 264 * MiB;
constexpr size_t WS_X1B = 328 * MiB;
constexpr size_t WS_P2 = 360 * MiB;
constexpr size_t WS_PLE = 424 * MiB;
constexpr size_t WS_R = 456 * MiB;
constexpr size_t WS_BG = WS_R, WS_U = WS_R + 32 * MiB, WS_Q = WS_R + 64 * MiB, WS_K = WS_R + 96 * MiB, WS_V = WS_R + 104 * MiB;
constexpr size_t WS_GC = WS_R + 112 * MiB, WS_GA = WS_R + 144 * MiB;
constexpr size_t WS_ZO = WS_R + 176 * MiB;
constexpr size_t WS_T1 = WS_R + 240 * MiB;
constexpr size_t WS_MG = WS_R + 304 * MiB;
constexpr size_t WS_H = WS_R;
constexpr size_t WS_Y = WS_R + 144 * MiB;
constexpr size_t WS_XQ = WS_R + 336 * MiB;
constexpr size_t WS_LSX = WS_XQ + 16 * MiB;
constexpr size_t WS_SX1 = WS_LSX + 2 * MiB;
constexpr size_t WS_END = WS_SX1 + 1 * MiB;
constexpr size_t WS_SCL = 65536;
constexpr size_t WS_WPG8 = 31 * MiB;
typedef int i32x4 __attribute__((ext_vector_type(4)));

constexpr int LDS_BYTES = 147456;
constexpr int MISC_OFF = 135168;
constexpr int BST_IDX = 66, TW_OFF = MISC_OFF + 512, UTAB_OFF = TW_OFF + 10240;
constexpr int BST_IDX_ = 0;

__device__ __forceinline__ unsigned f2bf(float f) { unsigned u = __builtin_bit_cast(unsigned, f); return (u + 0x7fffu + ((u >> 16) & 1u)) >> 16; }
__device__ __forceinline__ unsigned pk2(float lo, float hi) { return f2bf(lo) | (f2bf(hi) << 16); }
__device__ __forceinline__ float bflo(unsigned w) { return __builtin_bit_cast(float, w << 16); }
__device__ __forceinline__ float bfhi(unsigned w) { return __builtin_bit_cast(float, w & 0xffff0000u); }
__device__ __forceinline__ float fast_sigmoid(float v) { return __builtin_amdgcn_rcpf(1.0f + __builtin_amdgcn_exp2f(-LOG2E * v)); }
__device__ __forceinline__ float wave_sum(float v) {
#pragma unroll
    for (int o = 1; o < 64; o <<= 1) v += __shfl_xor(v, o);
    return v;
}

#define XB_TMO      128
#define XB_XCNT(j)  (256  + 64 * (j))
#define XB_XSUB(j)  (1280 + 64 * (j))
#define XB_XGEN(j)  (2304 + 64 * (j))
#define XB_TOP      3328
#define XB_TOPGEN   3392
#define XCD_BAR_WORDS 3456
#define XB_SPIN_CAP (1u << 18)

__device__ __forceinline__ unsigned xb_ld(unsigned* p)              { return __hip_atomic_load(p, __ATOMIC_RELAXED, __HIP_MEMORY_SCOPE_AGENT); }
__device__ __forceinline__ unsigned xb_add(unsigned* p, unsigned v) { return __hip_atomic_fetch_add(p, v, __ATOMIC_RELAXED, __HIP_MEMORY_SCOPE_AGENT); }
__device__ __forceinline__ unsigned xb_xcc_id() { return (unsigned)__builtin_amdgcn_s_getreg((3 << 11) | 20) & 0xFu; }
#define XB_SPIN(cond, bar) do { unsigned _sp = 0; while (cond) { __builtin_amdgcn_s_sleep(1); \
    if ((++_sp & 255u) == 0u) { if (xb_ld(&(bar)[XB_TMO])) break; if (_sp > XB_SPIN_CAP) { atomicAdd(&(bar)[XB_TMO], 1u); break; } } } } while (0)

struct XcdBarrier {
    unsigned* bar; unsigned x;
    volatile LAS unsigned* st;
};

__device__ __forceinline__ XcdBarrier xcd_barrier_post(unsigned* bar, volatile LAS unsigned* st) {
    XcdBarrier b; b.bar = bar; b.x = xb_xcc_id(); b.st = st;
    if (threadIdx.x == 0) (void)xb_add(&bar[XB_XCNT(b.x)], 1u);
    return b;
}
__device__ __forceinline__ void xcd_barrier_complete(unsigned* bar, unsigned x, unsigned& nloc, unsigned& nx) {
    const unsigned G = gridDim.x * gridDim.y * gridDim.z;
    unsigned sum, cnt, mine, sp = 0u;
    for (;;) {
        sum = 0u; cnt = 0u; mine = 0u;
#pragma unroll
        for (unsigned j = 0; j < 16; ++j) { const unsigned c = xb_ld(&bar[XB_XCNT(j)]); sum += c; cnt += (c > 0u) ? 1u : 0u; mine = (j == x) ? c : mine; }
        if (sum == G) break;
        __builtin_amdgcn_s_sleep(1);
        if ((++sp & 255u) == 0u) { if (xb_ld(&bar[XB_TMO])) break; if (sp > XB_SPIN_CAP) { atomicAdd(&bar[XB_TMO], 1u); break; } }
    }
    nloc = mine > 0u ? mine : 1u; nx = cnt > 0u ? cnt : 1u;
}

__device__ __forceinline__ void xcd_barrier(const XcdBarrier& b) {
    asm volatile("s_waitcnt vmcnt(0)" ::: "memory");
    __syncthreads();
    if (threadIdx.x == 0) {
        unsigned* bar = b.bar;
        __builtin_amdgcn_s_waitcnt(0);
        unsigned nloc = b.st[0], nx = b.st[1];
        if (nloc == 0u) { xcd_barrier_complete(bar, b.x, nloc, nx); b.st[0] = nloc; b.st[1] = nx; }
        const unsigned old = xb_add(&bar[XB_XSUB(b.x)], 1u);
        const unsigned gen = old / nloc;
        if (old + 1u == (gen + 1u) * nloc) {
            __builtin_amdgcn_fence(__ATOMIC_RELEASE, "agent");
            asm volatile("s_waitcnt vmcnt(0)" ::: "memory");
            const unsigned og = xb_add(&bar[XB_TOP], 1u);
            const unsigned tg = og / nx;
            if (og + 1u == (tg + 1u) * nx) xb_add(&bar[XB_TOPGEN], 1u);
            else XB_SPIN(xb_ld(&bar[XB_TOPGEN]) == tg, bar);
            __builtin_amdgcn_fence(__ATOMIC_ACQUIRE, "agent");
            xb_add(&bar[XB_XGEN(b.x)], 1u);
            asm volatile("s_waitcnt vmcnt(0)" ::: "memory");
        } else {
            XB_SPIN(xb_ld(&bar[XB_XGEN(b.x)]) == gen, bar);
            __builtin_amdgcn_fence(__ATOMIC_ACQUIRE, "agent");
            asm volatile("s_waitcnt vmcnt(0)" ::: "memory");
        }
    }
    __syncthreads();
}

namespace pg8 {
constexpr int BM = 256, BK = 64, HALF = 128, HTB = HALF * BK * 2  , STAGE_BYTES = 8 * HTB, NXCD = 8, WGM = 8;
__host__ __device__ __forceinline__ int lds_byte(int r, int c) { const int st = (r >> 4) * 2 + (c >> 5), rr = r & 15, cc = c & 31, ob = rr * 64 + cc * 2; return st * 1024 + (ob ^ (((ob >> 9) & 1) << 5)); }
__host__ __device__ __forceinline__ void stage_rc(int b, int& R, int& C) { const int st = b / 1024, sb = b % 1024, swz = sb ^ (((sb >> 9) & 1) << 5); R = (st >> 1) * 16 + swz / 64; C = (st & 1) * 32 + (swz % 64) / 2; }
__host__ __device__ __forceinline__ int perm32(int rho) { const int n = rho >> 4, i = rho & 15; return 8 * (i >> 2) + 4 * n + (i & 3); }

struct Unit { int pm, pn, om, on, e, mt, slot; };
struct Gemm { const bf16_t* A; const bf16_t* Bt; int K; };

__device__ __forceinline__ int xcd_remap(int L, int nwg) { const int q = nwg / NXCD, r = nwg % NXCD, xcd = L % NXCD, off = L / NXCD; return (xcd < r ? xcd * (q + 1) : r * (q + 1) + (xcd - r) * q) + off; }

__device__ __forceinline__ void plain_a_off(int pm, int tid, int K, unsigned (&o)[2][2]) {
#pragma unroll
    for (int i = 0; i < 2; ++i) { int R, C; stage_rc(tid * 16 + i * 8192, R, C);
#pragma unroll
        for (int h = 0; h < 2; ++h) o[h][i] = (unsigned)((pm * BM + h * HALF + R) * K + C) * 2u; }
}
struct TailSplit {
    int U, G, c, rounds, R, s;
    __device__ __forceinline__ void init(int U_, int G_, int c_, int smax) { U = U_; G = G_; c = c_; rounds = U / G; R = U - rounds * G; s = (smax >= 4 && R * 4 <= G) ? 4 : ((smax >= 2 && R * 2 <= G) ? 2 : 1); }
    __device__ __forceinline__ bool map(int i, int& L, int& q) const {
        if (i < rounds) { L = i * G + c; q = 0xF; return true; }
        if (i == rounds && c < R * s) { L = rounds * G + c / s; const int piece = c % s; q = s == 1 ? 0xF : (s == 2 ? (piece ? 0xC : 0x3) : (1 << piece)); return true; }
        return false;
    }
};
struct StaticOrder {
    int nM, nN, nwg; TailSplit ts;
    __device__ void init(int nM_, int nN_, int G_, int c_, int smax = 1) { nM = nM_; nN = nN_; nwg = nM * nN; ts.init(nwg, G_, c_, smax); }
    __device__ __forceinline__ bool tile(int i, int& pm, int& pn, int& q) const {
        int L; if (!ts.map(i, L, q)) return false;
        const int wgid = xcd_remap(L, nwg);
        const int nig = WGM * nN, gid = wgid / nig, fm = gid * WGM, gsz = (nM - fm) < WGM ? (nM - fm) : WGM;
        pm = fm + ((wgid % nig) % gsz); pn = (wgid % nig) / gsz; return true;
    }
    __device__ __forceinline__ bool next(int i, Unit& u) const { int pm, pn, q; if (!tile(i, pm, pn, q)) return false; u.pm = pm; u.pn = pn; u.om = pm; u.on = pn; u.e = 0; u.mt = 0; u.slot = 0; return true; }
    __device__ __forceinline__ void a_off(const Unit& u, int tid, int K, unsigned (&o)[2][2]) const { plain_a_off(u.pm, tid, K, o); }
};

__device__ __forceinline__ unsigned cvt_pk_bf16(float lo, float hi) { unsigned r; asm volatile("v_cvt_pk_bf16_f32 %0, %1, %2" : "=v"(r) : "v"(lo), "v"(hi)); return r; }

template <class Epi, class Sched, bool ALIGN_EPI, int DRY = 0, bool I8 = false>
__device__ __forceinline__ void gemm_phase(LAS unsigned char* lds, const Gemm g, const Sched& S, const Epi& E) {
    int tid_ = threadIdx.x; asm volatile("" : "+v"(tid_));
    const int tid = tid_, wid = __builtin_amdgcn_readfirstlane(tid >> 6), lane = tid & 63, wr = wid >> 2, wc = wid & 3, fr = lane & 15, fq = lane >> 4;
    const int K = g.K, nt = K / BK;
    unsigned voffB[2];
#pragma unroll
    for (int i = 0; i < 2; ++i) { int R, C; stage_rc(tid * 16 + i * 8192, R, C); const int Rb = Epi::PERM ? ((R & ~31) + perm32(R & 31)) : R;
        voffB[i] = (unsigned)(Rb * K + C) * 2u; }
    constexpr unsigned kstep = BK * 2;
    const unsigned hstep = (unsigned)HALF * K * 2;
    const unsigned tstep = 2 * hstep;
    const unsigned ldsw = (unsigned)wid * 1024u;
    const int aoff = lds_byte(wr * 64 + fr, fq * 8), boff = lds_byte(wc * 32 + fr, fq * 8);
#define PG8_SA(b, h) (((b) * 2 + (h)) * HTB)
#define PG8_SB(b, h) ((4 + (b) * 2 + (h)) * HTB)
#define PG8_STAGE(bufoff, gbase, voff) do { _Pragma("unroll") for (int _i = 0; _i < 2; ++_i) \
        __builtin_amdgcn_global_load_lds((const unsigned*)((const char*)(gbase) + (voff)[_i]), (LAS unsigned*)(lds + (bufoff) + ldsw + _i * 8192), 16, 0, 0); } while (0)
#define PG8_LDA(dst, b, h) do { _Pragma("unroll") for (int m = 0; m < 4; ++m) _Pragma("unroll") for (int k = 0; k < 2; ++k) dst[m][k] = *(const LAS bf16x8*)(lds + PG8_SA(b, h) + aoff + m * 2048 + k * 1024); } while (0)
#define PG8_LDB(dst, b, h) do { _Pragma("unroll") for (int n = 0; n < 2; ++n) _Pragma("unroll") for (int k = 0; k < 2; ++k) dst[n][k] = *(const LAS bf16x8*)(lds + PG8_SB(b, h) + boff + n * 2048 + k * 1024); } while (0)
#define PG8_MMA(ai, bj, At, Bt) do { if constexpr (DRY == 1) { _Pragma("unroll") for (int m = 0; m < 4; ++m) _Pragma("unroll") for (int k = 0; k < 2; ++k) asm volatile("" :: "v"(At[m][k])); _Pragma("unroll") for (int n = 0; n < 2; ++n) _Pragma("unroll") for (int k = 0; k < 2; ++k) asm volatile("" :: "v"(Bt[n][k])); break; } __builtin_amdgcn_s_setprio(1); _Pragma("unroll") for (int m = 0; m < 4; ++m) _Pragma("unroll") for (int n = 0; n < 2; ++n) _Pragma("unroll") for (int k = 0; k < 2; ++k) \
        { if constexpr (I8) acc[ai][bj][m][n] = __builtin_bit_cast(AccT, __builtin_amdgcn_mfma_i32_16x16x64_i8(__builtin_bit_cast(i32x4, Bt[n][k]), __builtin_bit_cast(i32x4, At[m][k]), __builtin_bit_cast(i32x4, acc[ai][bj][m][n]), 0, 0, 0)); \
          else acc[ai][bj][m][n] = __builtin_bit_cast(AccT, __builtin_amdgcn_mfma_f32_16x16x32_bf16(Bt[n][k], At[m][k], __builtin_bit_cast(f32x4, acc[ai][bj][m][n]), 0, 0, 0)); } __builtin_amdgcn_s_setprio(0); } while (0)
#define PG8_WAIT_V(n) asm volatile("s_waitcnt vmcnt(" #n ")" ::: "memory")
#define PG8_WAIT_L(n) asm volatile("s_waitcnt lgkmcnt(" #n ")" ::: "memory")
#define PG8_BAR __builtin_amdgcn_s_barrier()
#define PG8_SCHED __builtin_amdgcn_sched_barrier(0)
    Unit cur, nxt; int ui = 0;
    if (!S.next(0, cur)) return;
    typedef typename Epi::AccT AccT;
    AccT acc[2][2][4][2];
#pragma unroll
    for (int a = 0; a < 2; ++a)
#pragma unroll
        for (int b = 0; b < 2; ++b)
#pragma unroll
            for (int m = 0; m < 4; ++m)
#pragma unroll
                for (int n = 0; n < 2; ++n) acc[a][b][m][n] = AccT{};
    bf16x8 At[4][2], B0[2][2], B1[2][2];
    unsigned aC[2][2];
    S.a_off(cur, tid, K, aC);
    const char* const Ab = (const char*)g.A;
    const char* cB = (const char*)g.Bt + (size_t)cur.pn * tstep;
    PG8_STAGE(PG8_SB(0, 0), cB, voffB); PG8_STAGE(PG8_SB(0, 1), cB + hstep, voffB); PG8_STAGE(PG8_SA(0, 0), Ab, aC[0]); PG8_STAGE(PG8_SA(0, 1), Ab, aC[1]);
    if (wr == 1) PG8_BAR;
    PG8_WAIT_V(2); PG8_BAR;
    PG8_STAGE(PG8_SB(1, 0), cB + kstep, voffB); PG8_STAGE(PG8_SA(1, 0), Ab + kstep, aC[0]); PG8_STAGE(PG8_SB(1, 1), cB + hstep + kstep, voffB);
    PG8_WAIT_V(6); PG8_BAR;
    for (;;) {
        const bool has_next = S.next(ui + 1, nxt);
        const char* nB = has_next ? (const char*)g.Bt + (size_t)nxt.pn * tstep : cB;
        for (int t = 0; t < nt; t += 2) {
            const bool last = (t == nt - 2);
            const char* a1 = Ab + (size_t)(t + 1) * kstep;
            const char* a2 = last ? Ab : Ab + (size_t)(t + 2) * kstep; const char* b2 = last ? nB : cB + (size_t)(t + 2) * kstep;
            const char* a3 = a2 + kstep; const char* b3 = b2 + kstep;
            PG8_LDB(B0, 0, 0); PG8_LDB(B1, 0, 1); PG8_SCHED; PG8_LDA(At, 0, 0); PG8_STAGE(PG8_SA(1, 1), a1, aC[1]);
            if (last && has_next) S.a_off(nxt, tid, K, aC);
            PG8_WAIT_V(8); PG8_WAIT_L(0); PG8_BAR; PG8_MMA(0, 0, At, B0); PG8_MMA(0, 1, At, B1); PG8_BAR; PG8_SCHED;
            PG8_LDA(At, 0, 1); PG8_STAGE(PG8_SB(0, 0), b2, voffB); PG8_STAGE(PG8_SB(0, 1), b2 + hstep, voffB); PG8_STAGE(PG8_SA(0, 0), a2, aC[0]);
            PG8_WAIT_V(8); PG8_WAIT_L(0); PG8_BAR; PG8_MMA(1, 0, At, B0); PG8_MMA(1, 1, At, B1); PG8_BAR; PG8_SCHED;
            PG8_LDB(B0, 1, 0); PG8_LDB(B1, 1, 1); PG8_SCHED; PG8_LDA(At, 1, 0); PG8_STAGE(PG8_SA(0, 1), a2, aC[1]);
            PG8_WAIT_V(8); PG8_WAIT_L(0); PG8_BAR; PG8_MMA(0, 0, At, B0); PG8_MMA(0, 1, At, B1); PG8_BAR; PG8_SCHED;
            PG8_LDA(At, 1, 1); PG8_STAGE(PG8_SB(1, 0), b3, voffB); PG8_STAGE(PG8_SB(1, 1), b3 + hstep, voffB); PG8_STAGE(PG8_SA(1, 0), a3, aC[0]);
            PG8_WAIT_V(8); PG8_WAIT_L(0); PG8_BAR; PG8_MMA(1, 0, At, B0); PG8_MMA(1, 1, At, B1); PG8_BAR; PG8_SCHED;
        }
        if constexpr (ALIGN_EPI) { if (wr == 0) PG8_BAR; }
        if constexpr (DRY == 0) E(acc, cur, wr, wc, fr, fq); else { _Pragma("unroll") for (int a = 0; a < 2; ++a) _Pragma("unroll") for (int b = 0; b < 2; ++b) _Pragma("unroll") for (int m = 0; m < 4; ++m) _Pragma("unroll") for (int n = 0; n < 2; ++n) asm volatile("" :: "v"(acc[a][b][m][n])); }
        if (!has_next) break;
#pragma unroll
        for (int a = 0; a < 2; ++a)
#pragma unroll
            for (int b = 0; b < 2; ++b)
#pragma unroll
                for (int m = 0; m < 4; ++m)
#pragma unroll
                    for (int n = 0; n < 2; ++n) acc[a][b][m][n] = AccT{};
        cur = nxt; cB = nB; ++ui;
        if constexpr (ALIGN_EPI) { if (wr == 1) PG8_BAR; }
    }
    PG8_WAIT_V(0);
    if constexpr (!ALIGN_EPI) { if (wr == 0) PG8_BAR; }
    PG8_BAR;
#undef PG8_SA
#undef PG8_SB
#undef PG8_STAGE
#undef PG8_LDA
#undef PG8_LDB
#undef PG8_MMA
#undef PG8_WAIT_V
#undef PG8_WAIT_L
#undef PG8_BAR
#undef PG8_SCHED
}
}
namespace pg8 {
typedef const f32x4 (&AccRef)[2][2][4][2];
typedef const i32x4 (&AccRefI)[2][2][4][2];

struct EpiInProj {
    static constexpr bool PERM = true; typedef f32x4 AccT;
    unsigned char* ws;
    __device__ __forceinline__ void operator()(AccRef acc, const Unit& u, int wr, int wc, int fr, int fq) const {
        const int pn = u.on, row0 = u.om * BM + wr * 64 + fr, cw = wc * 32 + 8 * fq;
        if (pn >= 4 && pn < 12) {
#pragma unroll
            for (int ai = 0; ai < 2; ++ai)
#pragma unroll
                for (int m = 0; m < 4; ++m) { const f32x4 v0 = acc[ai][0][m][0] * acc[ai][1][m][0], v1 = acc[ai][0][m][1] * acc[ai][1][m][1];
                    u32x4 w; w.x = cvt_pk_bf16(v0[0], v0[1]); w.y = cvt_pk_bf16(v0[2], v0[3]); w.z = cvt_pk_bf16(v1[0], v1[1]); w.w = cvt_pk_bf16(v1[2], v1[3]);
                    *(u32x4*)((bf16_t*)(ws + WS_U) + (size_t)(row0 + ai * HALF + m * 16) * D + (pn - 4) * 128 + cw) = w; }
            return;
        }
        size_t doff; int ldc = D, cb, mode = 0;
        if (pn < 4) { doff = WS_BG; cb = pn * 256; }
        else if (pn < 16) { doff = WS_Q; cb = (pn - 12) * 256; mode = 1; }
        else if (pn == 16) { doff = WS_K; cb = 0; ldc = 256; }
        else if (pn == 17) { doff = WS_V; cb = 0; ldc = 256; }
        else if (pn < 22) { doff = WS_GC; cb = (pn - 18) * 256; mode = 2; }
        else { doff = WS_GA; cb = (pn - 22) * 256; mode = 2; }
        bf16_t* dst = (bf16_t*)(ws + doff);
#pragma unroll
        for (int ai = 0; ai < 2; ++ai)
#pragma unroll
            for (int m = 0; m < 4; ++m) { bf16_t* rowp = dst + (size_t)(row0 + ai * HALF + m * 16) * ldc + cb + cw;
#pragma unroll
                for (int bj = 0; bj < 2; ++bj) { f32x4 v0 = acc[ai][bj][m][0], v1 = acc[ai][bj][m][1];
                    if (mode == 1) { v0 = v0 * QSCALE; v1 = v1 * QSCALE; }
                    if (mode == 2) {
#pragma unroll
                        for (int j = 0; j < 4; ++j) { v0[j] = fast_sigmoid(v0[j]); v1[j] = fast_sigmoid(v1[j]); } }
                    u32x4 w; w.x = cvt_pk_bf16(v0[0], v0[1]); w.y = cvt_pk_bf16(v0[2], v0[3]); w.z = cvt_pk_bf16(v1[0], v1[1]); w.w = cvt_pk_bf16(v1[2], v1[3]);
                    *(u32x4*)(rowp + bj * HALF) = w; } }
    }
};

struct EpiDual {
    static constexpr bool PERM = true; typedef f32x4 AccT;
    unsigned char* ws;
    __device__ __forceinline__ void operator()(AccRef acc, const Unit& u, int wr, int wc, int fr, int fq) const {
        const int row0 = u.om * BM + wr * 64 + fr, col0 = u.on * BM + wc * 32 + 8 * fq;
        const bf16_t* G = (const bf16_t*)(ws + (u.e == 0 ? WS_GC : WS_GA)); float* T1 = (float*)(ws + WS_T1); bf16_t* MG = (bf16_t*)(ws + WS_MG);
#pragma unroll
        for (int ai = 0; ai < 2; ++ai)
#pragma unroll
            for (int m = 0; m < 4; ++m) { const size_t ro = (size_t)(row0 + ai * HALF + m * 16) * D + col0;
#pragma unroll
                for (int bj = 0; bj < 2; ++bj) { const size_t o = ro + bj * HALF;
                    const u32x4 gw = *(const u32x4*)(G + o);
                    f32x4 g0 = {bflo(gw.x), bfhi(gw.x), bflo(gw.y), bfhi(gw.y)}, g1 = {bflo(gw.z), bfhi(gw.z), bflo(gw.w), bfhi(gw.w)};
                    f32x4 v0 = g0 * acc[ai][bj][m][0], v1 = g1 * acc[ai][bj][m][1];
                    if (u.e == 0) { *(f32x4*)(T1 + o) = v0; *(f32x4*)(T1 + o + 4) = v1; }
                    else { v0 = v0 + *(const f32x4*)(T1 + o); v1 = v1 + *(const f32x4*)(T1 + o + 4);
                        u32x4 w; w.x = cvt_pk_bf16(v0[0], v0[1]); w.y = cvt_pk_bf16(v0[2], v0[3]); w.z = cvt_pk_bf16(v1[0], v1[1]); w.w = cvt_pk_bf16(v1[2], v1[3]);
                        *(u32x4*)(MG + o) = w; } } }
    }
};

struct EpiResid {
    static constexpr bool PERM = false; typedef f32x4 AccT;
    const float* X; float* C;
    __device__ __forceinline__ void operator()(AccRef acc, const Unit& u, int wr, int wc, int fr, int fq) const {
        const int row0 = u.om * BM + wr * 64 + fr, col0 = u.on * BM + wc * 32 + 4 * fq;
#pragma unroll
        for (int ai = 0; ai < 2; ++ai)
#pragma unroll
            for (int m = 0; m < 4; ++m) { const size_t ro = (size_t)(row0 + ai * HALF + m * 16) * D + col0;
#pragma unroll
                for (int bj = 0; bj < 2; ++bj)
#pragma unroll
                    for (int n = 0; n < 2; ++n) { const size_t o = ro + bj * HALF + n * 16; *(f32x4*)(C + o) = *(const f32x4*)(X + o) * DN_ALPHA + acc[ai][bj][m][n]; } }
    }
};

struct EpiF32 {
    static constexpr bool PERM = false; typedef f32x4 AccT;
    float* C;
    __device__ __forceinline__ void operator()(AccRef acc, const Unit& u, int wr, int wc, int fr, int fq) const {
        const int row0 = u.om * BM + wr * 64 + fr, col0 = u.on * BM + wc * 32 + 4 * fq;
#pragma unroll
        for (int ai = 0; ai < 2; ++ai)
#pragma unroll
            for (int m = 0; m < 4; ++m) { const size_t ro = (size_t)(row0 + ai * HALF + m * 16) * D + col0;
#pragma unroll
                for (int bj = 0; bj < 2; ++bj)
#pragma unroll
                    for (int n = 0; n < 2; ++n) *(f32x4*)(C + ro + bj * HALF + n * 16) = acc[ai][bj][m][n]; }
    }
};
__device__ __forceinline__ void ple_epilogue(AccRef acc, const Unit& u, int wr, int wc, int fr, int fq, const float* P2, bf16_t* PLE) {
    const int row0 = u.om * BM + wr * 64 + fr, col0 = u.on * BM + wc * 32 + 8 * fq;
#pragma unroll
    for (int ai = 0; ai < 2; ++ai)
#pragma unroll
        for (int m = 0; m < 4; ++m) { const size_t ro = (size_t)(row0 + ai * HALF + m * 16) * D + col0;
#pragma unroll
            for (int bj = 0; bj < 2; ++bj) { const size_t o = ro + bj * HALF; const f32x4 p0 = *(const f32x4*)(P2 + o), p1 = *(const f32x4*)(P2 + o + 4); const f32x4 a0 = acc[ai][bj][m][0], a1 = acc[ai][bj][m][1];
                u32x4 w; w.x = cvt_pk_bf16(fast_sigmoid(a0[0]) * p0[0], fast_sigmoid(a0[1]) * p0[1]); w.y = cvt_pk_bf16(fast_sigmoid(a0[2]) * p0[2], fast_sigmoid(a0[3]) * p0[3]);
                w.z = cvt_pk_bf16(fast_sigmoid(a1[0]) * p1[0], fast_sigmoid(a1[1]) * p1[1]); w.w = cvt_pk_bf16(fast_sigmoid(a1[2]) * p1[2], fast_sigmoid(a1[3]) * p1[3]);
                *(u32x4*)(PLE + o) = w; }
            if (m & 1) asm volatile("" ::: "memory"); }
}

struct EpiSwiglu {
    static constexpr bool PERM = true; typedef f32x4 AccT;
    bf16_t* H; const float* b_gu; const LAS unsigned* tw; unsigned char* ws;
    __device__ __forceinline__ void operator()(AccRef acc, const Unit& u, int wr, int wc, int fr, int fq) const {
        if (u.e < 0) { ple_epilogue(acc, u, wr, wc, fr, fq, (const float*)(ws + WS_P2), (bf16_t*)(ws + WS_PLE)); return; }
        const int trow0 = wr * 64 + fr, row0 = u.om * BM + trow0, cw = wc * 32 + 8 * fq, col0 = u.on * 128 + cw;
        const float* bg = b_gu + (size_t)u.e * 2048 + col0;
#pragma unroll
        for (int n = 0; n < 2; ++n) { const f32x4 bgn = *(const f32x4*)(bg + 4 * n), bun = *(const f32x4*)(bg + 1024 + 4 * n);
#pragma unroll
            for (int ai = 0; ai < 2; ++ai)
#pragma unroll
                for (int m = 0; m < 4; ++m) { const float w = bfhi(tw[u.slot * BM + trow0 + ai * HALF + m * 16]);
                    const f32x4 gt = acc[ai][0][m][n] + bgn, up = acc[ai][1][m][n] + bun; f32x4 hv;
#pragma unroll
                    for (int j = 0; j < 4; ++j) { const float gv = fminf(gt[j], 7.0f), uv = fminf(fmaxf(up[j], -7.0f), 7.0f); hv[j] = (uv + 1.0f) * gv * fast_sigmoid(1.702f * gv) * w; }
                    u32x2 o; o.x = cvt_pk_bf16(hv[0], hv[1]); o.y = cvt_pk_bf16(hv[2], hv[3]);
                    *(u32x2*)(H + (size_t)(row0 + ai * HALF + m * 16) * D + col0 + 4 * n) = o; } }
    }
};
__device__ __forceinline__ f32x4 i2f(const i32x4 v) { return (f32x4){(float)v[0], (float)v[1], (float)v[2], (float)v[3]}; }
struct EpiSwigluI8 {
    static constexpr bool PERM = true; typedef i32x4 AccT;
    bf16_t* H; const float* b_gu; const LAS unsigned* tw; unsigned char* ws;
    __device__ __forceinline__ void operator()(AccRefI acc, const Unit& u, int wr, int wc, int fr, int fq) const {
        const int trow0 = wr * 64 + fr, row0 = u.om * BM + trow0, cw = wc * 32 + 8 * fq;
        const float* scl = (const float*)(ws + WS_SCL);
        if (u.e < 0) {
            const float* P2 = (const float*)(ws + WS_P2); bf16_t* PLE = (bf16_t*)(ws + WS_PLE); const float* sx1 = (const float*)(ws + WS_SX1);
            const float spg = scl[NE]; const int col0 = u.on * BM + cw;
#pragma unroll
            for (int ai = 0; ai < 2; ++ai)
#pragma unroll
                for (int m = 0; m < 4; ++m) { const int r = row0 + ai * HALF + m * 16; const float s = sx1[r] * spg; const size_t ro = (size_t)r * D + col0;
#pragma unroll
                    for (int bj = 0; bj < 2; ++bj) { const size_t o = ro + bj * HALF; const f32x4 p0 = *(const f32x4*)(P2 + o), p1 = *(const f32x4*)(P2 + o + 4); const f32x4 a0 = i2f(acc[ai][bj][m][0]) * s, a1 = i2f(acc[ai][bj][m][1]) * s;
                        u32x4 w; w.x = cvt_pk_bf16(fast_sigmoid(a0[0]) * p0[0], fast_sigmoid(a0[1]) * p0[1]); w.y = cvt_pk_bf16(fast_sigmoid(a0[2]) * p0[2], fast_sigmoid(a0[3]) * p0[3]);
                        w.z = cvt_pk_bf16(fast_sigmoid(a1[0]) * p1[0], fast_sigmoid(a1[1]) * p1[1]); w.w = cvt_pk_bf16(fast_sigmoid(a1[2]) * p1[2], fast_sigmoid(a1[3]) * p1[3]);
                        *(u32x4*)(PLE + o) = w; }
                    if (m & 1) asm volatile("" ::: "memory"); }
            return; }
        const int col0 = u.on * 128 + cw;
        const float* bg = b_gu + (size_t)u.e * 2048 + col0; const float sg = scl[u.e];
        const float* lsx = (const float*)(ws + WS_LSX) + (size_t)u.e * LISTCAP + u.mt * BM + trow0;
#pragma unroll
        for (int n = 0; n < 2; ++n) { const f32x4 bgn = *(const f32x4*)(bg + 4 * n), bun = *(const f32x4*)(bg + 1024 + 4 * n);
#pragma unroll
            for (int ai = 0; ai < 2; ++ai)
#pragma unroll
                for (int m = 0; m < 4; ++m) { const unsigned twv = tw[u.slot * BM + trow0 + ai * HALF + m * 16]; const float w = bfhi(twv);
                    const float s = (w != 0.f ? lsx[ai * HALF + m * 16] : 0.f) * sg;
                    const f32x4 gt = i2f(acc[ai][0][m][n]) * s + bgn, up = i2f(acc[ai][1][m][n]) * s + bun; f32x4 hv;
#pragma unroll
                    for (int j = 0; j < 4; ++j) { const float gv = fminf(gt[j], 7.0f), uv = fminf(fmaxf(up[j], -7.0f), 7.0f); hv[j] = (uv + 1.0f) * gv * fast_sigmoid(1.702f * gv) * w; }
                    u32x2 o; o.x = cvt_pk_bf16(hv[0], hv[1]); o.y = cvt_pk_bf16(hv[2], hv[3]);
                    *(u32x2*)(H + (size_t)(row0 + ai * HALF + m * 16) * D + col0 + 4 * n) = o; } }
    }
};
struct EpiDown {
    static constexpr bool PERM = true; typedef f32x4 AccT;
    bf16_t* Y; unsigned char* ws;
    __device__ __forceinline__ void operator()(AccRef acc, const Unit& u, int wr, int wc, int fr, int fq) const {
        if (u.e < 0) { ple_epilogue(acc, u, wr, wc, fr, fq, (const float*)(ws + WS_P2), (bf16_t*)(ws + WS_PLE)); return; }
        bf16_t* yp = Y + (size_t)(u.om * BM + wr * 64 + fr) * D + u.on * BM + wc * 32 + 8 * fq;
#pragma unroll
        for (int ai = 0; ai < 2; ++ai)
#pragma unroll
            for (int m = 0; m < 4; ++m)
#pragma unroll
                for (int bj = 0; bj < 2; ++bj) { const f32x4 v0 = acc[ai][bj][m][0], v1 = acc[ai][bj][m][1];
                    u32x4 o; o.x = cvt_pk_bf16(v0[0], v0[1]); o.y = cvt_pk_bf16(v0[2], v0[3]); o.z = cvt_pk_bf16(v1[0], v1[1]); o.w = cvt_pk_bf16(v1[2], v1[3]);
                    *(u32x4*)(yp + (size_t)(ai * HALF + m * 16) * D + bj * HALF) = o; }
    }
};

struct DualOrder {
    StaticOrder so;
    __device__ __forceinline__ bool next(int i, Unit& u) const {
        int pm, pn, q; if (!so.tile(i >> 1, pm, pn, q)) return false;
        const int e = i & 1; u.pm = e * (M / BM) + pm; u.pn = e * 4 + pn; u.om = pm; u.on = pn; u.e = e; u.mt = 0; u.slot = 0; return true;
    }
    __device__ __forceinline__ void a_off(const Unit& u, int tid, int K, unsigned (&o)[2][2]) const { plain_a_off(u.pm, tid, K, o); }
};
struct MoeOrder {
    const LAS int* cntL; const LAS int* tsL; const LAS unsigned* tw; int NT, gather, btile0, btile_ple, n_extra, extra_first; unsigned abase, abase_ple; TailSplit ts; int U; const LAS int* utab; int nunits;
    __device__ __forceinline__ void init(const LAS int* cntL_, const LAS int* tsL_, const LAS unsigned* tw_, int NT_, int G_, int c_, int gather_, size_t aoff_, size_t boff_, int n_extra_, int extra_first_, size_t aoff_ple_, size_t boff_ple_, int tshift_) {
        cntL = cntL_; tsL = tsL_; tw = tw_; NT = NT_; gather = gather_; abase = (unsigned)aoff_; btile0 = (int)(boff_ >> tshift_); abase_ple = (unsigned)aoff_ple_; btile_ple = (int)(boff_ple_ >> tshift_); n_extra = n_extra_; extra_first = extra_first_;
        U = __builtin_amdgcn_readfirstlane(tsL_[NE]) * NT_; ts.init(U + n_extra_, G_, c_, 1); utab = nullptr; nunits = 0; }
    __device__ __forceinline__ void build_units(LAS int* tab, int maxu) {
        Unit u; int n = 0;
        for (; n < maxu && decode(n, u); ++n) { LAS int* p = tab + 8 * n; p[0] = u.pm; p[1] = u.pn; p[2] = u.on; p[3] = u.e; p[4] = u.mt; }
        __syncthreads();
        utab = tab; nunits = n;
    }
    __device__ __forceinline__ bool next(int i, Unit& u) const {
        if (i >= nunits) return false;
        const LAS int* p = utab + 8 * i;
        u.pm = __builtin_amdgcn_readfirstlane(p[0]); u.pn = __builtin_amdgcn_readfirstlane(p[1]); u.om = u.pm; u.on = __builtin_amdgcn_readfirstlane(p[2]);
        u.e = __builtin_amdgcn_readfirstlane(p[3]); u.mt = __builtin_amdgcn_readfirstlane(p[4]); u.slot = i; return true;
    }
    __device__ __forceinline__ bool decode(int i, Unit& u) const {
        int L, q; if (!ts.map(i, L, q)) return false;
        if (L >= U) { const int j = extra_first + (L - U), pm = (j >> 5) * 8 + (j & 7), pn = (j & 31) >> 3;
            u.pm = pm; u.pn = btile_ple + pn; u.om = pm; u.on = pn; u.e = -1; u.mt = 0; u.slot = 0; return true; }
        const int wgid = xcd_remap(L, U);
        int e = 0;
        for (int k = 1; k < NE; ++k) e += (wgid >= __builtin_amdgcn_readfirstlane(tsL[k]) * NT) ? 1 : 0;
        const int t0 = __builtin_amdgcn_readfirstlane(tsL[e]), ntl = __builtin_amdgcn_readfirstlane(tsL[e + 1]) - t0, r = wgid - t0 * NT;
        const int nt = r / ntl, mt = r - nt * ntl;
        u.pm = t0 + mt; u.pn = btile0 + e * NT + nt; u.om = t0 + mt; u.on = nt; u.e = e; u.mt = mt; u.slot = i; return true;
    }
    __device__ __forceinline__ void a_off(const Unit& u, int tid, int K, unsigned (&o)[2][2]) const {
        if (u.e < 0 || !gather) { plain_a_off(u.pm, tid, K, o); const unsigned base = u.e < 0 ? abase_ple : abase;
#pragma unroll
            for (int h = 0; h < 2; ++h)
#pragma unroll
                for (int i = 0; i < 2; ++i) o[h][i] += base;
            return; }
#pragma unroll
        for (int i = 0; i < 2; ++i) { int R, C; stage_rc(tid * 16 + i * 8192, R, C);
#pragma unroll
            for (int h = 0; h < 2; ++h) { const int tok = (int)(tw[u.slot * BM + h * HALF + R] & 0xffffu);
                o[h][i] = (unsigned)(tok * K + C) * 2u + abase; } }
    }
};
constexpr int MOE_MAXU = 10;
__device__ __forceinline__ void moe_preload(const MoeOrder& S, const LAS int* cntL, const int* list_tok, const float* list_w, LAS unsigned* tw) {
    Unit u;
    for (int i = 0; i < MOE_MAXU && S.next(i, u); ++i)
        if (u.e >= 0 && threadIdx.x < BM) { const int li = u.mt * BM + (int)threadIdx.x; unsigned v = 0u;
            if (li < cntL[u.e]) v = (unsigned)list_tok[(size_t)u.e * LISTCAP + li] | (f2bf(list_w[(size_t)u.e * LISTCAP + li]) << 16);
            tw[i * BM + threadIdx.x] = v; }
    __syncthreads();
}
struct Ple1Order {
    int first, n;
    __device__ __forceinline__ bool next(int i, Unit& u) const { if (i >= n) return false; const int j = first + i, pm = (j >> 5) * 8 + (j & 7), pn = (j & 31) >> 3;
        u.pm = pm; u.pn = pn; u.om = pm; u.on = pn; u.e = 0; u.mt = 0; u.slot = 0; return true; }
    __device__ __forceinline__ void a_off(const Unit& u, int tid, int K, unsigned (&o)[2][2]) const { plain_a_off(u.pm, tid, K, o); }
};
}
__device__ __forceinline__ int dst_row(int n, int map) {
    if (map == 1) { if (n >= 1024 && n < 3072) { const int hsel = n >= 2048, c = n - 1024 - hsel * 1024; return 1024 + (c >> 7) * 256 + hsel * 128 + (c & 127); } return n; }
    if (map == 2) { const int hsel = n >= 1024, c = n - hsel * 1024; return (c >> 7) * 256 + hsel * 128 + (c & 127); }
    return n;
}
struct P0Args { const float *x, *p, *w_in, *w_brc, *w_bra, *w_out, *w_pg, *w_pp, *w_gu, *w_dn; unsigned char* ws; };
struct P0Item { const float* src; bf16_t* dst; int K, N; float qinv; };
constexpr int P0_I_IN = 16 * (NIN / 64), P0_I_SQ = 16 * 16, P0_I_PP = 4 * 16, P0_I_GU = 16 * 32, P0_I_DN = 16 * 16;
constexpr int P0_NSMALL = P0_I_IN + 4 * P0_I_SQ + P0_I_PP;
constexpr int P0_NITEMS = P0_I_IN + 5 * P0_I_SQ + P0_I_PP + NE * P0_I_GU + NE * P0_I_DN;
__device__ __forceinline__ P0Item p0_decode(const P0Args& a, int it) {
    const float* W; bf16_t* WT; int K = D, N = D, map = 0, r = it; float qinv = 0.f; const float* scl = (const float*)(a.ws + WS_SCL);
    if (r < P0_I_IN) { W = a.w_in; WT = (bf16_t*)(a.ws + WS_WIN); N = NIN; map = 1; }
    else if ((r -= P0_I_IN) < P0_I_SQ) { W = a.w_brc; WT = (bf16_t*)(a.ws + WS_WBR); }
    else if ((r -= P0_I_SQ) < P0_I_SQ) { W = a.w_bra; WT = (bf16_t*)(a.ws + WS_WBR) + (size_t)D * D; }
    else if ((r -= P0_I_SQ) < P0_I_SQ) { W = a.w_out; WT = (bf16_t*)(a.ws + WS_WOUT); }
    else if ((r -= P0_I_SQ) < P0_I_SQ) { W = a.w_pg; WT = (bf16_t*)(a.ws + WS_WPG); }
    else if ((r -= P0_I_SQ) < P0_I_PP) { W = a.w_pp; WT = (bf16_t*)(a.ws + WS_WPP); K = DPLE; }
    else if ((r -= P0_I_PP) < P0_I_SQ) { W = a.w_pg; WT = (bf16_t*)(a.ws + WS_WPG8); qinv = 1.0f / scl[NE]; }
    else if ((r -= P0_I_SQ) < NE * P0_I_GU) { const int e = r / P0_I_GU; r -= e * P0_I_GU; W = a.w_gu + (size_t)e * D * 2048; WT = (bf16_t*)(a.ws + WS_WGU + (size_t)e * 2048 * D); N = 2048; map = 2; qinv = 1.0f / scl[e]; }
    else { r -= NE * P0_I_GU; const int e = r / P0_I_DN; r -= e * P0_I_DN; W = a.w_dn + (size_t)e * D * D; WT = (bf16_t*)(a.ws + WS_WDN) + (size_t)e * D * D; }
    const int nblk = N / 64, kb = r / nblk, nb = r - kb * nblk, k0 = 64 * kb, n0 = 64 * nb;
    P0Item d; d.src = W + (size_t)k0 * N + n0; d.K = K; d.N = N; d.qinv = qinv;
    d.dst = qinv != 0.f ? (bf16_t*)((unsigned char*)WT + (size_t)dst_row(n0, map) * K + k0) : WT + (size_t)dst_row(n0, map) * K + k0; return d;
}
__device__ __forceinline__ void p0_load(const P0Item& d, f32x4 (&v)[16], int lane) {
    const int lr = lane >> 4, lc = (lane & 15) * 4;
#pragma unroll
    for (int i = 0; i < 16; ++i) v[i] = __builtin_nontemporal_load((const f32x4*)(d.src + (size_t)(4 * i + lr) * d.N + lc));
}
__device__ __forceinline__ void p0_store(const P0Item& d, const f32x4 (&v)[16], LAS float* scr, int lane) {
    const int lr = lane >> 4, lc = (lane & 15) * 4;
#pragma unroll
    for (int i = 0; i < 16; ++i) { LAS float* s = scr + (4 * i + lr) * 65 + lc; s[0] = v[i][0]; s[1] = v[i][1]; s[2] = v[i][2]; s[3] = v[i][3]; }
    asm volatile("s_waitcnt lgkmcnt(0)" ::: "memory");
    const int c = lane & 7;
#pragma unroll
    for (int j = 0; j < 8; ++j) { const int n = (lane >> 3) + 8 * j; const LAS float* s = scr + (8 * c) * 65 + n;
        if (d.qinv != 0.f) { unsigned lo = 0u, hi = 0u;
#pragma unroll
            for (int q = 0; q < 4; ++q) { const int a0 = (int)fminf(fmaxf(rintf(s[q * 65] * d.qinv), -127.f), 127.f), a1 = (int)fminf(fmaxf(rintf(s[(q + 4) * 65] * d.qinv), -127.f), 127.f);
                lo |= ((unsigned)a0 & 0xffu) << (8 * q); hi |= ((unsigned)a1 & 0xffu) << (8 * q); }
            *(u32x2*)((unsigned char*)d.dst + (size_t)n * d.K + 8 * c) = (u32x2){lo, hi}; }
        else { u32x4 o; o.x = pk2(s[0 * 65], s[1 * 65]); o.y = pk2(s[2 * 65], s[3 * 65]); o.z = pk2(s[4 * 65], s[5 * 65]); o.w = pk2(s[6 * 65], s[7 * 65]);
            *(u32x4*)(d.dst + (size_t)n * d.K + 8 * c) = o; } }
    asm volatile("s_waitcnt lgkmcnt(0)" ::: "memory");
}
__device__ __forceinline__ void p0_calibrate(const P0Args& a, LAS unsigned char* lds, int vcu) {
    if (vcu > NE) return;
    __syncthreads();
    const int tid = threadIdx.x; const float* Wm = vcu < NE ? a.w_gu + (size_t)vcu * D * 2048 : a.w_pg; const size_t stride = vcu < NE ? 4096 : 2048;
    const f32x4 v0 = *(const f32x4*)(Wm + tid * stride), v1 = *(const f32x4*)(Wm + tid * stride + 4);
    float ss = (v0[0] * v0[0] + v0[1] * v0[1]) + (v0[2] * v0[2] + v0[3] * v0[3]) + (v1[0] * v1[0] + v1[1] * v1[1]) + (v1[2] * v1[2] + v1[3] * v1[3]);
    float mx = fmaxf(fmaxf(fmaxf(fabsf(v0[0]), fabsf(v0[1])), fmaxf(fabsf(v0[2]), fabsf(v0[3]))), fmaxf(fmaxf(fabsf(v1[0]), fabsf(v1[1])), fmaxf(fabsf(v1[2]), fabsf(v1[3]))));
    ss = wave_sum(ss);
#pragma unroll
    for (int o = 1; o < 64; o <<= 1) mx = fmaxf(mx, __shfl_xor(mx, o));
    LAS float* red = (LAS float*)lds;
    if ((tid & 63) == 0) { red[tid >> 6] = ss; red[8 + (tid >> 6)] = mx; }
    __syncthreads();
    if (tid == 0) { float s = 0.f, m = 0.f; for (int w = 0; w < NWAVES; ++w) { s += red[w]; m = fmaxf(m, red[8 + w]); }
        const float clip = fmaxf(6.5f * sqrtf(s * (1.0f / 4096.0f)), 1.25f * m); ((float*)(a.ws + WS_SCL))[vcu] = fmaxf(clip, 1e-30f) * (1.0f / 127.0f); }
    __syncthreads();
}
__device__ __forceinline__ void p0_phase(const P0Args& a, LAS unsigned char* lds, int vcu, int G, int it_lo, int it_hi, bool do_xp) {
    int tid_ = threadIdx.x; asm volatile("" : "+v"(tid_));
    const int tid = tid_, lane = tid & 63, wave = __builtin_amdgcn_readfirstlane(tid >> 6);
    LAS float* scr = (LAS float*)(lds + wave * 16640);
    const int gw = vcu * NWAVES + wave, NGW = G * NWAVES;
    f32x4 va[16], vb[16]; P0Item da, db;
    int it = it_lo + gw;
    if (it < it_hi) { da = p0_decode(a, it); p0_load(da, va, lane); }
    while (it < it_hi) {
        const bool hb = it + NGW < it_hi;
        if (hb) { db = p0_decode(a, it + NGW); p0_load(db, vb, lane); }
        p0_store(da, va, scr, lane);
        if (!hb) break;
        const bool ha = it + 2 * NGW < it_hi;
        if (ha) { da = p0_decode(a, it + 2 * NGW); p0_load(da, va, lane); }
        p0_store(db, vb, scr, lane);
        if (!ha) break;
        it += 2 * NGW;
    }
    if (!do_xp) return;
    p0_calibrate(a, lds, vcu);
    const int gt = vcu * NTHREADS + tid, NGT = G * NTHREADS;
    for (int i = gt; i < M * D / 8; i += 4 * NGT) { f32x4 v[4][2];
#pragma unroll
        for (int u = 0; u < 4; ++u) { const size_t o = (size_t)(i + u * NGT) * 8; v[u][0] = __builtin_nontemporal_load((const f32x4*)(a.x + o)); v[u][1] = __builtin_nontemporal_load((const f32x4*)(a.x + o + 4)); }
#pragma unroll
        for (int u = 0; u < 4; ++u) { u32x4 o; o.x = pk2(v[u][0][0], v[u][0][1]); o.y = pk2(v[u][0][2], v[u][0][3]); o.z = pk2(v[u][1][0], v[u][1][1]); o.w = pk2(v[u][1][2], v[u][1][3]);
            *(u32x4*)((bf16_t*)(a.ws + WS_XB) + (size_t)(i + u * NGT) * 8) = o; } }
    for (int i = gt; i < M * DPLE / 8; i += 4 * NGT) { f32x4 v[4][2];
#pragma unroll
        for (int u = 0; u < 4; ++u) { const size_t o = (size_t)(i + u * NGT) * 8; v[u][0] = __builtin_nontemporal_load((const f32x4*)(a.p + o)); v[u][1] = __builtin_nontemporal_load((const f32x4*)(a.p + o + 4)); }
#pragma unroll
        for (int u = 0; u < 4; ++u) { u32x4 o; o.x = pk2(v[u][0][0], v[u][0][1]); o.y = pk2(v[u][0][2], v[u][0][3]); o.z = pk2(v[u][1][0], v[u][1][1]); o.w = pk2(v[u][1][2], v[u][1][3]);
            *(u32x4*)((bf16_t*)(a.ws + WS_PB) + (size_t)(i + u * NGT) * 8) = o; } }
}

__device__ __forceinline__ int crow(int r, int hi) { return (r & 3) + 8 * (r >> 2) + 4 * hi; }
typedef short v4i16_t __attribute__((ext_vector_type(4)));
__device__ __forceinline__ s16x4 vtr(const LAS unsigned char* p) { return __builtin_bit_cast(s16x4, __builtin_amdgcn_ds_read_tr16_b64_v4i16((LAS v4i16_t*)p)); }
__device__ __forceinline__ void attn_unit(LAS unsigned char* lds, const bf16_t* Q, const bf16_t* Kg, const bf16_t* Vg, const float* sinks, bf16_t* O, int b, int kvh, int nb) {
    int tid_ = threadIdx.x; asm volatile("" : "+v"(tid_));
    const int tid = tid_, lane = tid & 63, r32 = lane & 31, hi = lane >> 5; const int wid = __builtin_amdgcn_readfirstlane(tid >> 6);
    const int t0 = b * SEQ + nb * 128;
#pragma unroll
    for (int it = 0; it < 4; ++it) { const int idx = tid + it * NTHREADS, key = idx >> 3, c = idx & 7;
        int row = t0 - 128 + key; if (row < b * SEQ) row = b * SEQ;
        const u32x4 kv = *(const u32x4*)(Kg + (size_t)row * 256 + kvh * HD + c * 8);
        const u32x4 vv = *(const u32x4*)(Vg + (size_t)row * 256 + kvh * HD + c * 8);
        *(LAS u32x4*)(lds + c * 4096 + key * 16) = kv;
        *(LAS u32x4*)(lds + 32768 + (c >> 2) * 16384 + (key >> 4) * 1024 + (key & 15) * 64 + (c & 3) * 16) = vv; }
    __syncthreads();
    const int g = wid >> 1, half = wid & 1, h = kvh * 4 + g;
    const float sink2 = sinks[h] * LOG2E;
    const LAS unsigned char* vbase = lds + 32768 + ((lane >> 4) & 1) * 32 + (lane & 3) * 8 + (4 * hi + ((lane & 15) >> 2)) * 64;
#pragma unroll 1
    for (int qq = 0; qq < 2; ++qq) {
        const int qt = half * 2 + qq;
        const bf16_t* qp = Q + (size_t)(t0 + 32 * qt + r32) * D + h * HD + hi * 8;
        bf16x8 qr[4];
#pragma unroll
        for (int d0 = 0; d0 < 4; ++d0) qr[d0] = *(const bf16x8*)(qp + d0 * 16);
        f32x16 s[5];
#pragma unroll
        for (int j = 0; j < 5; ++j) { const LAS unsigned char* kp = lds + hi * 4096 + ((qt + j) * 32 + r32) * 16; f32x16 a = {};
#pragma unroll
            for (int d0 = 0; d0 < 4; ++d0) a = __builtin_amdgcn_mfma_f32_32x32x16_bf16(*(const LAS bf16x8*)(kp + d0 * 8192), qr[d0], a, 0, 0, 0);
            s[j] = a; }
#pragma unroll
        for (int r = 0; r < 16; ++r) { const int cr = crow(r, hi); if (cr <= r32) s[0][r] = -INFINITY; if (cr > r32) s[4][r] = -INFINITY; }
        if (nb == 0) {
#pragma unroll
            for (int j = 0; j < 4; ++j) if (qt + j < 4) {
#pragma unroll
                for (int r = 0; r < 16; ++r) s[j][r] = -INFINITY; } }
        float mx = -INFINITY;
#pragma unroll
        for (int j = 0; j < 5; ++j)
#pragma unroll
            for (int r = 0; r < 16; ++r) mx = fmaxf(mx, s[j][r]);
        mx = fmaxf(mx, __shfl_xor(mx, 32)); mx = fmaxf(mx, sink2);
        float ls = 0.f;
#pragma unroll
        for (int j = 0; j < 5; ++j)
#pragma unroll
            for (int r = 0; r < 16; ++r) { s[j][r] = __builtin_amdgcn_exp2f(s[j][r] - mx); ls += s[j][r]; }
        ls += __shfl_xor(ls, 32); ls += __builtin_amdgcn_exp2f(sink2 - mx);
        const float linv = 1.0f / ls;
        f32x16 o[2]; o[0] = f32x16{}; o[1] = f32x16{};
#pragma unroll
        for (int j = 0; j < 5; ++j)
#pragma unroll
            for (int ks = 0; ks < 2; ++ks) {
                u32x4 pw; pw.x = pk2(s[j][8 * ks + 0], s[j][8 * ks + 1]); pw.y = pk2(s[j][8 * ks + 2], s[j][8 * ks + 3]); pw.z = pk2(s[j][8 * ks + 4], s[j][8 * ks + 5]); pw.w = pk2(s[j][8 * ks + 6], s[j][8 * ks + 7]);
                const bf16x8 pa = __builtin_bit_cast(bf16x8, pw);
                const LAS unsigned char* vp = vbase + ((qt + j) * 2 + ks) * 1024;
#pragma unroll
                for (int dh = 0; dh < 2; ++dh) { const s16x4 lo = vtr(vp + dh * 16384), hi4 = vtr(vp + dh * 16384 + 512);
                    const bf16x8 vf = {lo[0], lo[1], lo[2], lo[3], hi4[0], hi4[1], hi4[2], hi4[3]};
                    o[dh] = __builtin_amdgcn_mfma_f32_32x32x16_bf16(pa, vf, o[dh], 0, 0, 0); } }
        bf16_t* op = O + (size_t)(t0 + 32 * qt) * D + h * HD + r32;
#pragma unroll
        for (int r = 0; r < 16; ++r) { const int q = crow(r, hi); const float sc = __shfl(linv, q);
            op[(size_t)q * D] = (bf16_t)f2bf(o[0][r] * sc); op[(size_t)q * D + 32] = (bf16_t)f2bf(o[1][r] * sc); }
    }
    __syncthreads();
}
__device__ __forceinline__ void conv_phase(const bf16_t* Bg, const bf16_t* U, const float* cw, bf16_t* Z, int vcu, int G) {
    int tid_ = threadIdx.x; asm volatile("" : "+v"(tid_));
    const int gt = vcu * NTHREADS + tid_, NGT = G * NTHREADS;
    for (int i = gt; i < (M / 8) * (D / 8); i += NGT) {
        const int t0 = (i >> 7) * 8, c = (i & 127) * 8, tl0 = t0 & (SEQ - 1);
        f32x4 w[3][2];
#pragma unroll
        for (int k = 0; k < 3; ++k) { w[k][0] = *(const f32x4*)(cw + k * D + c); w[k][1] = *(const f32x4*)(cw + k * D + c + 4); }
        u32x4 ur[10], br[8];
#pragma unroll
        for (int r = 0; r < 10; ++r) { if (r >= 2 || tl0 != 0) ur[r] = *(const u32x4*)(U + (size_t)(t0 + r - 2) * D + c); else ur[r] = (u32x4){0u, 0u, 0u, 0u}; }
#pragma unroll
        for (int r = 0; r < 8; ++r) br[r] = *(const u32x4*)(Bg + (size_t)(t0 + r) * D + c);
#pragma unroll
        for (int r = 0; r < 8; ++r) { float y[8];
#pragma unroll
            for (int j = 0; j < 8; ++j) y[j] = 0.f;
#pragma unroll
            for (int k = 0; k < 3; ++k) { const u32x4 uw = ur[r + k];
                y[0] += w[k][0][0] * bflo(uw.x); y[1] += w[k][0][1] * bfhi(uw.x); y[2] += w[k][0][2] * bflo(uw.y); y[3] += w[k][0][3] * bfhi(uw.y);
                y[4] += w[k][1][0] * bflo(uw.z); y[5] += w[k][1][1] * bfhi(uw.z); y[6] += w[k][1][2] * bflo(uw.w); y[7] += w[k][1][3] * bfhi(uw.w); }
            const u32x4 bw = br[r];
            u32x4 o; o.x = pk2(y[0] * bflo(bw.x), y[1] * bfhi(bw.x)); o.y = pk2(y[2] * bflo(bw.y), y[3] * bfhi(bw.y)); o.z = pk2(y[4] * bflo(bw.z), y[5] * bfhi(bw.z)); o.w = pk2(y[6] * bflo(bw.w), y[7] * bfhi(bw.w));
            *(u32x4*)(Z + (size_t)(t0 + r) * D + c) = o; }
    }
}
#ifndef DBG_ATTN
#define DBG_ATTN 0
#endif
#if DBG_ATTN
__device__ __forceinline__ void dbg_attn_check(const bf16_t* Q, const bf16_t* Kg, const bf16_t* Vg, const float* sinks, const bf16_t* O, float* acc3, int vcu, int G) {
    const int lane = threadIdx.x & 63, wave = threadIdx.x >> 6;
    const int gw = vcu * NWAVES + wave, nw = G * NWAVES;
    float lnum = 0.f, lden = 0.f, lmax = 0.f;
    for (int it = gw; it < M * NH; it += nw) {
        const int t = it / NH, h = it % NH, kvh = h / 4, tl = t % SEQ;
        const int slo = tl - 127 < 0 ? 0 : tl - 127, n = tl - slo + 1;
        const bf16_t* qp = Q + (size_t)t * D + h * HD;
        float sc[2];
#pragma unroll
        for (int u = 0; u < 2; ++u) { const int j = lane + 64 * u; float dot = -INFINITY;
            if (j < n) { const bf16_t* kp = Kg + (size_t)(t - tl + slo + j) * 256 + kvh * HD; dot = 0.f;
                for (int d = 0; d < HD; ++d) dot = fmaf(bflo((unsigned)qp[d]), bflo((unsigned)kp[d]), dot);
                dot *= (1.0f / LOG2E); }
            sc[u] = dot; }
        const float sink = sinks[h];
        float m = fmaxf(sc[0], sc[1]);
        for (int o = 1; o < 64; o <<= 1) m = fmaxf(m, __shfl_xor(m, o));
        m = fmaxf(m, sink);
        float e0 = (lane < n) ? expf(sc[0] - m) : 0.f, e1 = (lane + 64 < n) ? expf(sc[1] - m) : 0.f;
        float s = e0 + e1;
        for (int o = 1; o < 64; o <<= 1) s += __shfl_xor(s, o);
        const float denom = s + expf(sink - m);
        e0 /= denom; e1 /= denom;
        float a = 0.f;
        for (int j = 0; j < n; ++j) { const float pj = __shfl(j < 64 ? e0 : e1, j & 63); a = fmaf(pj, bflo((unsigned)Vg[(size_t)(t - tl + slo + j) * 256 + kvh * HD + lane]), a); }
        const float o = bflo((unsigned)O[(size_t)t * D + h * HD + lane]);
        const float rn = wave_sum((o - a) * (o - a)), rd = wave_sum(a * a);
        lnum += rn; lden += rd; lmax = fmaxf(lmax, rn / fmaxf(rd, 1e-20f));
    }
    if (lane == 0) { atomicAdd(acc3, lnum); atomicAdd(acc3 + 1, lden); atomicMax((unsigned*)(acc3 + 2), __float_as_uint(lmax)); }
}
#endif
constexpr int WR_STRIDE = 1028;
struct RouteArgs { float* X1F; bf16_t* X1B; const float *g1, *b1, *w_r, *b_r; int* gcnt; int* list_tok; float* list_w; int* tk_e; int* tk_rank; float* tk_w; unsigned char* XQ; float* sx1; float* list_sx; };
__device__ __forceinline__ void route_phase(const RouteArgs& a, LAS unsigned char* lds, int vcu, int G, bool dry) {
    int tid_ = threadIdx.x; asm volatile("" : "+v"(tid_));
    const int tid = tid_, lane = tid & 63, wave = __builtin_amdgcn_readfirstlane(tid >> 6);
    LAS float* wrt = (LAS float*)lds;
    LAS int* misc = (LAS int*)(lds + MISC_OFF);
    LAS int* lcnt = misc + 96; LAS int* gbase = misc + 128; LAS int* rowe = misc + 160; LAS float* roww = (LAS float*)(misc + 416); LAS float* rowsx = (LAS float*)(misc + 672);
    for (int i = tid; i < D * NE; i += NTHREADS) { const int c = i >> 5, e = i & 31; wrt[e * WR_STRIDE + c] = a.w_r[i]; }
    if (tid < NE) lcnt[tid] = 0;
    __syncthreads();
    const int rows_per_wg = M / G;
    for (int rr = 2 * wave; rr < rows_per_wg; rr += 2 * NWAVES) {
        f32x4 v[2][4];
#pragma unroll
        for (int x = 0; x < 2; ++x) { const int t = vcu * rows_per_wg + rr + x; float s = 0.f;
#pragma unroll
            for (int j = 0; j < 4; ++j) { v[x][j] = *(const f32x4*)(a.X1F + (size_t)t * D + 256 * j + 4 * lane); s += (v[x][j][0] + v[x][j][1]) + (v[x][j][2] + v[x][j][3]); }
            const float mean = wave_sum(s) * (1.0f / D); float q = 0.f;
#pragma unroll
            for (int j = 0; j < 4; ++j) { v[x][j] = v[x][j] - mean; q += (v[x][j][0] * v[x][j][0] + v[x][j][1] * v[x][j][1]) + (v[x][j][2] * v[x][j][2] + v[x][j][3] * v[x][j][3]); }
            const float rstd = 1.0f / sqrtf(wave_sum(q) * (1.0f / D) + LN_EPS);
#pragma unroll
            for (int j = 0; j < 4; ++j) { const f32x4 gg = *(const f32x4*)(a.g1 + 256 * j + 4 * lane), bb = *(const f32x4*)(a.b1 + 256 * j + 4 * lane);
                v[x][j] = v[x][j] * rstd * gg + bb;
                if (!dry) { u32x2 w; w.x = pk2(v[x][j][0], v[x][j][1]); w.y = pk2(v[x][j][2], v[x][j][3]); *(u32x2*)(a.X1B + (size_t)t * D + 256 * j + 4 * lane) = w; } }
            float am = 0.f;
#pragma unroll
            for (int j = 0; j < 4; ++j) am = fmaxf(am, fmaxf(fmaxf(fabsf(v[x][j][0]), fabsf(v[x][j][1])), fmaxf(fabsf(v[x][j][2]), fabsf(v[x][j][3]))));
#pragma unroll
            for (int o = 1; o < 64; o <<= 1) am = fmaxf(am, __shfl_xor(am, o));
            const float sxr = fmaxf(am, 1e-30f) * (1.0f / 127.0f), qi = 1.0f / sxr;
            if (!dry) {
#pragma unroll
                for (int j = 0; j < 4; ++j) { unsigned q = 0u;
#pragma unroll
                    for (int z = 0; z < 4; ++z) q |= ((unsigned)(int)rintf(v[x][j][z] * qi) & 0xffu) << (8 * z);
                    *(unsigned*)(a.XQ + (size_t)t * D + 256 * j + 4 * lane) = q; }
                if (lane == 0) { a.sx1[t] = sxr; rowsx[rr + x] = sxr; } } }
        float pl[2][32];
#pragma unroll
        for (int e = 0; e < 32; ++e) { float a0 = 0.f, a1 = 0.f;
#pragma unroll
            for (int j = 0; j < 4; ++j) { const f32x4 w = *(const LAS f32x4*)(wrt + e * WR_STRIDE + 256 * j + 4 * lane);
                a0 += (v[0][j][0] * w[0] + v[0][j][1] * w[1]) + (v[0][j][2] * w[2] + v[0][j][3] * w[3]); a1 += (v[1][j][0] * w[0] + v[1][j][1] * w[1]) + (v[1][j][2] * w[2] + v[1][j][3] * w[3]); }
            pl[0][e] = a0; pl[1][e] = a1; }
#pragma unroll
        for (int o = 32, n = 16; o >= 2; o >>= 1, n >>= 1) { const bool up = (lane & o) != 0;
#pragma unroll
            for (int i = 0; i < 16; ++i) if (i < n) {
#pragma unroll
                for (int x = 0; x < 2; ++x) { const float send = up ? pl[x][i] : pl[x][i + n], keep = up ? pl[x][i + n] : pl[x][i]; pl[x][i] = keep + __shfl_xor(send, o); } } }
        const int myexp = lane >> 1; const float brv = a.b_r[myexp];
        float logit[2];
#pragma unroll
        for (int x = 0; x < 2; ++x) logit[x] = pl[x][0] + __shfl_xor(pl[x][0], 1) + brv;
        int se[2][4]; float sv[2][4];
#pragma unroll
        for (int k = 0; k < 4; ++k) { float bv[2]; int bi[2];
#pragma unroll
            for (int x = 0; x < 2; ++x) { bv[x] = logit[x]; bi[x] = myexp; }
#pragma unroll
            for (int o = 1; o < 64; o <<= 1) {
#pragma unroll
                for (int x = 0; x < 2; ++x) { const float ov = __shfl_xor(bv[x], o); const int oi = __shfl_xor(bi[x], o); if (ov > bv[x] || (ov == bv[x] && oi < bi[x])) { bv[x] = ov; bi[x] = oi; } } }
#pragma unroll
            for (int x = 0; x < 2; ++x) { se[x][k] = bi[x]; sv[x][k] = bv[x]; if (myexp == bi[x]) logit[x] = -INFINITY; } }
#pragma unroll
        for (int x = 0; x < 2; ++x) { const float e1 = __expf(sv[x][1] - sv[x][0]), e2 = __expf(sv[x][2] - sv[x][0]), e3 = __expf(sv[x][3] - sv[x][0]);
            const float inv = 1.0f / (1.0f + e1 + e2 + e3);
            if (lane < 4) { const int e = lane == 0 ? se[x][0] : lane == 1 ? se[x][1] : lane == 2 ? se[x][2] : se[x][3];
                const float w = (lane == 0 ? 1.0f : lane == 1 ? e1 : lane == 2 ? e2 : e3) * inv;
                rowe[(rr + x) * 4 + lane] = e; roww[(rr + x) * 4 + lane] = w; } }
    }
    __syncthreads();
    if (dry) return;
    const int nent = rows_per_wg * 4;
    int my_e = 0, my_lr = 0;
    if (tid < nent) { my_e = rowe[tid]; my_lr = atomicAdd((int*)(lcnt + my_e), 1); }
    __syncthreads();
    if (tid < NE) gbase[tid] = atomicAdd(a.gcnt + tid, lcnt[tid]);
    __syncthreads();
    if (tid < nent) { const int t = vcu * rows_per_wg + (tid >> 2), rank = gbase[my_e] + my_lr;
        a.list_tok[(size_t)my_e * LISTCAP + rank] = t; a.list_w[(size_t)my_e * LISTCAP + rank] = roww[tid]; a.list_sx[(size_t)my_e * LISTCAP + rank] = rowsx[tid >> 2];
        a.tk_e[t * 4 + (tid & 3)] = my_e; a.tk_rank[t * 4 + (tid & 3)] = rank; a.tk_w[t * 4 + (tid & 3)] = roww[tid]; }
    __syncthreads();
}
__device__ __forceinline__ void build_tables(const int* gcnt, LAS unsigned char* lds) {
    LAS int* misc = (LAS int*)(lds + MISC_OFF);
    if (threadIdx.x == 0) { int a = 0; for (int e = 0; e < NE; ++e) { const int c = __hip_atomic_load(gcnt + e, __ATOMIC_RELAXED, __HIP_MEMORY_SCOPE_AGENT); misc[e] = c; misc[32 + e] = a; a += (c + 255) >> 8; } misc[32 + NE] = a; }
    __syncthreads();
}
struct FinalArgs { float dbg_scale; int pad_; const bf16_t* X1B; const bf16_t* PLE; const bf16_t* Y; const int* tk_e; const int* tk_rank; const float* tk_w; const float* b_down; const float *g2, *b2; float* out; };
__device__ __forceinline__ void final_phase(const FinalArgs& a, LAS unsigned char* lds, int vcu, int G) {
    int tid_ = threadIdx.x; asm volatile("" : "+v"(tid_));
    const int tid = tid_, lane = tid & 63, wave = __builtin_amdgcn_readfirstlane(tid >> 6);
    const LAS int* ts = (const LAS int*)(lds + MISC_OFF) + 32;
    LAS float* bdl = (LAS float*)lds;
    for (int i = tid; i < NE * D / 4; i += NTHREADS) *(LAS f32x4*)(bdl + 4 * i) = *(const f32x4*)(a.b_down + 4 * i);
    __syncthreads();
    const int gw = vcu * NWAVES + wave, NGW = G * NWAVES;
    for (int t0 = 2 * gw; t0 < M; t0 += 2 * NGW) {
        size_t pos[2][4]; int ek[2][4]; float wk[2][4];
#pragma unroll
        for (int x = 0; x < 2; ++x)
#pragma unroll
            for (int k = 0; k < 4; ++k) { const int t = t0 + x, e = a.tk_e[t * 4 + k], rk = a.tk_rank[t * 4 + k]; pos[x][k] = ((size_t)ts[e] * 256 + rk) * D; ek[x][k] = e * D; wk[x][k] = a.tk_w[t * 4 + k]; }
        f32x4 v[2][4]; float s[2] = {0.f, 0.f};
#pragma unroll
        for (int x = 0; x < 2; ++x)
#pragma unroll
            for (int j = 0; j < 4; ++j) { const int c = 256 * j + 4 * lane; const size_t ro = (size_t)(t0 + x) * D + c;
                const u32x2 xw = *(const u32x2*)(a.X1B + ro), pw = *(const u32x2*)(a.PLE + ro);
                f32x4 xx = {bflo(xw.x) * DN_ALPHA + bflo(pw.x), bfhi(xw.x) * DN_ALPHA + bfhi(pw.x), bflo(xw.y) * DN_ALPHA + bflo(pw.y), bfhi(xw.y) * DN_ALPHA + bfhi(pw.y)};
#pragma unroll
                for (int k = 0; k < 4; ++k) { const u32x2 yw = *(const u32x2*)(a.Y + pos[x][k] + c); const f32x4 bd = *(const LAS f32x4*)(bdl + ek[x][k] + c);
                    xx[0] += bflo(yw.x) + wk[x][k] * bd[0]; xx[1] += bfhi(yw.x) + wk[x][k] * bd[1]; xx[2] += bflo(yw.y) + wk[x][k] * bd[2]; xx[3] += bfhi(yw.y) + wk[x][k] * bd[3]; }
                v[x][j] = xx; s[x] += (xx[0] + xx[1]) + (xx[2] + xx[3]); }
#pragma unroll
        for (int x = 0; x < 2; ++x) { const float mean = wave_sum(s[x]) * (1.0f / D); float q = 0.f;
#pragma unroll
            for (int j = 0; j < 4; ++j) { v[x][j] = v[x][j] - mean; q += (v[x][j][0] * v[x][j][0] + v[x][j][1] * v[x][j][1]) + (v[x][j][2] * v[x][j][2] + v[x][j][3] * v[x][j][3]); }
            const float rstd = 1.0f / sqrtf(wave_sum(q) * (1.0f / D) + LN_EPS);
#pragma unroll
            for (int j = 0; j < 4; ++j) { const int c = 256 * j + 4 * lane; const f32x4 gg = *(const f32x4*)(a.g2 + c), bb = *(const f32x4*)(a.b2 + c);
                *(f32x4*)(a.out + (size_t)(t0 + x) * D + c) = (v[x][j] * rstd * gg + bb) * a.dbg_scale; } }
    }
}

#ifndef PROBE_REP
#define PROBE_REP 0
#endif
struct Args { const float* in[20]; float* out; unsigned char* ws; };
__global__ void __launch_bounds__(NTHREADS, 2) mega_fwd(Args args) {
    extern __shared__ __attribute__((aligned(16))) unsigned char lds_raw[];
    LAS unsigned char* lds = (LAS unsigned char*)lds_raw;
    cg::grid_group grid = cg::this_grid();
    const int G = gridDim.x, bx = blockIdx.x;
    const int vcu = (G % 8 == 0) ? (bx % 8) * (G / 8) + bx / 8 : bx;
    unsigned char* const ws = args.ws;
    const LAS int* cntL = (const LAS int*)(lds + MISC_OFF); const LAS int* tsL = cntL + 32;
    { volatile LAS unsigned* bst = (volatile LAS unsigned*)(lds + MISC_OFF) + BST_IDX;
      if (threadIdx.x < 2) bst[threadIdx.x] = 0u;
      __syncthreads();
      (void)xcd_barrier_post((unsigned*)(ws + WS_BAR), bst); }
#define GRID_BAR() do { XcdBarrier b_; b_.bar = (unsigned*)(ws + WS_BAR); b_.x = xb_xcc_id(); b_.st = (volatile LAS unsigned*)(lds + MISC_OFF) + BST_IDX; xcd_barrier(b_); } while (0)
#define WSP(T, off) ((T*)(ws + (off)))

    _Pragma("unroll 1") for (int rep_ = 0; rep_ < ((PROBE_REP & 1) ? 2 : 1); ++rep_) { P0Args a{args.in[0], args.in[1], args.in[2], args.in[4], args.in[5], args.in[7], args.in[17], args.in[16], args.in[12], args.in[14], ws}; p0_phase(a, lds, vcu, G, 0, P0_NSMALL, true); }
    grid.sync();
    _Pragma("unroll 1") for (int rep_ = 0; rep_ < ((PROBE_REP & 2) ? 2 : 1); ++rep_) { pg8::Gemm g{WSP(bf16_t, WS_XB), (const bf16_t*)(ws + WS_WIN), D}; pg8::StaticOrder S; S.init(M / 256, NIN / 256, G, bx, 1);
      pg8::EpiInProj E{ws};
      pg8::gemm_phase<pg8::EpiInProj, pg8::StaticOrder, true>(lds, g, S, E);
#if (PROBE_REP & 0x10000)
      pg8::gemm_phase<pg8::EpiInProj, pg8::StaticOrder, true, 1>(lds, g, S, E);
#endif
#if (PROBE_REP & 0x20000)
      pg8::gemm_phase<pg8::EpiInProj, pg8::StaticOrder, true, 2>(lds, g, S, E);
#endif
      }
    { constexpr int U1 = (M / 256) * (NIN / 256); const int R1 = U1 % G, nidle = R1 ? G - R1 : G, per = 256 / nidle;
      if (R1 == 0 || bx >= R1) {
        pg8::Gemm g{WSP(bf16_t, WS_PB), (const bf16_t*)(ws + WS_WPP), DPLE}; pg8::Ple1Order S{(bx - R1) * per, per};
        pg8::EpiF32 E{WSP(float, WS_P2)};
        pg8::gemm_phase<pg8::EpiF32, pg8::Ple1Order, false>(lds, g, S, E); } }
    GRID_BAR();
    if (PROBE_REP & 4096) { _Pragma("unroll 1") for (int k_ = 0; k_ < 8; ++k_) GRID_BAR(); }
    _Pragma("unroll 1") for (int rep_ = 0; rep_ < ((PROBE_REP & 4) ? 2 : 1); ++rep_) for (int it = vcu; it < BATCH * NKV * (SEQ / 128); it += G) { const int nb = it & 63, kvh = (it >> 6) & 3, b = it >> 8;
        attn_unit(lds, WSP(bf16_t, WS_Q), WSP(bf16_t, WS_K), WSP(bf16_t, WS_V), args.in[6], WSP(bf16_t, WS_ZO) + (size_t)M * D, b, kvh, nb); }
    _Pragma("unroll 1") for (int rep_ = 0; rep_ < ((PROBE_REP & 8) ? 2 : 1); ++rep_) conv_phase(WSP(bf16_t, WS_BG), WSP(bf16_t, WS_U), args.in[3], WSP(bf16_t, WS_ZO), vcu, G);
    GRID_BAR();
#if DBG_ATTN
    dbg_attn_check(WSP(bf16_t, WS_Q), WSP(bf16_t, WS_K), WSP(bf16_t, WS_V), args.in[6], WSP(bf16_t, WS_ZO) + (size_t)M * D, WSP(float, WS_CTL) + 64, vcu, G);
#endif
    _Pragma("unroll 1") for (int rep_ = 0; rep_ < ((PROBE_REP & 16) ? 2 : 1); ++rep_) { pg8::Gemm g{WSP(bf16_t, WS_ZO), (const bf16_t*)(ws + WS_WBR), D}; pg8::DualOrder S; S.so.init(M / 256, D / 256, G, bx);
      pg8::EpiDual E{ws};
      pg8::gemm_phase<pg8::EpiDual, pg8::DualOrder, false>(lds, g, S, E); }
    GRID_BAR();
    _Pragma("unroll 1") for (int rep_ = 0; rep_ < ((PROBE_REP & 32) ? 2 : 1); ++rep_) { pg8::Gemm g{WSP(bf16_t, WS_MG), (const bf16_t*)(ws + WS_WOUT), D}; pg8::StaticOrder S; S.init(M / 256, D / 256, G, bx);
      pg8::EpiResid E{args.in[0], WSP(float, WS_X1F)};
      pg8::gemm_phase<pg8::EpiResid, pg8::StaticOrder, false>(lds, g, S, E); }
    GRID_BAR();
    { P0Args a{args.in[0], args.in[1], args.in[2], args.in[4], args.in[5], args.in[7], args.in[17], args.in[16], args.in[12], args.in[14], ws}; p0_phase(a, lds, vcu, G, P0_NSMALL, P0_NITEMS, false); __syncthreads(); }
    _Pragma("unroll 1") for (int rep_ = ((PROBE_REP & 64) ? 0 : 1); rep_ < 2; ++rep_) { RouteArgs a{WSP(float, WS_X1F), WSP(bf16_t, WS_X1B), args.in[8], args.in[9], args.in[10], args.in[11], WSP(int, WS_CTL), WSP(int, WS_LTOK), WSP(float, WS_LW), WSP(int, WS_TKE), WSP(int, WS_TKR), WSP(float, WS_TKW), ws + WS_XQ, WSP(float, WS_SX1), WSP(float, WS_LSX)}; route_phase(a, lds, vcu, G, rep_ == 0); }
    GRID_BAR();
    build_tables(WSP(int, WS_CTL), lds);
    const int U5_ = __builtin_amdgcn_readfirstlane(tsL[NE]) * 8, idle5_ = (G - U5_ % G) % G, nx5_ = idle5_ < 256 ? idle5_ : 256;
    { pg8::MoeOrder S; S.init(cntL, tsL, (const LAS unsigned*)(lds + TW_OFF), 8, G, bx, 1, WS_XQ, WS_WGU, nx5_, 0, WS_XQ, WS_WPG8, 18); S.build_units((LAS int*)(lds + UTAB_OFF), 12);
      pg8::moe_preload(S, cntL, WSP(int, WS_LTOK), WSP(float, WS_LW), (LAS unsigned*)(lds + TW_OFF));
      _Pragma("unroll 1") for (int rep_ = 0; rep_ < ((PROBE_REP & 128) ? 2 : 1); ++rep_) { pg8::Gemm g{(const bf16_t*)ws, (const bf16_t*)ws, D / 2};
        pg8::EpiSwigluI8 E{WSP(bf16_t, WS_H), args.in[13], (const LAS unsigned*)(lds + TW_OFF), ws};
        pg8::gemm_phase<pg8::EpiSwigluI8, pg8::MoeOrder, true, 0, true>(lds, g, S, E); } }
    GRID_BAR();
    _Pragma("unroll 1") for (int rep_ = 0; rep_ < ((PROBE_REP & 1024) ? 2 : 1); ++rep_) { pg8::Gemm g{(const bf16_t*)ws, (const bf16_t*)ws, D};
      pg8::MoeOrder S; S.init(cntL, tsL, (const LAS unsigned*)(lds + TW_OFF), 4, G, bx, 0, WS_H, WS_WDN, 256 - nx5_, nx5_, WS_X1B, WS_WPG, 19); S.build_units((LAS int*)(lds + UTAB_OFF), 12);
      pg8::EpiDown E{WSP(bf16_t, WS_Y), ws};
      pg8::gemm_phase<pg8::EpiDown, pg8::MoeOrder, true>(lds, g, S, E); }
    GRID_BAR();
    _Pragma("unroll 1") for (int rep_ = 0; rep_ < ((PROBE_REP & 2048) ? 2 : 1); ++rep_) { float dbgs_ = 1.0f;
#if DBG_ATTN
      { const float* a3 = WSP(float, WS_CTL) + 64; const float num = __hip_atomic_load(a3, __ATOMIC_RELAXED, __HIP_MEMORY_SCOPE_AGENT), den = __hip_atomic_load(a3 + 1, __ATOMIC_RELAXED, __HIP_MEMORY_SCOPE_AGENT), mx = __hip_atomic_load(a3 + 2, __ATOMIC_RELAXED, __HIP_MEMORY_SCOPE_AGENT);
        dbgs_ = 1.0f + sqrtf(100.0f * (DBG_ATTN == 1 ? num / den : mx)); }
#endif
      FinalArgs a{dbgs_, 0, WSP(bf16_t, WS_X1B), WSP(bf16_t, WS_PLE), WSP(bf16_t, WS_Y), WSP(int, WS_TKE), WSP(int, WS_TKR), WSP(float, WS_TKW), args.in[15], args.in[18], args.in[19], args.out}; final_phase(a, lds, vcu, G); }
}

extern "C" void kernel_launch(void* const* d_in, const int* in_sizes, int n_in, void* d_out, int out_size, void* d_ws, size_t ws_size, hipStream_t stream) {
    static int grid = 0;
    if (grid == 0) {
        if (n_in != 20 || out_size != M * D || ws_size < WS_END) { fprintf(stderr, "kernel_launch: unexpected sizes (n_in %d, out %d, ws %zu < %zu)\n", n_in, out_size, ws_size, (size_t)WS_END); grid = -1; return; }
        int dev = 0, cus = 0, per_cu = 0;
        if (hipGetDevice(&dev) != hipSuccess || hipDeviceGetAttribute(&cus, hipDeviceAttributeMultiprocessorCount, dev) != hipSuccess) { grid = -1; return; }
        if (hipFuncSetAttribute((const void*)mega_fwd, hipFuncAttributeMaxDynamicSharedMemorySize, LDS_BYTES) != hipSuccess) { fprintf(stderr, "kernel_launch: hipFuncSetAttribute failed\n"); grid = -1; return; }
        if (hipOccupancyMaxActiveBlocksPerMultiprocessor(&per_cu, (const void*)mega_fwd, NTHREADS, LDS_BYTES) != hipSuccess || per_cu < 1) { fprintf(stderr, "kernel_launch: occupancy query says %d blocks per CU\n", per_cu); grid = -1; return; }
        grid = cus;
        if (grid != 256) fprintf(stderr, "kernel_launch: note: %d CUs (built and tuned for 256)\n", grid);
    }
    if (grid < 0) return;
    if (hipMemsetAsync((char*)d_ws + WS_CTL, 0, CTL_ZERO_BYTES, stream) != hipSuccess) return;
    Args a{};
    for (int i = 0; i < 20; ++i) a.in[i] = (const float*)d_in[i];
    a.out = (float*)d_out; a.ws = (unsigned char*)d_ws;
    void* kargs[] = {&a};
    const hipError_t e = hipLaunchCooperativeKernel((const void*)mega_fwd, dim3(grid), dim3(NTHREADS), kargs, LDS_BYTES, stream);
    if (e != hipSuccess) fprintf(stderr, "kernel_launch: cooperative launch failed: %s (grid %d)\n", hipGetErrorString(e), grid);
}
```

```cpp
#include <hip/hip_runtime.h>
#include <hip/hip_cooperative_groups.h>
#include <cstdio>
#include <cstdint>
namespace cg = cooperative_groups;

#define LAS __attribute__((address_space(3)))
typedef unsigned short bf16_t;
typedef short bf16x8 __attribute__((ext_vector_type(8)));
typedef short s16x4 __attribute__((ext_vector_type(4)));
typedef float f32x4 __attribute__((ext_vector_type(4)));
typedef float f32x16 __attribute__((ext_vector_type(16)));
typedef unsigned u32x4 __attribute__((ext_vector_type(4)));
typedef unsigned u32x2 __attribute__((ext_vector_type(2)));

constexpr int BATCH = 2, SEQ = 8192, M = BATCH * SEQ, D = 1024, NIN = 6656, NE = 32, DPLE = 256, NH = 16, HD = 64, NKV = 4;
constexpr float DN_ALPHA = 1.189207115002721f, LN_EPS = 1e-5f, LOG2E = 1.4426950408889634f;
constexpr float QSCALE = 0.125f * LOG2E;
constexpr int LISTCAP = M;
constexpr int MAXTILES = (M * 4) / 256 + NE;
constexpr int NWAVES = 8, NTHREADS = 512;

constexpr size_t MiB = 1u << 20;
constexpr size_t WS_CTL = 0;
constexpr size_t WS_BAR = 16384, CTL_ZERO_BYTES = 65536;
constexpr size_t WS_TKE = 1 * MiB, WS_TKR = 2 * MiB, WS_TKW = 3 * MiB;
constexpr size_t WS_LTOK = 4 * MiB, WS_LW = 6 * MiB;
constexpr size_t WS_WIN = 8 * MiB;
constexpr size_t WS_WBR = 22 * MiB;
constexpr size_t WS_WOUT = 26 * MiB, WS_WPG = 28 * MiB;
constexpr size_t WS_WPP = 30 * MiB;
constexpr size_t WS_WGU = 32 * MiB;
constexpr size_t WS_WDN = 160 * MiB;
constexpr size_t WS_XB = 224 * MiB;
constexpr size_t WS_PB = 256 * MiB;
constexpr size_t WS_X1F = 264 * MiB;
constexpr size_t WS_X1B = 328 * MiB;
constexpr size_t WS_P2 = 360 * MiB;
constexpr size_t WS_PLE = 424 * MiB;
constexpr size_t WS_R = 456 * MiB;
constexpr size_t WS_BG = WS_R, WS_U = WS_R + 32 * MiB, WS_Q = WS_R + 64 * MiB, WS_K = WS_R + 96 * MiB, WS_V = WS_R + 104 * MiB;
constexpr size_t WS_GC = WS_R + 112 * MiB, WS_GA = WS_R + 144 * MiB;
constexpr size_t WS_ZO = WS_R + 176 * MiB;
constexpr size_t WS_T1 = WS_R + 240 * MiB;
constexpr size_t WS_MG = WS_R + 304 * MiB;
constexpr size_t WS_H = WS_R;
constexpr size_t WS_Y = WS_R + 144 * MiB;
constexpr size_t WS_XQ = WS_R + 336 * MiB;
constexpr size_t WS_LSX = WS_XQ + 16 * MiB;
constexpr size_t WS_SX1 = WS_LSX + 2 * MiB;
constexpr size_t WS_SX0 = WS_SX1 + 1 * MiB;
constexpr size_t WS_END = WS_SX0 + 1 * MiB;
constexpr size_t WS_SCL = 65536;
constexpr size_t WS_WPG8 = 31 * MiB;
typedef int i32x4 __attribute__((ext_vector_type(4)));

constexpr int LDS_BYTES = 147456;
constexpr int MISC_OFF = 135168;
constexpr int BST_IDX = 66, TW_OFF = MISC_OFF + 512, UTAB_OFF = TW_OFF + 10240;
constexpr int BST_IDX_ = 0;

__device__ __forceinline__ int lane_id_asm() { int l; asm volatile("v_mbcnt_lo_u32_b32 %0, -1, 0\n\tv_mbcnt_hi_u32_b32 %0, -1, %0" : "=v"(l)); return l; }
__device__ __forceinline__ unsigned f2bf(float f) { unsigned u = __builtin_bit_cast(unsigned, f); return (u + 0x7fffu + ((u >> 16) & 1u)) >> 16; }
__device__ __forceinline__ unsigned pk2(float lo, float hi) { return f2bf(lo) | (f2bf(hi) << 16); }
__device__ __forceinline__ float bflo(unsigned w) { return __builtin_bit_cast(float, w << 16); }
__device__ __forceinline__ float bfhi(unsigned w) { return __builtin_bit_cast(float, w & 0xffff0000u); }
__device__ __forceinline__ float fast_sigmoid(float v) { return __builtin_amdgcn_rcpf(1.0f + __builtin_amdgcn_exp2f(-LOG2E * v)); }
__device__ __forceinline__ float wave_sum(float v) {
#pragma unroll
    for (int o = 1; o < 64; o <<= 1) v += __shfl_xor(v, o);
    return v;
}

#define XB_TMO      128
#define XB_XCNT(j)  (256  + 64 * (j))
#define XB_XSUB(j)  (1280 + 64 * (j))
#define XB_XGEN(j)  (2304 + 64 * (j))
#define XB_TOP      3328
#define XB_TOPGEN   3392
#define XCD_BAR_WORDS 3456
#define XB_SPIN_CAP (1u << 18)

__device__ __forceinline__ unsigned xb_ld(unsigned* p)              { return __hip_atomic_load(p, __ATOMIC_RELAXED, __HIP_MEMORY_SCOPE_AGENT); }
__device__ __forceinline__ unsigned xb_add(unsigned* p, unsigned v) { return __hip_atomic_fetch_add(p, v, __ATOMIC_RELAXED, __HIP_MEMORY_SCOPE_AGENT); }
__device__ __forceinline__ unsigned xb_xcc_id() { return (unsigned)__builtin_amdgcn_s_getreg((3 << 11) | 20) & 0xFu; }
#define XB_SPIN(cond, bar) do { unsigned _sp = 0; while (cond) { __builtin_amdgcn_s_sleep(1); \
    if ((++_sp & 255u) == 0u) { if (xb_ld(&(bar)[XB_TMO])) break; if (_sp > XB_SPIN_CAP) { atomicAdd(&(bar)[XB_TMO], 1u); break; } } } } while (0)

struct XcdBarrier {
    bool lead;
    unsigned* bar; unsigned x;
    volatile LAS unsigned* st;
};

__device__ __forceinline__ XcdBarrier xcd_barrier_post(unsigned* bar, volatile LAS unsigned* st, bool lead) {
    XcdBarrier b; b.bar = bar; b.x = xb_xcc_id(); b.st = st; b.lead = lead;
    if (lead) (void)xb_add(&bar[XB_XCNT(b.x)], 1u);
    return b;
}
__device__ __forceinline__ void xcd_barrier_complete(unsigned* bar, unsigned x, unsigned& nloc, unsigned& nx) {
    const unsigned G = gridDim.x * gridDim.y * gridDim.z;
    unsigned sum, cnt, mine, sp = 0u;
    for (;;) {
        sum = 0u; cnt = 0u; mine = 0u;
#pragma unroll
        for (unsigned j = 0; j < 16; ++j) { const unsigned c = xb_ld(&bar[XB_XCNT(j)]); sum += c; cnt += (c > 0u) ? 1u : 0u; mine = (j == x) ? c : mine; }
        if (sum == G) break;
        __builtin_amdgcn_s_sleep(1);
        if ((++sp & 255u) == 0u) { if (xb_ld(&bar[XB_TMO])) break; if (sp > XB_SPIN_CAP) { atomicAdd(&bar[XB_TMO], 1u); break; } }
    }
    nloc = mine > 0u ? mine : 1u; nx = cnt > 0u ? cnt : 1u;
}

__device__ __forceinline__ void xcd_barrier(const XcdBarrier& b) {
    asm volatile("s_waitcnt vmcnt(0)" ::: "memory");
    __syncthreads();
    if (b.lead) {
        unsigned* bar = b.bar;
        __builtin_amdgcn_s_waitcnt(0);
        unsigned nloc = b.st[0], nx = b.st[1];
        if (nloc == 0u) { xcd_barrier_complete(bar, b.x, nloc, nx); b.st[0] = nloc; b.st[1] = nx; }
        const unsigned old = xb_add(&bar[XB_XSUB(b.x)], 1u);
        const unsigned gen = old / nloc;
        if (old + 1u == (gen + 1u) * nloc) {
            __builtin_amdgcn_fence(__ATOMIC_RELEASE, "agent");
            asm volatile("s_waitcnt vmcnt(0)" ::: "memory");
            const unsigned og = xb_add(&bar[XB_TOP], 1u);
            const unsigned tg = og / nx;
            if (og + 1u == (tg + 1u) * nx) xb_add(&bar[XB_TOPGEN], 1u);
            else XB_SPIN(xb_ld(&bar[XB_TOPGEN]) == tg, bar);
            __builtin_amdgcn_fence(__ATOMIC_ACQUIRE, "agent");
            xb_add(&bar[XB_XGEN(b.x)], 1u);
            asm volatile("s_waitcnt vmcnt(0)" ::: "memory");
        } else {
            XB_SPIN(xb_ld(&bar[XB_XGEN(b.x)]) == gen, bar);
            __builtin_amdgcn_fence(__ATOMIC_ACQUIRE, "agent");
            asm volatile("s_waitcnt vmcnt(0)" ::: "memory");
        }
    }
    __syncthreads();
}

namespace pg8 {
constexpr int BM = 256, BK = 64, HALF = 128, HTB = HALF * BK * 2  , STAGE_BYTES = 8 * HTB, NXCD = 8, WGM = 8;
__host__ __device__ __forceinline__ int lds_byte(int r, int c) { const int st = (r >> 4) * 2 + (c >> 5), rr = r & 15, cc = c & 31, ob = rr * 64 + cc * 2; return st * 1024 + (ob ^ (((ob >> 9) & 1) << 5)); }
__host__ __device__ __forceinline__ void stage_rc(int b, int& R, int& C) { const int st = b / 1024, sb = b % 1024, swz = sb ^ (((sb >> 9) & 1) << 5); R = (st >> 1) * 16 + swz / 64; C = (st & 1) * 32 + (swz % 64) / 2; }
__host__ __device__ __forceinline__ int perm32(int rho) { const int n = rho >> 4, i = rho & 15; return 8 * (i >> 2) + 4 * n + (i & 3); }

struct Unit { int pm, pn, om, on, e, mt, slot; };
struct Gemm { const bf16_t* A; const bf16_t* Bt; int K; };

__device__ __forceinline__ int xcd_remap(int L, int nwg) { const int q = nwg / NXCD, r = nwg % NXCD, xcd = L % NXCD, off = L / NXCD; return (xcd < r ? xcd * (q + 1) : r * (q + 1) + (xcd - r) * q) + off; }

__device__ __forceinline__ void plain_a_off(int pm, int tid, int K, unsigned (&o)[2][2]) {
#pragma unroll
    for (int i = 0; i < 2; ++i) { int R, C; stage_rc(tid * 16 + i * 8192, R, C);
#pragma unroll
        for (int h = 0; h < 2; ++h) o[h][i] = (unsigned)((pm * BM + h * HALF + R) * K + C) * 2u; }
}
struct StaticOrder {
    int nM, nN, nwg, G, c;
    __device__ void init(int nM_, int nN_, int G_, int c_, int = 1) { nM = nM_; nN = nN_; nwg = nM * nN; G = G_; c = c_; }
    __device__ __forceinline__ bool tile(int i, int& pm, int& pn, int& q) const {
        const int L = i * G + c; if (L >= nwg) return false;
        q = 0xF; const int wgid = xcd_remap(L, nwg);
        const int nig = WGM * nN, gid = wgid / nig, fm = gid * WGM, gsz = (nM - fm) < WGM ? (nM - fm) : WGM;
        pm = fm + ((wgid % nig) % gsz); pn = (wgid % nig) / gsz; return true;
    }
    __device__ __forceinline__ bool next(int i, Unit& u) const { int pm, pn, q; if (!tile(i, pm, pn, q)) return false; u.pm = pm; u.pn = pn; u.om = pm; u.on = pn; u.e = 0; u.mt = 0; u.slot = 0; return true; }
    __device__ __forceinline__ void a_off(const Unit& u, int tid, int K, unsigned (&o)[2][2]) const { plain_a_off(u.pm, tid, K, o); }
};

__device__ __forceinline__ unsigned cvt_pk_bf16(float lo, float hi) { unsigned r; asm volatile("v_cvt_pk_bf16_f32 %0, %1, %2" : "=v"(r) : "v"(lo), "v"(hi)); return r; }

template <class Epi, class Sched, bool ALIGN_EPI, int DRY = 0, bool I8 = false>
__device__ __forceinline__ void gemm_phase(LAS unsigned char* lds, const Gemm g, const Sched& S, const Epi& E, int wvid) {
    int tid_ = (wvid * 64 + lane_id_asm()); asm volatile("" : "+v"(tid_));
    const int tid = tid_, wid = __builtin_amdgcn_readfirstlane(tid >> 6), lane = tid & 63, wr = wid >> 2, wc = wid & 3, fr = lane & 15, fq = lane >> 4;
    const int K = g.K, nt = K / BK;
    unsigned voffB[2];
#pragma unroll
    for (int i = 0; i < 2; ++i) { int R, C; stage_rc(tid * 16 + i * 8192, R, C); const int Rb = Epi::PERM ? ((R & ~31) + perm32(R & 31)) : R;
        voffB[i] = (unsigned)(Rb * K + C) * 2u; }
    constexpr unsigned kstep = BK * 2;
    const unsigned hstep = (unsigned)HALF * K * 2;
    const unsigned tstep = 2 * hstep;
    const unsigned ldsw = (unsigned)wid * 1024u;
    const int aoff = lds_byte(wr * 64 + fr, fq * 8), boff = lds_byte(wc * 32 + fr, fq * 8);
#define PG8_SA(b, h) (((b) * 2 + (h)) * HTB)
#define PG8_SB(b, h) ((4 + (b) * 2 + (h)) * HTB)
#define PG8_STAGE(bufoff, gbase, voff) do { _Pragma("unroll") for (int _i = 0; _i < 2; ++_i) \
        __builtin_amdgcn_global_load_lds((const unsigned*)((const char*)(gbase) + (voff)[_i]), (LAS unsigned*)(lds + (bufoff) + ldsw + _i * 8192), 16, 0, 0); } while (0)
#define PG8_LDA(dst, b, h) do { _Pragma("unroll") for (int m = 0; m < 4; ++m) _Pragma("unroll") for (int k = 0; k < 2; ++k) dst[m][k] = *(const LAS bf16x8*)(lds + PG8_SA(b, h) + aoff + m * 2048 + k * 1024); } while (0)
#define PG8_LDB(dst, b, h) do { _Pragma("unroll") for (int n = 0; n < 2; ++n) _Pragma("unroll") for (int k = 0; k < 2; ++k) dst[n][k] = *(const LAS bf16x8*)(lds + PG8_SB(b, h) + boff + n * 2048 + k * 1024); } while (0)
#define PG8_MMA(ai, bj, At, Bt) do { if constexpr (DRY == 1) { _Pragma("unroll") for (int m = 0; m < 4; ++m) _Pragma("unroll") for (int k = 0; k < 2; ++k) asm volatile("" :: "v"(At[m][k])); _Pragma("unroll") for (int n = 0; n < 2; ++n) _Pragma("unroll") for (int k = 0; k < 2; ++k) asm volatile("" :: "v"(Bt[n][k])); break; } __builtin_amdgcn_s_setprio(1); _Pragma("unroll") for (int m = 0; m < 4; ++m) _Pragma("unroll") for (int n = 0; n < 2; ++n) _Pragma("unroll") for (int k = 0; k < 2; ++k) \
        { if constexpr (I8) acc[ai][bj][m][n] = __builtin_bit_cast(AccT, __builtin_amdgcn_mfma_i32_16x16x64_i8(__builtin_bit_cast(i32x4, Bt[n][k]), __builtin_bit_cast(i32x4, At[m][k]), __builtin_bit_cast(i32x4, acc[ai][bj][m][n]), 0, 0, 0)); \
          else acc[ai][bj][m][n] = __builtin_bit_cast(AccT, __builtin_amdgcn_mfma_f32_16x16x32_bf16(Bt[n][k], At[m][k], __builtin_bit_cast(f32x4, acc[ai][bj][m][n]), 0, 0, 0)); } __builtin_amdgcn_s_setprio(0); } while (0)
#define PG8_WAIT_V(n) asm volatile("s_waitcnt vmcnt(" #n ")" ::: "memory")
#define PG8_WAIT_L(n) asm volatile("s_waitcnt lgkmcnt(" #n ")" ::: "memory")
#define PG8_BAR __builtin_amdgcn_s_barrier()
#define PG8_SCHED __builtin_amdgcn_sched_barrier(0)
    Unit cur, nxt; int ui = 0;
    if (!S.next(0, cur)) return;
    typedef typename Epi::AccT AccT;
    AccT acc[2][2][4][2];
#pragma unroll
    for (int a = 0; a < 2; ++a)
#pragma unroll
        for (int b = 0; b < 2; ++b)
#pragma unroll
            for (int m = 0; m < 4; ++m)
#pragma unroll
                for (int n = 0; n < 2; ++n) acc[a][b][m][n] = AccT{};
    bf16x8 At[4][2], B0[2][2], B1[2][2];
    unsigned aC[2][2];
    S.a_off(cur, tid, K, aC);
    const char* const Ab = (const char*)g.A;
    const char* cB = (const char*)g.Bt + (size_t)cur.pn * tstep;
    PG8_STAGE(PG8_SB(0, 0), cB, voffB); PG8_STAGE(PG8_SB(0, 1), cB + hstep, voffB); PG8_STAGE(PG8_SA(0, 0), Ab, aC[0]); PG8_STAGE(PG8_SA(0, 1), Ab, aC[1]);
    if (wr == 1) PG8_BAR;
    PG8_WAIT_V(2); PG8_BAR;
    PG8_STAGE(PG8_SB(1, 0), cB + kstep, voffB); PG8_STAGE(PG8_SA(1, 0), Ab + kstep, aC[0]); PG8_STAGE(PG8_SB(1, 1), cB + hstep + kstep, voffB);
    PG8_WAIT_V(6); PG8_BAR;
    for (;;) {
        const bool has_next = S.next(ui + 1, nxt);
        const char* nB = has_next ? (const char*)g.Bt + (size_t)nxt.pn * tstep : cB;
        for (int t = 0; t < nt; t += 2) {
            const bool last = (t == nt - 2);
            const char* a1 = Ab + (size_t)(t + 1) * kstep;
            const char* a2 = last ? Ab : Ab + (size_t)(t + 2) * kstep; const char* b2 = last ? nB : cB + (size_t)(t + 2) * kstep;
            const char* a3 = a2 + kstep; const char* b3 = b2 + kstep;
            PG8_LDB(B0, 0, 0); PG8_LDB(B1, 0, 1); PG8_SCHED; PG8_LDA(At, 0, 0); PG8_STAGE(PG8_SA(1, 1), a1, aC[1]);
            if (last && has_next) S.a_off(nxt, tid, K, aC);
            PG8_WAIT_V(8); PG8_WAIT_L(0); PG8_BAR; PG8_MMA(0, 0, At, B0); PG8_MMA(0, 1, At, B1); PG8_BAR; PG8_SCHED;
            PG8_LDA(At, 0, 1); PG8_STAGE(PG8_SB(0, 0), b2, voffB); PG8_STAGE(PG8_SB(0, 1), b2 + hstep, voffB); PG8_STAGE(PG8_SA(0, 0), a2, aC[0]);
            PG8_WAIT_V(8); PG8_WAIT_L(0); PG8_BAR; PG8_MMA(1, 0, At, B0); PG8_MMA(1, 1, At, B1); PG8_BAR; PG8_SCHED;
            PG8_LDB(B0, 1, 0); PG8_LDB(B1, 1, 1); PG8_SCHED; PG8_LDA(At, 1, 0); PG8_STAGE(PG8_SA(0, 1), a2, aC[1]);
            PG8_WAIT_V(8); PG8_WAIT_L(0); PG8_BAR; PG8_MMA(0, 0, At, B0); PG8_MMA(0, 1, At, B1); PG8_BAR; PG8_SCHED;
            PG8_LDA(At, 1, 1); PG8_STAGE(PG8_SB(1, 0), b3, voffB); PG8_STAGE(PG8_SB(1, 1), b3 + hstep, voffB); PG8_STAGE(PG8_SA(1, 0), a3, aC[0]);
            PG8_WAIT_V(8); PG8_WAIT_L(0); PG8_BAR; PG8_MMA(1, 0, At, B0); PG8_MMA(1, 1, At, B1); PG8_BAR; PG8_SCHED;
        }
        if constexpr (ALIGN_EPI) { if (wr == 0) PG8_BAR; }
        if constexpr (DRY == 0) E(acc, cur, wr, wc, fr, fq); else { _Pragma("unroll") for (int a = 0; a < 2; ++a) _Pragma("unroll") for (int b = 0; b < 2; ++b) _Pragma("unroll") for (int m = 0; m < 4; ++m) _Pragma("unroll") for (int n = 0; n < 2; ++n) asm volatile("" :: "v"(acc[a][b][m][n])); }
        if (!has_next) break;
#pragma unroll
        for (int a = 0; a < 2; ++a)
#pragma unroll
            for (int b = 0; b < 2; ++b)
#pragma unroll
                for (int m = 0; m < 4; ++m)
#pragma unroll
                    for (int n = 0; n < 2; ++n) acc[a][b][m][n] = AccT{};
        cur = nxt; cB = nB; ++ui;
        if constexpr (ALIGN_EPI) { if (wr == 1) PG8_BAR; }
    }
    PG8_WAIT_V(0);
    if constexpr (!ALIGN_EPI) { if (wr == 0) PG8_BAR; }
    PG8_BAR;
#undef PG8_SA
#undef PG8_SB
#undef PG8_STAGE
#undef PG8_LDA
#undef PG8_LDB
#undef PG8_MMA
#undef PG8_WAIT_V
#undef PG8_WAIT_L
#undef PG8_BAR
#undef PG8_SCHED
}
}
namespace pg8 {
typedef const f32x4 (&AccRef)[2][2][4][2];
typedef const i32x4 (&AccRefI)[2][2][4][2];
__device__ __forceinline__ f32x4 i2f(const i32x4 v) { return (f32x4){(float)v[0], (float)v[1], (float)v[2], (float)v[3]}; }

struct EpiInProj {
    static constexpr bool PERM = true; typedef f32x4 AccT;
    unsigned char* ws;
    __device__ __forceinline__ void operator()(AccRef acc, const Unit& u, int wr, int wc, int fr, int fq) const {
        const int pn = u.on, row0 = u.om * BM + wr * 64 + fr, cw = wc * 32 + 8 * fq;
        if (pn >= 4 && pn < 12) {
#pragma unroll
            for (int ai = 0; ai < 2; ++ai)
#pragma unroll
                for (int m = 0; m < 4; ++m) { const f32x4 v0 = acc[ai][0][m][0] * acc[ai][1][m][0], v1 = acc[ai][0][m][1] * acc[ai][1][m][1];
                    u32x4 w; w.x = cvt_pk_bf16(v0[0], v0[1]); w.y = cvt_pk_bf16(v0[2], v0[3]); w.z = cvt_pk_bf16(v1[0], v1[1]); w.w = cvt_pk_bf16(v1[2], v1[3]);
                    *(u32x4*)((bf16_t*)(ws + WS_U) + (size_t)(row0 + ai * HALF + m * 16) * D + (pn - 4) * 128 + cw) = w; }
            return;
        }
        size_t doff; int ldc = D, cb, mode = 0;
        if (pn < 4) { doff = WS_BG; cb = pn * 256; }
        else if (pn < 16) { doff = WS_Q; cb = (pn - 12) * 256; mode = 1; }
        else if (pn == 16) { doff = WS_K; cb = 0; ldc = 256; }
        else if (pn == 17) { doff = WS_V; cb = 0; ldc = 256; }
        else if (pn < 22) { doff = WS_GC; cb = (pn - 18) * 256; mode = 2; }
        else { doff = WS_GA; cb = (pn - 22) * 256; mode = 2; }
        bf16_t* dst = (bf16_t*)(ws + doff);
#pragma unroll
        for (int ai = 0; ai < 2; ++ai)
#pragma unroll
            for (int m = 0; m < 4; ++m) { bf16_t* rowp = dst + (size_t)(row0 + ai * HALF + m * 16) * ldc + cb + cw;
#pragma unroll
                for (int bj = 0; bj < 2; ++bj) { f32x4 v0 = acc[ai][bj][m][0], v1 = acc[ai][bj][m][1];
                    if (mode == 1) { v0 = v0 * QSCALE; v1 = v1 * QSCALE; }
                    if (mode == 2) {
#pragma unroll
                        for (int j = 0; j < 4; ++j) { v0[j] = fast_sigmoid(v0[j]); v1[j] = fast_sigmoid(v1[j]); } }
                    u32x4 w; w.x = cvt_pk_bf16(v0[0], v0[1]); w.y = cvt_pk_bf16(v0[2], v0[3]); w.z = cvt_pk_bf16(v1[0], v1[1]); w.w = cvt_pk_bf16(v1[2], v1[3]);
                    *(u32x4*)(rowp + bj * HALF) = w; } }
    }
};

struct EpiInProjI8 {
    static constexpr bool PERM = true; typedef i32x4 AccT;
    unsigned char* ws; float sw;
    __device__ __forceinline__ void operator()(AccRefI acc, const Unit& u, int wr, int wc, int fr, int fq) const {
        const int pn = u.on, row0 = u.om * BM + wr * 64 + fr, cw = wc * 32 + 8 * fq;
        const float* sx0 = (const float*)(ws + WS_SX0) + row0;
        if (pn >= 4 && pn < 12) {
#pragma unroll
            for (int ai = 0; ai < 2; ++ai)
#pragma unroll
                for (int m = 0; m < 4; ++m) { const float s = sx0[ai * HALF + m * 16] * sw, s2 = s * s;
                    const f32x4 v0 = i2f(acc[ai][0][m][0]) * i2f(acc[ai][1][m][0]) * s2, v1 = i2f(acc[ai][0][m][1]) * i2f(acc[ai][1][m][1]) * s2;
                    u32x4 w; w.x = cvt_pk_bf16(v0[0], v0[1]); w.y = cvt_pk_bf16(v0[2], v0[3]); w.z = cvt_pk_bf16(v1[0], v1[1]); w.w = cvt_pk_bf16(v1[2], v1[3]);
                    *(u32x4*)((bf16_t*)(ws + WS_U) + (size_t)(row0 + ai * HALF + m * 16) * D + (pn - 4) * 128 + cw) = w; asm volatile("" ::: "memory"); }
            return;
        }
        size_t doff; int ldc = D, cb, mode = 0;
        if (pn < 4) { doff = WS_BG; cb = pn * 256; }
        else if (pn < 16) { doff = WS_Q; cb = (pn - 12) * 256; mode = 1; }
        else if (pn == 16) { doff = WS_K; cb = 0; ldc = 256; }
        else if (pn == 17) { doff = WS_V; cb = 0; ldc = 256; }
        else if (pn < 22) { doff = WS_GC; cb = (pn - 18) * 256; mode = 2; }
        else { doff = WS_GA; cb = (pn - 22) * 256; mode = 2; }
        bf16_t* dst = (bf16_t*)(ws + doff);
#pragma unroll
        for (int ai = 0; ai < 2; ++ai)
#pragma unroll
            for (int m = 0; m < 4; ++m) { bf16_t* rowp = dst + (size_t)(row0 + ai * HALF + m * 16) * ldc + cb + cw; const float s = sx0[ai * HALF + m * 16] * sw * (mode == 1 ? QSCALE : 1.0f);
#pragma unroll
                for (int bj = 0; bj < 2; ++bj) { f32x4 v0 = i2f(acc[ai][bj][m][0]) * s, v1 = i2f(acc[ai][bj][m][1]) * s;
                    if (mode == 2) {
#pragma unroll
                        for (int j = 0; j < 4; ++j) { v0[j] = fast_sigmoid(v0[j]); v1[j] = fast_sigmoid(v1[j]); } }
                    u32x4 w; w.x = cvt_pk_bf16(v0[0], v0[1]); w.y = cvt_pk_bf16(v0[2], v0[3]); w.z = cvt_pk_bf16(v1[0], v1[1]); w.w = cvt_pk_bf16(v1[2], v1[3]);
                    *(u32x4*)(rowp + bj * HALF) = w; }
                asm volatile("" ::: "memory"); }
    }
};

struct EpiDual {
    static constexpr bool PERM = true; typedef f32x4 AccT;
    unsigned char* ws;
    __device__ __forceinline__ void operator()(AccRef acc, const Unit& u, int wr, int wc, int fr, int fq) const {
        const int row0 = u.om * BM + wr * 64 + fr, col0 = u.on * BM + wc * 32 + 8 * fq;
        const bf16_t* G = (const bf16_t*)(ws + (u.e == 0 ? WS_GC : WS_GA)); float* T1 = (float*)(ws + WS_T1); bf16_t* MG = (bf16_t*)(ws + WS_MG);
#pragma unroll
        for (int ai = 0; ai < 2; ++ai)
#pragma unroll
            for (int m = 0; m < 4; ++m) { const size_t ro = (size_t)(row0 + ai * HALF + m * 16) * D + col0;
#pragma unroll
                for (int bj = 0; bj < 2; ++bj) { const size_t o = ro + bj * HALF;
                    const u32x4 gw = *(const u32x4*)(G + o);
                    f32x4 g0 = {bflo(gw.x), bfhi(gw.x), bflo(gw.y), bfhi(gw.y)}, g1 = {bflo(gw.z), bfhi(gw.z), bflo(gw.w), bfhi(gw.w)};
                    f32x4 v0 = g0 * acc[ai][bj][m][0], v1 = g1 * acc[ai][bj][m][1];
                    if (u.e == 0) { *(f32x4*)(T1 + o) = v0; *(f32x4*)(T1 + o + 4) = v1; }
                    else { v0 = v0 + *(const f32x4*)(T1 + o); v1 = v1 + *(const f32x4*)(T1 + o + 4);
                        u32x4 w; w.x = cvt_pk_bf16(v0[0], v0[1]); w.y = cvt_pk_bf16(v0[2], v0[3]); w.z = cvt_pk_bf16(v1[0], v1[1]); w.w = cvt_pk_bf16(v1[2], v1[3]);
                        *(u32x4*)(MG + o) = w; } } }
    }
};

struct EpiResid {
    static constexpr bool PERM = false; typedef f32x4 AccT;
    const float* X; float* C;
    __device__ __forceinline__ void operator()(AccRef acc, const Unit& u, int wr, int wc, int fr, int fq) const {
        const int row0 = u.om * BM + wr * 64 + fr, col0 = u.on * BM + wc * 32 + 4 * fq;
#pragma unroll
        for (int ai = 0; ai < 2; ++ai)
#pragma unroll
            for (int m = 0; m < 4; ++m) { const size_t ro = (size_t)(row0 + ai * HALF + m * 16) * D + col0;
#pragma unroll
                for (int bj = 0; bj < 2; ++bj)
#pragma unroll
                    for (int n = 0; n < 2; ++n) { const size_t o = ro + bj * HALF + n * 16; *(f32x4*)(C + o) = *(const f32x4*)(X + o) * DN_ALPHA + acc[ai][bj][m][n]; } }
    }
};

struct EpiF32 {
    static constexpr bool PERM = false; typedef f32x4 AccT;
    float* C;
    __device__ __forceinline__ void operator()(AccRef acc, const Unit& u, int wr, int wc, int fr, int fq) const {
        const int row0 = u.om * BM + wr * 64 + fr, col0 = u.on * BM + wc * 32 + 4 * fq;
#pragma unroll
        for (int ai = 0; ai < 2; ++ai)
#pragma unroll
            for (int m = 0; m < 4; ++m) { const size_t ro = (size_t)(row0 + ai * HALF + m * 16) * D + col0;
#pragma unroll
                for (int bj = 0; bj < 2; ++bj)
#pragma unroll
                    for (int n = 0; n < 2; ++n) *(f32x4*)(C + ro + bj * HALF + n * 16) = acc[ai][bj][m][n]; }
    }
};
__device__ __forceinline__ void ple_epilogue(AccRef acc, const Unit& u, int wr, int wc, int fr, int fq, const float* P2, bf16_t* PLE) {
    const int row0 = u.om * BM + wr * 64 + fr, col0 = u.on * BM + wc * 32 + 8 * fq;
#pragma unroll
    for (int ai = 0; ai < 2; ++ai)
#pragma unroll
        for (int m = 0; m < 4; ++m) { const size_t ro = (size_t)(row0 + ai * HALF + m * 16) * D + col0;
#pragma unroll
            for (int bj = 0; bj < 2; ++bj) { const size_t o = ro + bj * HALF; const f32x4 p0 = *(const f32x4*)(P2 + o), p1 = *(const f32x4*)(P2 + o + 4); const f32x4 a0 = acc[ai][bj][m][0], a1 = acc[ai][bj][m][1];
                u32x4 w; w.x = cvt_pk_bf16(fast_sigmoid(a0[0]) * p0[0], fast_sigmoid(a0[1]) * p0[1]); w.y = cvt_pk_bf16(fast_sigmoid(a0[2]) * p0[2], fast_sigmoid(a0[3]) * p0[3]);
                w.z = cvt_pk_bf16(fast_sigmoid(a1[0]) * p1[0], fast_sigmoid(a1[1]) * p1[1]); w.w = cvt_pk_bf16(fast_sigmoid(a1[2]) * p1[2], fast_sigmoid(a1[3]) * p1[3]);
                *(u32x4*)(PLE + o) = w; }
            if (m & 1) asm volatile("" ::: "memory"); }
}

struct EpiSwiglu {
    static constexpr bool PERM = true; typedef f32x4 AccT;
    bf16_t* H; const float* b_gu; const LAS unsigned* tw; unsigned char* ws;
    __device__ __forceinline__ void operator()(AccRef acc, const Unit& u, int wr, int wc, int fr, int fq) const {
        if (u.e < 0) { ple_epilogue(acc, u, wr, wc, fr, fq, (const float*)(ws + WS_P2), (bf16_t*)(ws + WS_PLE)); return; }
        const int trow0 = wr * 64 + fr, row0 = u.om * BM + trow0, cw = wc * 32 + 8 * fq, col0 = u.on * 128 + cw;
        const float* bg = b_gu + (size_t)u.e * 2048 + col0;
#pragma unroll
        for (int n = 0; n < 2; ++n) { const f32x4 bgn = *(const f32x4*)(bg + 4 * n), bun = *(const f32x4*)(bg + 1024 + 4 * n);
#pragma unroll
            for (int ai = 0; ai < 2; ++ai)
#pragma unroll
                for (int m = 0; m < 4; ++m) { const float w = bfhi(tw[u.slot * BM + trow0 + ai * HALF + m * 16]);
                    const f32x4 gt = acc[ai][0][m][n] + bgn, up = acc[ai][1][m][n] + bun; f32x4 hv;
#pragma unroll
                    for (int j = 0; j < 4; ++j) { const float gv = fminf(gt[j], 7.0f), uv = fminf(fmaxf(up[j], -7.0f), 7.0f); hv[j] = (uv + 1.0f) * gv * fast_sigmoid(1.702f * gv) * w; }
                    u32x2 o; o.x = cvt_pk_bf16(hv[0], hv[1]); o.y = cvt_pk_bf16(hv[2], hv[3]);
                    *(u32x2*)(H + (size_t)(row0 + ai * HALF + m * 16) * D + col0 + 4 * n) = o; } }
    }
};
struct EpiSwigluI8 {
    static constexpr bool PERM = true; typedef i32x4 AccT;
    bf16_t* H; const float* b_gu; const LAS unsigned* tw; unsigned char* ws;
    __device__ __forceinline__ void operator()(AccRefI acc, const Unit& u, int wr, int wc, int fr, int fq) const {
        const int trow0 = wr * 64 + fr, row0 = u.om * BM + trow0, cw = wc * 32 + 8 * fq;
        const float* scl = (const float*)(ws + WS_SCL);
        if (u.e < 0) {
            const float* P2 = (const float*)(ws + WS_P2); bf16_t* PLE = (bf16_t*)(ws + WS_PLE); const float* sx1 = (const float*)(ws + WS_SX1);
            const float spg = scl[NE]; const int col0 = u.on * BM + cw;
#pragma unroll
            for (int ai = 0; ai < 2; ++ai)
#pragma unroll
                for (int m = 0; m < 4; ++m) { const int r = row0 + ai * HALF + m * 16; const float s = sx1[r] * spg; const size_t ro = (size_t)r * D + col0;
#pragma unroll
                    for (int bj = 0; bj < 2; ++bj) { const size_t o = ro + bj * HALF; const f32x4 p0 = *(const f32x4*)(P2 + o), p1 = *(const f32x4*)(P2 + o + 4); const f32x4 a0 = i2f(acc[ai][bj][m][0]) * s, a1 = i2f(acc[ai][bj][m][1]) * s;
                        u32x4 w; w.x = cvt_pk_bf16(fast_sigmoid(a0[0]) * p0[0], fast_sigmoid(a0[1]) * p0[1]); w.y = cvt_pk_bf16(fast_sigmoid(a0[2]) * p0[2], fast_sigmoid(a0[3]) * p0[3]);
                        w.z = cvt_pk_bf16(fast_sigmoid(a1[0]) * p1[0], fast_sigmoid(a1[1]) * p1[1]); w.w = cvt_pk_bf16(fast_sigmoid(a1[2]) * p1[2], fast_sigmoid(a1[3]) * p1[3]);
                        *(u32x4*)(PLE + o) = w; }
                    if (m & 1) asm volatile("" ::: "memory"); }
            return; }
        const int col0 = u.on * 128 + cw;
        const float* bg = b_gu + (size_t)u.e * 2048 + col0; const float sg = scl[u.e];
        const float* lsx = (const float*)(ws + WS_LSX) + (size_t)u.e * LISTCAP + u.mt * BM + trow0;
#pragma unroll
        for (int n = 0; n < 2; ++n) { const f32x4 bgn = *(const f32x4*)(bg + 4 * n), bun = *(const f32x4*)(bg + 1024 + 4 * n);
#pragma unroll
            for (int ai = 0; ai < 2; ++ai)
#pragma unroll
                for (int m = 0; m < 4; ++m) { const unsigned twv = tw[u.slot * BM + trow0 + ai * HALF + m * 16]; const float w = bfhi(twv);
                    const float s = (w != 0.f ? lsx[ai * HALF + m * 16] : 0.f) * sg;
                    const f32x4 gt = i2f(acc[ai][0][m][n]) * s + bgn, up = i2f(acc[ai][1][m][n]) * s + bun; f32x4 hv;
#pragma unroll
                    for (int j = 0; j < 4; ++j) { const float gv = fminf(gt[j], 7.0f), uv = fminf(fmaxf(up[j], -7.0f), 7.0f); hv[j] = (uv + 1.0f) * gv * fast_sigmoid(1.702f * gv) * w; }
                    u32x2 o; o.x = cvt_pk_bf16(hv[0], hv[1]); o.y = cvt_pk_bf16(hv[2], hv[3]);
                    *(u32x2*)(H + (size_t)(row0 + ai * HALF + m * 16) * D + col0 + 4 * n) = o; } }
    }
};
struct EpiDown {
    static constexpr bool PERM = true; typedef f32x4 AccT;
    bf16_t* Y; unsigned char* ws;
    __device__ __forceinline__ void operator()(AccRef acc, const Unit& u, int wr, int wc, int fr, int fq) const {
        if (u.e < 0) { ple_epilogue(acc, u, wr, wc, fr, fq, (const float*)(ws + WS_P2), (bf16_t*)(ws + WS_PLE)); return; }
        bf16_t* yp = Y + (size_t)(u.om * BM + wr * 64 + fr) * D + u.on * BM + wc * 32 + 8 * fq;
#pragma unroll
        for (int ai = 0; ai < 2; ++ai)
#pragma unroll
            for (int m = 0; m < 4; ++m)
#pragma unroll
                for (int bj = 0; bj < 2; ++bj) { const f32x4 v0 = acc[ai][bj][m][0], v1 = acc[ai][bj][m][1];
                    u32x4 o; o.x = cvt_pk_bf16(v0[0], v0[1]); o.y = cvt_pk_bf16(v0[2], v0[3]); o.z = cvt_pk_bf16(v1[0], v1[1]); o.w = cvt_pk_bf16(v1[2], v1[3]);
                    *(u32x4*)(yp + (size_t)(ai * HALF + m * 16) * D + bj * HALF) = o; }
    }
};

struct DualOrder {
    StaticOrder so;
    __device__ __forceinline__ bool next(int i, Unit& u) const {
        int pm, pn, q; if (!so.tile(i >> 1, pm, pn, q)) return false;
        const int e = i & 1; u.pm = e * (M / BM) + pm; u.pn = e * 4 + pn; u.om = pm; u.on = pn; u.e = e; u.mt = 0; u.slot = 0; return true;
    }
    __device__ __forceinline__ void a_off(const Unit& u, int tid, int K, unsigned (&o)[2][2]) const { plain_a_off(u.pm, tid, K, o); }
};
struct MoeOrder {
    const LAS int* cntL; const LAS int* tsL; const LAS unsigned* tw; int NT, gather, btile0, btile_ple, n_extra, extra_first; unsigned abase, abase_ple; int U, UT, G, c; const LAS int* utab; int nunits;
    __device__ __forceinline__ void init(const LAS int* cntL_, const LAS int* tsL_, const LAS unsigned* tw_, int NT_, int G_, int c_, int gather_, size_t aoff_, size_t boff_, int n_extra_, int extra_first_, size_t aoff_ple_, size_t boff_ple_, int tshift_) {
        cntL = cntL_; tsL = tsL_; tw = tw_; NT = NT_; gather = gather_; abase = (unsigned)aoff_; btile0 = (int)(boff_ >> tshift_); abase_ple = (unsigned)aoff_ple_; btile_ple = (int)(boff_ple_ >> tshift_); n_extra = n_extra_; extra_first = extra_first_;
        U = __builtin_amdgcn_readfirstlane(tsL_[NE]) * NT_; UT = U + n_extra_; G = G_; c = c_; utab = nullptr; nunits = 0; }
    __device__ __forceinline__ void build_units(LAS int* tab, int maxu) {
        Unit u; int n = 0;
        for (; n < maxu && decode(n, u); ++n) { LAS int* p = tab + 8 * n; p[0] = u.pm; p[1] = u.pn; p[2] = u.on; p[3] = u.e; p[4] = u.mt; }
        __syncthreads();
        utab = tab; nunits = n;
    }
    __device__ __forceinline__ bool next(int i, Unit& u) const {
        if (i >= nunits) return false;
        const LAS int* p = utab + 8 * i;
        u.pm = __builtin_amdgcn_readfirstlane(p[0]); u.pn = __builtin_amdgcn_readfirstlane(p[1]); u.om = u.pm; u.on = __builtin_amdgcn_readfirstlane(p[2]);
        u.e = __builtin_amdgcn_readfirstlane(p[3]); u.mt = __builtin_amdgcn_readfirstlane(p[4]); u.slot = i; return true;
    }
    __device__ __forceinline__ bool decode(int i, Unit& u) const {
        const int L = i * G + c; if (L >= UT) return false;
        if (L >= U) { const int j = extra_first + (L - U), pm = (j >> 5) * 8 + (j & 7), pn = (j & 31) >> 3;
            u.pm = pm; u.pn = btile_ple + pn; u.om = pm; u.on = pn; u.e = -1; u.mt = 0; u.slot = 0; return true; }
        const int wgid = xcd_remap(L, U);
        int e = 0;
        for (int k = 1; k < NE; ++k) e += (wgid >= __builtin_amdgcn_readfirstlane(tsL[k]) * NT) ? 1 : 0;
        const int t0 = __builtin_amdgcn_readfirstlane(tsL[e]), ntl = __builtin_amdgcn_readfirstlane(tsL[e + 1]) - t0, r = wgid - t0 * NT;
        const int nt = r / ntl, mt = r - nt * ntl;
        u.pm = t0 + mt; u.pn = btile0 + e * NT + nt; u.om = t0 + mt; u.on = nt; u.e = e; u.mt = mt; u.slot = i; return true;
    }
    __device__ __forceinline__ void a_off(const Unit& u, int tid, int K, unsigned (&o)[2][2]) const {
        if (u.e < 0 || !gather) { plain_a_off(u.pm, tid, K, o); const unsigned base = u.e < 0 ? abase_ple : abase;
#pragma unroll
            for (int h = 0; h < 2; ++h)
#pragma unroll
                for (int i = 0; i < 2; ++i) o[h][i] += base;
            return; }
#pragma unroll
        for (int i = 0; i < 2; ++i) { int R, C; stage_rc(tid * 16 + i * 8192, R, C);
#pragma unroll
            for (int h = 0; h < 2; ++h) { const int tok = (int)(tw[u.slot * BM + h * HALF + R] & 0xffffu);
                o[h][i] = (unsigned)(tok * K + C) * 2u + abase; } }
    }
};
constexpr int MOE_MAXU = 10;
__device__ __forceinline__ void moe_preload(const MoeOrder& S, const LAS int* cntL, const int* list_tok, const float* list_w, LAS unsigned* tw, int wvid) {
    Unit u; int tid_ = (wvid * 64 + lane_id_asm()); asm volatile("" : "+v"(tid_)); const int tid = tid_;
    for (int i = 0; i < MOE_MAXU && S.next(i, u); ++i)
        if (u.e >= 0 && tid < BM) { const int li = u.mt * BM + tid; unsigned v = 0u;
            if (li < cntL[u.e]) v = (unsigned)list_tok[(size_t)u.e * LISTCAP + li] | (f2bf(list_w[(size_t)u.e * LISTCAP + li]) << 16);
            tw[i * BM + tid] = v; }
    __syncthreads();
}
struct Ple1Order {
    int first, n;
    __device__ __forceinline__ bool next(int i, Unit& u) const { if (i >= n) return false; const int j = first + i, pm = (j >> 5) * 8 + (j & 7), pn = (j & 31) >> 3;
        u.pm = pm; u.pn = pn; u.om = pm; u.on = pn; u.e = 0; u.mt = 0; u.slot = 0; return true; }
    __device__ __forceinline__ void a_off(const Unit& u, int tid, int K, unsigned (&o)[2][2]) const { plain_a_off(u.pm, tid, K, o); }
};
}
__device__ __forceinline__ int dst_row(int n, int map) {
    if (map == 1) { if (n >= 1024 && n < 3072) { const int hsel = n >= 2048, c = n - 1024 - hsel * 1024; return 1024 + (c >> 7) * 256 + hsel * 128 + (c & 127); } return n; }
    if (map == 2) { const int hsel = n >= 1024, c = n - hsel * 1024; return (c >> 7) * 256 + hsel * 128 + (c & 127); }
    return n;
}
struct P0Args { const float *x, *p, *w_in, *w_brc, *w_bra, *w_out, *w_pg, *w_pp, *w_gu, *w_dn; unsigned char* ws; float s_in; };
struct P0Item { const float* src; bf16_t* dst; int K, N; float qinv; };
constexpr int P0_I_IN = 16 * (NIN / 64), P0_I_SQ = 16 * 16, P0_I_PP = 4 * 16, P0_I_GU = 16 * 32, P0_I_DN = 16 * 16;
constexpr int P0_NSMALL = P0_I_IN + 4 * P0_I_SQ + P0_I_PP;
constexpr int P0_NITEMS = P0_I_IN + 5 * P0_I_SQ + P0_I_PP + NE * P0_I_GU + NE * P0_I_DN;
__device__ __forceinline__ P0Item p0_decode(const P0Args& a, int it) {
    const float* W; bf16_t* WT; int K = D, N = D, map = 0, r = it; float qinv = 0.f; const float* scl = (const float*)(a.ws + WS_SCL);
    if (r < P0_I_IN) { W = a.w_in; WT = (bf16_t*)(a.ws + WS_WIN); N = NIN; map = 1; qinv = 1.0f / a.s_in; }
    else if ((r -= P0_I_IN) < P0_I_SQ) { W = a.w_brc; WT = (bf16_t*)(a.ws + WS_WBR); }
    else if ((r -= P0_I_SQ) < P0_I_SQ) { W = a.w_bra; WT = (bf16_t*)(a.ws + WS_WBR) + (size_t)D * D; }
    else if ((r -= P0_I_SQ) < P0_I_SQ) { W = a.w_out; WT = (bf16_t*)(a.ws + WS_WOUT); }
    else if ((r -= P0_I_SQ) < P0_I_SQ) { W = a.w_pg; WT = (bf16_t*)(a.ws + WS_WPG); }
    else if ((r -= P0_I_SQ) < P0_I_PP) { W = a.w_pp; WT = (bf16_t*)(a.ws + WS_WPP); K = DPLE; }
    else if ((r -= P0_I_PP) < P0_I_SQ) { W = a.w_pg; WT = (bf16_t*)(a.ws + WS_WPG8); qinv = 1.0f / scl[NE]; }
    else if ((r -= P0_I_SQ) < NE * P0_I_GU) { const int e = r / P0_I_GU; r -= e * P0_I_GU; W = a.w_gu + (size_t)e * D * 2048; WT = (bf16_t*)(a.ws + WS_WGU + (size_t)e * 2048 * D); N = 2048; map = 2; qinv = 1.0f / scl[e]; }
    else { r -= NE * P0_I_GU; const int e = r / P0_I_DN; r -= e * P0_I_DN; W = a.w_dn + (size_t)e * D * D; WT = (bf16_t*)(a.ws + WS_WDN) + (size_t)e * D * D; }
    const int nblk = N / 64, kb = r / nblk, nb = r - kb * nblk, k0 = 64 * kb, n0 = 64 * nb;
    P0Item d; d.src = W + (size_t)k0 * N + n0; d.K = K; d.N = N; d.qinv = qinv;
    d.dst = qinv != 0.f ? (bf16_t*)((unsigned char*)WT + (size_t)dst_row(n0, map) * K + k0) : WT + (size_t)dst_row(n0, map) * K + k0; return d;
}
__device__ __forceinline__ void p0_load(const P0Item& d, f32x4 (&v)[16], int lane) {
    const int lr = lane >> 4, lc = (lane & 15) * 4;
#pragma unroll
    for (int i = 0; i < 16; ++i) v[i] = __builtin_nontemporal_load((const f32x4*)(d.src + (size_t)(4 * i + lr) * d.N + lc));
}
__device__ __forceinline__ void p0_store(const P0Item& d, const f32x4 (&v)[16], LAS float* scr, int lane) {
    const int lr = lane >> 4, lc = (lane & 15) * 4;
#pragma unroll
    for (int i = 0; i < 16; ++i) { LAS float* s = scr + (4 * i + lr) * 65 + lc; s[0] = v[i][0]; s[1] = v[i][1]; s[2] = v[i][2]; s[3] = v[i][3]; }
    asm volatile("s_waitcnt lgkmcnt(0)" ::: "memory");
    const int c = lane & 7;
#pragma unroll
    for (int j = 0; j < 8; ++j) { const int n = (lane >> 3) + 8 * j; const LAS float* s = scr + (8 * c) * 65 + n;
        if (d.qinv != 0.f) { unsigned lo = 0u, hi = 0u;
#pragma unroll
            for (int q = 0; q < 4; ++q) { const int a0 = (int)fminf(fmaxf(rintf(s[q * 65] * d.qinv), -127.f), 127.f), a1 = (int)fminf(fmaxf(rintf(s[(q + 4) * 65] * d.qinv), -127.f), 127.f);
                lo |= ((unsigned)a0 & 0xffu) << (8 * q); hi |= ((unsigned)a1 & 0xffu) << (8 * q); }
            *(u32x2*)((unsigned char*)d.dst + (size_t)n * d.K + 8 * c) = (u32x2){lo, hi}; }
        else { u32x4 o; o.x = pk2(s[0 * 65], s[1 * 65]); o.y = pk2(s[2 * 65], s[3 * 65]); o.z = pk2(s[4 * 65], s[5 * 65]); o.w = pk2(s[6 * 65], s[7 * 65]);
            *(u32x4*)(d.dst + (size_t)n * d.K + 8 * c) = o; } }
    asm volatile("s_waitcnt lgkmcnt(0)" ::: "memory");
}
__device__ __forceinline__ float sample_scale(const float* Wm, unsigned stride, LAS unsigned char* lds, int wvid) {
    int tid_ = (wvid * 64 + lane_id_asm()); asm volatile("" : "+v"(tid_)); const int tid = tid_;
    const unsigned so = (unsigned)tid * stride;
    const f32x4 v0 = *(const f32x4*)(Wm + so), v1 = *(const f32x4*)(Wm + so + 4);
    float ss = (v0[0] * v0[0] + v0[1] * v0[1]) + (v0[2] * v0[2] + v0[3] * v0[3]) + (v1[0] * v1[0] + v1[1] * v1[1]) + (v1[2] * v1[2] + v1[3] * v1[3]);
    float mx = fmaxf(fmaxf(fmaxf(fabsf(v0[0]), fabsf(v0[1])), fmaxf(fabsf(v0[2]), fabsf(v0[3]))), fmaxf(fmaxf(fabsf(v1[0]), fabsf(v1[1])), fmaxf(fabsf(v1[2]), fabsf(v1[3]))));
    ss = wave_sum(ss);
#pragma unroll
    for (int o = 1; o < 64; o <<= 1) mx = fmaxf(mx, __shfl_xor(mx, o));
    LAS float* red = (LAS float*)lds;
    __syncthreads();
    if ((tid & 63) == 0) { red[tid >> 6] = ss; red[8 + (tid >> 6)] = mx; }
    __syncthreads();
    float s = 0.f, m = 0.f;
#pragma unroll
    for (int w = 0; w < NWAVES; ++w) { s += red[w]; m = fmaxf(m, red[8 + w]); }
    __syncthreads();
    return fmaxf(fmaxf(6.5f * sqrtf(s * (1.0f / 4096.0f)), 1.25f * m), 1e-30f) * (1.0f / 127.0f);
}
__device__ __forceinline__ void p0_calibrate(const P0Args& a, LAS unsigned char* lds, int vcu, int wvid) {
    if (vcu > NE) return;
    const float sc = sample_scale(vcu < NE ? a.w_gu + (size_t)vcu * D * 2048 : a.w_pg, vcu < NE ? 4096 : 2048, lds, wvid);
    if ((wvid * 64 + lane_id_asm()) == 0) ((float*)(a.ws + WS_SCL))[vcu] = sc;
}
__device__ __forceinline__ void p0_phase(const P0Args& a, LAS unsigned char* lds, int vcu, int G, int it_lo, int it_hi, bool do_xp, int wvid) {
    int tid_ = (wvid * 64 + lane_id_asm()); asm volatile("" : "+v"(tid_));
    const int tid = tid_, lane = tid & 63, wave = __builtin_amdgcn_readfirstlane(tid >> 6);
    LAS float* scr = (LAS float*)(lds + wave * 16640);
    const int gw = vcu * NWAVES + wave, NGW = G * NWAVES;
    f32x4 va[16], vb[16]; P0Item da, db;
    int it = it_lo + gw;
    if (it < it_hi) { da = p0_decode(a, it); p0_load(da, va, lane); }
    while (it < it_hi) {
        const bool hb = it + NGW < it_hi;
        if (hb) { db = p0_decode(a, it + NGW); p0_load(db, vb, lane); }
        p0_store(da, va, scr, lane);
        if (!hb) break;
        const bool ha = it + 2 * NGW < it_hi;
        if (ha) { da = p0_decode(a, it + 2 * NGW); p0_load(da, va, lane); }
        p0_store(db, vb, scr, lane);
        if (!ha) break;
        it += 2 * NGW;
    }
    if (!do_xp) return;
    p0_calibrate(a, lds, vcu, wvid);
    const int gt = vcu * NTHREADS + tid, NGT = G * NTHREADS;
    for (int t0 = 2 * gw; t0 < M; t0 += 2 * NGW) { f32x4 v[2][4];
#pragma unroll
        for (int x = 0; x < 2; ++x)
#pragma unroll
            for (int j = 0; j < 4; ++j) v[x][j] = __builtin_nontemporal_load((const f32x4*)(a.x + (size_t)(t0 + x) * D + 256 * j + 4 * lane));
#pragma unroll
        for (int x = 0; x < 2; ++x) { float am = 0.f;
#pragma unroll
            for (int j = 0; j < 4; ++j) am = fmaxf(am, fmaxf(fmaxf(fabsf(v[x][j][0]), fabsf(v[x][j][1])), fmaxf(fabsf(v[x][j][2]), fabsf(v[x][j][3]))));
#pragma unroll
            for (int o = 1; o < 64; o <<= 1) am = fmaxf(am, __shfl_xor(am, o));
            const float sxr = fmaxf(am, 1e-30f) * (1.0f / 127.0f), qi = 1.0f / sxr;
#pragma unroll
            for (int j = 0; j < 4; ++j) { unsigned q = 0u;
#pragma unroll
                for (int z = 0; z < 4; ++z) q |= ((unsigned)(int)rintf(v[x][j][z] * qi) & 0xffu) << (8 * z);
                *(unsigned*)(a.ws + WS_XB + (size_t)(t0 + x) * D + 256 * j + 4 * lane) = q; }
            if (lane == 0) ((float*)(a.ws + WS_SX0))[t0 + x] = sxr; } }
    for (int i = gt; i < M * DPLE / 8; i += 4 * NGT) { f32x4 v[4][2];
#pragma unroll
        for (int u = 0; u < 4; ++u) { const size_t o = (size_t)(i + u * NGT) * 8; v[u][0] = __builtin_nontemporal_load((const f32x4*)(a.p + o)); v[u][1] = __builtin_nontemporal_load((const f32x4*)(a.p + o + 4)); }
#pragma unroll
        for (int u = 0; u < 4; ++u) { u32x4 o; o.x = pk2(v[u][0][0], v[u][0][1]); o.y = pk2(v[u][0][2], v[u][0][3]); o.z = pk2(v[u][1][0], v[u][1][1]); o.w = pk2(v[u][1][2], v[u][1][3]);
            *(u32x4*)((bf16_t*)(a.ws + WS_PB) + (size_t)(i + u * NGT) * 8) = o; } }
}

__device__ __forceinline__ int crow(int r, int hi) { return (r & 3) + 8 * (r >> 2) + 4 * hi; }
typedef short v4i16_t __attribute__((ext_vector_type(4)));
__device__ __forceinline__ s16x4 vtr(const LAS unsigned char* p) { return __builtin_bit_cast(s16x4, __builtin_amdgcn_ds_read_tr16_b64_v4i16((LAS v4i16_t*)p)); }
__device__ __forceinline__ void attn_unit(LAS unsigned char* lds, const bf16_t* Q, const bf16_t* Kg, const bf16_t* Vg, const float* sinks, bf16_t* O, int b, int kvh, int nb, int wvid) {
    int tid_ = (wvid * 64 + lane_id_asm()); asm volatile("" : "+v"(tid_));
    const int tid = tid_, lane = tid & 63, r32 = lane & 31, hi = lane >> 5; const int wid = __builtin_amdgcn_readfirstlane(tid >> 6);
    const int t0 = b * SEQ + nb * 128;
#pragma unroll
    for (int it = 0; it < 4; ++it) { const int idx = tid + it * NTHREADS, key = idx >> 3, c = idx & 7;
        int row = t0 - 128 + key; if (row < b * SEQ) row = b * SEQ;
        const u32x4 kv = *(const u32x4*)(Kg + (size_t)row * 256 + kvh * HD + c * 8);
        const u32x4 vv = *(const u32x4*)(Vg + (size_t)row * 256 + kvh * HD + c * 8);
        *(LAS u32x4*)(lds + c * 4096 + key * 16) = kv;
        *(LAS u32x4*)(lds + 32768 + (c >> 2) * 16384 + (key >> 4) * 1024 + (key & 15) * 64 + (c & 3) * 16) = vv; }
    __syncthreads();
    const int g = wid >> 1, half = wid & 1, h = kvh * 4 + g;
    const float sink2 = sinks[h] * LOG2E;
    const LAS unsigned char* vbase = lds + 32768 + ((lane >> 4) & 1) * 32 + (lane & 3) * 8 + (4 * hi + ((lane & 15) >> 2)) * 64;
#pragma unroll 1
    for (int qq = 0; qq < 2; ++qq) {
        const int qt = half * 2 + qq;
        const bf16_t* qp = Q + (size_t)(t0 + 32 * qt + r32) * D + h * HD + hi * 8;
        bf16x8 qr[4];
#pragma unroll
        for (int d0 = 0; d0 < 4; ++d0) qr[d0] = *(const bf16x8*)(qp + d0 * 16);
        f32x16 s[5];
#pragma unroll
        for (int j = 0; j < 5; ++j) { const LAS unsigned char* kp = lds + hi * 4096 + ((qt + j) * 32 + r32) * 16; f32x16 a = {};
#pragma unroll
            for (int d0 = 0; d0 < 4; ++d0) a = __builtin_amdgcn_mfma_f32_32x32x16_bf16(*(const LAS bf16x8*)(kp + d0 * 8192), qr[d0], a, 0, 0, 0);
            s[j] = a; }
#pragma unroll
        for (int r = 0; r < 16; ++r) { const int cr = crow(r, hi); if (cr <= r32) s[0][r] = -INFINITY; if (cr > r32) s[4][r] = -INFINITY; }
        if (nb == 0) {
#pragma unroll
            for (int j = 0; j < 4; ++j) if (qt + j < 4) {
#pragma unroll
                for (int r = 0; r < 16; ++r) s[j][r] = -INFINITY; } }
        float mx = -INFINITY;
#pragma unroll
        for (int j = 0; j < 5; ++j)
#pragma unroll
            for (int r = 0; r < 16; ++r) mx = fmaxf(mx, s[j][r]);
        mx = fmaxf(mx, __shfl_xor(mx, 32)); mx = fmaxf(mx, sink2);
        float ls = 0.f;
#pragma unroll
        for (int j = 0; j < 5; ++j)
#pragma unroll
            for (int r = 0; r < 16; ++r) { s[j][r] = __builtin_amdgcn_exp2f(s[j][r] - mx); ls += s[j][r]; }
        ls += __shfl_xor(ls, 32); ls += __builtin_amdgcn_exp2f(sink2 - mx);
        const float linv = 1.0f / ls;
        f32x16 o[2]; o[0] = f32x16{}; o[1] = f32x16{};
#pragma unroll
        for (int j = 0; j < 5; ++j)
#pragma unroll
            for (int ks = 0; ks < 2; ++ks) {
                u32x4 pw; pw.x = pk2(s[j][8 * ks + 0], s[j][8 * ks + 1]); pw.y = pk2(s[j][8 * ks + 2], s[j][8 * ks + 3]); pw.z = pk2(s[j][8 * ks + 4], s[j][8 * ks + 5]); pw.w = pk2(s[j][8 * ks + 6], s[j][8 * ks + 7]);
                const bf16x8 pa = __builtin_bit_cast(bf16x8, pw);
                const LAS unsigned char* vp = vbase + ((qt + j) * 2 + ks) * 1024;
#pragma unroll
                for (int dh = 0; dh < 2; ++dh) { const s16x4 lo = vtr(vp + dh * 16384), hi4 = vtr(vp + dh * 16384 + 512);
                    const bf16x8 vf = {lo[0], lo[1], lo[2], lo[3], hi4[0], hi4[1], hi4[2], hi4[3]};
                    o[dh] = __builtin_amdgcn_mfma_f32_32x32x16_bf16(pa, vf, o[dh], 0, 0, 0); } }
        bf16_t* op = O + (size_t)(t0 + 32 * qt) * D + h * HD + r32;
#pragma unroll
        for (int r = 0; r < 16; ++r) { const int q = crow(r, hi); const float sc = __shfl(linv, q);
            op[(size_t)q * D] = (bf16_t)f2bf(o[0][r] * sc); op[(size_t)q * D + 32] = (bf16_t)f2bf(o[1][r] * sc); }
    }
    __syncthreads();
}
__device__ __forceinline__ void conv_phase(const bf16_t* Bg, const bf16_t* U, const float* cw, bf16_t* Z, int vcu, int G, int wvid) {
    int tid_ = (wvid * 64 + lane_id_asm()); asm volatile("" : "+v"(tid_));
    const int gt = vcu * NTHREADS + tid_, NGT = G * NTHREADS;
    for (int i = gt; i < (M / 8) * (D / 8); i += NGT) {
        const int t0 = (i >> 7) * 8, c = (i & 127) * 8, tl0 = t0 & (SEQ - 1);
        f32x4 w[3][2];
#pragma unroll
        for (int k = 0; k < 3; ++k) { w[k][0] = *(const f32x4*)(cw + k * D + c); w[k][1] = *(const f32x4*)(cw + k * D + c + 4); }
        u32x4 ur[10], br[8];
#pragma unroll
        for (int r = 0; r < 10; ++r) { if (r >= 2 || tl0 != 0) ur[r] = *(const u32x4*)(U + (size_t)(t0 + r - 2) * D + c); else ur[r] = (u32x4){0u, 0u, 0u, 0u}; }
#pragma unroll
        for (int r = 0; r < 8; ++r) br[r] = *(const u32x4*)(Bg + (size_t)(t0 + r) * D + c);
#pragma unroll
        for (int r = 0; r < 8; ++r) { float y[8];
#pragma unroll
            for (int j = 0; j < 8; ++j) y[j] = 0.f;
#pragma unroll
            for (int k = 0; k < 3; ++k) { const u32x4 uw = ur[r + k];
                y[0] += w[k][0][0] * bflo(uw.x); y[1] += w[k][0][1] * bfhi(uw.x); y[2] += w[k][0][2] * bflo(uw.y); y[3] += w[k][0][3] * bfhi(uw.y);
                y[4] += w[k][1][0] * bflo(uw.z); y[5] += w[k][1][1] * bfhi(uw.z); y[6] += w[k][1][2] * bflo(uw.w); y[7] += w[k][1][3] * bfhi(uw.w); }
            const u32x4 bw = br[r];
            u32x4 o; o.x = pk2(y[0] * bflo(bw.x), y[1] * bfhi(bw.x)); o.y = pk2(y[2] * bflo(bw.y), y[3] * bfhi(bw.y)); o.z = pk2(y[4] * bflo(bw.z), y[5] * bfhi(bw.z)); o.w = pk2(y[6] * bflo(bw.w), y[7] * bfhi(bw.w));
            *(u32x4*)(Z + (size_t)(t0 + r) * D + c) = o; }
    }
}
#ifndef DBG_ATTN
#define DBG_ATTN 0
#endif
#if DBG_ATTN
__device__ __forceinline__ void dbg_attn_check(const bf16_t* Q, const bf16_t* Kg, const bf16_t* Vg, const float* sinks, const bf16_t* O, float* acc3, int vcu, int G, int wvid) {
    const int lane = (wvid * 64 + lane_id_asm()) & 63, wave = wvid;
    const int gw = vcu * NWAVES + wave, nw = G * NWAVES;
    float lnum = 0.f, lden = 0.f, lmax = 0.f;
    for (int it = gw; it < M * NH; it += nw) {
        const int t = it / NH, h = it % NH, kvh = h / 4, tl = t % SEQ;
        const int slo = tl - 127 < 0 ? 0 : tl - 127, n = tl - slo + 1;
        const bf16_t* qp = Q + (size_t)t * D + h * HD;
        float sc[2];
#pragma unroll
        for (int u = 0; u < 2; ++u) { const int j = lane + 64 * u; float dot = -INFINITY;
            if (j < n) { const bf16_t* kp = Kg + (size_t)(t - tl + slo + j) * 256 + kvh * HD; dot = 0.f;
                for (int d = 0; d < HD; ++d) dot = fmaf(bflo((unsigned)qp[d]), bflo((unsigned)kp[d]), dot);
                dot *= (1.0f / LOG2E); }
            sc[u] = dot; }
        const float sink = sinks[h];
        float m = fmaxf(sc[0], sc[1]);
        for (int o = 1; o < 64; o <<= 1) m = fmaxf(m, __shfl_xor(m, o));
        m = fmaxf(m, sink);
        float e0 = (lane < n) ? expf(sc[0] - m) : 0.f, e1 = (lane + 64 < n) ? expf(sc[1] - m) : 0.f;
        float s = e0 + e1;
        for (int o = 1; o < 64; o <<= 1) s += __shfl_xor(s, o);
        const float denom = s + expf(sink - m);
        e0 /= denom; e1 /= denom;
        float a = 0.f;
        for (int j = 0; j < n; ++j) { const float pj = __shfl(j < 64 ? e0 : e1, j & 63); a = fmaf(pj, bflo((unsigned)Vg[(size_t)(t - tl + slo + j) * 256 + kvh * HD + lane]), a); }
        const float o = bflo((unsigned)O[(size_t)t * D + h * HD + lane]);
        const float rn = wave_sum((o - a) * (o - a)), rd = wave_sum(a * a);
        lnum += rn; lden += rd; lmax = fmaxf(lmax, rn / fmaxf(rd, 1e-20f));
    }
    if (lane == 0) { atomicAdd(acc3, lnum); atomicAdd(acc3 + 1, lden); atomicMax((unsigned*)(acc3 + 2), __float_as_uint(lmax)); }
}
#endif
constexpr int WR_STRIDE = 1028;
struct RouteArgs { float* X1F; bf16_t* X1B; const float *g1, *b1, *w_r, *b_r; int* gcnt; int* list_tok; float* list_w; int* tk_e; int* tk_rank; float* tk_w; unsigned char* XQ; float* sx1; float* list_sx; };
__device__ __forceinline__ void route_phase(const RouteArgs& a, LAS unsigned char* lds, int vcu, int G, bool dry, int wvid) {
    int tid_ = (wvid * 64 + lane_id_asm()); asm volatile("" : "+v"(tid_));
    const int tid = tid_, lane = tid & 63, wave = __builtin_amdgcn_readfirstlane(tid >> 6);
    LAS float* wrt = (LAS float*)lds;
    LAS int* misc = (LAS int*)(lds + MISC_OFF);
    LAS int* lcnt = misc + 96; LAS int* gbase = misc + 128; LAS int* rowe = misc + 160; LAS float* roww = (LAS float*)(misc + 416); LAS float* rowsx = (LAS float*)(misc + 672);
    for (int i = tid; i < D * NE; i += NTHREADS) { const int c = i >> 5, e = i & 31; wrt[e * WR_STRIDE + c] = a.w_r[i]; }
    if (tid < NE) lcnt[tid] = 0;
    __syncthreads();
    const int rows_per_wg = M / G;
    for (int rr = 2 * wave; rr < rows_per_wg; rr += 2 * NWAVES) {
        f32x4 v[2][4];
#pragma unroll
        for (int x = 0; x < 2; ++x) { const int t = vcu * rows_per_wg + rr + x; float s = 0.f;
#pragma unroll
            for (int j = 0; j < 4; ++j) { v[x][j] = *(const f32x4*)(a.X1F + (size_t)t * D + 256 * j + 4 * lane); s += (v[x][j][0] + v[x][j][1]) + (v[x][j][2] + v[x][j][3]); }
            const float mean = wave_sum(s) * (1.0f / D); float q = 0.f;
#pragma unroll
            for (int j = 0; j < 4; ++j) { v[x][j] = v[x][j] - mean; q += (v[x][j][0] * v[x][j][0] + v[x][j][1] * v[x][j][1]) + (v[x][j][2] * v[x][j][2] + v[x][j][3] * v[x][j][3]); }
            const float rstd = 1.0f / sqrtf(wave_sum(q) * (1.0f / D) + LN_EPS);
#pragma unroll
            for (int j = 0; j < 4; ++j) { const f32x4 gg = *(const f32x4*)(a.g1 + 256 * j + 4 * lane), bb = *(const f32x4*)(a.b1 + 256 * j + 4 * lane);
                v[x][j] = v[x][j] * rstd * gg + bb;
                if (!dry) { u32x2 w; w.x = pk2(v[x][j][0], v[x][j][1]); w.y = pk2(v[x][j][2], v[x][j][3]); *(u32x2*)(a.X1B + (size_t)t * D + 256 * j + 4 * lane) = w; } }
            float am = 0.f;
#pragma unroll
            for (int j = 0; j < 4; ++j) am = fmaxf(am, fmaxf(fmaxf(fabsf(v[x][j][0]), fabsf(v[x][j][1])), fmaxf(fabsf(v[x][j][2]), fabsf(v[x][j][3]))));
#pragma unroll
            for (int o = 1; o < 64; o <<= 1) am = fmaxf(am, __shfl_xor(am, o));
            const float sxr = fmaxf(am, 1e-30f) * (1.0f / 127.0f), qi = 1.0f / sxr;
            if (!dry) {
#pragma unroll
                for (int j = 0; j < 4; ++j) { unsigned q = 0u;
#pragma unroll
                    for (int z = 0; z < 4; ++z) q |= ((unsigned)(int)rintf(v[x][j][z] * qi) & 0xffu) << (8 * z);
                    *(unsigned*)(a.XQ + (size_t)t * D + 256 * j + 4 * lane) = q; }
                if (lane == 0) { a.sx1[t] = sxr; rowsx[rr + x] = sxr; } } }
        float pl[2][32];
#pragma unroll
        for (int e = 0; e < 32; ++e) { float a0 = 0.f, a1 = 0.f;
#pragma unroll
            for (int j = 0; j < 4; ++j) { const f32x4 w = *(const LAS f32x4*)(wrt + e * WR_STRIDE + 256 * j + 4 * lane);
                a0 += (v[0][j][0] * w[0] + v[0][j][1] * w[1]) + (v[0][j][2] * w[2] + v[0][j][3] * w[3]); a1 += (v[1][j][0] * w[0] + v[1][j][1] * w[1]) + (v[1][j][2] * w[2] + v[1][j][3] * w[3]); }
            pl[0][e] = a0; pl[1][e] = a1; }
#pragma unroll
        for (int o = 32, n = 16; o >= 2; o >>= 1, n >>= 1) { const bool up = (lane & o) != 0;
#pragma unroll
            for (int i = 0; i < 16; ++i) if (i < n) {
#pragma unroll
                for (int x = 0; x < 2; ++x) { const float send = up ? pl[x][i] : pl[x][i + n], keep = up ? pl[x][i + n] : pl[x][i]; pl[x][i] = keep + __shfl_xor(send, o); } } }
        const int myexp = lane >> 1; const float brv = a.b_r[myexp];
        float logit[2];
#pragma unroll
        for (int x = 0; x < 2; ++x) logit[x] = pl[x][0] + __shfl_xor(pl[x][0], 1) + brv;
        int se[2][4]; float sv[2][4];
#pragma unroll
        for (int k = 0; k < 4; ++k) { float bv[2]; int bi[2];
#pragma unroll
            for (int x = 0; x < 2; ++x) { bv[x] = logit[x]; bi[x] = myexp; }
#pragma unroll
            for (int o = 1; o < 64; o <<= 1) {
#pragma unroll
                for (int x = 0; x < 2; ++x) { const float ov = __shfl_xor(bv[x], o); const int oi = __shfl_xor(bi[x], o); if (ov > bv[x] || (ov == bv[x] && oi < bi[x])) { bv[x] = ov; bi[x] = oi; } } }
#pragma unroll
            for (int x = 0; x < 2; ++x) { se[x][k] = bi[x]; sv[x][k] = bv[x]; if (myexp == bi[x]) logit[x] = -INFINITY; } }
#pragma unroll
        for (int x = 0; x < 2; ++x) { const float e1 = __expf(sv[x][1] - sv[x][0]), e2 = __expf(sv[x][2] - sv[x][0]), e3 = __expf(sv[x][3] - sv[x][0]);
            const float inv = 1.0f / (1.0f + e1 + e2 + e3);
            if (lane < 4) { const int e = lane == 0 ? se[x][0] : lane == 1 ? se[x][1] : lane == 2 ? se[x][2] : se[x][3];
                const float w = (lane == 0 ? 1.0f : lane == 1 ? e1 : lane == 2 ? e2 : e3) * inv;
                rowe[(rr + x) * 4 + lane] = e; roww[(rr + x) * 4 + lane] = w; } }
    }
    __syncthreads();
    if (dry) return;
    const int nent = rows_per_wg * 4;
    int my_e = 0, my_lr = 0;
    if (tid < nent) { my_e = rowe[tid]; my_lr = atomicAdd((int*)(lcnt + my_e), 1); }
    __syncthreads();
    if (tid < NE) gbase[tid] = atomicAdd(a.gcnt + tid, lcnt[tid]);
    __syncthreads();
    if (tid < nent) { const int t = vcu * rows_per_wg + (tid >> 2), rank = gbase[my_e] + my_lr;
        a.list_tok[(size_t)my_e * LISTCAP + rank] = t; a.list_w[(size_t)my_e * LISTCAP + rank] = roww[tid]; a.list_sx[(size_t)my_e * LISTCAP + rank] = rowsx[tid >> 2];
        a.tk_e[t * 4 + (tid & 3)] = my_e; a.tk_rank[t * 4 + (tid & 3)] = rank; a.tk_w[t * 4 + (tid & 3)] = roww[tid]; }
    __syncthreads();
}
__device__ __forceinline__ void build_tables(const int* gcnt, LAS unsigned char* lds, int wvid) {
    LAS int* misc = (LAS int*)(lds + MISC_OFF);
    if ((wvid * 64 + lane_id_asm()) == 0) { int a = 0; for (int e = 0; e < NE; ++e) { const int c = __hip_atomic_load(gcnt + e, __ATOMIC_RELAXED, __HIP_MEMORY_SCOPE_AGENT); misc[e] = c; misc[32 + e] = a; a += (c + 255) >> 8; } misc[32 + NE] = a; }
    __syncthreads();
}
struct FinalArgs { float dbg_scale; int pad_; const bf16_t* X1B; const bf16_t* PLE; const bf16_t* Y; const int* tk_e; const int* tk_rank; const float* tk_w; const float* b_down; const float *g2, *b2; float* out; };
__device__ __forceinline__ void final_phase(const FinalArgs& a, LAS unsigned char* lds, int vcu, int G, int wvid) {
    int tid_ = (wvid * 64 + lane_id_asm()); asm volatile("" : "+v"(tid_));
    const int tid = tid_, lane = tid & 63, wave = __builtin_amdgcn_readfirstlane(tid >> 6);
    const LAS int* ts = (const LAS int*)(lds + MISC_OFF) + 32;
    LAS float* bdl = (LAS float*)lds;
    for (int i = tid; i < NE * D / 4; i += NTHREADS) *(LAS f32x4*)(bdl + 4 * i) = *(const f32x4*)(a.b_down + 4 * i);
    __syncthreads();
    const int gw = vcu * NWAVES + wave, NGW = G * NWAVES;
    for (int t0 = 2 * gw; t0 < M; t0 += 2 * NGW) {
        size_t pos[2][4]; int ek[2][4]; float wk[2][4];
#pragma unroll
        for (int x = 0; x < 2; ++x)
#pragma unroll
            for (int k = 0; k < 4; ++k) { const int t = t0 + x, e = a.tk_e[t * 4 + k], rk = a.tk_rank[t * 4 + k]; pos[x][k] = ((size_t)ts[e] * 256 + rk) * D; ek[x][k] = e * D; wk[x][k] = a.tk_w[t * 4 + k]; }
        f32x4 v[2][4]; float s[2] = {0.f, 0.f};
#pragma unroll
        for (int x = 0; x < 2; ++x)
#pragma unroll
            for (int j = 0; j < 4; ++j) { const int c = 256 * j + 4 * lane; const size_t ro = (size_t)(t0 + x) * D + c;
                const u32x2 xw = *(const u32x2*)(a.X1B + ro), pw = *(const u32x2*)(a.PLE + ro);
                f32x4 xx = {bflo(xw.x) * DN_ALPHA + bflo(pw.x), bfhi(xw.x) * DN_ALPHA + bfhi(pw.x), bflo(xw.y) * DN_ALPHA + bflo(pw.y), bfhi(xw.y) * DN_ALPHA + bfhi(pw.y)};
#pragma unroll
                for (int k = 0; k < 4; ++k) { const u32x2 yw = *(const u32x2*)(a.Y + pos[x][k] + c); const f32x4 bd = *(const LAS f32x4*)(bdl + ek[x][k] + c);
                    xx[0] += bflo(yw.x) + wk[x][k] * bd[0]; xx[1] += bfhi(yw.x) + wk[x][k] * bd[1]; xx[2] += bflo(yw.y) + wk[x][k] * bd[2]; xx[3] += bfhi(yw.y) + wk[x][k] * bd[3]; }
                v[x][j] = xx; s[x] += (xx[0] + xx[1]) + (xx[2] + xx[3]); }
#pragma unroll
        for (int x = 0; x < 2; ++x) { const float mean = wave_sum(s[x]) * (1.0f / D); float q = 0.f;
#pragma unroll
            for (int j = 0; j < 4; ++j) { v[x][j] = v[x][j] - mean; q += (v[x][j][0] * v[x][j][0] + v[x][j][1] * v[x][j][1]) + (v[x][j][2] * v[x][j][2] + v[x][j][3] * v[x][j][3]); }
            const float rstd = 1.0f / sqrtf(wave_sum(q) * (1.0f / D) + LN_EPS);
#pragma unroll
            for (int j = 0; j < 4; ++j) { const int c = 256 * j + 4 * lane; const f32x4 gg = *(const f32x4*)(a.g2 + c), bb = *(const f32x4*)(a.b2 + c);
                *(f32x4*)(a.out + (size_t)(t0 + x) * D + c) = (v[x][j] * rstd * gg + bb) * a.dbg_scale; } }
    }
}

#ifndef PROBE_REP
#define PROBE_REP 0
#endif
struct Args { const float* in[20]; float* out; unsigned char* ws; };
__global__ void __launch_bounds__(NTHREADS, 2) mega_fwd(Args args) {
    extern __shared__ __attribute__((aligned(16))) unsigned char lds_raw[];
    LAS unsigned char* lds = (LAS unsigned char*)lds_raw;
    cg::grid_group grid = cg::this_grid();
    const int G = gridDim.x, bx = blockIdx.x;
    const int wvid = __builtin_amdgcn_readfirstlane((int)threadIdx.x >> 6);
    const int vcu = (G % 8 == 0) ? (bx % 8) * (G / 8) + bx / 8 : bx;
    unsigned char* const ws = args.ws;
    const LAS int* cntL = (const LAS int*)(lds + MISC_OFF); const LAS int* tsL = cntL + 32;
    { volatile LAS unsigned* bst = (volatile LAS unsigned*)(lds + MISC_OFF) + BST_IDX;
      { int t_ = (wvid * 64 + lane_id_asm()); asm volatile("" : "+v"(t_)); if (t_ < 2) bst[t_] = 0u; }
      __syncthreads();
      (void)xcd_barrier_post((unsigned*)(ws + WS_BAR), bst, (wvid * 64 + lane_id_asm()) == 0); }
#define GRID_BAR() do { XcdBarrier b_; b_.bar = (unsigned*)(ws + WS_BAR); b_.x = xb_xcc_id(); b_.st = (volatile LAS unsigned*)(lds + MISC_OFF) + BST_IDX; b_.lead = ((wvid * 64 + lane_id_asm()) == 0); xcd_barrier(b_); } while (0)
#define WSP(T, off) ((T*)(ws + (off)))

    { const float s_in = __builtin_bit_cast(float, __builtin_amdgcn_readfirstlane(__builtin_bit_cast(int, sample_scale(args.in[2], 13312, lds, wvid))));
    _Pragma("unroll 1") for (int rep_ = 0; rep_ < ((PROBE_REP & 1) ? 2 : 1); ++rep_) { P0Args a{args.in[0], args.in[1], args.in[2], args.in[4], args.in[5], args.in[7], args.in[17], args.in[16], args.in[12], args.in[14], ws, s_in}; p0_phase(a, lds, vcu, G, 0, P0_NSMALL, true, wvid); } }
    grid.sync();
    _Pragma("unroll 1") for (int rep_ = 0; rep_ < ((PROBE_REP & 2) ? 2 : 1); ++rep_) { pg8::Gemm g{WSP(bf16_t, WS_XB), (const bf16_t*)(ws + WS_WIN), D / 2}; pg8::StaticOrder S; S.init(M / 256, NIN / 256, G, bx, 1);
      const float s_in1 = __builtin_bit_cast(float, __builtin_amdgcn_readfirstlane(__builtin_bit_cast(int, sample_scale(args.in[2], 13312, lds, wvid))));
      pg8::EpiInProjI8 E{ws, s_in1};
      pg8::gemm_phase<pg8::EpiInProjI8, pg8::StaticOrder, true, 0, true>(lds, g, S, E, wvid); }
    { constexpr int U1 = (M / 256) * (NIN / 256); const int R1 = U1 % G, nidle = R1 ? G - R1 : G, per = 256 / nidle;
      if (R1 == 0 || bx >= R1) {
        pg8::Gemm g{WSP(bf16_t, WS_PB), (const bf16_t*)(ws + WS_WPP), DPLE}; pg8::Ple1Order S{(bx - R1) * per, per};
        pg8::EpiF32 E{WSP(float, WS_P2)};
        pg8::gemm_phase<pg8::EpiF32, pg8::Ple1Order, false>(lds, g, S, E, wvid); } }
    GRID_BAR();
    if (PROBE_REP & 4096) { _Pragma("unroll 1") for (int k_ = 0; k_ < 8; ++k_) GRID_BAR(); }
    _Pragma("unroll 1") for (int rep_ = 0; rep_ < ((PROBE_REP & 4) ? 2 : 1); ++rep_) for (int it = vcu; it < BATCH * NKV * (SEQ / 128); it += G) { const int nb = it & 63, kvh = (it >> 6) & 3, b = it >> 8;
        attn_unit(lds, WSP(bf16_t, WS_Q), WSP(bf16_t, WS_K), WSP(bf16_t, WS_V), args.in[6], WSP(bf16_t, WS_ZO) + (size_t)M * D, b, kvh, nb, wvid); }
    _Pragma("unroll 1") for (int rep_ = 0; rep_ < ((PROBE_REP & 8) ? 2 : 1); ++rep_) conv_phase(WSP(bf16_t, WS_BG), WSP(bf16_t, WS_U), args.in[3], WSP(bf16_t, WS_ZO), vcu, G, wvid);
    GRID_BAR();
#if DBG_ATTN
    dbg_attn_check(WSP(bf16_t, WS_Q), WSP(bf16_t, WS_K), WSP(bf16_t, WS_V), args.in[6], WSP(bf16_t, WS_ZO) + (size_t)M * D, WSP(float, WS_CTL) + 64, vcu, G, wvid);
#endif
    _Pragma("unroll 1") for (int rep_ = 0; rep_ < ((PROBE_REP & 16) ? 2 : 1); ++rep_) { pg8::Gemm g{WSP(bf16_t, WS_ZO), (const bf16_t*)(ws + WS_WBR), D}; pg8::DualOrder S; S.so.init(M / 256, D / 256, G, bx);
      pg8::EpiDual E{ws};
      pg8::gemm_phase<pg8::EpiDual, pg8::DualOrder, false>(lds, g, S, E, wvid); }
    GRID_BAR();
    _Pragma("unroll 1") for (int rep_ = 0; rep_ < ((PROBE_REP & 32) ? 2 : 1); ++rep_) { pg8::Gemm g{WSP(bf16_t, WS_MG), (const bf16_t*)(ws + WS_WOUT), D}; pg8::StaticOrder S; S.init(M / 256, D / 256, G, bx);
      pg8::EpiResid E{args.in[0], WSP(float, WS_X1F)};
      pg8::gemm_phase<pg8::EpiResid, pg8::StaticOrder, false>(lds, g, S, E, wvid); }
    GRID_BAR();
    { P0Args a{args.in[0], args.in[1], args.in[2], args.in[4], args.in[5], args.in[7], args.in[17], args.in[16], args.in[12], args.in[14], ws, 1.0f}; p0_phase(a, lds, vcu, G, P0_NSMALL, P0_NITEMS, false, wvid); __syncthreads(); }
    _Pragma("unroll 1") for (int rep_ = ((PROBE_REP & 64) ? 0 : 1); rep_ < 2; ++rep_) { RouteArgs a{WSP(float, WS_X1F), WSP(bf16_t, WS_X1B), args.in[8], args.in[9], args.in[10], args.in[11], WSP(int, WS_CTL), WSP(int, WS_LTOK), WSP(float, WS_LW), WSP(int, WS_TKE), WSP(int, WS_TKR), WSP(float, WS_TKW), ws + WS_XQ, WSP(float, WS_SX1), WSP(float, WS_LSX)}; route_phase(a, lds, vcu, G, rep_ == 0, wvid); }
    GRID_BAR();
    build_tables(WSP(int, WS_CTL), lds, wvid);
    { const int U5_ = __builtin_amdgcn_readfirstlane(tsL[NE]) * 8, idle5_ = (G - U5_ % G) % G, nx5_ = idle5_ < 256 ? idle5_ : 256;
      pg8::MoeOrder S; S.init(cntL, tsL, (const LAS unsigned*)(lds + TW_OFF), 8, G, bx, 1, WS_XQ, WS_WGU, nx5_, 0, WS_XQ, WS_WPG8, 18); S.build_units((LAS int*)(lds + UTAB_OFF), 12);
      pg8::moe_preload(S, cntL, WSP(int, WS_LTOK), WSP(float, WS_LW), (LAS unsigned*)(lds + TW_OFF), wvid);
      _Pragma("unroll 1") for (int rep_ = 0; rep_ < ((PROBE_REP & 128) ? 2 : 1); ++rep_) { pg8::Gemm g{(const bf16_t*)ws, (const bf16_t*)ws, D / 2};
        pg8::EpiSwigluI8 E{WSP(bf16_t, WS_H), args.in[13], (const LAS unsigned*)(lds + TW_OFF), ws};
        pg8::gemm_phase<pg8::EpiSwigluI8, pg8::MoeOrder, true, 0, true>(lds, g, S, E, wvid); } }
    GRID_BAR();
    _Pragma("unroll 1") for (int rep_ = 0; rep_ < ((PROBE_REP & 1024) ? 2 : 1); ++rep_) { pg8::Gemm g{(const bf16_t*)ws, (const bf16_t*)ws, D};
      const int U5b_ = __builtin_amdgcn_readfirstlane(tsL[NE]) * 8, idle5b_ = (G - U5b_ % G) % G, nx5_ = idle5b_ < 256 ? idle5b_ : 256;
      pg8::MoeOrder S; S.init(cntL, tsL, (const LAS unsigned*)(lds + TW_OFF), 4, G, bx, 0, WS_H, WS_WDN, 256 - nx5_, nx5_, WS_X1B, WS_WPG, 19); S.build_units((LAS int*)(lds + UTAB_OFF), 12);
      pg8::EpiDown E{WSP(bf16_t, WS_Y), ws};
      pg8::gemm_phase<pg8::EpiDown, pg8::MoeOrder, true>(lds, g, S, E, wvid); }
    GRID_BAR();
    _Pragma("unroll 1") for (int rep_ = 0; rep_ < ((PROBE_REP & 2048) ? 2 : 1); ++rep_) { float dbgs_ = 1.0f;
#if DBG_ATTN
      { const float* a3 = WSP(float, WS_CTL) + 64; const float num = __hip_atomic_load(a3, __ATOMIC_RELAXED, __HIP_MEMORY_SCOPE_AGENT), den = __hip_atomic_load(a3 + 1, __ATOMIC_RELAXED, __HIP_MEMORY_SCOPE_AGENT), mx = __hip_atomic_load(a3 + 2, __ATOMIC_RELAXED, __HIP_MEMORY_SCOPE_AGENT);
        dbgs_ = 1.0f + sqrtf(100.0f * (DBG_ATTN == 1 ? num / den : mx)); }
#endif
      FinalArgs a{dbgs_, 0, WSP(bf16_t, WS_X1B), WSP(bf16_t, WS_PLE), WSP(bf16_t, WS_Y), WSP(int, WS_TKE), WSP(int, WS_TKR), WSP(float, WS_TKW), args.in[15], args.in[18], args.in[19], args.out}; final_phase(a, lds, vcu, G, wvid); }
}

extern "C" void kernel_launch(void* const* d_in, const int* in_sizes, int n_in, void* d_out, int out_size, void* d_ws, size_t ws_size, hipStream_t stream) {
    static int grid = 0;
    if (grid == 0) {
        if (n_in != 20 || out_size != M * D || ws_size < WS_END) { fprintf(stderr, "kernel_launch: unexpected sizes (n_in %d, out %d, ws %zu < %zu)\n", n_in, out_size, ws_size, (size_t)WS_END); grid = -1; return; }
        int dev = 0, cus = 0, per_cu = 0;
        if (hipGetDevice(&dev) != hipSuccess || hipDeviceGetAttribute(&cus, hipDeviceAttributeMultiprocessorCount, dev) != hipSuccess) { grid = -1; return; }
        if (hipFuncSetAttribute((const void*)mega_fwd, hipFuncAttributeMaxDynamicSharedMemorySize, LDS_BYTES) != hipSuccess) { fprintf(stderr, "kernel_launch: hipFuncSetAttribute failed\n"); grid = -1; return; }
        if (hipOccupancyMaxActiveBlocksPerMultiprocessor(&per_cu, (const void*)mega_fwd, NTHREADS, LDS_BYTES) != hipSuccess || per_cu < 1) { fprintf(stderr, "kernel_launch: occupancy query says %d blocks per CU\n", per_cu); grid = -1; return; }
        grid = cus;
        if (grid != 256) fprintf(stderr, "kernel_launch: note: %d CUs (built and tuned for 256)\n", grid);
    }
    if (grid < 0) return;
    if (hipMemsetAsync((char*)d_ws + WS_CTL, 0, CTL_ZERO_BYTES, stream) != hipSuccess) return;
    Args a{};
    for (int i = 0; i < 20; ++i) a.in[i] = (const float*)d_in[i];
    a.out = (float*)d_out; a.ws = (unsigned char*)d_ws;
    void* kargs[] = {&a};
    const hipError_t e = hipLaunchCooperativeKernel((const void*)mega_fwd, dim3(grid), dim3(NTHREADS), kargs, LDS_BYTES, stream);
    if (e != hipSuccess) fprintf(stderr, "kernel_launch: cooperative launch failed: %s (grid %d)\n", hipGetErrorString(e), grid);
}
```

```cpp
#include <hip/hip_runtime.h>
#include <hip/hip_cooperative_groups.h>
#include <cstdio>
#include <cstdint>
namespace cg = cooperative_groups;

#define LAS __attribute__((address_space(3)))
typedef unsigned short bf16_t;
typedef short bf16x8 __attribute__((ext_vector_type(8)));
typedef short s16x4 __attribute__((ext_vector_type(4)));
typedef float f32x4 __attribute__((ext_vector_type(4)));
typedef float f32x16 __attribute__((ext_vector_type(16)));
typedef unsigned u32x4 __attribute__((ext_vector_type(4)));
typedef unsigned u32x2 __attribute__((ext_vector_type(2)));

constexpr int BATCH = 2, SEQ = 8192, M = BATCH * SEQ, D = 1024, NIN = 6656, NE = 32, DPLE = 256, NH = 16, HD = 64, NKV = 4;
constexpr float DN_ALPHA = 1.189207115002721f, LN_EPS = 1e-5f, LOG2E = 1.4426950408889634f;
constexpr float QSCALE = 0.125f * LOG2E;
constexpr int LISTCAP = M;
constexpr int MAXTILES = (M * 4) / 256 + NE;
constexpr int NWAVES = 8, NTHREADS = 512;

constexpr size_t MiB = 1u << 20;
constexpr size_t WS_CTL = 0;
constexpr size_t WS_BAR = 16384, CTL_ZERO_BYTES = 65536;
constexpr size_t WS_TKE = 1 * MiB, WS_TKR = 2 * MiB, WS_TKW = 3 * MiB;
constexpr size_t WS_LTOK = 4 * MiB, WS_LW = 6 * MiB;
constexpr size_t WS_WIN = 8 * MiB;
constexpr size_t WS_WBR = 22 * MiB;
constexpr size_t WS_WOUT = 26 * MiB, WS_WPG = 28 * MiB;
constexpr size_t WS_WPP = 30 * MiB;
constexpr size_t WS_WGU = 32 * MiB;
constexpr size_t WS_WDN = 160 * MiB;
constexpr size_t WS_XB = 224 * MiB;
constexpr size_t WS_PB = 256 * MiB;
constexpr size_t WS_X1F = 264 * MiB;
constexpr size_t WS_X1B = 328 * MiB;
constexpr size_t WS_P2 = 360 * MiB;
constexpr size_t WS_PLE = 424 * MiB;
constexpr size_t WS_R = 456 * MiB;
constexpr size_t WS_BG = WS_R, WS_U = WS_R + 32 * MiB, WS_Q = WS_R + 64 * MiB, WS_K = WS_R + 96 * MiB, WS_V = WS_R + 104 * MiB;
constexpr size_t WS_GC = WS_R + 112 * MiB, WS_GA = WS_R + 144 * MiB;
constexpr size_t WS_ZO = WS_R + 176 * MiB;
constexpr size_t WS_T1 = WS_R + 240 * MiB;
constexpr size_t WS_MG = WS_R + 304 * MiB;
constexpr size_t WS_H = WS_R;
constexpr size_t WS_Y = WS_R + 144 * MiB;
constexpr size_t WS_XQ = WS_R + 336 * MiB;
constexpr size_t WS_LSX = WS_XQ + 16 * MiB;
constexpr size_t WS_SX1 = WS_LSX + 2 * MiB;
constexpr size_t WS_SX0 = WS_SX1 + 1 * MiB;
constexpr size_t WS_LHS = WS_SX0 + 1 * MiB;
constexpr size_t WS_END = WS_LHS + 2 * MiB;
constexpr size_t WS_SCL = 65536;
constexpr size_t WS_WPG8 = 31 * MiB;
typedef int i32x4 __attribute__((ext_vector_type(4)));

constexpr int LDS_BYTES = 147456;
constexpr int MISC_OFF = 135168;
constexpr int BST_IDX = 66, TW_OFF = MISC_OFF + 512, UTAB_OFF = TW_OFF + 10240;
constexpr int BST_IDX_ = 0;

__device__ __forceinline__ int lane_id_asm() { int l; asm volatile("v_mbcnt_lo_u32_b32 %0, -1, 0\n\tv_mbcnt_hi_u32_b32 %0, -1, %0" : "=v"(l)); return l; }
__device__ __forceinline__ unsigned f2bf(float f) { unsigned u = __builtin_bit_cast(unsigned, f); return (u + 0x7fffu + ((u >> 16) & 1u)) >> 16; }
__device__ __forceinline__ unsigned pk2(float lo, float hi) { return f2bf(lo) | (f2bf(hi) << 16); }
__device__ __forceinline__ float bflo(unsigned w) { return __builtin_bit_cast(float, w << 16); }
__device__ __forceinline__ float bfhi(unsigned w) { return __builtin_bit_cast(float, w & 0xffff0000u); }
__device__ __forceinline__ float fast_sigmoid(float v) { return __builtin_amdgcn_rcpf(1.0f + __builtin_amdgcn_exp2f(-LOG2E * v)); }
__device__ __forceinline__ float wave_sum(float v) {
#pragma unroll
    for (int o = 1; o < 64; o <<= 1) v += __shfl_xor(v, o);
    return v;
}

#define XB_TMO      128
#define XB_XCNT(j)  (256  + 64 * (j))
#define XB_XSUB(j)  (1280 + 64 * (j))
#define XB_XGEN(j)  (2304 + 64 * (j))
#define XB_TOP      3328
#define XB_TOPGEN   3392
#define XCD_BAR_WORDS 3456
#define XB_SPIN_CAP (1u << 18)

__device__ __forceinline__ unsigned xb_ld(unsigned* p)              { return __hip_atomic_load(p, __ATOMIC_RELAXED, __HIP_MEMORY_SCOPE_AGENT); }
__device__ __forceinline__ unsigned xb_add(unsigned* p, unsigned v) { return __hip_atomic_fetch_add(p, v, __ATOMIC_RELAXED, __HIP_MEMORY_SCOPE_AGENT); }
__device__ __forceinline__ unsigned xb_xcc_id() { return (unsigned)__builtin_amdgcn_s_getreg((3 << 11) | 20) & 0xFu; }
#define XB_SPIN(cond, bar) do { unsigned _sp = 0; while (cond) { __builtin_amdgcn_s_sleep(1); \
    if ((++_sp & 255u) == 0u) { if (xb_ld(&(bar)[XB_TMO])) break; if (_sp > XB_SPIN_CAP) { atomicAdd(&(bar)[XB_TMO], 1u); break; } } } } while (0)

struct XcdBarrier {
    bool lead;
    unsigned* bar; unsigned x;
    volatile LAS unsigned* st;
};

__device__ __forceinline__ XcdBarrier xcd_barrier_post(unsigned* bar, volatile LAS unsigned* st, bool lead) {
    XcdBarrier b; b.bar = bar; b.x = xb_xcc_id(); b.st = st; b.lead = lead;
    if (lead) (void)xb_add(&bar[XB_XCNT(b.x)], 1u);
    return b;
}
__device__ __forceinline__ void xcd_barrier_complete(unsigned* bar, unsigned x, unsigned& nloc, unsigned& nx) {
    const unsigned G = gridDim.x * gridDim.y * gridDim.z;
    unsigned sum, cnt, mine, sp = 0u;
    for (;;) {
        sum = 0u; cnt = 0u; mine = 0u;
#pragma unroll
        for (unsigned j = 0; j < 16; ++j) { const unsigned c = xb_ld(&bar[XB_XCNT(j)]); sum += c; cnt += (c > 0u) ? 1u : 0u; mine = (j == x) ? c : mine; }
        if (sum == G) break;
        __builtin_amdgcn_s_sleep(1);
        if ((++sp & 255u) == 0u) { if (xb_ld(&bar[XB_TMO])) break; if (sp > XB_SPIN_CAP) { atomicAdd(&bar[XB_TMO], 1u); break; } }
    }
    nloc = mine > 0u ? mine : 1u; nx = cnt > 0u ? cnt : 1u;
}

__device__ __forceinline__ void xcd_barrier(const XcdBarrier& b) {
    asm volatile("s_waitcnt vmcnt(0)" ::: "memory");
    __syncthreads();
    if (b.lead) {
        unsigned* bar = b.bar;
        __builtin_amdgcn_s_waitcnt(0);
        unsigned nloc = b.st[0], nx = b.st[1];
        if (nloc == 0u) { xcd_barrier_complete(bar, b.x, nloc, nx); b.st[0] = nloc; b.st[1] = nx; }
        const unsigned old = xb_add(&bar[XB_XSUB(b.x)], 1u);
        const unsigned gen = old / nloc;
        if (old + 1u == (gen + 1u) * nloc) {
            __builtin_amdgcn_fence(__ATOMIC_RELEASE, "agent");
            asm volatile("s_waitcnt vmcnt(0)" ::: "memory");
            const unsigned og = xb_add(&bar[XB_TOP], 1u);
            const unsigned tg = og / nx;
            if (og + 1u == (tg + 1u) * nx) xb_add(&bar[XB_TOPGEN], 1u);
            else XB_SPIN(xb_ld(&bar[XB_TOPGEN]) == tg, bar);
            __builtin_amdgcn_fence(__ATOMIC_ACQUIRE, "agent");
            xb_add(&bar[XB_XGEN(b.x)], 1u);
            asm volatile("s_waitcnt vmcnt(0)" ::: "memory");
        } else {
            XB_SPIN(xb_ld(&bar[XB_XGEN(b.x)]) == gen, bar);
            __builtin_amdgcn_fence(__ATOMIC_ACQUIRE, "agent");
            asm volatile("s_waitcnt vmcnt(0)" ::: "memory");
        }
    }
    __syncthreads();
}

namespace pg8 {
constexpr int BM = 256, BK = 64, HALF = 128, HTB = HALF * BK * 2  , STAGE_BYTES = 8 * HTB, NXCD = 8, WGM = 8;
__host__ __device__ __forceinline__ int lds_byte(int r, int c) { const int st = (r >> 4) * 2 + (c >> 5), rr = r & 15, cc = c & 31, ob = rr * 64 + cc * 2; return st * 1024 + (ob ^ (((ob >> 9) & 1) << 5)); }
__host__ __device__ __forceinline__ void stage_rc(int b, int& R, int& C) { const int st = b / 1024, sb = b % 1024, swz = sb ^ (((sb >> 9) & 1) << 5); R = (st >> 1) * 16 + swz / 64; C = (st & 1) * 32 + (swz % 64) / 2; }
__host__ __device__ __forceinline__ int perm32(int rho) { const int n = rho >> 4, i = rho & 15; return 8 * (i >> 2) + 4 * n + (i & 3); }

struct Unit { int pm, pn, om, on, e, mt, slot; };
struct Gemm { const bf16_t* A; const bf16_t* Bt; int K; };

__device__ __forceinline__ int xcd_remap(int L, int nwg) { const int q = nwg / NXCD, r = nwg % NXCD, xcd = L % NXCD, off = L / NXCD; return (xcd < r ? xcd * (q + 1) : r * (q + 1) + (xcd - r) * q) + off; }

__device__ __forceinline__ void plain_a_off(int pm, int tid, int K, unsigned (&o)[2][2]) {
#pragma unroll
    for (int i = 0; i < 2; ++i) { int R, C; stage_rc(tid * 16 + i * 8192, R, C);
#pragma unroll
        for (int h = 0; h < 2; ++h) o[h][i] = (unsigned)((pm * BM + h * HALF + R) * K + C) * 2u; }
}
struct StaticOrder {
    int nM, nN, nwg, G, c;
    __device__ void init(int nM_, int nN_, int G_, int c_, int = 1) { nM = nM_; nN = nN_; nwg = nM * nN; G = G_; c = c_; }
    __device__ __forceinline__ bool tile(int i, int& pm, int& pn, int& q) const {
        const int L = i * G + c; if (L >= nwg) return false;
        q = 0xF; const int wgid = xcd_remap(L, nwg);
        const int nig = WGM * nN, gid = wgid / nig, fm = gid * WGM, gsz = (nM - fm) < WGM ? (nM - fm) : WGM;
        pm = fm + ((wgid % nig) % gsz); pn = (wgid % nig) / gsz; return true;
    }
    __device__ __forceinline__ bool next(int i, Unit& u) const { int pm, pn, q; if (!tile(i, pm, pn, q)) return false; u.pm = pm; u.pn = pn; u.om = pm; u.on = pn; u.e = 0; u.mt = 0; u.slot = 0; return true; }
    __device__ __forceinline__ void a_off(const Unit& u, int tid, int K, unsigned (&o)[2][2]) const { plain_a_off(u.pm, tid, K, o); }
};

__device__ __forceinline__ unsigned cvt_pk_bf16(float lo, float hi) { unsigned r; asm volatile("v_cvt_pk_bf16_f32 %0, %1, %2" : "=v"(r) : "v"(lo), "v"(hi)); return r; }

template <class Epi, class Sched, bool ALIGN_EPI, int DRY = 0, bool I8 = false>
__device__ __forceinline__ void gemm_phase(LAS unsigned char* lds, const Gemm g, const Sched& S, const Epi& E, int wvid) {
    int tid_ = (wvid * 64 + lane_id_asm()); asm volatile("" : "+v"(tid_));
    const int tid = tid_, wid = __builtin_amdgcn_readfirstlane(tid >> 6), lane = tid & 63, wr = wid >> 2, wc = wid & 3, fr = lane & 15, fq = lane >> 4;
    const int K = g.K, nt = K / BK;
    unsigned voffB[2];
#pragma unroll
    for (int i = 0; i < 2; ++i) { int R, C; stage_rc(tid * 16 + i * 8192, R, C); const int Rb = Epi::PERM ? ((R & ~31) + perm32(R & 31)) : R;
        voffB[i] = (unsigned)(Rb * K + C) * 2u; }
    constexpr unsigned kstep = BK * 2;
    const unsigned hstep = (unsigned)HALF * K * 2;
    const unsigned tstep = 2 * hstep;
    const unsigned ldsw = (unsigned)wid * 1024u;
    const int aoff = lds_byte(wr * 64 + fr, fq * 8), boff = lds_byte(wc * 32 + fr, fq * 8);
#define PG8_SA(b, h) (((b) * 2 + (h)) * HTB)
#define PG8_SB(b, h) ((4 + (b) * 2 + (h)) * HTB)
#define PG8_STAGE(bufoff, gbase, voff) do { _Pragma("unroll") for (int _i = 0; _i < 2; ++_i) \
        __builtin_amdgcn_global_load_lds((const unsigned*)((const char*)(gbase) + (voff)[_i]), (LAS unsigned*)(lds + (bufoff) + ldsw + _i * 8192), 16, 0, 0); } while (0)
#define PG8_LDA(dst, b, h) do { _Pragma("unroll") for (int m = 0; m < 4; ++m) _Pragma("unroll") for (int k = 0; k < 2; ++k) dst[m][k] = *(const LAS bf16x8*)(lds + PG8_SA(b, h) + aoff + m * 2048 + k * 1024); } while (0)
#define PG8_LDB(dst, b, h) do { _Pragma("unroll") for (int n = 0; n < 2; ++n) _Pragma("unroll") for (int k = 0; k < 2; ++k) dst[n][k] = *(const LAS bf16x8*)(lds + PG8_SB(b, h) + boff + n * 2048 + k * 1024); } while (0)
#define PG8_MMA(ai, bj, At, Bt) do { if constexpr (DRY == 1) { _Pragma("unroll") for (int m = 0; m < 4; ++m) _Pragma("unroll") for (int k = 0; k < 2; ++k) asm volatile("" :: "v"(At[m][k])); _Pragma("unroll") for (int n = 0; n < 2; ++n) _Pragma("unroll") for (int k = 0; k < 2; ++k) asm volatile("" :: "v"(Bt[n][k])); break; } __builtin_amdgcn_s_setprio(1); _Pragma("unroll") for (int m = 0; m < 4; ++m) _Pragma("unroll") for (int n = 0; n < 2; ++n) _Pragma("unroll") for (int k = 0; k < 2; ++k) \
        { if constexpr (I8) acc[ai][bj][m][n] = __builtin_bit_cast(AccT, __builtin_amdgcn_mfma_i32_16x16x64_i8(__builtin_bit_cast(i32x4, Bt[n][k]), __builtin_bit_cast(i32x4, At[m][k]), __builtin_bit_cast(i32x4, acc[ai][bj][m][n]), 0, 0, 0)); \
          else acc[ai][bj][m][n] = __builtin_bit_cast(AccT, __builtin_amdgcn_mfma_f32_16x16x32_bf16(Bt[n][k], At[m][k], __builtin_bit_cast(f32x4, acc[ai][bj][m][n]), 0, 0, 0)); } __builtin_amdgcn_s_setprio(0); } while (0)
#define PG8_WAIT_V(n) asm volatile("s_waitcnt vmcnt(" #n ")" ::: "memory")
#define PG8_WAIT_L(n) asm volatile("s_waitcnt lgkmcnt(" #n ")" ::: "memory")
#define PG8_BAR __builtin_amdgcn_s_barrier()
#define PG8_SCHED __builtin_amdgcn_sched_barrier(0)
    Unit cur, nxt; int ui = 0;
    if (!S.next(0, cur)) return;
    typedef typename Epi::AccT AccT;
    AccT acc[2][2][4][2];
#pragma unroll
    for (int a = 0; a < 2; ++a)
#pragma unroll
        for (int b = 0; b < 2; ++b)
#pragma unroll
            for (int m = 0; m < 4; ++m)
#pragma unroll
                for (int n = 0; n < 2; ++n) acc[a][b][m][n] = AccT{};
    bf16x8 At[4][2], B0[2][2], B1[2][2];
    unsigned aC[2][2];
    S.a_off(cur, tid, K, aC);
    const char* const Ab = (const char*)g.A;
    const char* cB = (const char*)g.Bt + (size_t)cur.pn * tstep;
    PG8_STAGE(PG8_SB(0, 0), cB, voffB); PG8_STAGE(PG8_SB(0, 1), cB + hstep, voffB); PG8_STAGE(PG8_SA(0, 0), Ab, aC[0]); PG8_STAGE(PG8_SA(0, 1), Ab, aC[1]);
    if (wr == 1) PG8_BAR;
    PG8_WAIT_V(2); PG8_BAR;
    PG8_STAGE(PG8_SB(1, 0), cB + kstep, voffB); PG8_STAGE(PG8_SA(1, 0), Ab + kstep, aC[0]); PG8_STAGE(PG8_SB(1, 1), cB + hstep + kstep, voffB);
    PG8_WAIT_V(6); PG8_BAR;
    for (;;) {
        const bool has_next = S.next(ui + 1, nxt);
        const char* nB = has_next ? (const char*)g.Bt + (size_t)nxt.pn * tstep : cB;
        for (int t = 0; t < nt; t += 2) {
            const bool last = (t == nt - 2);
            const char* a1 = Ab + (size_t)(t + 1) * kstep;
            const char* a2 = last ? Ab : Ab + (size_t)(t + 2) * kstep; const char* b2 = last ? nB : cB + (size_t)(t + 2) * kstep;
            const char* a3 = a2 + kstep; const char* b3 = b2 + kstep;
            PG8_LDB(B0, 0, 0); PG8_LDB(B1, 0, 1); PG8_SCHED; PG8_LDA(At, 0, 0); PG8_STAGE(PG8_SA(1, 1), a1, aC[1]);
            if (last && has_next) S.a_off(nxt, tid, K, aC);
            PG8_WAIT_V(8); PG8_WAIT_L(0); PG8_BAR; PG8_MMA(0, 0, At, B0); PG8_MMA(0, 1, At, B1); PG8_BAR; PG8_SCHED;
            PG8_LDA(At, 0, 1); PG8_STAGE(PG8_SB(0, 0), b2, voffB); PG8_STAGE(PG8_SB(0, 1), b2 + hstep, voffB); PG8_STAGE(PG8_SA(0, 0), a2, aC[0]);
            PG8_WAIT_V(8); PG8_WAIT_L(0); PG8_BAR; PG8_MMA(1, 0, At, B0); PG8_MMA(1, 1, At, B1); PG8_BAR; PG8_SCHED;
            PG8_LDB(B0, 1, 0); PG8_LDB(B1, 1, 1); PG8_SCHED; PG8_LDA(At, 1, 0); PG8_STAGE(PG8_SA(0, 1), a2, aC[1]);
            PG8_WAIT_V(8); PG8_WAIT_L(0); PG8_BAR; PG8_MMA(0, 0, At, B0); PG8_MMA(0, 1, At, B1); PG8_BAR; PG8_SCHED;
            PG8_LDA(At, 1, 1); PG8_STAGE(PG8_SB(1, 0), b3, voffB); PG8_STAGE(PG8_SB(1, 1), b3 + hstep, voffB); PG8_STAGE(PG8_SA(1, 0), a3, aC[0]);
            PG8_WAIT_V(8); PG8_WAIT_L(0); PG8_BAR; PG8_MMA(1, 0, At, B0); PG8_MMA(1, 1, At, B1); PG8_BAR; PG8_SCHED;
        }
        if constexpr (ALIGN_EPI) { if (wr == 0) PG8_BAR; }
        if constexpr (DRY == 0) E(acc, cur, wr, wc, fr, fq); else { _Pragma("unroll") for (int a = 0; a < 2; ++a) _Pragma("unroll") for (int b = 0; b < 2; ++b) _Pragma("unroll") for (int m = 0; m < 4; ++m) _Pragma("unroll") for (int n = 0; n < 2; ++n) asm volatile("" :: "v"(acc[a][b][m][n])); }
        if (!has_next) break;
#pragma unroll
        for (int a = 0; a < 2; ++a)
#pragma unroll
            for (int b = 0; b < 2; ++b)
#pragma unroll
                for (int m = 0; m < 4; ++m)
#pragma unroll
                    for (int n = 0; n < 2; ++n) acc[a][b][m][n] = AccT{};
        cur = nxt; cB = nB; ++ui;
        if constexpr (ALIGN_EPI) { if (wr == 1) PG8_BAR; }
    }
    PG8_WAIT_V(0);
    if constexpr (!ALIGN_EPI) { if (wr == 0) PG8_BAR; }
    PG8_BAR;
#undef PG8_SA
#undef PG8_SB
#undef PG8_STAGE
#undef PG8_LDA
#undef PG8_LDB
#undef PG8_MMA
#undef PG8_WAIT_V
#undef PG8_WAIT_L
#undef PG8_BAR
#undef PG8_SCHED
}
}
namespace pg8 {
typedef const f32x4 (&AccRef)[2][2][4][2];
typedef const i32x4 (&AccRefI)[2][2][4][2];
__device__ __forceinline__ f32x4 i2f(const i32x4 v) { return (f32x4){(float)v[0], (float)v[1], (float)v[2], (float)v[3]}; }

struct EpiInProj {
    static constexpr bool PERM = true; typedef f32x4 AccT;
    unsigned char* ws;
    __device__ __forceinline__ void operator()(AccRef acc, const Unit& u, int wr, int wc, int fr, int fq) const {
        const int pn = u.on, row0 = u.om * BM + wr * 64 + fr, cw = wc * 32 + 8 * fq;
        if (pn >= 4 && pn < 12) {
#pragma unroll
            for (int ai = 0; ai < 2; ++ai)
#pragma unroll
                for (int m = 0; m < 4; ++m) { const f32x4 v0 = acc[ai][0][m][0] * acc[ai][1][m][0], v1 = acc[ai][0][m][1] * acc[ai][1][m][1];
                    u32x4 w; w.x = cvt_pk_bf16(v0[0], v0[1]); w.y = cvt_pk_bf16(v0[2], v0[3]); w.z = cvt_pk_bf16(v1[0], v1[1]); w.w = cvt_pk_bf16(v1[2], v1[3]);
                    *(u32x4*)((bf16_t*)(ws + WS_U) + (size_t)(row0 + ai * HALF + m * 16) * D + (pn - 4) * 128 + cw) = w; }
            return;
        }
        size_t doff; int ldc = D, cb, mode = 0;
        if (pn < 4) { doff = WS_BG; cb = pn * 256; }
        else if (pn < 16) { doff = WS_Q; cb = (pn - 12) * 256; mode = 1; }
        else if (pn == 16) { doff = WS_K; cb = 0; ldc = 256; }
        else if (pn == 17) { doff = WS_V; cb = 0; ldc = 256; }
        else if (pn < 22) { doff = WS_GC; cb = (pn - 18) * 256; mode = 2; }
        else { doff = WS_GA; cb = (pn - 22) * 256; mode = 2; }
        bf16_t* dst = (bf16_t*)(ws + doff);
#pragma unroll
        for (int ai = 0; ai < 2; ++ai)
#pragma unroll
            for (int m = 0; m < 4; ++m) { bf16_t* rowp = dst + (size_t)(row0 + ai * HALF + m * 16) * ldc + cb + cw;
#pragma unroll
                for (int bj = 0; bj < 2; ++bj) { f32x4 v0 = acc[ai][bj][m][0], v1 = acc[ai][bj][m][1];
                    if (mode == 1) { v0 = v0 * QSCALE; v1 = v1 * QSCALE; }
                    if (mode == 2) {
#pragma unroll
                        for (int j = 0; j < 4; ++j) { v0[j] = fast_sigmoid(v0[j]); v1[j] = fast_sigmoid(v1[j]); } }
                    u32x4 w; w.x = cvt_pk_bf16(v0[0], v0[1]); w.y = cvt_pk_bf16(v0[2], v0[3]); w.z = cvt_pk_bf16(v1[0], v1[1]); w.w = cvt_pk_bf16(v1[2], v1[3]);
                    *(u32x4*)(rowp + bj * HALF) = w; } }
    }
};

struct EpiInProjI8 {
    static constexpr bool PERM = true; typedef i32x4 AccT;
    unsigned char* ws; float sw;
    __device__ __forceinline__ void operator()(AccRefI acc, const Unit& u, int wr, int wc, int fr, int fq) const {
        const int pn = u.on, row0 = u.om * BM + wr * 64 + fr, cw = wc * 32 + 8 * fq;
        const float* sx0 = (const float*)(ws + WS_SX0) + row0;
        if (pn >= 4 && pn < 12) {
#pragma unroll
            for (int ai = 0; ai < 2; ++ai)
#pragma unroll
                for (int m = 0; m < 4; ++m) { const float s = sx0[ai * HALF + m * 16] * sw, s2 = s * s;
                    const f32x4 v0 = i2f(acc[ai][0][m][0]) * i2f(acc[ai][1][m][0]) * s2, v1 = i2f(acc[ai][0][m][1]) * i2f(acc[ai][1][m][1]) * s2;
                    u32x4 w; w.x = cvt_pk_bf16(v0[0], v0[1]); w.y = cvt_pk_bf16(v0[2], v0[3]); w.z = cvt_pk_bf16(v1[0], v1[1]); w.w = cvt_pk_bf16(v1[2], v1[3]);
                    *(u32x4*)((bf16_t*)(ws + WS_U) + (size_t)(row0 + ai * HALF + m * 16) * D + (pn - 4) * 128 + cw) = w; asm volatile("" ::: "memory"); }
            return;
        }
        size_t doff; int ldc = D, cb, mode = 0;
        if (pn < 4) { doff = WS_BG; cb = pn * 256; }
        else if (pn < 16) { doff = WS_Q; cb = (pn - 12) * 256; mode = 1; }
        else if (pn == 16) { doff = WS_K; cb = 0; ldc = 256; }
        else if (pn == 17) { doff = WS_V; cb = 0; ldc = 256; }
        else if (pn < 22) { doff = WS_GC; cb = (pn - 18) * 256; mode = 2; }
        else { doff = WS_GA; cb = (pn - 22) * 256; mode = 2; }
        bf16_t* dst = (bf16_t*)(ws + doff);
#pragma unroll
        for (int ai = 0; ai < 2; ++ai)
#pragma unroll
            for (int m = 0; m < 4; ++m) { bf16_t* rowp = dst + (size_t)(row0 + ai * HALF + m * 16) * ldc + cb + cw; const float s = sx0[ai * HALF + m * 16] * sw * (mode == 1 ? QSCALE : 1.0f);
#pragma unroll
                for (int bj = 0; bj < 2; ++bj) { f32x4 v0 = i2f(acc[ai][bj][m][0]) * s, v1 = i2f(acc[ai][bj][m][1]) * s;
                    if (mode == 2) {
#pragma unroll
                        for (int j = 0; j < 4; ++j) { v0[j] = fast_sigmoid(v0[j]); v1[j] = fast_sigmoid(v1[j]); } }
                    u32x4 w; w.x = cvt_pk_bf16(v0[0], v0[1]); w.y = cvt_pk_bf16(v0[2], v0[3]); w.z = cvt_pk_bf16(v1[0], v1[1]); w.w = cvt_pk_bf16(v1[2], v1[3]);
                    *(u32x4*)(rowp + bj * HALF) = w; }
                asm volatile("" ::: "memory"); }
    }
};

struct EpiDual {
    static constexpr bool PERM = true; typedef f32x4 AccT;
    unsigned char* ws;
    __device__ __forceinline__ void operator()(AccRef acc, const Unit& u, int wr, int wc, int fr, int fq) const {
        const int row0 = u.om * BM + wr * 64 + fr, col0 = u.on * BM + wc * 32 + 8 * fq;
        const bf16_t* G = (const bf16_t*)(ws + (u.e == 0 ? WS_GC : WS_GA)); bf16_t* T1 = (bf16_t*)(ws + WS_T1); bf16_t* MG = (bf16_t*)(ws + WS_MG);
#pragma unroll
        for (int ai = 0; ai < 2; ++ai)
#pragma unroll
            for (int m = 0; m < 4; ++m) { const size_t ro = (size_t)(row0 + ai * HALF + m * 16) * D + col0;
#pragma unroll
                for (int bj = 0; bj < 2; ++bj) { const size_t o = ro + bj * HALF;
                    const u32x4 gw = *(const u32x4*)(G + o);
                    f32x4 g0 = {bflo(gw.x), bfhi(gw.x), bflo(gw.y), bfhi(gw.y)}, g1 = {bflo(gw.z), bfhi(gw.z), bflo(gw.w), bfhi(gw.w)};
                    f32x4 v0 = g0 * acc[ai][bj][m][0], v1 = g1 * acc[ai][bj][m][1];
                    if (u.e == 0) { u32x4 w; w.x = cvt_pk_bf16(v0[0], v0[1]); w.y = cvt_pk_bf16(v0[2], v0[3]); w.z = cvt_pk_bf16(v1[0], v1[1]); w.w = cvt_pk_bf16(v1[2], v1[3]); *(u32x4*)(T1 + o) = w; }
                    else { const u32x4 tw_ = *(const u32x4*)(T1 + o);
                        v0 = v0 + (f32x4){bflo(tw_.x), bfhi(tw_.x), bflo(tw_.y), bfhi(tw_.y)}; v1 = v1 + (f32x4){bflo(tw_.z), bfhi(tw_.z), bflo(tw_.w), bfhi(tw_.w)};
                        u32x4 w; w.x = cvt_pk_bf16(v0[0], v0[1]); w.y = cvt_pk_bf16(v0[2], v0[3]); w.z = cvt_pk_bf16(v1[0], v1[1]); w.w = cvt_pk_bf16(v1[2], v1[3]);
                        *(u32x4*)(MG + o) = w; } } }
    }
};

struct EpiResid {
    static constexpr bool PERM = false; typedef f32x4 AccT;
    const float* X; float* C;
    __device__ __forceinline__ void operator()(AccRef acc, const Unit& u, int wr, int wc, int fr, int fq) const {
        const int row0 = u.om * BM + wr * 64 + fr, col0 = u.on * BM + wc * 32 + 4 * fq;
#pragma unroll
        for (int ai = 0; ai < 2; ++ai)
#pragma unroll
            for (int m = 0; m < 4; ++m) { const size_t ro = (size_t)(row0 + ai * HALF + m * 16) * D + col0;
#pragma unroll
                for (int bj = 0; bj < 2; ++bj)
#pragma unroll
                    for (int n = 0; n < 2; ++n) { const size_t o = ro + bj * HALF + n * 16; *(f32x4*)(C + o) = *(const f32x4*)(X + o) * DN_ALPHA + acc[ai][bj][m][n]; } }
    }
};

struct EpiF32 {
    static constexpr bool PERM = false; typedef f32x4 AccT;
    float* C;
    __device__ __forceinline__ void operator()(AccRef acc, const Unit& u, int wr, int wc, int fr, int fq) const {
        const int row0 = u.om * BM + wr * 64 + fr, col0 = u.on * BM + wc * 32 + 4 * fq;
#pragma unroll
        for (int ai = 0; ai < 2; ++ai)
#pragma unroll
            for (int m = 0; m < 4; ++m) { const size_t ro = (size_t)(row0 + ai * HALF + m * 16) * D + col0;
#pragma unroll
                for (int bj = 0; bj < 2; ++bj)
#pragma unroll
                    for (int n = 0; n < 2; ++n) *(f32x4*)(C + ro + bj * HALF + n * 16) = acc[ai][bj][m][n]; }
    }
};
__device__ __forceinline__ void ple_epilogue(AccRef acc, const Unit& u, int wr, int wc, int fr, int fq, const float* P2, bf16_t* PLE) {
    const int row0 = u.om * BM + wr * 64 + fr, col0 = u.on * BM + wc * 32 + 8 * fq;
#pragma unroll
    for (int ai = 0; ai < 2; ++ai)
#pragma unroll
        for (int m = 0; m < 4; ++m) { const size_t ro = (size_t)(row0 + ai * HALF + m * 16) * D + col0;
#pragma unroll
            for (int bj = 0; bj < 2; ++bj) { const size_t o = ro + bj * HALF; const f32x4 p0 = *(const f32x4*)(P2 + o), p1 = *(const f32x4*)(P2 + o + 4); const f32x4 a0 = acc[ai][bj][m][0], a1 = acc[ai][bj][m][1];
                u32x4 w; w.x = cvt_pk_bf16(fast_sigmoid(a0[0]) * p0[0], fast_sigmoid(a0[1]) * p0[1]); w.y = cvt_pk_bf16(fast_sigmoid(a0[2]) * p0[2], fast_sigmoid(a0[3]) * p0[3]);
                w.z = cvt_pk_bf16(fast_sigmoid(a1[0]) * p1[0], fast_sigmoid(a1[1]) * p1[1]); w.w = cvt_pk_bf16(fast_sigmoid(a1[2]) * p1[2], fast_sigmoid(a1[3]) * p1[3]);
                *(u32x4*)(PLE + o) = w; }
            if (m & 1) asm volatile("" ::: "memory"); }
}

struct EpiSwiglu {
    static constexpr bool PERM = true; typedef f32x4 AccT;
    bf16_t* H; const float* b_gu; const LAS unsigned* tw; unsigned char* ws;
    __device__ __forceinline__ void operator()(AccRef acc, const Unit& u, int wr, int wc, int fr, int fq) const {
        if (u.e < 0) { ple_epilogue(acc, u, wr, wc, fr, fq, (const float*)(ws + WS_P2), (bf16_t*)(ws + WS_PLE)); return; }
        const int trow0 = wr * 64 + fr, row0 = u.om * BM + trow0, cw = wc * 32 + 8 * fq, col0 = u.on * 128 + cw;
        const float* bg = b_gu + (size_t)u.e * 2048 + col0;
#pragma unroll
        for (int n = 0; n < 2; ++n) { const f32x4 bgn = *(const f32x4*)(bg + 4 * n), bun = *(const f32x4*)(bg + 1024 + 4 * n);
#pragma unroll
            for (int ai = 0; ai < 2; ++ai)
#pragma unroll
                for (int m = 0; m < 4; ++m) { const float w = bfhi(tw[u.slot * BM + trow0 + ai * HALF + m * 16]);
                    const f32x4 gt = acc[ai][0][m][n] + bgn, up = acc[ai][1][m][n] + bun; f32x4 hv;
#pragma unroll
                    for (int j = 0; j < 4; ++j) { const float gv = fminf(gt[j], 7.0f), uv = fminf(fmaxf(up[j], -7.0f), 7.0f); hv[j] = (uv + 1.0f) * gv * fast_sigmoid(1.702f * gv) * w; }
                    u32x2 o; o.x = cvt_pk_bf16(hv[0], hv[1]); o.y = cvt_pk_bf16(hv[2], hv[3]);
                    *(u32x2*)(H + (size_t)(row0 + ai * HALF + m * 16) * D + col0 + 4 * n) = o; } }
    }
};
struct EpiSwigluI8 {
    static constexpr bool PERM = true; typedef i32x4 AccT;
    bf16_t* H; const float* b_gu; const LAS unsigned* tw; unsigned char* ws;
    __device__ __forceinline__ void operator()(AccRefI acc, const Unit& u, int wr, int wc, int fr, int fq) const {
        const int trow0 = wr * 64 + fr, row0 = u.om * BM + trow0, cw = wc * 32 + 8 * fq;
        const float* scl = (const float*)(ws + WS_SCL);
        if (u.e < 0) {
            const float* P2 = (const float*)(ws + WS_P2); bf16_t* PLE = (bf16_t*)(ws + WS_PLE); const float* sx1 = (const float*)(ws + WS_SX1);
            const float spg = scl[NE]; const int col0 = u.on * BM + cw;
#pragma unroll
            for (int ai = 0; ai < 2; ++ai)
#pragma unroll
                for (int m = 0; m < 4; ++m) { const int r = row0 + ai * HALF + m * 16; const float s = sx1[r] * spg; const size_t ro = (size_t)r * D + col0;
#pragma unroll
                    for (int bj = 0; bj < 2; ++bj) { const size_t o = ro + bj * HALF; const f32x4 p0 = *(const f32x4*)(P2 + o), p1 = *(const f32x4*)(P2 + o + 4); const f32x4 a0 = i2f(acc[ai][bj][m][0]) * s, a1 = i2f(acc[ai][bj][m][1]) * s;
                        u32x4 w; w.x = cvt_pk_bf16(fast_sigmoid(a0[0]) * p0[0], fast_sigmoid(a0[1]) * p0[1]); w.y = cvt_pk_bf16(fast_sigmoid(a0[2]) * p0[2], fast_sigmoid(a0[3]) * p0[3]);
                        w.z = cvt_pk_bf16(fast_sigmoid(a1[0]) * p1[0], fast_sigmoid(a1[1]) * p1[1]); w.w = cvt_pk_bf16(fast_sigmoid(a1[2]) * p1[2], fast_sigmoid(a1[3]) * p1[3]);
                        *(u32x4*)(PLE + o) = w; }
                    if (m & 1) asm volatile("" ::: "memory"); }
            return; }
        const int col0 = u.on * 128 + cw;
        const float* bg = b_gu + (size_t)u.e * 2048 + col0; const float sg = scl[u.e];
        const float* lsx = (const float*)(ws + WS_LSX) + (size_t)u.e * LISTCAP + u.mt * BM + trow0;
        const f32x4 bg0 = *(const f32x4*)(bg), bg1 = *(const f32x4*)(bg + 4), bu0 = *(const f32x4*)(bg + 1024), bu1 = *(const f32x4*)(bg + 1028);
        unsigned char* H8 = (unsigned char*)H;
#pragma unroll
        for (int ai = 0; ai < 2; ++ai)
#pragma unroll
            for (int m = 0; m < 4; ++m) { const unsigned twv = tw[u.slot * BM + trow0 + ai * HALF + m * 16]; const float qh = bfhi(twv);
                const float s = (qh != 0.f ? lsx[ai * HALF + m * 16] : 0.f) * sg;
                unsigned q8[2];
#pragma unroll
                for (int n = 0; n < 2; ++n) { const f32x4 gt = i2f(acc[ai][0][m][n]) * s + (n == 0 ? bg0 : bg1), up = i2f(acc[ai][1][m][n]) * s + (n == 0 ? bu0 : bu1); unsigned q = 0u;
#pragma unroll
                    for (int j = 0; j < 4; ++j) { const float gv = fminf(gt[j], 7.0f), uv = fminf(fmaxf(up[j], -7.0f), 7.0f); const float hq = (uv + 1.0f) * gv * fast_sigmoid(1.702f * gv) * qh;
                        q |= ((unsigned)(int)fminf(fmaxf(rintf(hq), -127.f), 127.f) & 0xffu) << (8 * j); }
                    q8[n] = q; }
                *(u32x2*)(H8 + (size_t)(row0 + ai * HALF + m * 16) * D + col0) = (u32x2){q8[0], q8[1]};
                if (m & 1) asm volatile("" ::: "memory"); }
    }
};
struct EpiDownI8 {
    static constexpr bool PERM = true; typedef i32x4 AccT;
    bf16_t* Y; unsigned char* ws; const LAS int* cntL;
    __device__ __forceinline__ void operator()(AccRefI acc, const Unit& u, int wr, int wc, int fr, int fq) const {
        const int trow0 = wr * 64 + fr, row0 = u.om * BM + trow0, cw = wc * 32 + 8 * fq;
        const float* scl = (const float*)(ws + WS_SCL);
        if (u.e < 0) {
            const float* P2 = (const float*)(ws + WS_P2); bf16_t* PLE = (bf16_t*)(ws + WS_PLE); const float* sx1 = (const float*)(ws + WS_SX1);
            const float spg = scl[NE]; const int col0 = u.on * BM + cw;
#pragma unroll
            for (int ai = 0; ai < 2; ++ai)
#pragma unroll
                for (int m = 0; m < 4; ++m) { const int r = row0 + ai * HALF + m * 16; const float s = sx1[r] * spg; const size_t ro = (size_t)r * D + col0;
#pragma unroll
                    for (int bj = 0; bj < 2; ++bj) { const size_t o = ro + bj * HALF; const f32x4 p0 = *(const f32x4*)(P2 + o), p1 = *(const f32x4*)(P2 + o + 4); const f32x4 a0 = i2f(acc[ai][bj][m][0]) * s, a1 = i2f(acc[ai][bj][m][1]) * s;
                        u32x4 w; w.x = cvt_pk_bf16(fast_sigmoid(a0[0]) * p0[0], fast_sigmoid(a0[1]) * p0[1]); w.y = cvt_pk_bf16(fast_sigmoid(a0[2]) * p0[2], fast_sigmoid(a0[3]) * p0[3]);
                        w.z = cvt_pk_bf16(fast_sigmoid(a1[0]) * p1[0], fast_sigmoid(a1[1]) * p1[1]); w.w = cvt_pk_bf16(fast_sigmoid(a1[2]) * p1[2], fast_sigmoid(a1[3]) * p1[3]);
                        *(u32x4*)(PLE + o) = w; }
                    if (m & 1) asm volatile("" ::: "memory"); }
            return; }
        const float sd = scl[128 + u.e]; const int cnt = cntL[u.e], li0 = u.mt * BM + trow0;
        const float* lhs = (const float*)(ws + WS_LHS) + (size_t)u.e * LISTCAP + li0;
        bf16_t* yp = Y + (size_t)row0 * D + u.on * BM + cw;
#pragma unroll
        for (int ai = 0; ai < 2; ++ai)
#pragma unroll
            for (int m = 0; m < 4; ++m) { const int dr = ai * HALF + m * 16; const float s = ((li0 + dr) < cnt ? lhs[dr] : 0.f) * sd;
#pragma unroll
                for (int bj = 0; bj < 2; ++bj) { const f32x4 v0 = i2f(acc[ai][bj][m][0]) * s, v1 = i2f(acc[ai][bj][m][1]) * s;
                    u32x4 o; o.x = cvt_pk_bf16(v0[0], v0[1]); o.y = cvt_pk_bf16(v0[2], v0[3]); o.z = cvt_pk_bf16(v1[0], v1[1]); o.w = cvt_pk_bf16(v1[2], v1[3]);
                    *(u32x4*)(yp + (size_t)dr * D + bj * HALF) = o; }
                if (m & 1) asm volatile("" ::: "memory"); }
    }
};
struct EpiDown {
    static constexpr bool PERM = true; typedef f32x4 AccT;
    bf16_t* Y; unsigned char* ws;
    __device__ __forceinline__ void operator()(AccRef acc, const Unit& u, int wr, int wc, int fr, int fq) const {
        if (u.e < 0) { ple_epilogue(acc, u, wr, wc, fr, fq, (const float*)(ws + WS_P2), (bf16_t*)(ws + WS_PLE)); return; }
        bf16_t* yp = Y + (size_t)(u.om * BM + wr * 64 + fr) * D + u.on * BM + wc * 32 + 8 * fq;
#pragma unroll
        for (int ai = 0; ai < 2; ++ai)
#pragma unroll
            for (int m = 0; m < 4; ++m)
#pragma unroll
                for (int bj = 0; bj < 2; ++bj) { const f32x4 v0 = acc[ai][bj][m][0], v1 = acc[ai][bj][m][1];
                    u32x4 o; o.x = cvt_pk_bf16(v0[0], v0[1]); o.y = cvt_pk_bf16(v0[2], v0[3]); o.z = cvt_pk_bf16(v1[0], v1[1]); o.w = cvt_pk_bf16(v1[2], v1[3]);
                    *(u32x4*)(yp + (size_t)(ai * HALF + m * 16) * D + bj * HALF) = o; }
    }
};

struct DualOrder {
    StaticOrder so;
    __device__ __forceinline__ bool next(int i, Unit& u) const {
        int pm, pn, q; if (!so.tile(i >> 1, pm, pn, q)) return false;
        const int e = i & 1; u.pm = e * (M / BM) + pm; u.pn = e * 4 + pn; u.om = pm; u.on = pn; u.e = e; u.mt = 0; u.slot = 0; return true;
    }
    __device__ __forceinline__ void a_off(const Unit& u, int tid, int K, unsigned (&o)[2][2]) const { plain_a_off(u.pm, tid, K, o); }
};
struct MoeOrder {
    const LAS int* cntL; const LAS int* tsL; const LAS unsigned* tw; int NT, gather, btile0, btile_ple, n_extra, extra_first; unsigned abase, abase_ple; int U, UT, G, c; const LAS int* utab; int nunits;
    __device__ __forceinline__ void init(const LAS int* cntL_, const LAS int* tsL_, const LAS unsigned* tw_, int NT_, int G_, int c_, int gather_, size_t aoff_, size_t boff_, int n_extra_, int extra_first_, size_t aoff_ple_, size_t boff_ple_, int tshift_) {
        cntL = cntL_; tsL = tsL_; tw = tw_; NT = NT_; gather = gather_; abase = (unsigned)aoff_; btile0 = (int)(boff_ >> tshift_); abase_ple = (unsigned)aoff_ple_; btile_ple = (int)(boff_ple_ >> tshift_); n_extra = n_extra_; extra_first = extra_first_;
        U = __builtin_amdgcn_readfirstlane(tsL_[NE]) * NT_; UT = U + n_extra_; G = G_; c = c_; utab = nullptr; nunits = 0; }
    struct Own { int ok, maxT, maxC, totalFree; };
    __device__ __forceinline__ Own own_params(int split) const {
        Own o; int mx = 0, sumT = 0;
        for (int e = 0; e < NE; ++e) { const int T = tsL[e + 1] - tsL[e]; mx = T > mx ? T : mx; sumT += T; }
        o.maxT = mx; o.maxC = split == 1 ? mx : (mx + 1) >> 1; o.ok = 0;
        o.totalFree = split == 1 ? 8 * (NE * o.maxC - sumT) : 4 * (2 * NE * o.maxC - sumT);
        return o;
    }
    __device__ __forceinline__ static int ple_in_p5(const LAS int* tsL_, int G_) {
        int mx = 0, sumT = 0;
        for (int e = 0; e < NE; ++e) { const int T = tsL_[e + 1] - tsL_[e]; mx = T > mx ? T : mx; sumT += T; }
        int nfree;
        { const int U5 = sumT * 8; nfree = (G_ - U5 % G_) % G_; }
        return nfree < 256 ? nfree : 256;
    }
    __device__ __forceinline__ void build_units(LAS int* tab, int maxu, int tid, int p, int split) {
        const Own o = own_params(split);
        if (o.ok) {
            const int e = p >> 3, sub = p & 7, nt = split == 1 ? sub : sub >> 1, half = split == 1 ? 0 : sub & 1;
            const int t0 = tsL[e], T = tsL[e + 1] - t0, h0 = (T + 1) >> 1;
            const int myc = split == 1 ? T : (half ? T - h0 : h0), mt0 = (split == 2 && half) ? h0 : 0, myfree = o.maxC - myc;
            int prefix = 0;
            for (int k = 0; k < e; ++k) { const int Tk = tsL[k + 1] - tsL[k]; prefix += split == 1 ? 8 * (o.maxC - Tk) : 4 * (2 * o.maxC - Tk); }
            prefix += split == 1 ? sub * (o.maxC - T) : (sub >> 1) * (2 * o.maxC - T) + (half ? (o.maxC - h0) : 0);
            int nfill = n_extra - prefix; nfill = nfill < 0 ? 0 : (nfill > myfree ? myfree : nfill);
            int nover = 0; if (n_extra > o.totalFree) { const int rem = n_extra - o.totalFree - p; nover = rem > 0 ? (rem + 255) >> 8 : 0; }
            int n = myc + nfill + nover; if (n > maxu) n = maxu;
            if (tid < n) { LAS int* q = tab + 8 * tid;
                if (tid < myc) { const int mt = mt0 + tid; q[0] = t0 + mt; q[1] = btile0 + e * NT + nt; q[2] = nt; q[3] = e; q[4] = mt; }
                else { const int k = tid - myc; const int idx = k < nfill ? prefix + k : o.totalFree + (k - nfill) * 256 + p;
                    const int j = extra_first + idx, pm = (j >> 5) * 8 + (j & 7), pn = (j & 31) >> 3; q[0] = pm; q[1] = btile_ple + pn; q[2] = pn; q[3] = -1; q[4] = 0; } }
            __syncthreads();
            utab = tab; nunits = n; return;
        }
        if (tid < maxu) { const int L = tid * G + c;
            if (L < UT) { LAS int* q = tab + 8 * tid;
                if (L >= U) { const int j = extra_first + (L - U), pm = (j >> 5) * 8 + (j & 7), pn = (j & 31) >> 3; q[0] = pm; q[1] = btile_ple + pn; q[2] = pn; q[3] = -1; q[4] = 0; }
                else { const int wgid = xcd_remap(L, U); int e = 0;
                    for (int k = 1; k < NE; ++k) e += (wgid >= tsL[k] * NT) ? 1 : 0;
                    const int t0 = tsL[e], ntl = tsL[e + 1] - t0, r = wgid - t0 * NT, nt = r / ntl, mt = r - nt * ntl;
                    q[0] = t0 + mt; q[1] = btile0 + e * NT + nt; q[2] = nt; q[3] = e; q[4] = mt; } } }
        __syncthreads();
        utab = tab; nunits = c < UT ? (UT - 1 - c) / G + 1 : 0; if (nunits > maxu) nunits = maxu;
    }
    __device__ __forceinline__ bool next(int i, Unit& u) const {
        if (i >= nunits) return false;
        const LAS int* p = utab + 8 * i;
        u.pm = __builtin_amdgcn_readfirstlane(p[0]); u.pn = __builtin_amdgcn_readfirstlane(p[1]); u.om = u.pm; u.on = __builtin_amdgcn_readfirstlane(p[2]);
        u.e = __builtin_amdgcn_readfirstlane(p[3]); u.mt = __builtin_amdgcn_readfirstlane(p[4]); u.slot = i; return true;
    }
    __device__ __forceinline__ void a_off(const Unit& u, int tid, int K, unsigned (&o)[2][2]) const {
        if (u.e < 0 || !gather) { plain_a_off(u.pm, tid, K, o); const unsigned base = u.e < 0 ? abase_ple : abase;
#pragma unroll
            for (int h = 0; h < 2; ++h)
#pragma unroll
                for (int i = 0; i < 2; ++i) o[h][i] += base;
            return; }
#pragma unroll
        for (int i = 0; i < 2; ++i) { int R, C; stage_rc(tid * 16 + i * 8192, R, C);
#pragma unroll
            for (int h = 0; h < 2; ++h) { const int tok = (int)(tw[u.slot * BM + h * HALF + R] & 0xffffu);
                o[h][i] = (unsigned)(tok * K + C) * 2u + abase; } }
    }
};
constexpr int MOE_MAXU = 10;
__device__ __forceinline__ void moe_preload(const MoeOrder& S, const LAS int* cntL, const int* list_tok, const float* list_w, LAS unsigned* tw, int wvid) {
    int tid_ = (wvid * 64 + lane_id_asm()); asm volatile("" : "+v"(tid_)); const int tid = tid_;
    int tokv[MOE_MAXU / 2]; float wv[MOE_MAXU / 2];
#pragma unroll
    for (int k = 0; k < MOE_MAXU / 2; ++k) { const int ent = tid + NTHREADS * k, slot = ent >> 8, row = ent & 255; tokv[k] = 0; wv[k] = 0.f;
        if (slot < S.nunits) { const LAS int* p = S.utab + 8 * slot; const int e = p[3], mt = p[4], li = mt * BM + row;
            if (e >= 0 && li < cntL[e]) { tokv[k] = list_tok[(size_t)e * LISTCAP + li]; wv[k] = list_w[(size_t)e * LISTCAP + li]; } } }
#pragma unroll
    for (int k = 0; k < MOE_MAXU / 2; ++k) { const int ent = tid + NTHREADS * k; if ((ent >> 8) < S.nunits) tw[ent] = (unsigned)tokv[k] | (f2bf(wv[k]) << 16); }
    __syncthreads();
}
struct Ple1Order {
    int first, n;
    __device__ __forceinline__ bool next(int i, Unit& u) const { if (i >= n) return false; const int j = first + i, pm = (j >> 5) * 8 + (j & 7), pn = (j & 31) >> 3;
        u.pm = pm; u.pn = pn; u.om = pm; u.on = pn; u.e = 0; u.mt = 0; u.slot = 0; return true; }
    __device__ __forceinline__ void a_off(const Unit& u, int tid, int K, unsigned (&o)[2][2]) const { plain_a_off(u.pm, tid, K, o); }
};
}
__device__ __forceinline__ int dst_row(int n, int map) {
    if (map == 1) { if (n >= 1024 && n < 3072) { const int hsel = n >= 2048, c = n - 1024 - hsel * 1024; return 1024 + (c >> 7) * 256 + hsel * 128 + (c & 127); } return n; }
    if (map == 2) { const int hsel = n >= 1024, c = n - hsel * 1024; return (c >> 7) * 256 + hsel * 128 + (c & 127); }
    return n;
}
struct P0Args { const float *x, *p, *w_in, *w_brc, *w_bra, *w_out, *w_pg, *w_pp, *w_gu, *w_dn; unsigned char* ws; float s_in; };
struct P0Item { const float* src; bf16_t* dst; int K, N; float qinv; };
constexpr int P0_I_IN = 16 * (NIN / 64), P0_I_SQ = 16 * 16, P0_I_PP = 4 * 16, P0_I_GU = 16 * 32, P0_I_DN = 16 * 16;
constexpr int P0_NSMALL = P0_I_IN + 3 * P0_I_SQ + P0_I_PP;
constexpr int P0_NITEMS = P0_I_IN + 4 * P0_I_SQ + P0_I_PP + NE * P0_I_GU + NE * P0_I_DN;
__device__ __forceinline__ P0Item p0_decode(const P0Args& a, int it) {
    const float* W; bf16_t* WT; int K = D, N = D, map = 0, r = it; float qinv = 0.f; const float* scl = (const float*)(a.ws + WS_SCL);
    if (r < P0_I_IN) { W = a.w_in; WT = (bf16_t*)(a.ws + WS_WIN); N = NIN; map = 1; qinv = 1.0f / a.s_in; }
    else if ((r -= P0_I_IN) < P0_I_SQ) { W = a.w_brc; WT = (bf16_t*)(a.ws + WS_WBR); }
    else if ((r -= P0_I_SQ) < P0_I_SQ) { W = a.w_bra; WT = (bf16_t*)(a.ws + WS_WBR) + (size_t)D * D; }
    else if ((r -= P0_I_SQ) < P0_I_SQ) { W = a.w_out; WT = (bf16_t*)(a.ws + WS_WOUT); }
    else if ((r -= P0_I_SQ) < P0_I_PP) { W = a.w_pp; WT = (bf16_t*)(a.ws + WS_WPP); K = DPLE; }
    else if ((r -= P0_I_PP) < P0_I_SQ) { W = a.w_pg; WT = (bf16_t*)(a.ws + WS_WPG8); qinv = 1.0f / scl[NE]; }
    else if ((r -= P0_I_SQ) < NE * P0_I_GU) { const int e = r / P0_I_GU; r -= e * P0_I_GU; W = a.w_gu + (size_t)e * D * 2048; WT = (bf16_t*)(a.ws + WS_WGU + (size_t)e * 2048 * D); N = 2048; map = 2; qinv = 1.0f / scl[e]; }
    else { r -= NE * P0_I_GU; const int e = r / P0_I_DN; r -= e * P0_I_DN; W = a.w_dn + (size_t)e * D * D; WT = (bf16_t*)(a.ws + WS_WDN + (size_t)e * D * D); qinv = 1.0f / scl[128 + e]; }
    const int nblk = N / 64, kb = r / nblk, nb = r - kb * nblk, k0 = 64 * kb, n0 = 64 * nb;
    P0Item d; d.src = W + (size_t)k0 * N + n0; d.K = K; d.N = N; d.qinv = qinv;
    d.dst = qinv != 0.f ? (bf16_t*)((unsigned char*)WT + (size_t)dst_row(n0, map) * K + k0) : WT + (size_t)dst_row(n0, map) * K + k0; return d;
}
__device__ __forceinline__ void p0_load(const P0Item& d, f32x4 (&v)[16], int lane) {
    const int lr = lane >> 4, lc = (lane & 15) * 4;
#pragma unroll
    for (int i = 0; i < 16; ++i) v[i] = __builtin_nontemporal_load((const f32x4*)(d.src + (size_t)(4 * i + lr) * d.N + lc));
}
__device__ __forceinline__ void p0_store(const P0Item& d, const f32x4 (&v)[16], LAS float* scr, int lane) {
    const int lr = lane >> 4, lc = (lane & 15) * 4;
#pragma unroll
    for (int i = 0; i < 16; ++i) { LAS float* s = scr + (4 * i + lr) * 65 + lc; s[0] = v[i][0]; s[1] = v[i][1]; s[2] = v[i][2]; s[3] = v[i][3]; }
    asm volatile("s_waitcnt lgkmcnt(0)" ::: "memory");
    const int c = lane & 7;
#pragma unroll
    for (int j = 0; j < 8; ++j) { const int n = (lane >> 3) + 8 * j; const LAS float* s = scr + (8 * c) * 65 + n;
        if (d.qinv != 0.f) { unsigned lo = 0u, hi = 0u;
#pragma unroll
            for (int q = 0; q < 4; ++q) { const int a0 = (int)fminf(fmaxf(rintf(s[q * 65] * d.qinv), -127.f), 127.f), a1 = (int)fminf(fmaxf(rintf(s[(q + 4) * 65] * d.qinv), -127.f), 127.f);
                lo |= ((unsigned)a0 & 0xffu) << (8 * q); hi |= ((unsigned)a1 & 0xffu) << (8 * q); }
            *(u32x2*)((unsigned char*)d.dst + (size_t)n * d.K + 8 * c) = (u32x2){lo, hi}; }
        else { u32x4 o; o.x = pk2(s[0 * 65], s[1 * 65]); o.y = pk2(s[2 * 65], s[3 * 65]); o.z = pk2(s[4 * 65], s[5 * 65]); o.w = pk2(s[6 * 65], s[7 * 65]);
            *(u32x4*)(d.dst + (size_t)n * d.K + 8 * c) = o; } }
    asm volatile("s_waitcnt lgkmcnt(0)" ::: "memory");
}
__device__ __forceinline__ float sample_scale(const float* Wm, unsigned stride, LAS unsigned char* lds, int wvid, float* rms_out = nullptr) {
    int tid_ = (wvid * 64 + lane_id_asm()); asm volatile("" : "+v"(tid_)); const int tid = tid_;
    const unsigned so = (unsigned)tid * stride;
    const f32x4 v0 = *(const f32x4*)(Wm + so), v1 = *(const f32x4*)(Wm + so + 4);
    float ss = (v0[0] * v0[0] + v0[1] * v0[1]) + (v0[2] * v0[2] + v0[3] * v0[3]) + (v1[0] * v1[0] + v1[1] * v1[1]) + (v1[2] * v1[2] + v1[3] * v1[3]);
    float mx = fmaxf(fmaxf(fmaxf(fabsf(v0[0]), fabsf(v0[1])), fmaxf(fabsf(v0[2]), fabsf(v0[3]))), fmaxf(fmaxf(fabsf(v1[0]), fabsf(v1[1])), fmaxf(fabsf(v1[2]), fabsf(v1[3]))));
    ss = wave_sum(ss);
#pragma unroll
    for (int o = 1; o < 64; o <<= 1) mx = fmaxf(mx, __shfl_xor(mx, o));
    LAS float* red = (LAS float*)lds;
    __syncthreads();
    if ((tid & 63) == 0) { red[tid >> 6] = ss; red[8 + (tid >> 6)] = mx; }
    __syncthreads();
    float s = 0.f, m = 0.f;
#pragma unroll
    for (int w = 0; w < NWAVES; ++w) { s += red[w]; m = fmaxf(m, red[8 + w]); }
    __syncthreads();
    const float rms = sqrtf(s * (1.0f / 4096.0f)); if (rms_out) *rms_out = rms;
    return fmaxf(fmaxf(6.5f * rms, 1.25f * m), 1e-30f) * (1.0f / 127.0f);
}
__device__ __forceinline__ void p0_calibrate(const P0Args& a, LAS unsigned char* lds, int vcu, int wvid) {
    if (vcu > 2 * NE) return;
    float rms = 0.f;
    const float* Wm = vcu < NE ? a.w_gu + (size_t)vcu * D * 2048 : (vcu == NE ? a.w_pg : a.w_dn + (size_t)(vcu - NE - 1) * D * D);
    const float sc = sample_scale(Wm, vcu < NE ? 4100 : 2044, lds, wvid, &rms);
    if ((wvid * 64 + lane_id_asm()) == 0) { float* scl = (float*)(a.ws + WS_SCL); if (vcu <= NE) scl[vcu] = sc; else scl[128 + vcu - NE - 1] = sc; if (vcu < NE) scl[64 + vcu] = rms; }
}
__device__ __forceinline__ void p0_phase(const P0Args& a, LAS unsigned char* lds, int vcu, int G, int it_lo, int it_hi, bool do_xp, int wvid) {
    int tid_ = (wvid * 64 + lane_id_asm()); asm volatile("" : "+v"(tid_));
    const int tid = tid_, lane = tid & 63, wave = __builtin_amdgcn_readfirstlane(tid >> 6);
    LAS float* scr = (LAS float*)(lds + wave * 16640);
    const int gw = vcu * NWAVES + wave, NGW = G * NWAVES;
    f32x4 va[16], vb[16]; P0Item da, db;
    int it = it_lo + gw;
    if (it < it_hi) { da = p0_decode(a, it); p0_load(da, va, lane); }
    while (it < it_hi) {
        const bool hb = it + NGW < it_hi;
        if (hb) { db = p0_decode(a, it + NGW); p0_load(db, vb, lane); }
        p0_store(da, va, scr, lane);
        if (!hb) break;
        const bool ha = it + 2 * NGW < it_hi;
        if (ha) { da = p0_decode(a, it + 2 * NGW); p0_load(da, va, lane); }
        p0_store(db, vb, scr, lane);
        if (!ha) break;
        it += 2 * NGW;
    }
    if (!do_xp) return;
    p0_calibrate(a, lds, vcu, wvid);
    const int gt = vcu * NTHREADS + tid, NGT = G * NTHREADS;
    for (int t0 = 2 * gw; t0 < M; t0 += 2 * NGW) { f32x4 v[2][4];
#pragma unroll
        for (int x = 0; x < 2; ++x)
#pragma unroll
            for (int j = 0; j < 4; ++j) v[x][j] = __builtin_nontemporal_load((const f32x4*)(a.x + (size_t)(t0 + x) * D + 256 * j + 4 * lane));
#pragma unroll
        for (int x = 0; x < 2; ++x) { float am = 0.f;
#pragma unroll
            for (int j = 0; j < 4; ++j) am = fmaxf(am, fmaxf(fmaxf(fabsf(v[x][j][0]), fabsf(v[x][j][1])), fmaxf(fabsf(v[x][j][2]), fabsf(v[x][j][3]))));
#pragma unroll
            for (int o = 1; o < 64; o <<= 1) am = fmaxf(am, __shfl_xor(am, o));
            const float sxr = fmaxf(am, 1e-30f) * (1.0f / 127.0f), qi = 1.0f / sxr;
#pragma unroll
            for (int j = 0; j < 4; ++j) { unsigned q = 0u;
#pragma unroll
                for (int z = 0; z < 4; ++z) q |= ((unsigned)(int)rintf(v[x][j][z] * qi) & 0xffu) << (8 * z);
                *(unsigned*)(a.ws + WS_XB + (size_t)(t0 + x) * D + 256 * j + 4 * lane) = q; }
            if (lane == 0) ((float*)(a.ws + WS_SX0))[t0 + x] = sxr; } }
    for (int i = gt; i < M * DPLE / 8; i += 4 * NGT) { f32x4 v[4][2];
#pragma unroll
        for (int u = 0; u < 4; ++u) { const size_t o = (size_t)(i + u * NGT) * 8; v[u][0] = __builtin_nontemporal_load((const f32x4*)(a.p + o)); v[u][1] = __builtin_nontemporal_load((const f32x4*)(a.p + o + 4)); }
#pragma unroll
        for (int u = 0; u < 4; ++u) { u32x4 o; o.x = pk2(v[u][0][0], v[u][0][1]); o.y = pk2(v[u][0][2], v[u][0][3]); o.z = pk2(v[u][1][0], v[u][1][1]); o.w = pk2(v[u][1][2], v[u][1][3]);
            *(u32x4*)((bf16_t*)(a.ws + WS_PB) + (size_t)(i + u * NGT) * 8) = o; } }
}

__device__ __forceinline__ int crow(int r, int hi) { return (r & 3) + 8 * (r >> 2) + 4 * hi; }
typedef short v4i16_t __attribute__((ext_vector_type(4)));
__device__ __forceinline__ s16x4 vtr(const LAS unsigned char* p) { return __builtin_bit_cast(s16x4, __builtin_amdgcn_ds_read_tr16_b64_v4i16((LAS v4i16_t*)p)); }
__device__ __forceinline__ void attn_unit(LAS unsigned char* lds, const bf16_t* Q, const bf16_t* Kg, const bf16_t* Vg, const float* sinks, bf16_t* O, int b, int kvh, int nb, int wvid) {
    int tid_ = (wvid * 64 + lane_id_asm()); asm volatile("" : "+v"(tid_));
    const int tid = tid_, lane = tid & 63, r32 = lane & 31, hi = lane >> 5; const int wid = __builtin_amdgcn_readfirstlane(tid >> 6);
    const int t0 = b * SEQ + nb * 128;
#pragma unroll
    for (int it = 0; it < 4; ++it) { const int idx = tid + it * NTHREADS, key = idx >> 3, c = idx & 7;
        int row = t0 - 128 + key; if (row < b * SEQ) row = b * SEQ;
        const u32x4 kv = *(const u32x4*)(Kg + (size_t)row * 256 + kvh * HD + c * 8);
        const u32x4 vv = *(const u32x4*)(Vg + (size_t)row * 256 + kvh * HD + c * 8);
        *(LAS u32x4*)(lds + c * 4096 + key * 16) = kv;
        *(LAS u32x4*)(lds + 32768 + (c >> 2) * 16384 + (key >> 4) * 1024 + (key & 15) * 64 + (c & 3) * 16) = vv; }
    __syncthreads();
    const int g = wid >> 1, half = wid & 1, h = kvh * 4 + g;
    const float sink2 = sinks[h] * LOG2E;
    const LAS unsigned char* vbase = lds + 32768 + ((lane >> 4) & 1) * 32 + (lane & 3) * 8 + (4 * hi + ((lane & 15) >> 2)) * 64;
#pragma unroll 1
    for (int qq = 0; qq < 2; ++qq) {
        const int qt = half * 2 + qq;
        const bf16_t* qp = Q + (size_t)(t0 + 32 * qt + r32) * D + h * HD + hi * 8;
        bf16x8 qr[4];
#pragma unroll
        for (int d0 = 0; d0 < 4; ++d0) qr[d0] = *(const bf16x8*)(qp + d0 * 16);
        f32x16 s[5];
#pragma unroll
        for (int j = 0; j < 5; ++j) { const LAS unsigned char* kp = lds + hi * 4096 + ((qt + j) * 32 + r32) * 16; f32x16 a = {};
#pragma unroll
            for (int d0 = 0; d0 < 4; ++d0) a = __builtin_amdgcn_mfma_f32_32x32x16_bf16(*(const LAS bf16x8*)(kp + d0 * 8192), qr[d0], a, 0, 0, 0);
            s[j] = a; }
#pragma unroll
        for (int r = 0; r < 16; ++r) { const int cr = crow(r, hi); if (cr <= r32) s[0][r] = -INFINITY; if (cr > r32) s[4][r] = -INFINITY; }
        if (nb == 0) {
#pragma unroll
            for (int j = 0; j < 4; ++j) if (qt + j < 4) {
#pragma unroll
                for (int r = 0; r < 16; ++r) s[j][r] = -INFINITY; } }
        float mx = -INFINITY;
#pragma unroll
        for (int j = 0; j < 5; ++j)
#pragma unroll
            for (int r = 0; r < 16; ++r) mx = fmaxf(mx, s[j][r]);
        mx = fmaxf(mx, __shfl_xor(mx, 32)); mx = fmaxf(mx, sink2);
        float ls = 0.f;
#pragma unroll
        for (int j = 0; j < 5; ++j)
#pragma unroll
            for (int r = 0; r < 16; ++r) { s[j][r] = __builtin_amdgcn_exp2f(s[j][r] - mx); ls += s[j][r]; }
        ls += __shfl_xor(ls, 32); ls += __builtin_amdgcn_exp2f(sink2 - mx);
        const float linv = 1.0f / ls;
        f32x16 o[2]; o[0] = f32x16{}; o[1] = f32x16{};
#pragma unroll
        for (int j = 0; j < 5; ++j)
#pragma unroll
            for (int ks = 0; ks < 2; ++ks) {
                u32x4 pw; pw.x = pk2(s[j][8 * ks + 0], s[j][8 * ks + 1]); pw.y = pk2(s[j][8 * ks + 2], s[j][8 * ks + 3]); pw.z = pk2(s[j][8 * ks + 4], s[j][8 * ks + 5]); pw.w = pk2(s[j][8 * ks + 6], s[j][8 * ks + 7]);
                const bf16x8 pa = __builtin_bit_cast(bf16x8, pw);
                const LAS unsigned char* vp = vbase + ((qt + j) * 2 + ks) * 1024;
#pragma unroll
                for (int dh = 0; dh < 2; ++dh) { const s16x4 lo = vtr(vp + dh * 16384), hi4 = vtr(vp + dh * 16384 + 512);
                    const bf16x8 vf = {lo[0], lo[1], lo[2], lo[3], hi4[0], hi4[1], hi4[2], hi4[3]};
                    o[dh] = __builtin_amdgcn_mfma_f32_32x32x16_bf16(pa, vf, o[dh], 0, 0, 0); } }
        bf16_t* op = O + (size_t)(t0 + 32 * qt) * D + h * HD + r32;
#pragma unroll
        for (int r = 0; r < 16; ++r) { const int q = crow(r, hi); const float sc = __shfl(linv, q);
            op[(size_t)q * D] = (bf16_t)f2bf(o[0][r] * sc); op[(size_t)q * D + 32] = (bf16_t)f2bf(o[1][r] * sc); }
    }
    __syncthreads();
}
__device__ __forceinline__ void conv_phase(const bf16_t* Bg, const bf16_t* U, const float* cw, bf16_t* Z, int vcu, int G, int wvid) {
    int tid_ = (wvid * 64 + lane_id_asm()); asm volatile("" : "+v"(tid_));
    const int gt = vcu * NTHREADS + tid_, NGT = G * NTHREADS;
    for (int i = gt; i < (M / 8) * (D / 8); i += NGT) {
        const int t0 = (i >> 7) * 8, c = (i & 127) * 8, tl0 = t0 & (SEQ - 1);
        f32x4 w[3][2];
#pragma unroll
        for (int k = 0; k < 3; ++k) { w[k][0] = *(const f32x4*)(cw + k * D + c); w[k][1] = *(const f32x4*)(cw + k * D + c + 4); }
        u32x4 ur[10], br[8];
#pragma unroll
        for (int r = 0; r < 10; ++r) { if (r >= 2 || tl0 != 0) ur[r] = *(const u32x4*)(U + (size_t)(t0 + r - 2) * D + c); else ur[r] = (u32x4){0u, 0u, 0u, 0u}; }
#pragma unroll
        for (int r = 0; r < 8; ++r) br[r] = *(const u32x4*)(Bg + (size_t)(t0 + r) * D + c);
#pragma unroll
        for (int r = 0; r < 8; ++r) { float y[8];
#pragma unroll
            for (int j = 0; j < 8; ++j) y[j] = 0.f;
#pragma unroll
            for (int k = 0; k < 3; ++k) { const u32x4 uw = ur[r + k];
                y[0] += w[k][0][0] * bflo(uw.x); y[1] += w[k][0][1] * bfhi(uw.x); y[2] += w[k][0][2] * bflo(uw.y); y[3] += w[k][0][3] * bfhi(uw.y);
                y[4] += w[k][1][0] * bflo(uw.z); y[5] += w[k][1][1] * bfhi(uw.z); y[6] += w[k][1][2] * bflo(uw.w); y[7] += w[k][1][3] * bfhi(uw.w); }
            const u32x4 bw = br[r];
            u32x4 o; o.x = pk2(y[0] * bflo(bw.x), y[1] * bfhi(bw.x)); o.y = pk2(y[2] * bflo(bw.y), y[3] * bfhi(bw.y)); o.z = pk2(y[4] * bflo(bw.z), y[5] * bfhi(bw.z)); o.w = pk2(y[6] * bflo(bw.w), y[7] * bfhi(bw.w));
            *(u32x4*)(Z + (size_t)(t0 + r) * D + c) = o; }
    }
}
#ifndef DBG_ATTN
#define DBG_ATTN 0
#endif
#if DBG_ATTN
__device__ __forceinline__ void dbg_attn_check(const bf16_t* Q, const bf16_t* Kg, const bf16_t* Vg, const float* sinks, const bf16_t* O, float* acc3, int vcu, int G, int wvid) {
    const int lane = (wvid * 64 + lane_id_asm()) & 63, wave = wvid;
    const int gw = vcu * NWAVES + wave, nw = G * NWAVES;
    float lnum = 0.f, lden = 0.f, lmax = 0.f;
    for (int it = gw; it < M * NH; it += nw) {
        const int t = it / NH, h = it % NH, kvh = h / 4, tl = t % SEQ;
        const int slo = tl - 127 < 0 ? 0 : tl - 127, n = tl - slo + 1;
        const bf16_t* qp = Q + (size_t)t * D + h * HD;
        float sc[2];
#pragma unroll
        for (int u = 0; u < 2; ++u) { const int j = lane + 64 * u; float dot = -INFINITY;
            if (j < n) { const bf16_t* kp = Kg + (size_t)(t - tl + slo + j) * 256 + kvh * HD; dot = 0.f;
                for (int d = 0; d < HD; ++d) dot = fmaf(bflo((unsigned)qp[d]), bflo((unsigned)kp[d]), dot);
                dot *= (1.0f / LOG2E); }
            sc[u] = dot; }
        const float sink = sinks[h];
        float m = fmaxf(sc[0], sc[1]);
        for (int o = 1; o < 64; o <<= 1) m = fmaxf(m, __shfl_xor(m, o));
        m = fmaxf(m, sink);
        float e0 = (lane < n) ? expf(sc[0] - m) : 0.f, e1 = (lane + 64 < n) ? expf(sc[1] - m) : 0.f;
        float s = e0 + e1;
        for (int o = 1; o < 64; o <<= 1) s += __shfl_xor(s, o);
        const float denom = s + expf(sink - m);
        e0 /= denom; e1 /= denom;
        float a = 0.f;
        for (int j = 0; j < n; ++j) { const float pj = __shfl(j < 64 ? e0 : e1, j & 63); a = fmaf(pj, bflo((unsigned)Vg[(size_t)(t - tl + slo + j) * 256 + kvh * HD + lane]), a); }
        const float o = bflo((unsigned)O[(size_t)t * D + h * HD + lane]);
        const float rn = wave_sum((o - a) * (o - a)), rd = wave_sum(a * a);
        lnum += rn; lden += rd; lmax = fmaxf(lmax, rn / fmaxf(rd, 1e-20f));
    }
    if (lane == 0) { atomicAdd(acc3, lnum); atomicAdd(acc3 + 1, lden); atomicMax((unsigned*)(acc3 + 2), __float_as_uint(lmax)); }
}
#endif
constexpr int WR_STRIDE = 1028;
struct RouteArgs { float* X1F; bf16_t* X1B; const float *g1, *b1, *w_r, *b_r; int* gcnt; int* list_tok; float* list_w; int* tk_e; int* tk_rank; float* tk_w; unsigned char* XQ; float* sx1; float* list_sx; float* list_hs; const float* scl; };
__device__ __forceinline__ void route_phase(const RouteArgs& a, LAS unsigned char* lds, int vcu, int G, bool dry, int wvid) {
    int tid_ = (wvid * 64 + lane_id_asm()); asm volatile("" : "+v"(tid_));
    const int tid = tid_, lane = tid & 63, wave = __builtin_amdgcn_readfirstlane(tid >> 6);
    LAS float* wrt = (LAS float*)lds;
    LAS int* misc = (LAS int*)(lds + MISC_OFF);
    LAS int* lcnt = misc + 96; LAS int* gbase = misc + 128; LAS int* rowe = misc + 160; LAS float* roww = (LAS float*)(misc + 416); LAS float* rowsx = (LAS float*)(misc + 672); LAS float* rownrm = (LAS float*)(misc + 736);
    for (int i = tid; i < D * NE; i += NTHREADS) { const int c = i >> 5, e = i & 31; wrt[e * WR_STRIDE + c] = a.w_r[i]; }
    if (tid < NE) lcnt[tid] = 0;
    __syncthreads();
    const int rows_per_wg = M / G;
    for (int rr = 2 * wave; rr < rows_per_wg; rr += 2 * NWAVES) {
        f32x4 v[2][4];
#pragma unroll
        for (int x = 0; x < 2; ++x) { const int t = vcu * rows_per_wg + rr + x; float s = 0.f;
#pragma unroll
            for (int j = 0; j < 4; ++j) { v[x][j] = *(const f32x4*)(a.X1F + (size_t)t * D + 256 * j + 4 * lane); s += (v[x][j][0] + v[x][j][1]) + (v[x][j][2] + v[x][j][3]); }
            const float mean = wave_sum(s) * (1.0f / D); float q = 0.f;
#pragma unroll
            for (int j = 0; j < 4; ++j) { v[x][j] = v[x][j] - mean; q += (v[x][j][0] * v[x][j][0] + v[x][j][1] * v[x][j][1]) + (v[x][j][2] * v[x][j][2] + v[x][j][3] * v[x][j][3]); }
            const float rstd = 1.0f / sqrtf(wave_sum(q) * (1.0f / D) + LN_EPS);
#pragma unroll
            for (int j = 0; j < 4; ++j) { const f32x4 gg = *(const f32x4*)(a.g1 + 256 * j + 4 * lane), bb = *(const f32x4*)(a.b1 + 256 * j + 4 * lane);
                v[x][j] = v[x][j] * rstd * gg + bb;
                if (!dry) { u32x2 w; w.x = pk2(v[x][j][0], v[x][j][1]); w.y = pk2(v[x][j][2], v[x][j][3]); *(u32x2*)(a.X1B + (size_t)t * D + 256 * j + 4 * lane) = w; } }
            float am = 0.f;
#pragma unroll
            for (int j = 0; j < 4; ++j) am = fmaxf(am, fmaxf(fmaxf(fabsf(v[x][j][0]), fabsf(v[x][j][1])), fmaxf(fabsf(v[x][j][2]), fabsf(v[x][j][3]))));
#pragma unroll
            for (int o = 1; o < 64; o <<= 1) am = fmaxf(am, __shfl_xor(am, o));
            const float sxr = fmaxf(am, 1e-30f) * (1.0f / 127.0f), qi = 1.0f / sxr;
            if (!dry) {
#pragma unroll
                for (int j = 0; j < 4; ++j) { unsigned q = 0u;
#pragma unroll
                    for (int z = 0; z < 4; ++z) q |= ((unsigned)(int)rintf(v[x][j][z] * qi) & 0xffu) << (8 * z);
                    *(unsigned*)(a.XQ + (size_t)t * D + 256 * j + 4 * lane) = q; }
                if (lane == 0) { a.sx1[t] = sxr; rowsx[rr + x] = sxr; } }
            { float ssq = 0.f;
#pragma unroll
              for (int j = 0; j < 4; ++j) ssq += (v[x][j][0] * v[x][j][0] + v[x][j][1] * v[x][j][1]) + (v[x][j][2] * v[x][j][2] + v[x][j][3] * v[x][j][3]);
              ssq = wave_sum(ssq); if (lane == 0) rownrm[rr + x] = sqrtf(ssq); } }
        float pl[2][32];
#pragma unroll
        for (int e = 0; e < 32; ++e) { float a0 = 0.f, a1 = 0.f;
#pragma unroll
            for (int j = 0; j < 4; ++j) { const f32x4 w = *(const LAS f32x4*)(wrt + e * WR_STRIDE + 256 * j + 4 * lane);
                a0 += (v[0][j][0] * w[0] + v[0][j][1] * w[1]) + (v[0][j][2] * w[2] + v[0][j][3] * w[3]); a1 += (v[1][j][0] * w[0] + v[1][j][1] * w[1]) + (v[1][j][2] * w[2] + v[1][j][3] * w[3]); }
            pl[0][e] = a0; pl[1][e] = a1; }
#pragma unroll
        for (int o = 32, n = 16; o >= 2; o >>= 1, n >>= 1) { const bool up = (lane & o) != 0;
#pragma unroll
            for (int i = 0; i < 16; ++i) if (i < n) {
#pragma unroll
                for (int x = 0; x < 2; ++x) { const float send = up ? pl[x][i] : pl[x][i + n], keep = up ? pl[x][i + n] : pl[x][i]; pl[x][i] = keep + __shfl_xor(send, o); } } }
        const int myexp = lane >> 1; const float brv = a.b_r[myexp];
        float logit[2];
#pragma unroll
        for (int x = 0; x < 2; ++x) logit[x] = pl[x][0] + __shfl_xor(pl[x][0], 1) + brv;
        int se[2][4]; float sv[2][4];
#pragma unroll
        for (int k = 0; k < 4; ++k) { float bv[2]; int bi[2];
#pragma unroll
            for (int x = 0; x < 2; ++x) { bv[x] = logit[x]; bi[x] = myexp; }
#pragma unroll
            for (int o = 1; o < 64; o <<= 1) {
#pragma unroll
                for (int x = 0; x < 2; ++x) { const float ov = __shfl_xor(bv[x], o); const int oi = __shfl_xor(bi[x], o); if (ov > bv[x] || (ov == bv[x] && oi < bi[x])) { bv[x] = ov; bi[x] = oi; } } }
#pragma unroll
            for (int x = 0; x < 2; ++x) { se[x][k] = bi[x]; sv[x][k] = bv[x]; if (myexp == bi[x]) logit[x] = -INFINITY; } }
#pragma unroll
        for (int x = 0; x < 2; ++x) { const float e1 = __expf(sv[x][1] - sv[x][0]), e2 = __expf(sv[x][2] - sv[x][0]), e3 = __expf(sv[x][3] - sv[x][0]);
            const float inv = 1.0f / (1.0f + e1 + e2 + e3);
            if (lane < 4) { const int e = lane == 0 ? se[x][0] : lane == 1 ? se[x][1] : lane == 2 ? se[x][2] : se[x][3];
                const float w = (lane == 0 ? 1.0f : lane == 1 ? e1 : lane == 2 ? e2 : e3) * inv;
                rowe[(rr + x) * 4 + lane] = e; roww[(rr + x) * 4 + lane] = w; } }
    }
    __syncthreads();
    if (dry) return;
    const int nent = rows_per_wg * 4;
    int my_e = 0, my_lr = 0;
    if (tid < nent) { my_e = rowe[tid]; my_lr = atomicAdd((int*)(lcnt + my_e), 1); }
    __syncthreads();
    if (tid < NE) gbase[tid] = atomicAdd(a.gcnt + tid, lcnt[tid]);
    __syncthreads();
    if (tid < nent) { const int t = vcu * rows_per_wg + (tid >> 2), rank = gbase[my_e] + my_lr;
        const float sig = rownrm[tid >> 2] * a.scl[64 + my_e], clip = fmaxf((1.0f + 3.5f * sig) * (3.5f * sig), 1e-20f);
        const float qh = bfhi(f2bf(127.0f / clip) << 16);
        a.list_tok[(size_t)my_e * LISTCAP + rank] = t; a.list_w[(size_t)my_e * LISTCAP + rank] = qh; a.list_sx[(size_t)my_e * LISTCAP + rank] = rowsx[tid >> 2];
        a.list_hs[(size_t)my_e * LISTCAP + rank] = roww[tid] / qh;
        a.tk_e[t * 4 + (tid & 3)] = my_e; a.tk_rank[t * 4 + (tid & 3)] = rank; a.tk_w[t * 4 + (tid & 3)] = roww[tid]; }
    __syncthreads();
}
__device__ __forceinline__ void build_tables(const int* gcnt, LAS unsigned char* lds, int wvid) {
    LAS int* misc = (LAS int*)(lds + MISC_OFF);
    const int tid = wvid * 64 + lane_id_asm();
    if (tid < NE) misc[tid] = __hip_atomic_load(gcnt + tid, __ATOMIC_RELAXED, __HIP_MEMORY_SCOPE_AGENT);
    __syncthreads();
    if (tid == 0) { int a = 0; for (int e = 0; e < NE; ++e) { misc[32 + e] = a; a += (misc[e] + 255) >> 8; } misc[32 + NE] = a; }
    __syncthreads();
}
struct FinalArgs { float dbg_scale; int pad_; const bf16_t* X1B; const bf16_t* PLE; const bf16_t* Y; const int* tk_e; const int* tk_rank; const float* tk_w; const float* b_down; const float *g2, *b2; float* out; };
__device__ __forceinline__ void final_phase(const FinalArgs& a, LAS unsigned char* lds, int vcu, int G, int wvid) {
    int tid_ = (wvid * 64 + lane_id_asm()); asm volatile("" : "+v"(tid_));
    const int tid = tid_, lane = tid & 63, wave = __builtin_amdgcn_readfirstlane(tid >> 6);
    const LAS int* ts = (const LAS int*)(lds + MISC_OFF) + 32;
    LAS float* bdl = (LAS float*)lds;
    for (int i = tid; i < NE * D / 4; i += NTHREADS) *(LAS f32x4*)(bdl + 4 * i) = *(const f32x4*)(a.b_down + 4 * i);
    __syncthreads();
    const int gw = vcu * NWAVES + wave, NGW = G * NWAVES;
    for (int t0 = 2 * gw; t0 < M; t0 += 2 * NGW) {
        size_t pos[2][4]; int ek[2][4]; float wk[2][4];
#pragma unroll
        for (int x = 0; x < 2; ++x)
#pragma unroll
            for (int k = 0; k < 4; ++k) { const int t = t0 + x, e = a.tk_e[t * 4 + k], rk = a.tk_rank[t * 4 + k]; pos[x][k] = ((size_t)ts[e] * 256 + rk) * D; ek[x][k] = e * D; wk[x][k] = a.tk_w[t * 4 + k]; }
        f32x4 v[2][4]; float s[2] = {0.f, 0.f};
#pragma unroll
        for (int x = 0; x < 2; ++x)
#pragma unroll
            for (int j = 0; j < 4; ++j) { const int c = 256 * j + 4 * lane; const size_t ro = (size_t)(t0 + x) * D + c;
                const u32x2 xw = *(const u32x2*)(a.X1B + ro), pw = *(const u32x2*)(a.PLE + ro);
                f32x4 xx = {bflo(xw.x) * DN_ALPHA + bflo(pw.x), bfhi(xw.x) * DN_ALPHA + bfhi(pw.x), bflo(xw.y) * DN_ALPHA + bflo(pw.y), bfhi(xw.y) * DN_ALPHA + bfhi(pw.y)};
#pragma unroll
                for (int k = 0; k < 4; ++k) { const u32x2 yw = *(const u32x2*)(a.Y + pos[x][k] + c); const f32x4 bd = *(const LAS f32x4*)(bdl + ek[x][k] + c);
                    xx[0] += bflo(yw.x) + wk[x][k] * bd[0]; xx[1] += bfhi(yw.x) + wk[x][k] * bd[1]; xx[2] += bflo(yw.y) + wk[x][k] * bd[2]; xx[3] += bfhi(yw.y) + wk[x][k] * bd[3]; }
                v[x][j] = xx; s[x] += (xx[0] + xx[1]) + (xx[2] + xx[3]); }
#pragma unroll
        for (int x = 0; x < 2; ++x) { const float mean = wave_sum(s[x]) * (1.0f / D); float q = 0.f;
#pragma unroll
            for (int j = 0; j < 4; ++j) { v[x][j] = v[x][j] - mean; q += (v[x][j][0] * v[x][j][0] + v[x][j][1] * v[x][j][1]) + (v[x][j][2] * v[x][j][2] + v[x][j][3] * v[x][j][3]); }
            const float rstd = 1.0f / sqrtf(wave_sum(q) * (1.0f / D) + LN_EPS);
#pragma unroll
            for (int j = 0; j < 4; ++j) { const int c = 256 * j + 4 * lane; const f32x4 gg = *(const f32x4*)(a.g2 + c), bb = *(const f32x4*)(a.b2 + c);
                *(f32x4*)(a.out + (size_t)(t0 + x) * D + c) = (v[x][j] * rstd * gg + bb) * a.dbg_scale; } }
    }
}

#ifndef PROBE_STAMP
#define PROBE_STAMP -1
#endif
#define STAMP(k) do { if (PROBE_STAMP >= 0 && bx == 0 && (wvid * 64 + lane_id_asm()) == 0) __hip_atomic_store(WSP(unsigned long long, WS_CTL + 32768) + (k), (unsigned long long)__builtin_amdgcn_s_memrealtime(), __ATOMIC_RELAXED, __HIP_MEMORY_SCOPE_AGENT); } while (0)
#ifndef PROBE_REP
#define PROBE_REP 0
#endif
struct Args { const float* in[20]; float* out; unsigned char* ws; };
__global__ void __launch_bounds__(NTHREADS, 2) mega_fwd(Args args) {
    extern __shared__ __attribute__((aligned(16))) unsigned char lds_raw[];
    LAS unsigned char* lds = (LAS unsigned char*)lds_raw;
    cg::grid_group grid = cg::this_grid();
    const int G = gridDim.x, bx = blockIdx.x;
    const int wvid = __builtin_amdgcn_readfirstlane((int)threadIdx.x >> 6);
    const int vcu = (G % 8 == 0) ? (bx % 8) * (G / 8) + bx / 8 : bx;
    unsigned char* const ws = args.ws;
    const LAS int* cntL = (const LAS int*)(lds + MISC_OFF); const LAS int* tsL = cntL + 32;
    { volatile LAS unsigned* bst = (volatile LAS unsigned*)(lds + MISC_OFF) + BST_IDX;
      { int t_ = (wvid * 64 + lane_id_asm()); asm volatile("" : "+v"(t_)); if (t_ < 2) bst[t_] = 0u; }
      __syncthreads();
      (void)xcd_barrier_post((unsigned*)(ws + WS_BAR), bst, (wvid * 64 + lane_id_asm()) == 0); }
#define GRID_BAR() do { XcdBarrier b_; b_.bar = (unsigned*)(ws + WS_BAR); b_.x = xb_xcc_id(); b_.st = (volatile LAS unsigned*)(lds + MISC_OFF) + BST_IDX; b_.lead = ((wvid * 64 + lane_id_asm()) == 0); xcd_barrier(b_); if (PROBE_REP & 0x80000) xcd_barrier(b_); } while (0)
#define WSP(T, off) ((T*)(ws + (off)))

    STAMP(0);
    { const float s_in = __builtin_bit_cast(float, __builtin_amdgcn_readfirstlane(__builtin_bit_cast(int, sample_scale(args.in[2], 13308, lds, wvid))));
    _Pragma("unroll 1") for (int rep_ = 0; rep_ < ((PROBE_REP & 1) ? 2 : 1); ++rep_) { P0Args a{args.in[0], args.in[1], args.in[2], args.in[4], args.in[5], args.in[7], args.in[17], args.in[16], args.in[12], args.in[14], ws, s_in}; p0_phase(a, lds, vcu, G, 0, P0_NSMALL, true, wvid); } }
#if (PROBE_REP & 0x200000)
    { u32x4* z_ = (u32x4*)(ws + WS_R); const int gt_ = vcu * NTHREADS + wvid * 64 + lane_id_asm(); for (size_t i_ = gt_; i_ < (176 * MiB) / 16; i_ += (size_t)G * NTHREADS) z_[i_] = (u32x4){0u, 0u, 0u, 0u}; }
#endif
    grid.sync();
    STAMP(1);
    _Pragma("unroll 1") for (int rep_ = 0; rep_ < ((PROBE_REP & 2) ? 2 : 1); ++rep_) { pg8::Gemm g{WSP(bf16_t, WS_XB), (const bf16_t*)(ws + WS_WIN), D / 2}; pg8::StaticOrder S; S.init(M / 256, NIN / 256, G, bx, 1);
      const float s_in1 = __builtin_bit_cast(float, __builtin_amdgcn_readfirstlane(__builtin_bit_cast(int, sample_scale(args.in[2], 13308, lds, wvid))));
      pg8::EpiInProjI8 E{ws, s_in1};
      pg8::gemm_phase<pg8::EpiInProjI8, pg8::StaticOrder, true, 0, true>(lds, g, S, E, wvid); }
    { constexpr int U1 = (M / 256) * (NIN / 256); const int R1 = U1 % G, nidle = R1 ? G - R1 : G, per = 256 / nidle;
      if (R1 == 0 || bx >= R1) {
        pg8::Gemm g{WSP(bf16_t, WS_PB), (const bf16_t*)(ws + WS_WPP), DPLE}; pg8::Ple1Order S{(bx - R1) * per, per};
        pg8::EpiF32 E{WSP(float, WS_P2)};
        pg8::gemm_phase<pg8::EpiF32, pg8::Ple1Order, false>(lds, g, S, E, wvid); } }
    GRID_BAR();
    STAMP(2);
    if (PROBE_REP & 4096) { _Pragma("unroll 1") for (int k_ = 0; k_ < 8; ++k_) GRID_BAR(); }
    _Pragma("unroll 1") for (int rep_ = 0; rep_ < ((PROBE_REP & 4) ? 2 : 1); ++rep_) for (int it = vcu; it < BATCH * NKV * (SEQ / 128); it += G) { const int nb = it & 63, kvh = (it >> 6) & 3, b = it >> 8;
        attn_unit(lds, WSP(bf16_t, WS_Q), WSP(bf16_t, WS_K), WSP(bf16_t, WS_V), args.in[6], WSP(bf16_t, WS_ZO) + (size_t)M * D, b, kvh, nb, wvid); }
    _Pragma("unroll 1") for (int rep_ = 0; rep_ < ((PROBE_REP & 8) ? 2 : 1); ++rep_) conv_phase(WSP(bf16_t, WS_BG), WSP(bf16_t, WS_U), args.in[3], WSP(bf16_t, WS_ZO), vcu, G, wvid);
    GRID_BAR();
    STAMP(3);
#if DBG_ATTN
    dbg_attn_check(WSP(bf16_t, WS_Q), WSP(bf16_t, WS_K), WSP(bf16_t, WS_V), args.in[6], WSP(bf16_t, WS_ZO) + (size_t)M * D, WSP(float, WS_CTL) + 64, vcu, G, wvid);
#endif
    _Pragma("unroll 1") for (int rep_ = 0; rep_ < ((PROBE_REP & 16) ? 2 : 1); ++rep_) { pg8::Gemm g{WSP(bf16_t, WS_ZO), (const bf16_t*)(ws + WS_WBR), D}; pg8::DualOrder S; S.so.init(M / 256, D / 256, G, bx);
      pg8::EpiDual E{ws};
      pg8::gemm_phase<pg8::EpiDual, pg8::DualOrder, true>(lds, g, S, E, wvid); }
    GRID_BAR();
    STAMP(4);
    _Pragma("unroll 1") for (int rep_ = 0; rep_ < ((PROBE_REP & 32) ? 2 : 1); ++rep_) { pg8::Gemm g{WSP(bf16_t, WS_MG), (const bf16_t*)(ws + WS_WOUT), D}; pg8::StaticOrder S; S.init(M / 256, D / 256, G, bx);
      pg8::EpiResid E{args.in[0], WSP(float, WS_X1F)};
      pg8::gemm_phase<pg8::EpiResid, pg8::StaticOrder, false>(lds, g, S, E, wvid); }
    GRID_BAR();
    STAMP(5);
    { P0Args a{args.in[0], args.in[1], args.in[2], args.in[4], args.in[5], args.in[7], args.in[17], args.in[16], args.in[12], args.in[14], ws, 1.0f}; p0_phase(a, lds, vcu, G, P0_NSMALL, P0_NITEMS, false, wvid); __syncthreads();
      if (PROBE_REP & 0x40000) { p0_phase(a, lds, vcu, G, P0_NSMALL, P0_NITEMS, false, wvid); __syncthreads(); } }
    _Pragma("unroll 1") for (int rep_ = ((PROBE_REP & 64) ? 0 : 1); rep_ < 2; ++rep_) { RouteArgs a{WSP(float, WS_X1F), WSP(bf16_t, WS_X1B), args.in[8], args.in[9], args.in[10], args.in[11], WSP(int, WS_CTL), WSP(int, WS_LTOK), WSP(float, WS_LW), WSP(int, WS_TKE), WSP(int, WS_TKR), WSP(float, WS_TKW), ws + WS_XQ, WSP(float, WS_SX1), WSP(float, WS_LSX), WSP(float, WS_LHS), WSP(float, WS_SCL)}; route_phase(a, lds, vcu, G, rep_ == 0, wvid); }
    GRID_BAR();
    STAMP(6);
    build_tables(WSP(int, WS_CTL), lds, wvid);
    { const int nx5_ = __builtin_amdgcn_readfirstlane(pg8::MoeOrder::ple_in_p5(tsL, G));
      pg8::MoeOrder S; S.init(cntL, tsL, (const LAS unsigned*)(lds + TW_OFF), 8, G, bx, 1, WS_XQ, WS_WGU, nx5_, 0, WS_XQ, WS_WPG8, 18); S.build_units((LAS int*)(lds + UTAB_OFF), 12, wvid * 64 + lane_id_asm(), vcu, 1);
      pg8::moe_preload(S, cntL, WSP(int, WS_LTOK), WSP(float, WS_LW), (LAS unsigned*)(lds + TW_OFF), wvid);
      _Pragma("unroll 1") for (int rep_ = 0; rep_ < ((PROBE_REP & 128) ? 2 : 1); ++rep_) { pg8::Gemm g{(const bf16_t*)ws, (const bf16_t*)ws, D / 2};
        pg8::EpiSwigluI8 E{WSP(bf16_t, WS_H), args.in[13], (const LAS unsigned*)(lds + TW_OFF), ws};
        pg8::gemm_phase<pg8::EpiSwigluI8, pg8::MoeOrder, true, 0, true>(lds, g, S, E, wvid); } }
    GRID_BAR();
    STAMP(7);
    _Pragma("unroll 1") for (int rep_ = 0; rep_ < ((PROBE_REP & 1024) ? 2 : 1); ++rep_) { pg8::Gemm g{(const bf16_t*)ws, (const bf16_t*)ws, D / 2};
      const int nx5_ = __builtin_amdgcn_readfirstlane(pg8::MoeOrder::ple_in_p5(tsL, G));
      pg8::MoeOrder S; S.init(cntL, tsL, (const LAS unsigned*)(lds + TW_OFF), 4, G, bx, 0, WS_H, WS_WDN, 256 - nx5_, nx5_, WS_XQ, WS_WPG8, 18); S.build_units((LAS int*)(lds + UTAB_OFF), 12, wvid * 64 + lane_id_asm(), vcu, 2);
      pg8::EpiDownI8 E{WSP(bf16_t, WS_Y), ws, cntL};
      pg8::gemm_phase<pg8::EpiDownI8, pg8::MoeOrder, true, 0, true>(lds, g, S, E, wvid); }
    STAMP(8);
    GRID_BAR();
    _Pragma("unroll 1") for (int rep_ = 0; rep_ < ((PROBE_REP & 2048) ? 2 : 1); ++rep_) { float dbgs_ = 1.0f;
      if (PROBE_STAMP >= 0) { const unsigned long long* st_ = WSP(unsigned long long, WS_CTL + 32768); const float dt_us = (float)(long long)(__hip_atomic_load(st_ + PROBE_STAMP + 1, __ATOMIC_RELAXED, __HIP_MEMORY_SCOPE_AGENT) - __hip_atomic_load(st_ + PROBE_STAMP, __ATOMIC_RELAXED, __HIP_MEMORY_SCOPE_AGENT)) * 0.01f; dbgs_ = 1.0f + sqrtf(dt_us * 1e-6f); }
#if DBG_ATTN
      { const float* a3 = WSP(float, WS_CTL) + 64; const float num = __hip_atomic_load(a3, __ATOMIC_RELAXED, __HIP_MEMORY_SCOPE_AGENT), den = __hip_atomic_load(a3 + 1, __ATOMIC_RELAXED, __HIP_MEMORY_SCOPE_AGENT), mx = __hip_atomic_load(a3 + 2, __ATOMIC_RELAXED, __HIP_MEMORY_SCOPE_AGENT);
        dbgs_ = 1.0f + sqrtf(100.0f * (DBG_ATTN == 1 ? num / den : mx)); }
#endif
      FinalArgs a{dbgs_, 0, WSP(bf16_t, WS_X1B), WSP(bf16_t, WS_PLE), WSP(bf16_t, WS_Y), WSP(int, WS_TKE), WSP(int, WS_TKR), WSP(float, WS_TKW), args.in[15], args.in[18], args.in[19], args.out}; final_phase(a, lds, vcu, G, wvid); }
}

extern "C" void kernel_launch(void* const* d_in, const int* in_sizes, int n_in, void* d_out, int out_size, void* d_ws, size_t ws_size, hipStream_t stream) {
    static int grid = 0;
    if (grid == 0) {
        if (n_in != 20 || out_size != M * D || ws_size < WS_END) { fprintf(stderr, "kernel_launch: unexpected sizes (n_in %d, out %d, ws %zu < %zu)\n", n_in, out_size, ws_size, (size_t)WS_END); grid = -1; return; }
        int dev = 0, cus = 0, per_cu = 0;
        if (hipGetDevice(&dev) != hipSuccess || hipDeviceGetAttribute(&cus, hipDeviceAttributeMultiprocessorCount, dev) != hipSuccess) { grid = -1; return; }
        if (hipFuncSetAttribute((const void*)mega_fwd, hipFuncAttributeMaxDynamicSharedMemorySize, LDS_BYTES) != hipSuccess) { fprintf(stderr, "kernel_launch: hipFuncSetAttribute failed\n"); grid = -1; return; }
        if (hipOccupancyMaxActiveBlocksPerMultiprocessor(&per_cu, (const void*)mega_fwd, NTHREADS, LDS_BYTES) != hipSuccess || per_cu < 1) { fprintf(stderr, "kernel_launch: occupancy query says %d blocks per CU\n", per_cu); grid = -1; return; }
        grid = cus;
        if (grid != 256) fprintf(stderr, "kernel_launch: note: %d CUs (built and tuned for 256)\n", grid);
    }
    if (grid < 0) return;
    if (hipMemsetAsync((char*)d_ws + WS_CTL, 0, CTL_ZERO_BYTES, stream) != hipSuccess) return;
    Args a{};
    for (int i = 0; i < 20; ++i) a.in[i] = (const float*)d_in[i];
    a.out = (float*)d_out; a.ws = (unsigned char*)d_ws;
    void* kargs[] = {&a};
    const hipError_t e = hipLaunchCooperativeKernel((const void*)mega_fwd, dim3(grid), dim3(NTHREADS), kargs, LDS_BYTES, stream);
    if (e != hipSuccess) fprintf(stderr, "kernel_launch: cooperative launch failed: %s (grid %d)\n", hipGetErrorString(e), grid);
}
```

```cpp
#include <hip/hip_runtime.h>
#include <hip/hip_cooperative_groups.h>
#include <cstdio>
#include <cstdint>
namespace cg = cooperative_groups;

#define LAS __attribute__((address_space(3)))
typedef unsigned short bf16_t;
typedef short bf16x8 __attribute__((ext_vector_type(8)));
typedef short s16x4 __attribute__((ext_vector_type(4)));
typedef float f32x4 __attribute__((ext_vector_type(4)));
typedef float f32x16 __attribute__((ext_vector_type(16)));
typedef unsigned u32x4 __attribute__((ext_vector_type(4)));
typedef unsigned u32x2 __attribute__((ext_vector_type(2)));

constexpr int BATCH = 2, SEQ = 8192, M = BATCH * SEQ, D = 1024, NIN = 6656, NE = 32, DPLE = 256, NH = 16, HD = 64, NKV = 4;
constexpr float DN_ALPHA = 1.189207115002721f, LN_EPS = 1e-5f, LOG2E = 1.4426950408889634f;
constexpr float QSCALE = 0.125f * LOG2E;
constexpr int LISTCAP = M;
constexpr int MAXTILES = (M * 4) / 256 + NE;
constexpr int NWAVES = 8, NTHREADS = 512;

constexpr size_t MiB = 1u << 20;
constexpr size_t WS_CTL = 0;
constexpr size_t WS_BAR = 16384, CTL_ZERO_BYTES = 65536;
constexpr size_t WS_TKE = 1 * MiB, WS_TKR = 2 * MiB, WS_TKW = 3 * MiB;
constexpr size_t WS_LTOK = 4 * MiB, WS_LW = 6 * MiB;
constexpr size_t WS_WIN = 8 * MiB;
constexpr size_t WS_WBR = 22 * MiB;
constexpr size_t WS_WOUT = 26 * MiB, WS_WPG = 28 * MiB;
constexpr size_t WS_WPP = 30 * MiB;
constexpr size_t WS_WGU = 32 * MiB;
constexpr size_t WS_WDN = 160 * MiB;
constexpr size_t WS_XB = 224 * MiB;
constexpr size_t WS_PB = 256 * MiB;
constexpr size_t WS_X1F = 264 * MiB;
constexpr size_t WS_X1B = 328 * MiB;
constexpr size_t WS_P2 = 360 * MiB;
constexpr size_t WS_PLE = 424 * MiB;
constexpr size_t WS_R = 456 * MiB;
constexpr size_t WS_BG = WS_R, WS_U = WS_R + 32 * MiB, WS_Q = WS_R + 64 * MiB, WS_K = WS_R + 96 * MiB, WS_V = WS_R + 104 * MiB;
constexpr size_t WS_GC = WS_R + 112 * MiB, WS_GA = WS_R + 144 * MiB;
constexpr size_t WS_ZO = WS_R + 176 * MiB;
constexpr size_t WS_T1 = WS_R + 240 * MiB;
constexpr size_t WS_MG = WS_R + 304 * MiB;
constexpr size_t WS_H = WS_R;
constexpr size_t WS_Y = WS_R + 144 * MiB;
constexpr size_t WS_XQ = WS_R + 336 * MiB;
constexpr size_t WS_LSX = WS_XQ + 16 * MiB;
constexpr size_t WS_SX1 = WS_LSX + 2 * MiB;
constexpr size_t WS_SX0 = WS_SX1 + 1 * MiB;
constexpr size_t WS_LHS = WS_SX0 + 1 * MiB;
constexpr size_t WS_END = WS_LHS + 2 * MiB;
constexpr size_t WS_SCL = 65536;
constexpr size_t WS_WPG8 = 31 * MiB;
typedef int i32x4 __attribute__((ext_vector_type(4)));

constexpr int LDS_BYTES = 147456;
constexpr int MISC_OFF = 135168;
constexpr int BST_IDX = 66, TW_OFF = MISC_OFF + 512, UTAB_OFF = TW_OFF + 10240;
constexpr int BST_IDX_ = 0;

__device__ __forceinline__ int lane_id_asm() { int l; asm volatile("v_mbcnt_lo_u32_b32 %0, -1, 0\n\tv_mbcnt_hi_u32_b32 %0, -1, %0" : "=v"(l)); return l; }
__device__ __forceinline__ unsigned f2bf(float f) { unsigned u = __builtin_bit_cast(unsigned, f); return (u + 0x7fffu + ((u >> 16) & 1u)) >> 16; }
__device__ __forceinline__ unsigned pk2(float lo, float hi) { return f2bf(lo) | (f2bf(hi) << 16); }
__device__ __forceinline__ float bflo(unsigned w) { return __builtin_bit_cast(float, w << 16); }
__device__ __forceinline__ float bfhi(unsigned w) { return __builtin_bit_cast(float, w & 0xffff0000u); }
__device__ __forceinline__ float fast_sigmoid(float v) { return __builtin_amdgcn_rcpf(1.0f + __builtin_amdgcn_exp2f(-LOG2E * v)); }
__device__ __forceinline__ float wave_sum(float v) {
#pragma unroll
    for (int o = 1; o < 64; o <<= 1) v += __shfl_xor(v, o);
    return v;
}

#define XB_TMO      128
#define XB_XCNT(j)  (256  + 64 * (j))
#define XB_XSUB(j)  (1280 + 64 * (j))
#define XB_XGEN(j)  (2304 + 64 * (j))
#define XB_TOP      3328
#define XB_TOPGEN   3392
#define XCD_BAR_WORDS 3456
#define XB_SPIN_CAP (1u << 18)

__device__ __forceinline__ unsigned xb_ld(unsigned* p)              { return __hip_atomic_load(p, __ATOMIC_RELAXED, __HIP_MEMORY_SCOPE_AGENT); }
__device__ __forceinline__ unsigned xb_add(unsigned* p, unsigned v) { return __hip_atomic_fetch_add(p, v, __ATOMIC_RELAXED, __HIP_MEMORY_SCOPE_AGENT); }
__device__ __forceinline__ unsigned xb_xcc_id() { return (unsigned)__builtin_amdgcn_s_getreg((3 << 11) | 20) & 0xFu; }
#define XB_SPIN(cond, bar) do { unsigned _sp = 0; while (cond) { __builtin_amdgcn_s_sleep(1); \
    if ((++_sp & 255u) == 0u) { if (xb_ld(&(bar)[XB_TMO])) break; if (_sp > XB_SPIN_CAP) { atomicAdd(&(bar)[XB_TMO], 1u); break; } } } } while (0)

struct XcdBarrier {
    bool lead;
    unsigned* bar; unsigned x;
    volatile LAS unsigned* st;
};

__device__ __forceinline__ XcdBarrier xcd_barrier_post(unsigned* bar, volatile LAS unsigned* st, bool lead) {
    XcdBarrier b; b.bar = bar; b.x = xb_xcc_id(); b.st = st; b.lead = lead;
    if (lead) (void)xb_add(&bar[XB_XCNT(b.x)], 1u);
    return b;
}
__device__ __forceinline__ void xcd_barrier_complete(unsigned* bar, unsigned x, unsigned& nloc, unsigned& nx) {
    const unsigned G = gridDim.x * gridDim.y * gridDim.z;
    unsigned sum, cnt, mine, sp = 0u;
    for (;;) {
        sum = 0u; cnt = 0u; mine = 0u;
#pragma unroll
        for (unsigned j = 0; j < 16; ++j) { const unsigned c = xb_ld(&bar[XB_XCNT(j)]); sum += c; cnt += (c > 0u) ? 1u : 0u; mine = (j == x) ? c : mine; }
        if (sum == G) break;
        __builtin_amdgcn_s_sleep(1);
        if ((++sp & 255u) == 0u) { if (xb_ld(&bar[XB_TMO])) break; if (sp > XB_SPIN_CAP) { atomicAdd(&bar[XB_TMO], 1u); break; } }
    }
    nloc = mine > 0u ? mine : 1u; nx = cnt > 0u ? cnt : 1u;
}

__device__ __forceinline__ void xcd_barrier_lead(const XcdBarrier& b);
__device__ __forceinline__ void xcd_barrier(const XcdBarrier& b) {
    asm volatile("s_waitcnt vmcnt(0)" ::: "memory");
    __syncthreads();
    xcd_barrier_lead(b);
    __syncthreads();
}
__device__ __forceinline__ void xcd_barrier_lead(const XcdBarrier& b) {
    if (b.lead) {
        unsigned* bar = b.bar;
        __builtin_amdgcn_s_waitcnt(0);
        unsigned nloc = b.st[0], nx = b.st[1];
        if (nloc == 0u) { xcd_barrier_complete(bar, b.x, nloc, nx); b.st[0] = nloc; b.st[1] = nx; }
        const unsigned old = xb_add(&bar[XB_XSUB(b.x)], 1u);
        const unsigned gen = old / nloc;
        if (old + 1u == (gen + 1u) * nloc) {
            __builtin_amdgcn_fence(__ATOMIC_RELEASE, "agent");
            asm volatile("s_waitcnt vmcnt(0)" ::: "memory");
            const unsigned og = xb_add(&bar[XB_TOP], 1u);
            const unsigned tg = og / nx;
            if (og + 1u == (tg + 1u) * nx) xb_add(&bar[XB_TOPGEN], 1u);
            else XB_SPIN(xb_ld(&bar[XB_TOPGEN]) == tg, bar);
            __builtin_amdgcn_fence(__ATOMIC_ACQUIRE, "agent");
            xb_add(&bar[XB_XGEN(b.x)], 1u);
            asm volatile("s_waitcnt vmcnt(0)" ::: "memory");
        } else {
            XB_SPIN(xb_ld(&bar[XB_XGEN(b.x)]) == gen, bar);
            __builtin_amdgcn_fence(__ATOMIC_ACQUIRE, "agent");
            asm volatile("s_waitcnt vmcnt(0)" ::: "memory");
        }
    }
}

namespace pg8 {
constexpr int BM = 256, BK = 64, HALF = 128, HTB = HALF * BK * 2  , STAGE_BYTES = 8 * HTB, NXCD = 8, WGM = 8;
__host__ __device__ __forceinline__ int lds_byte(int r, int c) { const int st = (r >> 4) * 2 + (c >> 5), rr = r & 15, cc = c & 31, ob = rr * 64 + cc * 2; return st * 1024 + (ob ^ (((ob >> 9) & 1) << 5)); }
__host__ __device__ __forceinline__ void stage_rc(int b, int& R, int& C) { const int st = b / 1024, sb = b % 1024, swz = sb ^ (((sb >> 9) & 1) << 5); R = (st >> 1) * 16 + swz / 64; C = (st & 1) * 32 + (swz % 64) / 2; }
__host__ __device__ __forceinline__ int perm32(int rho) { const int n = rho >> 4, i = rho & 15; return 8 * (i >> 2) + 4 * n + (i & 3); }

struct Unit { int pm, pn, om, on, e, mt, slot; };
struct Gemm { const bf16_t* A; const bf16_t* Bt; int K; };

__device__ __forceinline__ int xcd_remap(int L, int nwg) { const int q = nwg / NXCD, r = nwg % NXCD, xcd = L % NXCD, off = L / NXCD; return (xcd < r ? xcd * (q + 1) : r * (q + 1) + (xcd - r) * q) + off; }

__device__ __forceinline__ void plain_a_off(int pm, int tid, int K, unsigned (&o)[2][2]) {
#pragma unroll
    for (int i = 0; i < 2; ++i) { int R, C; stage_rc(tid * 16 + i * 8192, R, C);
#pragma unroll
        for (int h = 0; h < 2; ++h) o[h][i] = (unsigned)((pm * BM + h * HALF + R) * K + C) * 2u; }
}
struct StaticOrder {
    int nM, nN, nwg, G, c;
    __device__ void init(int nM_, int nN_, int G_, int c_, int = 1) { nM = nM_; nN = nN_; nwg = nM * nN; G = G_; c = c_; }
    __device__ __forceinline__ bool tile(int i, int& pm, int& pn, int& q) const {
        const int L = i * G + c; if (L >= nwg) return false;
        q = 0xF; const int wgid = xcd_remap(L, nwg);
        const int nig = WGM * nN, gid = wgid / nig, fm = gid * WGM, gsz = (nM - fm) < WGM ? (nM - fm) : WGM;
        pm = fm + ((wgid % nig) % gsz); pn = (wgid % nig) / gsz; return true;
    }
    __device__ __forceinline__ bool next(int i, Unit& u) const { int pm, pn, q; if (!tile(i, pm, pn, q)) return false; u.pm = pm; u.pn = pn; u.om = pm; u.on = pn; u.e = 0; u.mt = 0; u.slot = 0; return true; }
    __device__ __forceinline__ void a_off(const Unit& u, int tid, int K, unsigned (&o)[2][2]) const { plain_a_off(u.pm, tid, K, o); }
};

__device__ __forceinline__ unsigned cvt_pk_bf16(float lo, float hi) { unsigned r; asm volatile("v_cvt_pk_bf16_f32 %0, %1, %2" : "=v"(r) : "v"(lo), "v"(hi)); return r; }

template <class Epi, class Sched, bool ALIGN_EPI, int DRY = 0, bool I8 = false>
__device__ __forceinline__ void gemm_phase(LAS unsigned char* lds, const Gemm g, const Sched& S, const Epi& E, int wvid) {
    int tid_ = (wvid * 64 + lane_id_asm()); asm volatile("" : "+v"(tid_));
    const int tid = tid_, wid = __builtin_amdgcn_readfirstlane(tid >> 6), lane = tid & 63, wr = wid >> 2, wc = wid & 3, fr = lane & 15, fq = lane >> 4;
    const int K = g.K, nt = K / BK;
    unsigned voffB[2];
#pragma unroll
    for (int i = 0; i < 2; ++i) { int R, C; stage_rc(tid * 16 + i * 8192, R, C); const int Rb = Epi::PERM ? ((R & ~31) + perm32(R & 31)) : R;
        voffB[i] = (unsigned)(Rb * K + C) * 2u; }
    constexpr unsigned kstep = BK * 2;
    const unsigned hstep = (unsigned)HALF * K * 2;
    const unsigned tstep = 2 * hstep;
    const unsigned ldsw = (unsigned)wid * 1024u;
    const int aoff = lds_byte(wr * 64 + fr, fq * 8), boff = lds_byte(wc * 32 + fr, fq * 8);
#define PG8_SA(b, h) (((b) * 2 + (h)) * HTB)
#define PG8_SB(b, h) ((4 + (b) * 2 + (h)) * HTB)
#define PG8_STAGE(bufoff, gbase, voff) do { _Pragma("unroll") for (int _i = 0; _i < 2; ++_i) \
        __builtin_amdgcn_global_load_lds((const unsigned*)((const char*)(gbase) + (voff)[_i]), (LAS unsigned*)(lds + (bufoff) + ldsw + _i * 8192), 16, 0, 0); } while (0)
#define PG8_LDA(dst, b, h) do { _Pragma("unroll") for (int m = 0; m < 4; ++m) _Pragma("unroll") for (int k = 0; k < 2; ++k) dst[m][k] = *(const LAS bf16x8*)(lds + PG8_SA(b, h) + aoff + m * 2048 + k * 1024); } while (0)
#define PG8_LDB(dst, b, h) do { _Pragma("unroll") for (int n = 0; n < 2; ++n) _Pragma("unroll") for (int k = 0; k < 2; ++k) dst[n][k] = *(const LAS bf16x8*)(lds + PG8_SB(b, h) + boff + n * 2048 + k * 1024); } while (0)
#define PG8_MMA(ai, bj, At, Bt) do { if constexpr (DRY == 1) { _Pragma("unroll") for (int m = 0; m < 4; ++m) _Pragma("unroll") for (int k = 0; k < 2; ++k) asm volatile("" :: "v"(At[m][k])); _Pragma("unroll") for (int n = 0; n < 2; ++n) _Pragma("unroll") for (int k = 0; k < 2; ++k) asm volatile("" :: "v"(Bt[n][k])); break; } __builtin_amdgcn_s_setprio(1); _Pragma("unroll") for (int m = 0; m < 4; ++m) _Pragma("unroll") for (int n = 0; n < 2; ++n) _Pragma("unroll") for (int k = 0; k < 2; ++k) \
        { if constexpr (I8) acc[ai][bj][m][n] = __builtin_bit_cast(AccT, __builtin_amdgcn_mfma_i32_16x16x64_i8(__builtin_bit_cast(i32x4, Bt[n][k]), __builtin_bit_cast(i32x4, At[m][k]), __builtin_bit_cast(i32x4, acc[ai][bj][m][n]), 0, 0, 0)); \
          else acc[ai][bj][m][n] = __builtin_bit_cast(AccT, __builtin_amdgcn_mfma_f32_16x16x32_bf16(Bt[n][k], At[m][k], __builtin_bit_cast(f32x4, acc[ai][bj][m][n]), 0, 0, 0)); } __builtin_amdgcn_s_setprio(0); } while (0)
#define PG8_WAIT_V(n) asm volatile("s_waitcnt vmcnt(" #n ")" ::: "memory")
#define PG8_WAIT_L(n) asm volatile("s_waitcnt lgkmcnt(" #n ")" ::: "memory")
#define PG8_BAR __builtin_amdgcn_s_barrier()
#define PG8_SCHED __builtin_amdgcn_sched_barrier(0)
    Unit cur, nxt; int ui = 0;
    if (!S.next(0, cur)) return;
    typedef typename Epi::AccT AccT;
    AccT acc[2][2][4][2];
#pragma unroll
    for (int a = 0; a < 2; ++a)
#pragma unroll
        for (int b = 0; b < 2; ++b)
#pragma unroll
            for (int m = 0; m < 4; ++m)
#pragma unroll
                for (int n = 0; n < 2; ++n) acc[a][b][m][n] = AccT{};
    bf16x8 At[4][2], B0[2][2], B1[2][2];
    unsigned aC[2][2];
    S.a_off(cur, tid, K, aC);
    const char* const Ab = (const char*)g.A;
    const char* cB = (const char*)g.Bt + (size_t)cur.pn * tstep;
    PG8_STAGE(PG8_SB(0, 0), cB, voffB); PG8_STAGE(PG8_SB(0, 1), cB + hstep, voffB); PG8_STAGE(PG8_SA(0, 0), Ab, aC[0]); PG8_STAGE(PG8_SA(0, 1), Ab, aC[1]);
    if (wr == 1) PG8_BAR;
    PG8_WAIT_V(2); PG8_BAR;
    PG8_STAGE(PG8_SB(1, 0), cB + kstep, voffB); PG8_STAGE(PG8_SA(1, 0), Ab + kstep, aC[0]); PG8_STAGE(PG8_SB(1, 1), cB + hstep + kstep, voffB);
    PG8_WAIT_V(6); PG8_BAR;
    for (;;) {
        const bool has_next = S.next(ui + 1, nxt);
        const char* nB = has_next ? (const char*)g.Bt + (size_t)nxt.pn * tstep : cB;
        for (int t = 0; t < nt; t += 2) {
            const bool last = (t == nt - 2);
            const char* a1 = Ab + (size_t)(t + 1) * kstep;
            const char* a2 = last ? Ab : Ab + (size_t)(t + 2) * kstep; const char* b2 = last ? nB : cB + (size_t)(t + 2) * kstep;
            const char* a3 = a2 + kstep; const char* b3 = b2 + kstep;
            PG8_LDB(B0, 0, 0); PG8_LDB(B1, 0, 1); PG8_SCHED; PG8_LDA(At, 0, 0); PG8_STAGE(PG8_SA(1, 1), a1, aC[1]);
            if (last && has_next) S.a_off(nxt, tid, K, aC);
            PG8_WAIT_V(8); PG8_WAIT_L(0); PG8_BAR; PG8_MMA(0, 0, At, B0); PG8_MMA(0, 1, At, B1); PG8_BAR; PG8_SCHED;
            PG8_LDA(At, 0, 1); PG8_STAGE(PG8_SB(0, 0), b2, voffB); PG8_STAGE(PG8_SB(0, 1), b2 + hstep, voffB); PG8_STAGE(PG8_SA(0, 0), a2, aC[0]);
            PG8_WAIT_V(8); PG8_WAIT_L(0); PG8_BAR; PG8_MMA(1, 0, At, B0); PG8_MMA(1, 1, At, B1); PG8_BAR; PG8_SCHED;
            PG8_LDB(B0, 1, 0); PG8_LDB(B1, 1, 1); PG8_SCHED; PG8_LDA(At, 1, 0); PG8_STAGE(PG8_SA(0, 1), a2, aC[1]);
            PG8_WAIT_V(8); PG8_WAIT_L(0); PG8_BAR; PG8_MMA(0, 0, At, B0); PG8_MMA(0, 1, At, B1); PG8_BAR; PG8_SCHED;
            PG8_LDA(At, 1, 1); PG8_STAGE(PG8_SB(1, 0), b3, voffB); PG8_STAGE(PG8_SB(1, 1), b3 + hstep, voffB); PG8_STAGE(PG8_SA(1, 0), a3, aC[0]);
            PG8_WAIT_V(8); PG8_WAIT_L(0); PG8_BAR; PG8_MMA(1, 0, At, B0); PG8_MMA(1, 1, At, B1); PG8_BAR; PG8_SCHED;
        }
        if constexpr (ALIGN_EPI) { if (wr == 0) PG8_BAR; }
        if constexpr (DRY == 0) E(acc, cur, wr, wc, fr, fq); else { _Pragma("unroll") for (int a = 0; a < 2; ++a) _Pragma("unroll") for (int b = 0; b < 2; ++b) _Pragma("unroll") for (int m = 0; m < 4; ++m) _Pragma("unroll") for (int n = 0; n < 2; ++n) asm volatile("" :: "v"(acc[a][b][m][n])); }
        if (!has_next) break;
#pragma unroll
        for (int a = 0; a < 2; ++a)
#pragma unroll
            for (int b = 0; b < 2; ++b)
#pragma unroll
                for (int m = 0; m < 4; ++m)
#pragma unroll
                    for (int n = 0; n < 2; ++n) acc[a][b][m][n] = AccT{};
        cur = nxt; cB = nB; ++ui;
        if constexpr (ALIGN_EPI) { if (wr == 1) PG8_BAR; }
    }
    PG8_WAIT_V(0);
    if constexpr (!ALIGN_EPI) { if (wr == 0) PG8_BAR; }
    PG8_BAR;
#undef PG8_SA
#undef PG8_SB
#undef PG8_STAGE
#undef PG8_LDA
#undef PG8_LDB
#undef PG8_MMA
#undef PG8_WAIT_V
#undef PG8_WAIT_L
#undef PG8_BAR
#undef PG8_SCHED
}
}
namespace pg8 {
typedef const f32x4 (&AccRef)[2][2][4][2];
typedef const i32x4 (&AccRefI)[2][2][4][2];
__device__ __forceinline__ f32x4 i2f(const i32x4 v) { return (f32x4){(float)v[0], (float)v[1], (float)v[2], (float)v[3]}; }

struct EpiInProj {
    static constexpr bool PERM = true; typedef f32x4 AccT;
    unsigned char* ws;
    __device__ __forceinline__ void operator()(AccRef acc, const Unit& u, int wr, int wc, int fr, int fq) const {
        const int pn = u.on, row0 = u.om * BM + wr * 64 + fr, cw = wc * 32 + 8 * fq;
        if (pn >= 4 && pn < 12) {
#pragma unroll
            for (int ai = 0; ai < 2; ++ai)
#pragma unroll
                for (int m = 0; m < 4; ++m) { const f32x4 v0 = acc[ai][0][m][0] * acc[ai][1][m][0], v1 = acc[ai][0][m][1] * acc[ai][1][m][1];
                    u32x4 w; w.x = cvt_pk_bf16(v0[0], v0[1]); w.y = cvt_pk_bf16(v0[2], v0[3]); w.z = cvt_pk_bf16(v1[0], v1[1]); w.w = cvt_pk_bf16(v1[2], v1[3]);
                    *(u32x4*)((bf16_t*)(ws + WS_U) + (size_t)(row0 + ai * HALF + m * 16) * D + (pn - 4) * 128 + cw) = w; }
            return;
        }
        size_t doff; int ldc = D, cb, mode = 0;
        if (pn < 4) { doff = WS_BG; cb = pn * 256; }
        else if (pn < 16) { doff = WS_Q; cb = (pn - 12) * 256; mode = 1; }
        else if (pn == 16) { doff = WS_K; cb = 0; ldc = 256; }
        else if (pn == 17) { doff = WS_V; cb = 0; ldc = 256; }
        else if (pn < 22) { doff = WS_GC; cb = (pn - 18) * 256; mode = 2; }
        else { doff = WS_GA; cb = (pn - 22) * 256; mode = 2; }
        bf16_t* dst = (bf16_t*)(ws + doff);
#pragma unroll
        for (int ai = 0; ai < 2; ++ai)
#pragma unroll
            for (int m = 0; m < 4; ++m) { bf16_t* rowp = dst + (size_t)(row0 + ai * HALF + m * 16) * ldc + cb + cw;
#pragma unroll
                for (int bj = 0; bj < 2; ++bj) { f32x4 v0 = acc[ai][bj][m][0], v1 = acc[ai][bj][m][1];
                    if (mode == 1) { v0 = v0 * QSCALE; v1 = v1 * QSCALE; }
                    if (mode == 2) {
#pragma unroll
                        for (int j = 0; j < 4; ++j) { v0[j] = fast_sigmoid(v0[j]); v1[j] = fast_sigmoid(v1[j]); } }
                    u32x4 w; w.x = cvt_pk_bf16(v0[0], v0[1]); w.y = cvt_pk_bf16(v0[2], v0[3]); w.z = cvt_pk_bf16(v1[0], v1[1]); w.w = cvt_pk_bf16(v1[2], v1[3]);
                    *(u32x4*)(rowp + bj * HALF) = w; } }
    }
};

struct EpiInProjI8 {
    static constexpr bool PERM = true; typedef i32x4 AccT;
    unsigned char* ws; float sw;
    __device__ __forceinline__ void operator()(AccRefI acc, const Unit& u, int wr, int wc, int fr, int fq) const {
        const int pn = u.on, row0 = u.om * BM + wr * 64 + fr, cw = wc * 32 + 8 * fq;
        const float* sx0 = (const float*)(ws + WS_SX0) + row0;
        float sxv[2][4];
#pragma unroll
        for (int ai = 0; ai < 2; ++ai)
#pragma unroll
            for (int m = 0; m < 4; ++m) sxv[ai][m] = sx0[ai * HALF + m * 16];
        if (pn >= 4 && pn < 12) {
#pragma unroll
            for (int ai = 0; ai < 2; ++ai)
#pragma unroll
                for (int m = 0; m < 4; ++m) { const float s = sxv[ai][m] * sw, s2 = s * s;
                    const f32x4 v0 = i2f(acc[ai][0][m][0]) * i2f(acc[ai][1][m][0]) * s2, v1 = i2f(acc[ai][0][m][1]) * i2f(acc[ai][1][m][1]) * s2;
                    u32x4 w; w.x = cvt_pk_bf16(v0[0], v0[1]); w.y = cvt_pk_bf16(v0[2], v0[3]); w.z = cvt_pk_bf16(v1[0], v1[1]); w.w = cvt_pk_bf16(v1[2], v1[3]);
                    *(u32x4*)((bf16_t*)(ws + WS_U) + (size_t)(row0 + ai * HALF + m * 16) * D + (pn - 4) * 128 + cw) = w; asm volatile("" ::: "memory"); }
            return;
        }
        size_t doff; int ldc = D, cb, mode = 0;
        if (pn < 4) { doff = WS_BG; cb = pn * 256; }
        else if (pn < 16) { doff = WS_Q; cb = (pn - 12) * 256; mode = 1; }
        else if (pn == 16) { doff = WS_K; cb = 0; ldc = 256; }
        else if (pn == 17) { doff = WS_V; cb = 0; ldc = 256; }
        else if (pn < 22) { doff = WS_GC; cb = (pn - 18) * 256; mode = 2; }
        else { doff = WS_GA; cb = (pn - 22) * 256; mode = 2; }
        bf16_t* dst = (bf16_t*)(ws + doff);
#pragma unroll
        for (int ai = 0; ai < 2; ++ai)
#pragma unroll
            for (int m = 0; m < 4; ++m) { bf16_t* rowp = dst + (size_t)(row0 + ai * HALF + m * 16) * ldc + cb + cw; const float s = sxv[ai][m] * sw * (mode == 1 ? QSCALE : 1.0f);
#pragma unroll
                for (int bj = 0; bj < 2; ++bj) { f32x4 v0 = i2f(acc[ai][bj][m][0]) * s, v1 = i2f(acc[ai][bj][m][1]) * s;
                    if (mode == 2) {
#pragma unroll
                        for (int j = 0; j < 4; ++j) { v0[j] = fast_sigmoid(v0[j]); v1[j] = fast_sigmoid(v1[j]); } }
                    u32x4 w; w.x = cvt_pk_bf16(v0[0], v0[1]); w.y = cvt_pk_bf16(v0[2], v0[3]); w.z = cvt_pk_bf16(v1[0], v1[1]); w.w = cvt_pk_bf16(v1[2], v1[3]);
                    *(u32x4*)(rowp + bj * HALF) = w; }
                asm volatile("" ::: "memory"); }
    }
};

struct EpiDual {
    static constexpr bool PERM = true; typedef f32x4 AccT;
    unsigned char* ws;
    __device__ __forceinline__ void operator()(AccRef acc, const Unit& u, int wr, int wc, int fr, int fq) const {
        const int row0 = u.om * BM + wr * 64 + fr, col0 = u.on * BM + wc * 32 + 8 * fq;
        const bf16_t* G = (const bf16_t*)(ws + (u.e == 0 ? WS_GC : WS_GA)); bf16_t* T1 = (bf16_t*)(ws + WS_T1); bf16_t* MG = (bf16_t*)(ws + WS_MG);
#pragma unroll
        for (int ai = 0; ai < 2; ++ai)
#pragma unroll
            for (int m = 0; m < 4; ++m) { const size_t ro = (size_t)(row0 + ai * HALF + m * 16) * D + col0;
#pragma unroll
                for (int bj = 0; bj < 2; ++bj) { const size_t o = ro + bj * HALF;
                    const u32x4 gw = *(const u32x4*)(G + o);
                    f32x4 g0 = {bflo(gw.x), bfhi(gw.x), bflo(gw.y), bfhi(gw.y)}, g1 = {bflo(gw.z), bfhi(gw.z), bflo(gw.w), bfhi(gw.w)};
                    f32x4 v0 = g0 * acc[ai][bj][m][0], v1 = g1 * acc[ai][bj][m][1];
                    if (u.e == 0) { u32x4 w; w.x = cvt_pk_bf16(v0[0], v0[1]); w.y = cvt_pk_bf16(v0[2], v0[3]); w.z = cvt_pk_bf16(v1[0], v1[1]); w.w = cvt_pk_bf16(v1[2], v1[3]); *(u32x4*)(T1 + o) = w; }
                    else { const u32x4 tw_ = *(const u32x4*)(T1 + o);
                        v0 = v0 + (f32x4){bflo(tw_.x), bfhi(tw_.x), bflo(tw_.y), bfhi(tw_.y)}; v1 = v1 + (f32x4){bflo(tw_.z), bfhi(tw_.z), bflo(tw_.w), bfhi(tw_.w)};
                        u32x4 w; w.x = cvt_pk_bf16(v0[0], v0[1]); w.y = cvt_pk_bf16(v0[2], v0[3]); w.z = cvt_pk_bf16(v1[0], v1[1]); w.w = cvt_pk_bf16(v1[2], v1[3]);
                        *(u32x4*)(MG + o) = w; } } }
    }
};

struct EpiResid {
    static constexpr bool PERM = false; typedef f32x4 AccT;
    const float* X; float* C;
    __device__ __forceinline__ void operator()(AccRef acc, const Unit& u, int wr, int wc, int fr, int fq) const {
        const int row0 = u.om * BM + wr * 64 + fr, col0 = u.on * BM + wc * 32 + 4 * fq;
#pragma unroll
        for (int ai = 0; ai < 2; ++ai)
#pragma unroll
            for (int m = 0; m < 4; ++m) { const size_t ro = (size_t)(row0 + ai * HALF + m * 16) * D + col0;
#pragma unroll
                for (int bj = 0; bj < 2; ++bj)
#pragma unroll
                    for (int n = 0; n < 2; ++n) { const size_t o = ro + bj * HALF + n * 16; *(f32x4*)(C + o) = *(const f32x4*)(X + o) * DN_ALPHA + acc[ai][bj][m][n]; } }
    }
};

struct EpiF32 {
    static constexpr bool PERM = false; typedef f32x4 AccT;
    float* C;
    __device__ __forceinline__ void operator()(AccRef acc, const Unit& u, int wr, int wc, int fr, int fq) const {
        const int row0 = u.om * BM + wr * 64 + fr, col0 = u.on * BM + wc * 32 + 4 * fq;
#pragma unroll
        for (int ai = 0; ai < 2; ++ai)
#pragma unroll
            for (int m = 0; m < 4; ++m) { const size_t ro = (size_t)(row0 + ai * HALF + m * 16) * D + col0;
#pragma unroll
                for (int bj = 0; bj < 2; ++bj)
#pragma unroll
                    for (int n = 0; n < 2; ++n) *(f32x4*)(C + ro + bj * HALF + n * 16) = acc[ai][bj][m][n]; }
    }
};
__device__ __forceinline__ void ple_epilogue(AccRef acc, const Unit& u, int wr, int wc, int fr, int fq, const float* P2, bf16_t* PLE) {
    const int row0 = u.om * BM + wr * 64 + fr, col0 = u.on * BM + wc * 32 + 8 * fq;
#pragma unroll
    for (int ai = 0; ai < 2; ++ai)
#pragma unroll
        for (int m = 0; m < 4; ++m) { const size_t ro = (size_t)(row0 + ai * HALF + m * 16) * D + col0;
#pragma unroll
            for (int bj = 0; bj < 2; ++bj) { const size_t o = ro + bj * HALF; const f32x4 p0 = *(const f32x4*)(P2 + o), p1 = *(const f32x4*)(P2 + o + 4); const f32x4 a0 = acc[ai][bj][m][0], a1 = acc[ai][bj][m][1];
                u32x4 w; w.x = cvt_pk_bf16(fast_sigmoid(a0[0]) * p0[0], fast_sigmoid(a0[1]) * p0[1]); w.y = cvt_pk_bf16(fast_sigmoid(a0[2]) * p0[2], fast_sigmoid(a0[3]) * p0[3]);
                w.z = cvt_pk_bf16(fast_sigmoid(a1[0]) * p1[0], fast_sigmoid(a1[1]) * p1[1]); w.w = cvt_pk_bf16(fast_sigmoid(a1[2]) * p1[2], fast_sigmoid(a1[3]) * p1[3]);
                *(u32x4*)(PLE + o) = w; }
            if (m & 1) asm volatile("" ::: "memory"); }
}

struct EpiSwiglu {
    static constexpr bool PERM = true; typedef f32x4 AccT;
    bf16_t* H; const float* b_gu; const LAS unsigned* tw; unsigned char* ws;
    __device__ __forceinline__ void operator()(AccRef acc, const Unit& u, int wr, int wc, int fr, int fq) const {
        if (u.e < 0) { ple_epilogue(acc, u, wr, wc, fr, fq, (const float*)(ws + WS_P2), (bf16_t*)(ws + WS_PLE)); return; }
        const int trow0 = wr * 64 + fr, row0 = u.om * BM + trow0, cw = wc * 32 + 8 * fq, col0 = u.on * 128 + cw;
        const float* bg = b_gu + (size_t)u.e * 2048 + col0;
#pragma unroll
        for (int n = 0; n < 2; ++n) { const f32x4 bgn = *(const f32x4*)(bg + 4 * n), bun = *(const f32x4*)(bg + 1024 + 4 * n);
#pragma unroll
            for (int ai = 0; ai < 2; ++ai)
#pragma unroll
                for (int m = 0; m < 4; ++m) { const float w = bfhi(tw[u.slot * BM + trow0 + ai * HALF + m * 16]);
                    const f32x4 gt = acc[ai][0][m][n] + bgn, up = acc[ai][1][m][n] + bun; f32x4 hv;
#pragma unroll
                    for (int j = 0; j < 4; ++j) { const float gv = fminf(gt[j], 7.0f), uv = fminf(fmaxf(up[j], -7.0f), 7.0f); hv[j] = (uv + 1.0f) * gv * fast_sigmoid(1.702f * gv) * w; }
                    u32x2 o; o.x = cvt_pk_bf16(hv[0], hv[1]); o.y = cvt_pk_bf16(hv[2], hv[3]);
                    *(u32x2*)(H + (size_t)(row0 + ai * HALF + m * 16) * D + col0 + 4 * n) = o; } }
    }
};
struct EpiSwigluI8 {
    static constexpr bool PERM = true; typedef i32x4 AccT;
    bf16_t* H; const float* b_gu; const LAS unsigned* tw; unsigned char* ws;
    __device__ __forceinline__ void operator()(AccRefI acc, const Unit& u, int wr, int wc, int fr, int fq) const {
        const int trow0 = wr * 64 + fr, row0 = u.om * BM + trow0, cw = wc * 32 + 8 * fq;
        const float* scl = (const float*)(ws + WS_SCL);
        if (u.e < 0) {
            const float* P2 = (const float*)(ws + WS_P2); bf16_t* PLE = (bf16_t*)(ws + WS_PLE); const float* sx1 = (const float*)(ws + WS_SX1);
            const float spg = scl[NE]; const int col0 = u.on * BM + cw;
#pragma unroll
            for (int ai = 0; ai < 2; ++ai)
#pragma unroll
                for (int m = 0; m < 4; ++m) { const int r = row0 + ai * HALF + m * 16; const float s = sx1[r] * spg; const size_t ro = (size_t)r * D + col0;
#pragma unroll
                    for (int bj = 0; bj < 2; ++bj) { const size_t o = ro + bj * HALF; const f32x4 p0 = *(const f32x4*)(P2 + o), p1 = *(const f32x4*)(P2 + o + 4); const f32x4 a0 = i2f(acc[ai][bj][m][0]) * s, a1 = i2f(acc[ai][bj][m][1]) * s;
                        u32x4 w; w.x = cvt_pk_bf16(fast_sigmoid(a0[0]) * p0[0], fast_sigmoid(a0[1]) * p0[1]); w.y = cvt_pk_bf16(fast_sigmoid(a0[2]) * p0[2], fast_sigmoid(a0[3]) * p0[3]);
                        w.z = cvt_pk_bf16(fast_sigmoid(a1[0]) * p1[0], fast_sigmoid(a1[1]) * p1[1]); w.w = cvt_pk_bf16(fast_sigmoid(a1[2]) * p1[2], fast_sigmoid(a1[3]) * p1[3]);
                        *(u32x4*)(PLE + o) = w; }
                    if (m & 1) asm volatile("" ::: "memory"); }
            return; }
        const int col0 = u.on * 128 + cw;
        const float* bg = b_gu + (size_t)u.e * 2048 + col0; const float sg = scl[u.e];
        const float* lsx = (const float*)(ws + WS_LSX) + (size_t)u.e * LISTCAP + u.mt * BM + trow0;
        const f32x4 bg0 = *(const f32x4*)(bg), bg1 = *(const f32x4*)(bg + 4), bu0 = *(const f32x4*)(bg + 1024), bu1 = *(const f32x4*)(bg + 1028);
        unsigned char* H8 = (unsigned char*)H;
        float lsv[2][4];
#pragma unroll
        for (int ai = 0; ai < 2; ++ai)
#pragma unroll
            for (int m = 0; m < 4; ++m) lsv[ai][m] = lsx[ai * HALF + m * 16];
#pragma unroll
        for (int ai = 0; ai < 2; ++ai)
#pragma unroll
            for (int m = 0; m < 4; ++m) { const unsigned twv = tw[u.slot * BM + trow0 + ai * HALF + m * 16]; const float qh = bfhi(twv);
                const float s = (qh != 0.f ? lsv[ai][m] : 0.f) * sg;
                unsigned q8[2];
#pragma unroll
                for (int n = 0; n < 2; ++n) { const f32x4 gt = i2f(acc[ai][0][m][n]) * s + (n == 0 ? bg0 : bg1), up = i2f(acc[ai][1][m][n]) * s + (n == 0 ? bu0 : bu1); unsigned q = 0u;
#pragma unroll
                    for (int j = 0; j < 4; ++j) { const float gv = fminf(gt[j], 7.0f), uv = __builtin_amdgcn_fmed3f(up[j], -7.0f, 7.0f);
                        const float sg_ = __builtin_amdgcn_rcpf(1.0f + __builtin_amdgcn_exp2f((-1.702f * LOG2E) * gv));
                        const float hq = __builtin_fmaf(__builtin_fmaf(uv, gv, gv) * sg_, qh, 128.0f);
                        q = __builtin_amdgcn_cvt_pk_u8_f32(__builtin_amdgcn_fmed3f(__builtin_rintf(hq), 1.0f, 255.0f), j, q); }
                    q8[n] = q ^ 0x80808080u; }
                *(u32x2*)(H8 + (size_t)(row0 + ai * HALF + m * 16) * D + col0) = (u32x2){q8[0], q8[1]};
                if (m & 1) asm volatile("" ::: "memory"); }
    }
};
struct EpiDownI8 {
    static constexpr bool PERM = true; typedef i32x4 AccT;
    bf16_t* Y; unsigned char* ws; const LAS int* cntL;
    __device__ __forceinline__ void operator()(AccRefI acc, const Unit& u, int wr, int wc, int fr, int fq) const {
        const int trow0 = wr * 64 + fr, row0 = u.om * BM + trow0, cw = wc * 32 + 8 * fq;
        const float* scl = (const float*)(ws + WS_SCL);
        if (u.e < 0) {
            const float* P2 = (const float*)(ws + WS_P2); bf16_t* PLE = (bf16_t*)(ws + WS_PLE); const float* sx1 = (const float*)(ws + WS_SX1);
            const float spg = scl[NE]; const int col0 = u.on * BM + cw;
#pragma unroll
            for (int ai = 0; ai < 2; ++ai)
#pragma unroll
                for (int m = 0; m < 4; ++m) { const int r = row0 + ai * HALF + m * 16; const float s = sx1[r] * spg; const size_t ro = (size_t)r * D + col0;
#pragma unroll
                    for (int bj = 0; bj < 2; ++bj) { const size_t o = ro + bj * HALF; const f32x4 p0 = *(const f32x4*)(P2 + o), p1 = *(const f32x4*)(P2 + o + 4); const f32x4 a0 = i2f(acc[ai][bj][m][0]) * s, a1 = i2f(acc[ai][bj][m][1]) * s;
                        u32x4 w; w.x = cvt_pk_bf16(fast_sigmoid(a0[0]) * p0[0], fast_sigmoid(a0[1]) * p0[1]); w.y = cvt_pk_bf16(fast_sigmoid(a0[2]) * p0[2], fast_sigmoid(a0[3]) * p0[3]);
                        w.z = cvt_pk_bf16(fast_sigmoid(a1[0]) * p1[0], fast_sigmoid(a1[1]) * p1[1]); w.w = cvt_pk_bf16(fast_sigmoid(a1[2]) * p1[2], fast_sigmoid(a1[3]) * p1[3]);
                        *(u32x4*)(PLE + o) = w; }
                    if (m & 1) asm volatile("" ::: "memory"); }
            return; }
        const float sd = scl[128 + u.e]; const int cnt = cntL[u.e], li0 = u.mt * BM + trow0;
        const float* lhs = (const float*)(ws + WS_LHS) + (size_t)u.e * LISTCAP + li0;
        bf16_t* yp = Y + (size_t)row0 * D + u.on * BM + cw;
        float lhv[2][4];
#pragma unroll
        for (int ai = 0; ai < 2; ++ai)
#pragma unroll
            for (int m = 0; m < 4; ++m) lhv[ai][m] = lhs[ai * HALF + m * 16];
#pragma unroll
        for (int ai = 0; ai < 2; ++ai)
#pragma unroll
            for (int m = 0; m < 4; ++m) { const int dr = ai * HALF + m * 16; const float s = ((li0 + dr) < cnt ? lhv[ai][m] : 0.f) * sd;
#pragma unroll
                for (int bj = 0; bj < 2; ++bj) { const f32x4 v0 = i2f(acc[ai][bj][m][0]) * s, v1 = i2f(acc[ai][bj][m][1]) * s;
                    u32x4 o; o.x = cvt_pk_bf16(v0[0], v0[1]); o.y = cvt_pk_bf16(v0[2], v0[3]); o.z = cvt_pk_bf16(v1[0], v1[1]); o.w = cvt_pk_bf16(v1[2], v1[3]);
                    *(u32x4*)(yp + (size_t)dr * D + bj * HALF) = o; }
                if (m & 1) asm volatile("" ::: "memory"); }
    }
};
struct EpiDown {
    static constexpr bool PERM = true; typedef f32x4 AccT;
    bf16_t* Y; unsigned char* ws;
    __device__ __forceinline__ void operator()(AccRef acc, const Unit& u, int wr, int wc, int fr, int fq) const {
        if (u.e < 0) { ple_epilogue(acc, u, wr, wc, fr, fq, (const float*)(ws + WS_P2), (bf16_t*)(ws + WS_PLE)); return; }
        bf16_t* yp = Y + (size_t)(u.om * BM + wr * 64 + fr) * D + u.on * BM + wc * 32 + 8 * fq;
#pragma unroll
        for (int ai = 0; ai < 2; ++ai)
#pragma unroll
            for (int m = 0; m < 4; ++m)
#pragma unroll
                for (int bj = 0; bj < 2; ++bj) { const f32x4 v0 = acc[ai][bj][m][0], v1 = acc[ai][bj][m][1];
                    u32x4 o; o.x = cvt_pk_bf16(v0[0], v0[1]); o.y = cvt_pk_bf16(v0[2], v0[3]); o.z = cvt_pk_bf16(v1[0], v1[1]); o.w = cvt_pk_bf16(v1[2], v1[3]);
                    *(u32x4*)(yp + (size_t)(ai * HALF + m * 16) * D + bj * HALF) = o; }
    }
};

struct DualOrder {
    StaticOrder so;
    __device__ __forceinline__ bool next(int i, Unit& u) const {
        int pm, pn, q; if (!so.tile(i >> 1, pm, pn, q)) return false;
        const int e = i & 1; u.pm = e * (M / BM) + pm; u.pn = e * 4 + pn; u.om = pm; u.on = pn; u.e = e; u.mt = 0; u.slot = 0; return true;
    }
    __device__ __forceinline__ void a_off(const Unit& u, int tid, int K, unsigned (&o)[2][2]) const { plain_a_off(u.pm, tid, K, o); }
};
struct MoeOrder {
    const LAS int* cntL; const LAS int* tsL; const LAS unsigned* tw; int NT, gather, btile0, btile_ple, n_extra, extra_first; unsigned abase, abase_ple; int U, UT, G, c; const LAS int* utab; int nunits;
    __device__ __forceinline__ void init(const LAS int* cntL_, const LAS int* tsL_, const LAS unsigned* tw_, int NT_, int G_, int c_, int gather_, size_t aoff_, size_t boff_, int n_extra_, int extra_first_, size_t aoff_ple_, size_t boff_ple_, int tshift_) {
        cntL = cntL_; tsL = tsL_; tw = tw_; NT = NT_; gather = gather_; abase = (unsigned)aoff_; btile0 = (int)(boff_ >> tshift_); abase_ple = (unsigned)aoff_ple_; btile_ple = (int)(boff_ple_ >> tshift_); n_extra = n_extra_; extra_first = extra_first_;
        U = __builtin_amdgcn_readfirstlane(tsL_[NE]) * NT_; UT = U + n_extra_; G = G_; c = c_; utab = nullptr; nunits = 0; }
    struct Own { int ok, maxT, maxC, totalFree; };
    __device__ __forceinline__ Own own_params(int split) const {
        Own o; int mx = 0, sumT = 0;
        for (int e = 0; e < NE; ++e) { const int T = tsL[e + 1] - tsL[e]; mx = T > mx ? T : mx; sumT += T; }
        o.maxT = mx; o.maxC = split == 1 ? mx : (mx + 1) >> 1; o.ok = 0;
        o.totalFree = split == 1 ? 8 * (NE * o.maxC - sumT) : 4 * (2 * NE * o.maxC - sumT);
        return o;
    }
    __device__ __forceinline__ static int ple_in_p5(const LAS int* tsL_, int G_) {
        int mx = 0, sumT = 0;
        for (int e = 0; e < NE; ++e) { const int T = tsL_[e + 1] - tsL_[e]; mx = T > mx ? T : mx; sumT += T; }
        int nfree;
        { const int U5 = sumT * 8; nfree = (G_ - U5 % G_) % G_; }
        return nfree < 256 ? nfree : 256;
    }
    __device__ __forceinline__ void build_units(LAS int* tab, int maxu, int tid, int p, int split) {
        const Own o = own_params(split);
        if (o.ok) {
            const int e = p >> 3, sub = p & 7, nt = split == 1 ? sub : sub >> 1, half = split == 1 ? 0 : sub & 1;
            const int t0 = tsL[e], T = tsL[e + 1] - t0, h0 = (T + 1) >> 1;
            const int myc = split == 1 ? T : (half ? T - h0 : h0), mt0 = (split == 2 && half) ? h0 : 0, myfree = o.maxC - myc;
            int prefix = 0;
            for (int k = 0; k < e; ++k) { const int Tk = tsL[k + 1] - tsL[k]; prefix += split == 1 ? 8 * (o.maxC - Tk) : 4 * (2 * o.maxC - Tk); }
            prefix += split == 1 ? sub * (o.maxC - T) : (sub >> 1) * (2 * o.maxC - T) + (half ? (o.maxC - h0) : 0);
            int nfill = n_extra - prefix; nfill = nfill < 0 ? 0 : (nfill > myfree ? myfree : nfill);
            int nover = 0; if (n_extra > o.totalFree) { const int rem = n_extra - o.totalFree - p; nover = rem > 0 ? (rem + 255) >> 8 : 0; }
            int n = myc + nfill + nover; if (n > maxu) n = maxu;
            if (tid < n) { LAS int* q = tab + 8 * tid;
                if (tid < myc) { const int mt = mt0 + tid; q[0] = t0 + mt; q[1] = btile0 + e * NT + nt; q[2] = nt; q[3] = e; q[4] = mt; }
                else { const int k = tid - myc; const int idx = k < nfill ? prefix + k : o.totalFree + (k - nfill) * 256 + p;
                    const int j = extra_first + idx, pm = (j >> 5) * 8 + (j & 7), pn = (j & 31) >> 3; q[0] = pm; q[1] = btile_ple + pn; q[2] = pn; q[3] = -1; q[4] = 0; } }
            __syncthreads();
            utab = tab; nunits = n; return;
        }
        if (tid < maxu) { const int L = tid * G + c;
            if (L < UT) { LAS int* q = tab + 8 * tid;
                if (L >= U) { const int j = extra_first + (L - U), pm = (j >> 5) * 8 + (j & 7), pn = (j & 31) >> 3; q[0] = pm; q[1] = btile_ple + pn; q[2] = pn; q[3] = -1; q[4] = 0; }
                else { const int wgid = xcd_remap(L, U); int e = 0;
                    for (int k = 1; k < NE; ++k) e += (wgid >= tsL[k] * NT) ? 1 : 0;
                    const int t0 = tsL[e], ntl = tsL[e + 1] - t0, r = wgid - t0 * NT, nt = r / ntl, mt = r - nt * ntl;
                    q[0] = t0 + mt; q[1] = btile0 + e * NT + nt; q[2] = nt; q[3] = e; q[4] = mt; } } }
        __syncthreads();
        utab = tab; nunits = c < UT ? (UT - 1 - c) / G + 1 : 0; if (nunits > maxu) nunits = maxu;
    }
    __device__ __forceinline__ bool next(int i, Unit& u) const {
        if (i >= nunits) return false;
        const LAS int* p = utab + 8 * i;
        u.pm = __builtin_amdgcn_readfirstlane(p[0]); u.pn = __builtin_amdgcn_readfirstlane(p[1]); u.om = u.pm; u.on = __builtin_amdgcn_readfirstlane(p[2]);
        u.e = __builtin_amdgcn_readfirstlane(p[3]); u.mt = __builtin_amdgcn_readfirstlane(p[4]); u.slot = i; return true;
    }
    __device__ __forceinline__ void a_off(const Unit& u, int tid, int K, unsigned (&o)[2][2]) const {
        if (u.e < 0 || !gather) { plain_a_off(u.pm, tid, K, o); const unsigned base = u.e < 0 ? abase_ple : abase;
#pragma unroll
            for (int h = 0; h < 2; ++h)
#pragma unroll
                for (int i = 0; i < 2; ++i) o[h][i] += base;
            return; }
#pragma unroll
        for (int i = 0; i < 2; ++i) { int R, C; stage_rc(tid * 16 + i * 8192, R, C);
#pragma unroll
            for (int h = 0; h < 2; ++h) { const int tok = (int)(tw[u.slot * BM + h * HALF + R] & 0xffffu);
                o[h][i] = (unsigned)(tok * K + C) * 2u + abase; } }
    }
};
constexpr int MOE_MAXU = 10;
__device__ __forceinline__ void moe_preload(const MoeOrder& S, const LAS int* cntL, const int* list_tok, const float* list_w, LAS unsigned* tw, int wvid) {
    int tid_ = (wvid * 64 + lane_id_asm()); asm volatile("" : "+v"(tid_)); const int tid = tid_;
    int tokv[MOE_MAXU / 2]; float wv[MOE_MAXU / 2];
#pragma unroll
    for (int k = 0; k < MOE_MAXU / 2; ++k) { const int ent = tid + NTHREADS * k, slot = ent >> 8, row = ent & 255; tokv[k] = 0; wv[k] = 0.f;
        if (slot < S.nunits) { const LAS int* p = S.utab + 8 * slot; const int e = p[3], mt = p[4], li = mt * BM + row;
            if (e >= 0 && li < cntL[e]) { tokv[k] = list_tok[(size_t)e * LISTCAP + li]; wv[k] = list_w[(size_t)e * LISTCAP + li]; } } }
#pragma unroll
    for (int k = 0; k < MOE_MAXU / 2; ++k) { const int ent = tid + NTHREADS * k; if ((ent >> 8) < S.nunits) tw[ent] = (unsigned)tokv[k] | (f2bf(wv[k]) << 16); }
    __syncthreads();
}
struct Ple1Order {
    int first, n;
    __device__ __forceinline__ bool next(int i, Unit& u) const { if (i >= n) return false; const int j = first + i, pm = (j >> 5) * 8 + (j & 7), pn = (j & 31) >> 3;
        u.pm = pm; u.pn = pn; u.om = pm; u.on = pn; u.e = 0; u.mt = 0; u.slot = 0; return true; }
    __device__ __forceinline__ void a_off(const Unit& u, int tid, int K, unsigned (&o)[2][2]) const { plain_a_off(u.pm, tid, K, o); }
};
}
__device__ __forceinline__ int dst_row(int n, int map) {
    if (map == 1) { if (n >= 1024 && n < 3072) { const int hsel = n >= 2048, c = n - 1024 - hsel * 1024; return 1024 + (c >> 7) * 256 + hsel * 128 + (c & 127); } return n; }
    if (map == 2) { const int hsel = n >= 1024, c = n - hsel * 1024; return (c >> 7) * 256 + hsel * 128 + (c & 127); }
    return n;
}
struct P0Args { const float *x, *p, *w_in, *w_brc, *w_bra, *w_out, *w_pg, *w_pp, *w_gu, *w_dn; unsigned char* ws; float s_in; };
struct P0Item { const float* src; bf16_t* dst; int K, N; float qinv; };
constexpr int P0_I_IN = 16 * (NIN / 64), P0_I_SQ = 16 * 16, P0_I_PP = 4 * 16, P0_I_GU = 16 * 32, P0_I_DN = 16 * 16;
constexpr int P0_NSMALL = P0_I_IN + 3 * P0_I_SQ + P0_I_PP;
constexpr int P0_NITEMS = P0_I_IN + 4 * P0_I_SQ + P0_I_PP + NE * P0_I_GU + NE * P0_I_DN;
__device__ __forceinline__ P0Item p0_decode(const P0Args& a, int it) {
    const float* W; bf16_t* WT; int K = D, N = D, map = 0, r = it; float qinv = 0.f; const float* scl = (const float*)(a.ws + WS_SCL);
    if (r < P0_I_IN) { W = a.w_in; WT = (bf16_t*)(a.ws + WS_WIN); N = NIN; map = 1; qinv = 1.0f / a.s_in; }
    else if ((r -= P0_I_IN) < P0_I_SQ) { W = a.w_brc; WT = (bf16_t*)(a.ws + WS_WBR); }
    else if ((r -= P0_I_SQ) < P0_I_SQ) { W = a.w_bra; WT = (bf16_t*)(a.ws + WS_WBR) + (size_t)D * D; }
    else if ((r -= P0_I_SQ) < P0_I_SQ) { W = a.w_out; WT = (bf16_t*)(a.ws + WS_WOUT); }
    else if ((r -= P0_I_SQ) < P0_I_PP) { W = a.w_pp; WT = (bf16_t*)(a.ws + WS_WPP); K = DPLE; }
    else if ((r -= P0_I_PP) < P0_I_SQ) { W = a.w_pg; WT = (bf16_t*)(a.ws + WS_WPG8); qinv = 1.0f / scl[NE]; }
    else if ((r -= P0_I_SQ) < NE * P0_I_GU) { const int e = r / P0_I_GU; r -= e * P0_I_GU; W = a.w_gu + (size_t)e * D * 2048; WT = (bf16_t*)(a.ws + WS_WGU + (size_t)e * 2048 * D); N = 2048; map = 2; qinv = 1.0f / scl[e]; }
    else { r -= NE * P0_I_GU; const int e = r / P0_I_DN; r -= e * P0_I_DN; W = a.w_dn + (size_t)e * D * D; WT = (bf16_t*)(a.ws + WS_WDN + (size_t)e * D * D); qinv = 1.0f / scl[128 + e]; }
    const int nblk = N / 64, kb = r / nblk, nb = r - kb * nblk, k0 = 64 * kb, n0 = 64 * nb;
    P0Item d; d.src = W + (size_t)k0 * N + n0; d.K = K; d.N = N; d.qinv = qinv;
    d.dst = qinv != 0.f ? (bf16_t*)((unsigned char*)WT + (size_t)dst_row(n0, map) * K + k0) : WT + (size_t)dst_row(n0, map) * K + k0; return d;
}
__device__ __forceinline__ void p0_load(const P0Item& d, f32x4 (&v)[16], int lane) {
    const int lr = lane >> 4, lc = (lane & 15) * 4;
#pragma unroll
    for (int i = 0; i < 16; ++i) v[i] = __builtin_nontemporal_load((const f32x4*)(d.src + (size_t)(4 * i + lr) * d.N + lc));
}
__device__ __forceinline__ void p0_store(const P0Item& d, const f32x4 (&v)[16], LAS float* scr, int lane) {
    const int lr = lane >> 4, lc = (lane & 15) * 4;
#pragma unroll
    for (int i = 0; i < 16; ++i) { LAS float* s = scr + (4 * i + lr) * 65 + lc; s[0] = v[i][0]; s[1] = v[i][1]; s[2] = v[i][2]; s[3] = v[i][3]; }
    asm volatile("s_waitcnt lgkmcnt(0)" ::: "memory");
    const int c = lane & 7;
#pragma unroll
    for (int j = 0; j < 8; ++j) { const int n = (lane >> 3) + 8 * j; const LAS float* s = scr + (8 * c) * 65 + n;
        if (d.qinv != 0.f) { unsigned lo = 0u, hi = 0u;
#pragma unroll
            for (int q = 0; q < 4; ++q) { const int a0 = (int)fminf(fmaxf(rintf(s[q * 65] * d.qinv), -127.f), 127.f), a1 = (int)fminf(fmaxf(rintf(s[(q + 4) * 65] * d.qinv), -127.f), 127.f);
                lo |= ((unsigned)a0 & 0xffu) << (8 * q); hi |= ((unsigned)a1 & 0xffu) << (8 * q); }
            *(u32x2*)((unsigned char*)d.dst + (size_t)n * d.K + 8 * c) = (u32x2){lo, hi}; }
        else { u32x4 o; o.x = pk2(s[0 * 65], s[1 * 65]); o.y = pk2(s[2 * 65], s[3 * 65]); o.z = pk2(s[4 * 65], s[5 * 65]); o.w = pk2(s[6 * 65], s[7 * 65]);
            *(u32x4*)(d.dst + (size_t)n * d.K + 8 * c) = o; } }
    asm volatile("s_waitcnt lgkmcnt(0)" ::: "memory");
}
constexpr int P0_FILL = 2, P0_FILL_SEAMS = 4;
__device__ __forceinline__ void p0_fill(const P0Args& a, LAS unsigned char* lds, int vcu, int G, int seam, int wave) {
    const int lane = lane_id_asm();
    LAS float* scr = (LAS float*)(lds + wave * 16640);
    const int base = P0_NSMALL + (((seam - 1) * G + vcu) * 7 + (wave - 1)) * P0_FILL;
    f32x4 va[16], vb[16];
    const P0Item da = p0_decode(a, base); p0_load(da, va, lane);
    if (P0_FILL >= 2) { const P0Item db = p0_decode(a, base + 1); p0_load(db, vb, lane); p0_store(da, va, scr, lane);
        if (P0_FILL >= 3) { const P0Item dc = p0_decode(a, base + 2); p0_load(dc, va, lane); p0_store(db, vb, scr, lane); p0_store(dc, va, scr, lane); }
        else p0_store(db, vb, scr, lane); }
    else p0_store(da, va, scr, lane);
}
__device__ __forceinline__ float sample_scale(const float* Wm, unsigned stride, LAS unsigned char* lds, int wvid, float* rms_out = nullptr) {
    int tid_ = (wvid * 64 + lane_id_asm()); asm volatile("" : "+v"(tid_)); const int tid = tid_;
    const unsigned so = (unsigned)tid * stride;
    const f32x4 v0 = *(const f32x4*)(Wm + so), v1 = *(const f32x4*)(Wm + so + 4);
    float ss = (v0[0] * v0[0] + v0[1] * v0[1]) + (v0[2] * v0[2] + v0[3] * v0[3]) + (v1[0] * v1[0] + v1[1] * v1[1]) + (v1[2] * v1[2] + v1[3] * v1[3]);
    float mx = fmaxf(fmaxf(fmaxf(fabsf(v0[0]), fabsf(v0[1])), fmaxf(fabsf(v0[2]), fabsf(v0[3]))), fmaxf(fmaxf(fabsf(v1[0]), fabsf(v1[1])), fmaxf(fabsf(v1[2]), fabsf(v1[3]))));
    ss = wave_sum(ss);
#pragma unroll
    for (int o = 1; o < 64; o <<= 1) mx = fmaxf(mx, __shfl_xor(mx, o));
    LAS float* red = (LAS float*)lds;
    __syncthreads();
    if ((tid & 63) == 0) { red[tid >> 6] = ss; red[8 + (tid >> 6)] = mx; }
    __syncthreads();
    float s = 0.f, m = 0.f;
#pragma unroll
    for (int w = 0; w < NWAVES; ++w) { s += red[w]; m = fmaxf(m, red[8 + w]); }
    __syncthreads();
    const float rms = sqrtf(s * (1.0f / 4096.0f)); if (rms_out) *rms_out = rms;
    return fmaxf(fmaxf(6.5f * rms, 1.25f * m), 1e-30f) * (1.0f / 127.0f);
}
__device__ __forceinline__ void p0_calibrate(const P0Args& a, LAS unsigned char* lds, int vcu, int wvid) {
    if (vcu > 2 * NE) return;
    float rms = 0.f;
    const float* Wm = vcu < NE ? a.w_gu + (size_t)vcu * D * 2048 : (vcu == NE ? a.w_pg : a.w_dn + (size_t)(vcu - NE - 1) * D * D);
    const float sc = sample_scale(Wm, vcu < NE ? 4100 : 2044, lds, wvid, &rms);
    if ((wvid * 64 + lane_id_asm()) == 0) { float* scl = (float*)(a.ws + WS_SCL); if (vcu <= NE) scl[vcu] = sc; else scl[128 + vcu - NE - 1] = sc; if (vcu < NE) scl[64 + vcu] = rms; }
}
__device__ __forceinline__ void p0_phase(const P0Args& a, LAS unsigned char* lds, int vcu, int G, int it_lo, int it_hi, bool do_xp, int wvid) {
    int tid_ = (wvid * 64 + lane_id_asm()); asm volatile("" : "+v"(tid_));
    const int tid = tid_, lane = tid & 63, wave = __builtin_amdgcn_readfirstlane(tid >> 6);
    LAS float* scr = (LAS float*)(lds + wave * 16640);
    const int gw = vcu * NWAVES + wave, NGW = G * NWAVES;
    f32x4 va[16], vb[16]; P0Item da, db;
    int it = it_lo + gw;
    if (it < it_hi) { da = p0_decode(a, it); p0_load(da, va, lane); }
    while (it < it_hi) {
        const bool hb = it + NGW < it_hi;
        if (hb) { db = p0_decode(a, it + NGW); p0_load(db, vb, lane); }
        p0_store(da, va, scr, lane);
        if (!hb) break;
        const bool ha = it + 2 * NGW < it_hi;
        if (ha) { da = p0_decode(a, it + 2 * NGW); p0_load(da, va, lane); }
        p0_store(db, vb, scr, lane);
        if (!ha) break;
        it += 2 * NGW;
    }
    if (!do_xp) return;
    p0_calibrate(a, lds, vcu, wvid);
    const int gt = vcu * NTHREADS + tid, NGT = G * NTHREADS;
    for (int t0 = 2 * gw; t0 < M; t0 += 2 * NGW) { f32x4 v[2][4];
#pragma unroll
        for (int x = 0; x < 2; ++x)
#pragma unroll
            for (int j = 0; j < 4; ++j) v[x][j] = __builtin_nontemporal_load((const f32x4*)(a.x + (size_t)(t0 + x) * D + 256 * j + 4 * lane));
#pragma unroll
        for (int x = 0; x < 2; ++x) { float am = 0.f;
#pragma unroll
            for (int j = 0; j < 4; ++j) am = fmaxf(am, fmaxf(fmaxf(fabsf(v[x][j][0]), fabsf(v[x][j][1])), fmaxf(fabsf(v[x][j][2]), fabsf(v[x][j][3]))));
#pragma unroll
            for (int o = 1; o < 64; o <<= 1) am = fmaxf(am, __shfl_xor(am, o));
            const float sxr = fmaxf(am, 1e-30f) * (1.0f / 127.0f), qi = 1.0f / sxr;
#pragma unroll
            for (int j = 0; j < 4; ++j) { unsigned q = 0u;
#pragma unroll
                for (int z = 0; z < 4; ++z) q |= ((unsigned)(int)rintf(v[x][j][z] * qi) & 0xffu) << (8 * z);
                *(unsigned*)(a.ws + WS_XB + (size_t)(t0 + x) * D + 256 * j + 4 * lane) = q; }
            if (lane == 0) ((float*)(a.ws + WS_SX0))[t0 + x] = sxr; } }
    for (int i = gt; i < M * DPLE / 8; i += 4 * NGT) { f32x4 v[4][2];
#pragma unroll
        for (int u = 0; u < 4; ++u) { const size_t o = (size_t)(i + u * NGT) * 8; v[u][0] = __builtin_nontemporal_load((const f32x4*)(a.p + o)); v[u][1] = __builtin_nontemporal_load((const f32x4*)(a.p + o + 4)); }
#pragma unroll
        for (int u = 0; u < 4; ++u) { u32x4 o; o.x = pk2(v[u][0][0], v[u][0][1]); o.y = pk2(v[u][0][2], v[u][0][3]); o.z = pk2(v[u][1][0], v[u][1][1]); o.w = pk2(v[u][1][2], v[u][1][3]);
            *(u32x4*)((bf16_t*)(a.ws + WS_PB) + (size_t)(i + u * NGT) * 8) = o; } }
}

__device__ __forceinline__ int crow(int r, int hi) { return (r & 3) + 8 * (r >> 2) + 4 * hi; }
typedef short v4i16_t __attribute__((ext_vector_type(4)));
__device__ __forceinline__ s16x4 vtr(const LAS unsigned char* p) { return __builtin_bit_cast(s16x4, __builtin_amdgcn_ds_read_tr16_b64_v4i16((LAS v4i16_t*)p)); }
__device__ __forceinline__ void attn_unit(LAS unsigned char* lds, const bf16_t* Q, const bf16_t* Kg, const bf16_t* Vg, const float* sinks, bf16_t* O, int b, int kvh, int nb, int wvid) {
    int tid_ = (wvid * 64 + lane_id_asm()); asm volatile("" : "+v"(tid_));
    const int tid = tid_, lane = tid & 63, r32 = lane & 31, hi = lane >> 5; const int wid = __builtin_amdgcn_readfirstlane(tid >> 6);
    const int t0 = b * SEQ + nb * 128;
#pragma unroll
    for (int it = 0; it < 4; ++it) { const int idx = tid + it * NTHREADS, key = idx >> 3, c = idx & 7;
        int row = t0 - 128 + key; if (row < b * SEQ) row = b * SEQ;
        const u32x4 kv = *(const u32x4*)(Kg + (size_t)row * 256 + kvh * HD + c * 8);
        const u32x4 vv = *(const u32x4*)(Vg + (size_t)row * 256 + kvh * HD + c * 8);
        *(LAS u32x4*)(lds + c * 4096 + key * 16) = kv;
        *(LAS u32x4*)(lds + 32768 + (c >> 2) * 16384 + (key >> 4) * 1024 + (key & 15) * 64 + (c & 3) * 16) = vv; }
    __syncthreads();
    const int g = wid >> 1, half = wid & 1, h = kvh * 4 + g;
    const float sink2 = sinks[h] * LOG2E;
    const LAS unsigned char* vbase = lds + 32768 + ((lane >> 4) & 1) * 32 + (lane & 3) * 8 + (4 * hi + ((lane & 15) >> 2)) * 64;
#pragma unroll 1
    for (int qq = 0; qq < 2; ++qq) {
        const int qt = half * 2 + qq;
        const bf16_t* qp = Q + (size_t)(t0 + 32 * qt + r32) * D + h * HD + hi * 8;
        bf16x8 qr[4];
#pragma unroll
        for (int d0 = 0; d0 < 4; ++d0) qr[d0] = *(const bf16x8*)(qp + d0 * 16);
        f32x16 s[5];
#pragma unroll
        for (int j = 0; j < 5; ++j) { const LAS unsigned char* kp = lds + hi * 4096 + ((qt + j) * 32 + r32) * 16; f32x16 a = {};
#pragma unroll
            for (int d0 = 0; d0 < 4; ++d0) a = __builtin_amdgcn_mfma_f32_32x32x16_bf16(*(const LAS bf16x8*)(kp + d0 * 8192), qr[d0], a, 0, 0, 0);
            s[j] = a; }
#pragma unroll
        for (int r = 0; r < 16; ++r) { const int cr = crow(r, hi); if (cr <= r32) s[0][r] = -INFINITY; if (cr > r32) s[4][r] = -INFINITY; }
        if (nb == 0) {
#pragma unroll
            for (int j = 0; j < 4; ++j) if (qt + j < 4) {
#pragma unroll
                for (int r = 0; r < 16; ++r) s[j][r] = -INFINITY; } }
        float mx = -INFINITY;
#pragma unroll
        for (int j = 0; j < 5; ++j)
#pragma unroll
            for (int r = 0; r < 16; ++r) mx = fmaxf(mx, s[j][r]);
        mx = fmaxf(mx, __shfl_xor(mx, 32)); mx = fmaxf(mx, sink2);
        float ls = 0.f;
#pragma unroll
        for (int j = 0; j < 5; ++j)
#pragma unroll
            for (int r = 0; r < 16; ++r) { s[j][r] = __builtin_amdgcn_exp2f(s[j][r] - mx); ls += s[j][r]; }
        ls += __shfl_xor(ls, 32); ls += __builtin_amdgcn_exp2f(sink2 - mx);
        const float linv = 1.0f / ls;
        f32x16 o[2]; o[0] = f32x16{}; o[1] = f32x16{};
#pragma unroll
        for (int j = 0; j < 5; ++j)
#pragma unroll
            for (int ks = 0; ks < 2; ++ks) {
                u32x4 pw; pw.x = pk2(s[j][8 * ks + 0], s[j][8 * ks + 1]); pw.y = pk2(s[j][8 * ks + 2], s[j][8 * ks + 3]); pw.z = pk2(s[j][8 * ks + 4], s[j][8 * ks + 5]); pw.w = pk2(s[j][8 * ks + 6], s[j][8 * ks + 7]);
                const bf16x8 pa = __builtin_bit_cast(bf16x8, pw);
                const LAS unsigned char* vp = vbase + ((qt + j) * 2 + ks) * 1024;
#pragma unroll
                for (int dh = 0; dh < 2; ++dh) { const s16x4 lo = vtr(vp + dh * 16384), hi4 = vtr(vp + dh * 16384 + 512);
                    const bf16x8 vf = {lo[0], lo[1], lo[2], lo[3], hi4[0], hi4[1], hi4[2], hi4[3]};
                    o[dh] = __builtin_amdgcn_mfma_f32_32x32x16_bf16(pa, vf, o[dh], 0, 0, 0); } }
        LAS bf16_t* stg = (LAS bf16_t*)(lds + 65536 + wid * 4096);
#pragma unroll
        for (int r = 0; r < 16; ++r) { const int q = crow(r, hi); const float sc = __shfl(linv, q);
            stg[q * 64 + r32] = (bf16_t)f2bf(o[0][r] * sc); stg[q * 64 + 32 + r32] = (bf16_t)f2bf(o[1][r] * sc); }
        asm volatile("s_waitcnt lgkmcnt(0)" ::: "memory");
        bf16_t* ob = O + (size_t)(t0 + 32 * qt) * D + h * HD;
#pragma unroll
        for (int i = 0; i < 4; ++i) { const int row = i * 8 + (lane >> 3), ch = lane & 7;
            *(u32x4*)(ob + (size_t)row * D + ch * 8) = *(const LAS u32x4*)(stg + row * 64 + ch * 8); }
        asm volatile("s_waitcnt lgkmcnt(0)" ::: "memory");
    }
    __syncthreads();
}
__device__ __forceinline__ void conv_phase(const bf16_t* Bg, const bf16_t* U, const float* cw, bf16_t* Z, int vcu, int G, int wvid) {
    int tid_ = (wvid * 64 + lane_id_asm()); asm volatile("" : "+v"(tid_));
    const int gt = vcu * NTHREADS + tid_, NGT = G * NTHREADS;
    for (int i = gt; i < (M / 8) * (D / 8); i += NGT) {
        const int t0 = (i >> 7) * 8, c = (i & 127) * 8, tl0 = t0 & (SEQ - 1);
        f32x4 w[3][2];
#pragma unroll
        for (int k = 0; k < 3; ++k) { w[k][0] = *(const f32x4*)(cw + k * D + c); w[k][1] = *(const f32x4*)(cw + k * D + c + 4); }
        u32x4 ur[10], br[8];
#pragma unroll
        for (int r = 0; r < 10; ++r) { if (r >= 2 || tl0 != 0) ur[r] = *(const u32x4*)(U + (size_t)(t0 + r - 2) * D + c); else ur[r] = (u32x4){0u, 0u, 0u, 0u}; }
#pragma unroll
        for (int r = 0; r < 8; ++r) br[r] = *(const u32x4*)(Bg + (size_t)(t0 + r) * D + c);
#pragma unroll
        for (int r = 0; r < 8; ++r) { float y[8];
#pragma unroll
            for (int j = 0; j < 8; ++j) y[j] = 0.f;
#pragma unroll
            for (int k = 0; k < 3; ++k) { const u32x4 uw = ur[r + k];
                y[0] += w[k][0][0] * bflo(uw.x); y[1] += w[k][0][1] * bfhi(uw.x); y[2] += w[k][0][2] * bflo(uw.y); y[3] += w[k][0][3] * bfhi(uw.y);
                y[4] += w[k][1][0] * bflo(uw.z); y[5] += w[k][1][1] * bfhi(uw.z); y[6] += w[k][1][2] * bflo(uw.w); y[7] += w[k][1][3] * bfhi(uw.w); }
            const u32x4 bw = br[r];
            u32x4 o; o.x = pk2(y[0] * bflo(bw.x), y[1] * bfhi(bw.x)); o.y = pk2(y[2] * bflo(bw.y), y[3] * bfhi(bw.y)); o.z = pk2(y[4] * bflo(bw.z), y[5] * bfhi(bw.z)); o.w = pk2(y[6] * bflo(bw.w), y[7] * bfhi(bw.w));
            *(u32x4*)(Z + (size_t)(t0 + r) * D + c) = o; }
    }
}
#ifndef DBG_ATTN
#define DBG_ATTN 0
#endif
#if DBG_ATTN
__device__ __forceinline__ void dbg_attn_check(const bf16_t* Q, const bf16_t* Kg, const bf16_t* Vg, const float* sinks, const bf16_t* O, float* acc3, int vcu, int G, int wvid) {
    const int lane = (wvid * 64 + lane_id_asm()) & 63, wave = wvid;
    const int gw = vcu * NWAVES + wave, nw = G * NWAVES;
    float lnum = 0.f, lden = 0.f, lmax = 0.f;
    for (int it = gw; it < M * NH; it += nw) {
        const int t = it / NH, h = it % NH, kvh = h / 4, tl = t % SEQ;
        const int slo = tl - 127 < 0 ? 0 : tl - 127, n = tl - slo + 1;
        const bf16_t* qp = Q + (size_t)t * D + h * HD;
        float sc[2];
#pragma unroll
        for (int u = 0; u < 2; ++u) { const int j = lane + 64 * u; float dot = -INFINITY;
            if (j < n) { const bf16_t* kp = Kg + (size_t)(t - tl + slo + j) * 256 + kvh * HD; dot = 0.f;
                for (int d = 0; d < HD; ++d) dot = fmaf(bflo((unsigned)qp[d]), bflo((unsigned)kp[d]), dot);
                dot *= (1.0f / LOG2E); }
            sc[u] = dot; }
        const float sink = sinks[h];
        float m = fmaxf(sc[0], sc[1]);
        for (int o = 1; o < 64; o <<= 1) m = fmaxf(m, __shfl_xor(m, o));
        m = fmaxf(m, sink);
        float e0 = (lane < n) ? expf(sc[0] - m) : 0.f, e1 = (lane + 64 < n) ? expf(sc[1] - m) : 0.f;
        float s = e0 + e1;
        for (int o = 1; o < 64; o <<= 1) s += __shfl_xor(s, o);
        const float denom = s + expf(sink - m);
        e0 /= denom; e1 /= denom;
        float a = 0.f;
        for (int j = 0; j < n; ++j) { const float pj = __shfl(j < 64 ? e0 : e1, j & 63); a = fmaf(pj, bflo((unsigned)Vg[(size_t)(t - tl + slo + j) * 256 + kvh * HD + lane]), a); }
        const float o = bflo((unsigned)O[(size_t)t * D + h * HD + lane]);
        const float rn = wave_sum((o - a) * (o - a)), rd = wave_sum(a * a);
        lnum += rn; lden += rd; lmax = fmaxf(lmax, rn / fmaxf(rd, 1e-20f));
    }
    if (lane == 0) { atomicAdd(acc3, lnum); atomicAdd(acc3 + 1, lden); atomicMax((unsigned*)(acc3 + 2), __float_as_uint(lmax)); }
}
#endif
constexpr int WR_STRIDE = 1028;
struct RouteArgs { float* X1F; bf16_t* X1B; const float *g1, *b1, *w_r, *b_r; int* gcnt; int* list_tok; float* list_w; int* tk_e; int* tk_rank; float* tk_w; unsigned char* XQ; float* sx1; float* list_sx; float* list_hs; const float* scl; };
__device__ __forceinline__ void route_phase(const RouteArgs& a, LAS unsigned char* lds, int vcu, int G, bool dry, int wvid) {
    int tid_ = (wvid * 64 + lane_id_asm()); asm volatile("" : "+v"(tid_));
    const int tid = tid_, lane = tid & 63, wave = __builtin_amdgcn_readfirstlane(tid >> 6);
    LAS float* wrt = (LAS float*)lds;
    LAS int* misc = (LAS int*)(lds + MISC_OFF);
    LAS int* lcnt = misc + 96; LAS int* gbase = misc + 128; LAS int* rowe = misc + 160; LAS float* roww = (LAS float*)(misc + 416); LAS float* rowsx = (LAS float*)(misc + 672); LAS float* rownrm = (LAS float*)(misc + 736);
    for (int i = tid; i < D * NE; i += NTHREADS) { const int c = i >> 5, e = i & 31; wrt[e * WR_STRIDE + c] = a.w_r[i]; }
    if (tid < NE) lcnt[tid] = 0;
    __syncthreads();
    const int rows_per_wg = M / G;
    for (int rr = 2 * wave; rr < rows_per_wg; rr += 2 * NWAVES) {
        f32x4 v[2][4];
#pragma unroll
        for (int x = 0; x < 2; ++x) { const int t = vcu * rows_per_wg + rr + x; float s = 0.f;
#pragma unroll
            for (int j = 0; j < 4; ++j) { v[x][j] = *(const f32x4*)(a.X1F + (size_t)t * D + 256 * j + 4 * lane); s += (v[x][j][0] + v[x][j][1]) + (v[x][j][2] + v[x][j][3]); }
            const float mean = wave_sum(s) * (1.0f / D); float q = 0.f;
#pragma unroll
            for (int j = 0; j < 4; ++j) { v[x][j] = v[x][j] - mean; q += (v[x][j][0] * v[x][j][0] + v[x][j][1] * v[x][j][1]) + (v[x][j][2] * v[x][j][2] + v[x][j][3] * v[x][j][3]); }
            const float rstd = 1.0f / sqrtf(wave_sum(q) * (1.0f / D) + LN_EPS);
#pragma unroll
            for (int j = 0; j < 4; ++j) { const f32x4 gg = *(const f32x4*)(a.g1 + 256 * j + 4 * lane), bb = *(const f32x4*)(a.b1 + 256 * j + 4 * lane);
                v[x][j] = v[x][j] * rstd * gg + bb;
                if (!dry) { u32x2 w; w.x = pk2(v[x][j][0], v[x][j][1]); w.y = pk2(v[x][j][2], v[x][j][3]); *(u32x2*)(a.X1B + (size_t)t * D + 256 * j + 4 * lane) = w; } }
            float am = 0.f;
#pragma unroll
            for (int j = 0; j < 4; ++j) am = fmaxf(am, fmaxf(fmaxf(fabsf(v[x][j][0]), fabsf(v[x][j][1])), fmaxf(fabsf(v[x][j][2]), fabsf(v[x][j][3]))));
#pragma unroll
            for (int o = 1; o < 64; o <<= 1) am = fmaxf(am, __shfl_xor(am, o));
            const float sxr = fmaxf(am, 1e-30f) * (1.0f / 127.0f), qi = 1.0f / sxr;
            if (!dry) {
#pragma unroll
                for (int j = 0; j < 4; ++j) { unsigned q = 0u;
#pragma unroll
                    for (int z = 0; z < 4; ++z) q |= ((unsigned)(int)rintf(v[x][j][z] * qi) & 0xffu) << (8 * z);
                    *(unsigned*)(a.XQ + (size_t)t * D + 256 * j + 4 * lane) = q; }
                if (lane == 0) { a.sx1[t] = sxr; rowsx[rr + x] = sxr; } }
            { float ssq = 0.f;
#pragma unroll
              for (int j = 0; j < 4; ++j) ssq += (v[x][j][0] * v[x][j][0] + v[x][j][1] * v[x][j][1]) + (v[x][j][2] * v[x][j][2] + v[x][j][3] * v[x][j][3]);
              ssq = wave_sum(ssq); if (lane == 0) rownrm[rr + x] = sqrtf(ssq); } }
        float pl[2][32];
#pragma unroll
        for (int e = 0; e < 32; ++e) { float a0 = 0.f, a1 = 0.f;
#pragma unroll
            for (int j = 0; j < 4; ++j) { const f32x4 w = *(const LAS f32x4*)(wrt + e * WR_STRIDE + 256 * j + 4 * lane);
                a0 += (v[0][j][0] * w[0] + v[0][j][1] * w[1]) + (v[0][j][2] * w[2] + v[0][j][3] * w[3]); a1 += (v[1][j][0] * w[0] + v[1][j][1] * w[1]) + (v[1][j][2] * w[2] + v[1][j][3] * w[3]); }
            pl[0][e] = a0; pl[1][e] = a1; }
#pragma unroll
        for (int o = 32, n = 16; o >= 2; o >>= 1, n >>= 1) { const bool up = (lane & o) != 0;
#pragma unroll
            for (int i = 0; i < 16; ++i) if (i < n) {
#pragma unroll
                for (int x = 0; x < 2; ++x) { const float send = up ? pl[x][i] : pl[x][i + n], keep = up ? pl[x][i + n] : pl[x][i]; pl[x][i] = keep + __shfl_xor(send, o); } } }
        const int myexp = lane >> 1; const float brv = a.b_r[myexp];
        float logit[2];
#pragma unroll
        for (int x = 0; x < 2; ++x) logit[x] = pl[x][0] + __shfl_xor(pl[x][0], 1) + brv;
        int se[2][4]; float sv[2][4];
#pragma unroll
        for (int k = 0; k < 4; ++k) { float bv[2]; int bi[2];
#pragma unroll
            for (int x = 0; x < 2; ++x) { bv[x] = logit[x]; bi[x] = myexp; }
#pragma unroll
            for (int o = 1; o < 64; o <<= 1) {
#pragma unroll
                for (int x = 0; x < 2; ++x) { const float ov = __shfl_xor(bv[x], o); const int oi = __shfl_xor(bi[x], o); if (ov > bv[x] || (ov == bv[x] && oi < bi[x])) { bv[x] = ov; bi[x] = oi; } } }
#pragma unroll
            for (int x = 0; x < 2; ++x) { se[x][k] = bi[x]; sv[x][k] = bv[x]; if (myexp == bi[x]) logit[x] = -INFINITY; } }
#pragma unroll
        for (int x = 0; x < 2; ++x) { const float e1 = __expf(sv[x][1] - sv[x][0]), e2 = __expf(sv[x][2] - sv[x][0]), e3 = __expf(sv[x][3] - sv[x][0]);
            const float inv = 1.0f / (1.0f + e1 + e2 + e3);
            if (lane < 4) { const int e = lane == 0 ? se[x][0] : lane == 1 ? se[x][1] : lane == 2 ? se[x][2] : se[x][3];
                const float w = (lane == 0 ? 1.0f : lane == 1 ? e1 : lane == 2 ? e2 : e3) * inv;
                rowe[(rr + x) * 4 + lane] = e; roww[(rr + x) * 4 + lane] = w; } }
    }
    __syncthreads();
    if (dry) return;
    const int nent = rows_per_wg * 4;
    int my_e = 0, my_lr = 0;
    if (tid < nent) { my_e = rowe[tid]; my_lr = atomicAdd((int*)(lcnt + my_e), 1); }
    __syncthreads();
    if (tid < NE) gbase[tid] = atomicAdd(a.gcnt + tid, lcnt[tid]);
    __syncthreads();
    if (tid < nent) { const int t = vcu * rows_per_wg + (tid >> 2), rank = gbase[my_e] + my_lr;
        const float sig = rownrm[tid >> 2] * a.scl[64 + my_e], clip = fmaxf((1.0f + 3.5f * sig) * (3.5f * sig), 1e-20f);
        const float qh = bfhi(f2bf(127.0f / clip) << 16);
        a.list_tok[(size_t)my_e * LISTCAP + rank] = t; a.list_w[(size_t)my_e * LISTCAP + rank] = qh; a.list_sx[(size_t)my_e * LISTCAP + rank] = rowsx[tid >> 2];
        a.list_hs[(size_t)my_e * LISTCAP + rank] = roww[tid] / qh;
        a.tk_e[t * 4 + (tid & 3)] = my_e; a.tk_rank[t * 4 + (tid & 3)] = rank; a.tk_w[t * 4 + (tid & 3)] = roww[tid]; }
    __syncthreads();
}
__device__ __forceinline__ void build_tables(const int* gcnt, LAS unsigned char* lds, int wvid) {
    LAS int* misc = (LAS int*)(lds + MISC_OFF);
    const int tid = wvid * 64 + lane_id_asm();
    if (tid < NE) misc[tid] = __hip_atomic_load(gcnt + tid, __ATOMIC_RELAXED, __HIP_MEMORY_SCOPE_AGENT);
    __syncthreads();
    if (tid == 0) { int a = 0; for (int e = 0; e < NE; ++e) { misc[32 + e] = a; a += (misc[e] + 255) >> 8; } misc[32 + NE] = a; }
    __syncthreads();
}
struct FinalArgs { float dbg_scale; int pad_; const bf16_t* X1B; const bf16_t* PLE; const bf16_t* Y; const int* tk_e; const int* tk_rank; const float* tk_w; const float* b_down; const float *g2, *b2; float* out; };
__device__ __forceinline__ void final_phase(const FinalArgs& a, LAS unsigned char* lds, int vcu, int G, int wvid) {
    int tid_ = (wvid * 64 + lane_id_asm()); asm volatile("" : "+v"(tid_));
    const int tid = tid_, lane = tid & 63, wave = __builtin_amdgcn_readfirstlane(tid >> 6);
    const LAS int* ts = (const LAS int*)(lds + MISC_OFF) + 32;
    LAS float* bdl = (LAS float*)lds;
    for (int i = tid; i < NE * D / 4; i += NTHREADS) *(LAS f32x4*)(bdl + 4 * i) = *(const f32x4*)(a.b_down + 4 * i);
    __syncthreads();
    const int gw = vcu * NWAVES + wave, NGW = G * NWAVES;
    for (int t0 = 2 * gw; t0 < M; t0 += 2 * NGW) {
        size_t pos[2][4]; int ek[2][4]; float wk[2][4];
#pragma unroll
        for (int x = 0; x < 2; ++x)
#pragma unroll
            for (int k = 0; k < 4; ++k) { const int t = t0 + x, e = a.tk_e[t * 4 + k], rk = a.tk_rank[t * 4 + k]; pos[x][k] = ((size_t)ts[e] * 256 + rk) * D; ek[x][k] = e * D; wk[x][k] = a.tk_w[t * 4 + k]; }
        f32x4 v[2][4]; float s[2] = {0.f, 0.f};
#pragma unroll
        for (int x = 0; x < 2; ++x)
#pragma unroll
            for (int j = 0; j < 4; ++j) { const int c = 256 * j + 4 * lane; const size_t ro = (size_t)(t0 + x) * D + c;
                const u32x2 xw = *(const u32x2*)(a.X1B + ro), pw = *(const u32x2*)(a.PLE + ro);
                f32x4 xx = {bflo(xw.x) * DN_ALPHA + bflo(pw.x), bfhi(xw.x) * DN_ALPHA + bfhi(pw.x), bflo(xw.y) * DN_ALPHA + bflo(pw.y), bfhi(xw.y) * DN_ALPHA + bfhi(pw.y)};
#pragma unroll
                for (int k = 0; k < 4; ++k) { const u32x2 yw = *(const u32x2*)(a.Y + pos[x][k] + c); const f32x4 bd = *(const LAS f32x4*)(bdl + ek[x][k] + c);
                    xx[0] += bflo(yw.x) + wk[x][k] * bd[0]; xx[1] += bfhi(yw.x) + wk[x][k] * bd[1]; xx[2] += bflo(yw.y) + wk[x][k] * bd[2]; xx[3] += bfhi(yw.y) + wk[x][k] * bd[3]; }
                v[x][j] = xx; s[x] += (xx[0] + xx[1]) + (xx[2] + xx[3]); }
#pragma unroll
        for (int x = 0; x < 2; ++x) { const float mean = wave_sum(s[x]) * (1.0f / D); float q = 0.f;
#pragma unroll
            for (int j = 0; j < 4; ++j) { v[x][j] = v[x][j] - mean; q += (v[x][j][0] * v[x][j][0] + v[x][j][1] * v[x][j][1]) + (v[x][j][2] * v[x][j][2] + v[x][j][3] * v[x][j][3]); }
            const float rstd = 1.0f / sqrtf(wave_sum(q) * (1.0f / D) + LN_EPS);
#pragma unroll
            for (int j = 0; j < 4; ++j) { const int c = 256 * j + 4 * lane; const f32x4 gg = *(const f32x4*)(a.g2 + c), bb = *(const f32x4*)(a.b2 + c);
                *(f32x4*)(a.out + (size_t)(t0 + x) * D + c) = (v[x][j] * rstd * gg + bb) * a.dbg_scale; } }
    }
}

#ifndef PROBE_STAMP
#define PROBE_STAMP -1
#endif
#define STAMP(k) do { if (PROBE_STAMP >= 0 && bx == 0 && (wvid * 64 + lane_id_asm()) == 0) __hip_atomic_store(WSP(unsigned long long, WS_CTL + 32768) + (k), (unsigned long long)__builtin_amdgcn_s_memrealtime(), __ATOMIC_RELAXED, __HIP_MEMORY_SCOPE_AGENT); } while (0)
#ifndef PROBE_REP
#define PROBE_REP 0
#endif
struct Args { const float* in[20]; float* out; unsigned char* ws; };
__global__ void __launch_bounds__(NTHREADS, 2) mega_fwd(Args args) {
    extern __shared__ __attribute__((aligned(16))) unsigned char lds_raw[];
    LAS unsigned char* lds = (LAS unsigned char*)lds_raw;
    cg::grid_group grid = cg::this_grid();
    const int G = gridDim.x, bx = blockIdx.x;
    const int wvid = __builtin_amdgcn_readfirstlane((int)threadIdx.x >> 6);
    const int vcu = (G % 8 == 0) ? (bx % 8) * (G / 8) + bx / 8 : bx;
    unsigned char* const ws = args.ws;
    const LAS int* cntL = (const LAS int*)(lds + MISC_OFF); const LAS int* tsL = cntL + 32;
    { volatile LAS unsigned* bst = (volatile LAS unsigned*)(lds + MISC_OFF) + BST_IDX;
      { int t_ = (wvid * 64 + lane_id_asm()); asm volatile("" : "+v"(t_)); if (t_ < 2) bst[t_] = 0u; }
      __syncthreads();
      (void)xcd_barrier_post((unsigned*)(ws + WS_BAR), bst, (wvid * 64 + lane_id_asm()) == 0); }
#define GRID_BAR() do { XcdBarrier b_; b_.bar = (unsigned*)(ws + WS_BAR); b_.x = xb_xcc_id(); b_.st = (volatile LAS unsigned*)(lds + MISC_OFF) + BST_IDX; b_.lead = ((wvid * 64 + lane_id_asm()) == 0); xcd_barrier(b_); if (PROBE_REP & 0x80000) xcd_barrier(b_); } while (0)
#define WSP(T, off) ((T*)(ws + (off)))
#define GRID_BAR_F(seam) do { XcdBarrier b_; b_.bar = (unsigned*)(ws + WS_BAR); b_.x = xb_xcc_id(); b_.st = (volatile LAS unsigned*)(lds + MISC_OFF) + BST_IDX; b_.lead = ((wvid * 64 + lane_id_asm()) == 0); \
    asm volatile("s_waitcnt vmcnt(0)" ::: "memory"); __syncthreads(); \
    if (wvid == 0) xcd_barrier_lead(b_); \
    else { P0Args a_{args.in[0], args.in[1], args.in[2], args.in[4], args.in[5], args.in[7], args.in[17], args.in[16], args.in[12], args.in[14], ws, 1.0f}; p0_fill(a_, lds, vcu, G, seam, wvid); } \
    __syncthreads(); } while (0)

    STAMP(0);
    { const float s_in = __builtin_bit_cast(float, __builtin_amdgcn_readfirstlane(__builtin_bit_cast(int, sample_scale(args.in[2], 13308, lds, wvid))));
    _Pragma("unroll 1") for (int rep_ = 0; rep_ < ((PROBE_REP & 1) ? 2 : 1); ++rep_) { P0Args a{args.in[0], args.in[1], args.in[2], args.in[4], args.in[5], args.in[7], args.in[17], args.in[16], args.in[12], args.in[14], ws, s_in}; p0_phase(a, lds, vcu, G, 0, P0_NSMALL, true, wvid); } }
#if (PROBE_REP & 0x200000)
    { u32x4* z_ = (u32x4*)(ws + WS_R); const int gt_ = vcu * NTHREADS + wvid * 64 + lane_id_asm(); for (size_t i_ = gt_; i_ < (176 * MiB) / 16; i_ += (size_t)G * NTHREADS) z_[i_] = (u32x4){0u, 0u, 0u, 0u}; }
#endif
    grid.sync();
    STAMP(1);
    _Pragma("unroll 1") for (int rep_ = 0; rep_ < ((PROBE_REP & 2) ? 2 : 1); ++rep_) { pg8::Gemm g{WSP(bf16_t, WS_XB), (const bf16_t*)(ws + WS_WIN), D / 2}; pg8::StaticOrder S; S.init(M / 256, NIN / 256, G, bx, 1);
      const float s_in1 = __builtin_bit_cast(float, __builtin_amdgcn_readfirstlane(__builtin_bit_cast(int, sample_scale(args.in[2], 13308, lds, wvid))));
      pg8::EpiInProjI8 E{ws, s_in1};
      pg8::gemm_phase<pg8::EpiInProjI8, pg8::StaticOrder, true, 0, true>(lds, g, S, E, wvid); }
    { constexpr int U1 = (M / 256) * (NIN / 256); const int R1 = U1 % G, nidle = R1 ? G - R1 : G, per = 256 / nidle;
      if (R1 == 0 || bx >= R1) {
        pg8::Gemm g{WSP(bf16_t, WS_PB), (const bf16_t*)(ws + WS_WPP), DPLE}; pg8::Ple1Order S{(bx - R1) * per, per};
        pg8::EpiF32 E{WSP(float, WS_P2)};
        pg8::gemm_phase<pg8::EpiF32, pg8::Ple1Order, false>(lds, g, S, E, wvid); } }
    GRID_BAR_F(1);
    STAMP(2);
    if (PROBE_REP & 4096) { _Pragma("unroll 1") for (int k_ = 0; k_ < 8; ++k_) GRID_BAR(); }
    _Pragma("unroll 1") for (int rep_ = 0; rep_ < ((PROBE_REP & 4) ? 2 : 1); ++rep_) for (int it = vcu; it < BATCH * NKV * (SEQ / 128); it += G) { const int nb = it & 63, kvh = (it >> 6) & 3, b = it >> 8;
        attn_unit(lds, WSP(bf16_t, WS_Q), WSP(bf16_t, WS_K), WSP(bf16_t, WS_V), args.in[6], WSP(bf16_t, WS_ZO) + (size_t)M * D, b, kvh, nb, wvid); }
    _Pragma("unroll 1") for (int rep_ = 0; rep_ < ((PROBE_REP & 8) ? 2 : 1); ++rep_) conv_phase(WSP(bf16_t, WS_BG), WSP(bf16_t, WS_U), args.in[3], WSP(bf16_t, WS_ZO), vcu, G, wvid);
    GRID_BAR_F(2);
    STAMP(3);
#if DBG_ATTN
    dbg_attn_check(WSP(bf16_t, WS_Q), WSP(bf16_t, WS_K), WSP(bf16_t, WS_V), args.in[6], WSP(bf16_t, WS_ZO) + (size_t)M * D, WSP(float, WS_CTL) + 64, vcu, G, wvid);
#endif
    _Pragma("unroll 1") for (int rep_ = 0; rep_ < ((PROBE_REP & 16) ? 2 : 1); ++rep_) { pg8::Gemm g{WSP(bf16_t, WS_ZO), (const bf16_t*)(ws + WS_WBR), D}; pg8::DualOrder S; S.so.init(M / 256, D / 256, G, bx);
      pg8::EpiDual E{ws};
      pg8::gemm_phase<pg8::EpiDual, pg8::DualOrder, true>(lds, g, S, E, wvid); }
    GRID_BAR_F(3);
    STAMP(4);
    _Pragma("unroll 1") for (int rep_ = 0; rep_ < ((PROBE_REP & 32) ? 2 : 1); ++rep_) { pg8::Gemm g{WSP(bf16_t, WS_MG), (const bf16_t*)(ws + WS_WOUT), D}; pg8::StaticOrder S; S.init(M / 256, D / 256, G, bx);
      pg8::EpiResid E{args.in[0], WSP(float, WS_X1F)};
      pg8::gemm_phase<pg8::EpiResid, pg8::StaticOrder, false>(lds, g, S, E, wvid); }
    GRID_BAR_F(4);
    STAMP(5);
    { P0Args a{args.in[0], args.in[1], args.in[2], args.in[4], args.in[5], args.in[7], args.in[17], args.in[16], args.in[12], args.in[14], ws, 1.0f}; p0_phase(a, lds, vcu, G, P0_NSMALL + P0_FILL_SEAMS * G * 7 * P0_FILL, P0_NITEMS, false, wvid); __syncthreads();
      if (PROBE_REP & 0x40000) { p0_phase(a, lds, vcu, G, P0_NSMALL, P0_NITEMS, false, wvid); __syncthreads(); } }
    _Pragma("unroll 1") for (int rep_ = ((PROBE_REP & 64) ? 0 : 1); rep_ < 2; ++rep_) { RouteArgs a{WSP(float, WS_X1F), WSP(bf16_t, WS_X1B), args.in[8], args.in[9], args.in[10], args.in[11], WSP(int, WS_CTL), WSP(int, WS_LTOK), WSP(float, WS_LW), WSP(int, WS_TKE), WSP(int, WS_TKR), WSP(float, WS_TKW), ws + WS_XQ, WSP(float, WS_SX1), WSP(float, WS_LSX), WSP(float, WS_LHS), WSP(float, WS_SCL)}; route_phase(a, lds, vcu, G, rep_ == 0, wvid); }
    GRID_BAR();
    STAMP(6);
    build_tables(WSP(int, WS_CTL), lds, wvid);
    { const int nx5_ = __builtin_amdgcn_readfirstlane(pg8::MoeOrder::ple_in_p5(tsL, G));
      pg8::MoeOrder S; S.init(cntL, tsL, (const LAS unsigned*)(lds + TW_OFF), 8, G, bx, 1, WS_XQ, WS_WGU, nx5_, 0, WS_XQ, WS_WPG8, 18); S.build_units((LAS int*)(lds + UTAB_OFF), 12, wvid * 64 + lane_id_asm(), vcu, 1);
      pg8::moe_preload(S, cntL, WSP(int, WS_LTOK), WSP(float, WS_LW), (LAS unsigned*)(lds + TW_OFF), wvid);
      _Pragma("unroll 1") for (int rep_ = 0; rep_ < ((PROBE_REP & 128) ? 2 : 1); ++rep_) { pg8::Gemm g{(const bf16_t*)ws, (const bf16_t*)ws, D / 2};
        pg8::EpiSwigluI8 E{WSP(bf16_t, WS_H), args.in[13], (const LAS unsigned*)(lds + TW_OFF), ws};
        pg8::gemm_phase<pg8::EpiSwigluI8, pg8::MoeOrder, true, 0, true>(lds, g, S, E, wvid);
#if (PROBE_REP & 0x400000)
        pg8::gemm_phase<pg8::EpiSwigluI8, pg8::MoeOrder, true, 1, true>(lds, g, S, E, wvid);
#endif
#if (PROBE_REP & 0x800000)
        pg8::gemm_phase<pg8::EpiSwigluI8, pg8::MoeOrder, true, 2, true>(lds, g, S, E, wvid);
#endif
        } }
    GRID_BAR();
    STAMP(7);
    _Pragma("unroll 1") for (int rep_ = 0; rep_ < ((PROBE_REP & 1024) ? 2 : 1); ++rep_) { pg8::Gemm g{(const bf16_t*)ws, (const bf16_t*)ws, D / 2};
      const int nx5_ = __builtin_amdgcn_readfirstlane(pg8::MoeOrder::ple_in_p5(tsL, G));
      pg8::MoeOrder S; S.init(cntL, tsL, (const LAS unsigned*)(lds + TW_OFF), 4, G, bx, 0, WS_H, WS_WDN, 256 - nx5_, nx5_, WS_XQ, WS_WPG8, 18); S.build_units((LAS int*)(lds + UTAB_OFF), 12, wvid * 64 + lane_id_asm(), vcu, 2);
      pg8::EpiDownI8 E{WSP(bf16_t, WS_Y), ws, cntL};
      pg8::gemm_phase<pg8::EpiDownI8, pg8::MoeOrder, true, 0, true>(lds, g, S, E, wvid); }
    STAMP(8);
    GRID_BAR();
    _Pragma("unroll 1") for (int rep_ = 0; rep_ < ((PROBE_REP & 2048) ? 2 : 1); ++rep_) { float dbgs_ = 1.0f;
      if (PROBE_STAMP >= 0) { const unsigned long long* st_ = WSP(unsigned long long, WS_CTL + 32768); const float dt_us = (float)(long long)(__hip_atomic_load(st_ + PROBE_STAMP + 1, __ATOMIC_RELAXED, __HIP_MEMORY_SCOPE_AGENT) - __hip_atomic_load(st_ + PROBE_STAMP, __ATOMIC_RELAXED, __HIP_MEMORY_SCOPE_AGENT)) * 0.01f; dbgs_ = 1.0f + sqrtf(dt_us * 1e-6f); }
#if DBG_ATTN
      { const float* a3 = WSP(float, WS_CTL) + 64; const float num = __hip_atomic_load(a3, __ATOMIC_RELAXED, __HIP_MEMORY_SCOPE_AGENT), den = __hip_atomic_load(a3 + 1, __ATOMIC_RELAXED, __HIP_MEMORY_SCOPE_AGENT), mx = __hip_atomic_load(a3 + 2, __ATOMIC_RELAXED, __HIP_MEMORY_SCOPE_AGENT);
        dbgs_ = 1.0f + sqrtf(100.0f * (DBG_ATTN == 1 ? num / den : mx)); }
#endif
      FinalArgs a{dbgs_, 0, WSP(bf16_t, WS_X1B), WSP(bf16_t, WS_PLE), WSP(bf16_t, WS_Y), WSP(int, WS_TKE), WSP(int, WS_TKR), WSP(float, WS_TKW), args.in[15], args.in[18], args.in[19], args.out}; final_phase(a, lds, vcu, G, wvid); }
}

extern "C" void kernel_launch(void* const* d_in, const int* in_sizes, int n_in, void* d_out, int out_size, void* d_ws, size_t ws_size, hipStream_t stream) {
    static int grid = 0;
    if (grid == 0) {
        if (n_in != 20 || out_size != M * D || ws_size < WS_END) { fprintf(stderr, "kernel_launch: unexpected sizes (n_in %d, out %d, ws %zu < %zu)\n", n_in, out_size, ws_size, (size_t)WS_END); grid = -1; return; }
        int dev = 0, cus = 0, per_cu = 0;
        if (hipGetDevice(&dev) != hipSuccess || hipDeviceGetAttribute(&cus, hipDeviceAttributeMultiprocessorCount, dev) != hipSuccess) { grid = -1; return; }
        if (hipFuncSetAttribute((const void*)mega_fwd, hipFuncAttributeMaxDynamicSharedMemorySize, LDS_BYTES) != hipSuccess) { fprintf(stderr, "kernel_launch: hipFuncSetAttribute failed\n"); grid = -1; return; }
        if (hipOccupancyMaxActiveBlocksPerMultiprocessor(&per_cu, (const void*)mega_fwd, NTHREADS, LDS_BYTES) != hipSuccess || per_cu < 1) { fprintf(stderr, "kernel_launch: occupancy query says %d blocks per CU\n", per_cu); grid = -1; return; }
        grid = cus;
        if (grid != 256) fprintf(stderr, "kernel_launch: note: %d CUs (built and tuned for 256)\n", grid);
    }
    if (grid < 0) return;
    if (hipMemsetAsync((char*)d_ws + WS_CTL, 0, CTL_ZERO_BYTES, stream) != hipSuccess) return;
    Args a{};
    for (int i = 0; i < 20; ++i) a.in[i] = (const float*)d_in[i];
    a.out = (float*)d_out; a.ws = (unsigned char*)d_ws;
    void* kargs[] = {&a};
    const hipError_t e = hipLaunchCooperativeKernel((const void*)mega_fwd, dim3(grid), dim3(NTHREADS), kargs, LDS_BYTES, stream);
    if (e != hipSuccess) fprintf(stderr, "kernel_launch: cooperative launch failed: %s (grid %d)\n", hipGetErrorString(e), grid);
}
```

```cpp
#include <hip/hip_runtime.h>
#include <hip/hip_cooperative_groups.h>
#include <cstdio>
#include <cstdint>
namespace cg = cooperative_groups;

#define LAS __attribute__((address_space(3)))
typedef unsigned short bf16_t;
typedef short bf16x8 __attribute__((ext_vector_type(8)));
typedef short s16x4 __attribute__((ext_vector_type(4)));
typedef float f32x4 __attribute__((ext_vector_type(4)));
typedef float f32x16 __attribute__((ext_vector_type(16)));
typedef unsigned u32x4 __attribute__((ext_vector_type(4)));
typedef unsigned u32x2 __attribute__((ext_vector_type(2)));

constexpr int BATCH = 2, SEQ = 8192, M = BATCH * SEQ, D = 1024, NIN = 6656, NE = 32, DPLE = 256, NH = 16, HD = 64, NKV = 4;
constexpr float DN_ALPHA = 1.189207115002721f, LN_EPS = 1e-5f, LOG2E = 1.4426950408889634f;
constexpr float QSCALE = 0.125f * LOG2E;
constexpr int LISTCAP = M;
constexpr int MAXTILES = (M * 4) / 256 + NE;
constexpr int NWAVES = 8, NTHREADS = 512;

constexpr size_t MiB = 1u << 20;
constexpr size_t WS_CTL = 0;
constexpr size_t WS_BAR = 16384, CTL_ZERO_BYTES = 65536;
constexpr size_t WS_TKE = 1 * MiB, WS_TKR = 2 * MiB, WS_TKW = 3 * MiB;
constexpr size_t WS_LTOK = 4 * MiB, WS_LW = 6 * MiB;
constexpr size_t WS_WIN = 8 * MiB;
constexpr size_t WS_WBR = 22 * MiB;
constexpr size_t WS_WOUT = 26 * MiB, WS_WPG = 28 * MiB;
constexpr size_t WS_WPP = 30 * MiB;
constexpr size_t WS_WGU = 32 * MiB;
constexpr size_t WS_WDN = 160 * MiB;
constexpr size_t WS_XB = 224 * MiB;
constexpr size_t WS_PB = 256 * MiB;
constexpr size_t WS_X1F = 264 * MiB;
constexpr size_t WS_X1B = 328 * MiB;
constexpr size_t WS_P2 = 360 * MiB;
constexpr size_t WS_PLE = 424 * MiB;
constexpr size_t WS_R = 456 * MiB;
constexpr size_t WS_BG = WS_R, WS_U = WS_R + 32 * MiB, WS_Q = WS_R + 64 * MiB, WS_K = WS_R + 96 * MiB, WS_V = WS_R + 104 * MiB;
constexpr size_t WS_GC = WS_R + 112 * MiB, WS_GA = WS_R + 144 * MiB;
constexpr size_t WS_ZO = WS_R + 176 * MiB;
constexpr size_t WS_T1 = WS_R + 240 * MiB;
constexpr size_t WS_MG = WS_R + 304 * MiB;
constexpr size_t WS_H = WS_R;
constexpr size_t WS_Y = WS_R + 144 * MiB;
constexpr size_t WS_XQ = WS_R + 336 * MiB;
constexpr size_t WS_LSX = WS_XQ + 16 * MiB;
constexpr size_t WS_SX1 = WS_LSX + 2 * MiB;
constexpr size_t WS_SX0 = WS_SX1 + 1 * MiB;
constexpr size_t WS_SP = WS_SX0 + 512 * 1024;
constexpr size_t WS_LHS = WS_SX0 + 1 * MiB;
constexpr size_t WS_END = WS_LHS + 2 * MiB;
constexpr size_t WS_SCL = 65536;
constexpr size_t WS_WPG8 = 31 * MiB;
typedef int i32x4 __attribute__((ext_vector_type(4)));

constexpr int LDS_BYTES = 147456;
constexpr int MISC_OFF = 135168;
constexpr int BST_IDX = 66, TW_OFF = MISC_OFF + 512, UTAB_OFF = TW_OFF + 10240;
constexpr int BST_IDX_ = 0;

__device__ __forceinline__ int lane_id_asm() { int l; asm volatile("v_mbcnt_lo_u32_b32 %0, -1, 0\n\tv_mbcnt_hi_u32_b32 %0, -1, %0" : "=v"(l)); return l; }
__device__ __forceinline__ unsigned f2bf(float f) { unsigned u = __builtin_bit_cast(unsigned, f); return (u + 0x7fffu + ((u >> 16) & 1u)) >> 16; }
__device__ __forceinline__ unsigned pk2(float lo, float hi) { return f2bf(lo) | (f2bf(hi) << 16); }
__device__ __forceinline__ float bflo(unsigned w) { return __builtin_bit_cast(float, w << 16); }
__device__ __forceinline__ float bfhi(unsigned w) { return __builtin_bit_cast(float, w & 0xffff0000u); }
__device__ __forceinline__ float fast_sigmoid(float v) { return __builtin_amdgcn_rcpf(1.0f + __builtin_amdgcn_exp2f(-LOG2E * v)); }
__device__ __forceinline__ float shx(float v, int o, int lane) { return __builtin_bit_cast(float, __builtin_amdgcn_ds_bpermute((lane ^ o) << 2, __builtin_bit_cast(int, v))); }
__device__ __forceinline__ int shxi(int v, int o, int lane) { return __builtin_amdgcn_ds_bpermute((lane ^ o) << 2, v); }
__device__ __forceinline__ float shidx(float v, int src) { return __builtin_bit_cast(float, __builtin_amdgcn_ds_bpermute(src << 2, __builtin_bit_cast(int, v))); }
__device__ __forceinline__ float wave_sum(float v, int lane) {
#pragma unroll
    for (int o = 1; o < 64; o <<= 1) v += shx(v, o, lane);
    return v;
}

#define XB_TMO      128
#define XB_XCNT(j)  (256  + 64 * (j))
#define XB_XSUB(j)  (1280 + 64 * (j))
#define XB_XGEN(j)  (2304 + 64 * (j))
#define XB_TOP      3328
#define XB_TOPGEN   3392
#define XCD_BAR_WORDS 3456
#define XB_SPIN_CAP (1u << 18)

__device__ __forceinline__ unsigned xb_ld(unsigned* p)              { return __hip_atomic_load(p, __ATOMIC_RELAXED, __HIP_MEMORY_SCOPE_AGENT); }
__device__ __forceinline__ unsigned xb_add(unsigned* p, unsigned v) { return __hip_atomic_fetch_add(p, v, __ATOMIC_RELAXED, __HIP_MEMORY_SCOPE_AGENT); }
__device__ __forceinline__ unsigned xb_xcc_id() { return (unsigned)__builtin_amdgcn_s_getreg((3 << 11) | 20) & 0xFu; }
#define XB_SPIN(cond, bar) do { unsigned _sp = 0; while (cond) { __builtin_amdgcn_s_sleep(1); \
    if ((++_sp & 255u) == 0u) { if (xb_ld(&(bar)[XB_TMO])) break; if (_sp > XB_SPIN_CAP) { atomicAdd(&(bar)[XB_TMO], 1u); break; } } } } while (0)

struct XcdBarrier {
    bool lead;
    unsigned* bar; unsigned x;
    volatile LAS unsigned* st;
};

__device__ __forceinline__ XcdBarrier xcd_barrier_post(unsigned* bar, volatile LAS unsigned* st, bool lead) {
    XcdBarrier b; b.bar = bar; b.x = xb_xcc_id(); b.st = st; b.lead = lead;
    if (lead) (void)xb_add(&bar[XB_XCNT(b.x)], 1u);
    return b;
}
__device__ __forceinline__ void xcd_barrier_complete(unsigned* bar, unsigned x, unsigned& nloc, unsigned& nx) {
    const unsigned G = gridDim.x * gridDim.y * gridDim.z;
    unsigned sum, cnt, mine, sp = 0u;
    for (;;) {
        sum = 0u; cnt = 0u; mine = 0u;
#pragma unroll
        for (unsigned j = 0; j < 16; ++j) { const unsigned c = xb_ld(&bar[XB_XCNT(j)]); sum += c; cnt += (c > 0u) ? 1u : 0u; mine = (j == x) ? c : mine; }
        if (sum == G) break;
        __builtin_amdgcn_s_sleep(1);
        if ((++sp & 255u) == 0u) { if (xb_ld(&bar[XB_TMO])) break; if (sp > XB_SPIN_CAP) { atomicAdd(&bar[XB_TMO], 1u); break; } }
    }
    nloc = mine > 0u ? mine : 1u; nx = cnt > 0u ? cnt : 1u;
}

__device__ __forceinline__ void xcd_barrier_lead(const XcdBarrier& b);
__device__ __forceinline__ void xcd_barrier(const XcdBarrier& b) {
    asm volatile("s_waitcnt vmcnt(0)" ::: "memory");
    __syncthreads();
    xcd_barrier_lead(b);
    __syncthreads();
}
__device__ __forceinline__ void xcd_barrier_lead(const XcdBarrier& b) {
    if (b.lead) {
        unsigned* bar = b.bar;
        __builtin_amdgcn_s_waitcnt(0);
        unsigned nloc = b.st[0], nx = b.st[1];
        if (nloc == 0u) { xcd_barrier_complete(bar, b.x, nloc, nx); b.st[0] = nloc; b.st[1] = nx; }
        const unsigned old = xb_add(&bar[XB_XSUB(b.x)], 1u);
        const unsigned gen = old / nloc;
        if (old + 1u == (gen + 1u) * nloc) {
            __builtin_amdgcn_fence(__ATOMIC_RELEASE, "agent");
            asm volatile("s_waitcnt vmcnt(0)" ::: "memory");
            const unsigned og = xb_add(&bar[XB_TOP], 1u);
            const unsigned tg = og / nx;
            if (og + 1u == (tg + 1u) * nx) xb_add(&bar[XB_TOPGEN], 1u);
            else XB_SPIN(xb_ld(&bar[XB_TOPGEN]) == tg, bar);
            __builtin_amdgcn_fence(__ATOMIC_ACQUIRE, "agent");
            xb_add(&bar[XB_XGEN(b.x)], 1u);
            asm volatile("s_waitcnt vmcnt(0)" ::: "memory");
        } else {
            XB_SPIN(xb_ld(&bar[XB_XGEN(b.x)]) == gen, bar);
            __builtin_amdgcn_fence(__ATOMIC_ACQUIRE, "agent");
            asm volatile("s_waitcnt vmcnt(0)" ::: "memory");
        }
    }
}

namespace pg8 {
constexpr int BM = 256, BK = 64, HALF = 128, HTB = HALF * BK * 2  , STAGE_BYTES = 8 * HTB, NXCD = 8, WGM = 8;
__host__ __device__ __forceinline__ int lds_byte(int r, int c) { const int st = (r >> 4) * 2 + (c >> 5), rr = r & 15, cc = c & 31, ob = rr * 64 + cc * 2; return st * 1024 + (ob ^ (((ob >> 9) & 1) << 5)); }
__host__ __device__ __forceinline__ void stage_rc(int b, int& R, int& C) { const int st = b / 1024, sb = b % 1024, swz = sb ^ (((sb >> 9) & 1) << 5); R = (st >> 1) * 16 + swz / 64; C = (st & 1) * 32 + (swz % 64) / 2; }
__host__ __device__ __forceinline__ int perm32(int rho) { const int n = rho >> 4, i = rho & 15; return 8 * (i >> 2) + 4 * n + (i & 3); }

struct Unit { int pm, pn, om, on, e, mt, slot; };
struct Gemm { const bf16_t* A; const bf16_t* Bt; int K; };

__device__ __forceinline__ int xcd_remap(int L, int nwg) { const int q = nwg / NXCD, r = nwg % NXCD, xcd = L % NXCD, off = L / NXCD; return (xcd < r ? xcd * (q + 1) : r * (q + 1) + (xcd - r) * q) + off; }

__device__ __forceinline__ void plain_a_off(int pm, int tid, int K, unsigned (&o)[2][2]) {
#pragma unroll
    for (int i = 0; i < 2; ++i) { int R, C; stage_rc(tid * 16 + i * 8192, R, C);
#pragma unroll
        for (int h = 0; h < 2; ++h) o[h][i] = (unsigned)((pm * BM + h * HALF + R) * K + C) * 2u; }
}
struct StaticOrder {
    int nM, nN, nwg, G, c;
    __device__ void init(int nM_, int nN_, int G_, int c_, int = 1) { nM = nM_; nN = nN_; nwg = nM * nN; G = G_; c = c_; }
    __device__ __forceinline__ bool tile(int i, int& pm, int& pn, int& q) const {
        const int L = i * G + c; if (L >= nwg) return false;
        q = 0xF; const int wgid = xcd_remap(L, nwg);
        const int nig = WGM * nN, gid = wgid / nig, fm = gid * WGM, gsz = (nM - fm) < WGM ? (nM - fm) : WGM;
        pm = fm + ((wgid % nig) % gsz); pn = (wgid % nig) / gsz; return true;
    }
    __device__ __forceinline__ bool next(int i, Unit& u) const { int pm, pn, q; if (!tile(i, pm, pn, q)) return false; u.pm = pm; u.pn = pn; u.om = pm; u.on = pn; u.e = 0; u.mt = 0; u.slot = 0; return true; }
    __device__ __forceinline__ void a_off(const Unit& u, int tid, int K, unsigned (&o)[2][2]) const { plain_a_off(u.pm, tid, K, o); }
};

__device__ __forceinline__ unsigned cvt_pk_bf16(float lo, float hi) { unsigned r; asm volatile("v_cvt_pk_bf16_f32 %0, %1, %2" : "=v"(r) : "v"(lo), "v"(hi)); return r; }

template <class Epi, class Sched, bool ALIGN_EPI, int DRY = 0, bool I8 = false>
__device__ __forceinline__ void gemm_phase(LAS unsigned char* lds, const Gemm g, const Sched& S, const Epi& E, int wvid) {
    int tid_ = (wvid * 64 + lane_id_asm()); asm volatile("" : "+v"(tid_));
    const int tid = tid_, wid = __builtin_amdgcn_readfirstlane(tid >> 6), lane = tid & 63, wr = wid >> 2, wc = wid & 3, fr = lane & 15, fq = lane >> 4;
    const int K = g.K, nt = K / BK;
    unsigned voffB[2];
#pragma unroll
    for (int i = 0; i < 2; ++i) { int R, C; stage_rc(tid * 16 + i * 8192, R, C); const int Rb = Epi::PERM ? ((R & ~31) + perm32(R & 31)) : R;
        voffB[i] = (unsigned)(Rb * K + C) * 2u; }
    constexpr unsigned kstep = BK * 2;
    const unsigned hstep = (unsigned)HALF * K * 2;
    const unsigned tstep = 2 * hstep;
    const unsigned ldsw = (unsigned)wid * 1024u;
    const int aoff = lds_byte(wr * 64 + fr, fq * 8), boff = lds_byte(wc * 32 + fr, fq * 8);
#define PG8_SA(b, h) (((b) * 2 + (h)) * HTB)
#define PG8_SB(b, h) ((4 + (b) * 2 + (h)) * HTB)
#define PG8_STAGE(bufoff, gbase, voff) do { _Pragma("unroll") for (int _i = 0; _i < 2; ++_i) \
        __builtin_amdgcn_global_load_lds((const unsigned*)((const char*)(gbase) + (voff)[_i]), (LAS unsigned*)(lds + (bufoff) + ldsw + _i * 8192), 16, 0, 0); } while (0)
#define PG8_LDA(dst, b, h) do { _Pragma("unroll") for (int m = 0; m < 4; ++m) _Pragma("unroll") for (int k = 0; k < 2; ++k) dst[m][k] = *(const LAS bf16x8*)(lds + PG8_SA(b, h) + aoff + m * 2048 + k * 1024); } while (0)
#define PG8_LDB(dst, b, h) do { _Pragma("unroll") for (int n = 0; n < 2; ++n) _Pragma("unroll") for (int k = 0; k < 2; ++k) dst[n][k] = *(const LAS bf16x8*)(lds + PG8_SB(b, h) + boff + n * 2048 + k * 1024); } while (0)
#define PG8_MMA(ai, bj, At, Bt) do { if constexpr (DRY == 1) { _Pragma("unroll") for (int m = 0; m < 4; ++m) _Pragma("unroll") for (int k = 0; k < 2; ++k) asm volatile("" :: "v"(At[m][k])); _Pragma("unroll") for (int n = 0; n < 2; ++n) _Pragma("unroll") for (int k = 0; k < 2; ++k) asm volatile("" :: "v"(Bt[n][k])); break; } __builtin_amdgcn_s_setprio(1); _Pragma("unroll") for (int m = 0; m < 4; ++m) _Pragma("unroll") for (int n = 0; n < 2; ++n) _Pragma("unroll") for (int k = 0; k < 2; ++k) \
        { if constexpr (I8) acc[ai][bj][m][n] = __builtin_bit_cast(AccT, __builtin_amdgcn_mfma_i32_16x16x64_i8(__builtin_bit_cast(i32x4, Bt[n][k]), __builtin_bit_cast(i32x4, At[m][k]), __builtin_bit_cast(i32x4, acc[ai][bj][m][n]), 0, 0, 0)); \
          else acc[ai][bj][m][n] = __builtin_bit_cast(AccT, __builtin_amdgcn_mfma_f32_16x16x32_bf16(Bt[n][k], At[m][k], __builtin_bit_cast(f32x4, acc[ai][bj][m][n]), 0, 0, 0)); } __builtin_amdgcn_s_setprio(0); } while (0)
#define PG8_WAIT_V(n) asm volatile("s_waitcnt vmcnt(" #n ")" ::: "memory")
#define PG8_WAIT_L(n) asm volatile("s_waitcnt lgkmcnt(" #n ")" ::: "memory")
#define PG8_BAR __builtin_amdgcn_s_barrier()
#define PG8_SCHED __builtin_amdgcn_sched_barrier(0)
    Unit cur, nxt; int ui = 0;
    if (!S.next(0, cur)) return;
    typedef typename Epi::AccT AccT;
    AccT acc[2][2][4][2];
#pragma unroll
    for (int a = 0; a < 2; ++a)
#pragma unroll
        for (int b = 0; b < 2; ++b)
#pragma unroll
            for (int m = 0; m < 4; ++m)
#pragma unroll
                for (int n = 0; n < 2; ++n) acc[a][b][m][n] = AccT{};
    bf16x8 At[4][2], B0[2][2], B1[2][2];
    unsigned aC[2][2];
    S.a_off(cur, tid, K, aC);
    const char* const Ab = (const char*)g.A;
    const char* cB = (const char*)g.Bt + (size_t)cur.pn * tstep;
    PG8_STAGE(PG8_SB(0, 0), cB, voffB); PG8_STAGE(PG8_SB(0, 1), cB + hstep, voffB); PG8_STAGE(PG8_SA(0, 0), Ab, aC[0]); PG8_STAGE(PG8_SA(0, 1), Ab, aC[1]);
    if (wr == 1) PG8_BAR;
    PG8_WAIT_V(2); PG8_BAR;
    PG8_STAGE(PG8_SB(1, 0), cB + kstep, voffB); PG8_STAGE(PG8_SA(1, 0), Ab + kstep, aC[0]); PG8_STAGE(PG8_SB(1, 1), cB + hstep + kstep, voffB);
    PG8_WAIT_V(6); PG8_BAR;
    for (;;) {
        const bool has_next = S.next(ui + 1, nxt);
        const char* nB = has_next ? (const char*)g.Bt + (size_t)nxt.pn * tstep : cB;
        for (int t = 0; t < nt; t += 2) {
            const bool last = (t == nt - 2);
            const char* a1 = Ab + (size_t)(t + 1) * kstep;
            const char* a2 = last ? Ab : Ab + (size_t)(t + 2) * kstep; const char* b2 = last ? nB : cB + (size_t)(t + 2) * kstep;
            const char* a3 = a2 + kstep; const char* b3 = b2 + kstep;
            PG8_LDB(B0, 0, 0); PG8_LDB(B1, 0, 1); PG8_SCHED; PG8_LDA(At, 0, 0); PG8_STAGE(PG8_SA(1, 1), a1, aC[1]);
            if (last && has_next) S.a_off(nxt, tid, K, aC);
            PG8_WAIT_V(8); PG8_WAIT_L(0); PG8_BAR; PG8_MMA(0, 0, At, B0); PG8_MMA(0, 1, At, B1); PG8_BAR; PG8_SCHED;
            PG8_LDA(At, 0, 1); PG8_STAGE(PG8_SB(0, 0), b2, voffB); PG8_STAGE(PG8_SB(0, 1), b2 + hstep, voffB); PG8_STAGE(PG8_SA(0, 0), a2, aC[0]);
            PG8_WAIT_V(8); PG8_WAIT_L(0); PG8_BAR; PG8_MMA(1, 0, At, B0); PG8_MMA(1, 1, At, B1); PG8_BAR; PG8_SCHED;
            PG8_LDB(B0, 1, 0); PG8_LDB(B1, 1, 1); PG8_SCHED; PG8_LDA(At, 1, 0); PG8_STAGE(PG8_SA(0, 1), a2, aC[1]);
            PG8_WAIT_V(8); PG8_WAIT_L(0); PG8_BAR; PG8_MMA(0, 0, At, B0); PG8_MMA(0, 1, At, B1); PG8_BAR; PG8_SCHED;
            PG8_LDA(At, 1, 1); PG8_STAGE(PG8_SB(1, 0), b3, voffB); PG8_STAGE(PG8_SB(1, 1), b3 + hstep, voffB); PG8_STAGE(PG8_SA(1, 0), a3, aC[0]);
            PG8_WAIT_V(8); PG8_WAIT_L(0); PG8_BAR; PG8_MMA(1, 0, At, B0); PG8_MMA(1, 1, At, B1); PG8_BAR; PG8_SCHED;
        }
        if constexpr (ALIGN_EPI) { if (wr == 0) PG8_BAR; }
        if constexpr (DRY == 0) E(acc, cur, wr, wc, fr, fq); else { _Pragma("unroll") for (int a = 0; a < 2; ++a) _Pragma("unroll") for (int b = 0; b < 2; ++b) _Pragma("unroll") for (int m = 0; m < 4; ++m) _Pragma("unroll") for (int n = 0; n < 2; ++n) asm volatile("" :: "v"(acc[a][b][m][n])); }
        if (!has_next) break;
#pragma unroll
        for (int a = 0; a < 2; ++a)
#pragma unroll
            for (int b = 0; b < 2; ++b)
#pragma unroll
                for (int m = 0; m < 4; ++m)
#pragma unroll
                    for (int n = 0; n < 2; ++n) acc[a][b][m][n] = AccT{};
        cur = nxt; cB = nB; ++ui;
        if constexpr (ALIGN_EPI) { if (wr == 1) PG8_BAR; }
    }
    PG8_WAIT_V(0);
    if constexpr (!ALIGN_EPI) { if (wr == 0) PG8_BAR; }
    PG8_BAR;
#undef PG8_SA
#undef PG8_SB
#undef PG8_STAGE
#undef PG8_LDA
#undef PG8_LDB
#undef PG8_MMA
#undef PG8_WAIT_V
#undef PG8_WAIT_L
#undef PG8_BAR
#undef PG8_SCHED
}
}
namespace pg8 {
typedef const f32x4 (&AccRef)[2][2][4][2];
typedef const i32x4 (&AccRefI)[2][2][4][2];
__device__ __forceinline__ f32x4 i2f(const i32x4 v) { return (f32x4){(float)v[0], (float)v[1], (float)v[2], (float)v[3]}; }

struct EpiInProj {
    static constexpr bool PERM = true; typedef f32x4 AccT;
    unsigned char* ws;
    __device__ __forceinline__ void operator()(AccRef acc, const Unit& u, int wr, int wc, int fr, int fq) const {
        const int pn = u.on, row0 = u.om * BM + wr * 64 + fr, cw = wc * 32 + 8 * fq;
        if (pn >= 4 && pn < 12) {
#pragma unroll
            for (int ai = 0; ai < 2; ++ai)
#pragma unroll
                for (int m = 0; m < 4; ++m) { const f32x4 v0 = acc[ai][0][m][0] * acc[ai][1][m][0], v1 = acc[ai][0][m][1] * acc[ai][1][m][1];
                    u32x4 w; w.x = cvt_pk_bf16(v0[0], v0[1]); w.y = cvt_pk_bf16(v0[2], v0[3]); w.z = cvt_pk_bf16(v1[0], v1[1]); w.w = cvt_pk_bf16(v1[2], v1[3]);
                    *(u32x4*)((bf16_t*)(ws + WS_U) + (size_t)(row0 + ai * HALF + m * 16) * D + (pn - 4) * 128 + cw) = w; }
            return;
        }
        size_t doff; int ldc = D, cb, mode = 0;
        if (pn < 4) { doff = WS_BG; cb = pn * 256; }
        else if (pn < 16) { doff = WS_Q; cb = (pn - 12) * 256; mode = 1; }
        else if (pn == 16) { doff = WS_K; cb = 0; ldc = 256; }
        else if (pn == 17) { doff = WS_V; cb = 0; ldc = 256; }
        else if (pn < 22) { doff = WS_GC; cb = (pn - 18) * 256; mode = 2; }
        else { doff = WS_GA; cb = (pn - 22) * 256; mode = 2; }
        bf16_t* dst = (bf16_t*)(ws + doff);
#pragma unroll
        for (int ai = 0; ai < 2; ++ai)
#pragma unroll
            for (int m = 0; m < 4; ++m) { bf16_t* rowp = dst + (size_t)(row0 + ai * HALF + m * 16) * ldc + cb + cw;
#pragma unroll
                for (int bj = 0; bj < 2; ++bj) { f32x4 v0 = acc[ai][bj][m][0], v1 = acc[ai][bj][m][1];
                    if (mode == 1) { v0 = v0 * QSCALE; v1 = v1 * QSCALE; }
                    if (mode == 2) {
#pragma unroll
                        for (int j = 0; j < 4; ++j) { v0[j] = fast_sigmoid(v0[j]); v1[j] = fast_sigmoid(v1[j]); } }
                    u32x4 w; w.x = cvt_pk_bf16(v0[0], v0[1]); w.y = cvt_pk_bf16(v0[2], v0[3]); w.z = cvt_pk_bf16(v1[0], v1[1]); w.w = cvt_pk_bf16(v1[2], v1[3]);
                    *(u32x4*)(rowp + bj * HALF) = w; } }
    }
};

struct EpiInProjI8 {
    static constexpr bool PERM = true; typedef i32x4 AccT;
    unsigned char* ws; float sw;
    __device__ __forceinline__ void operator()(AccRefI acc, const Unit& u, int wr, int wc, int fr, int fq) const {
        const int pn = u.on, row0 = u.om * BM + wr * 64 + fr, cw = wc * 32 + 8 * fq;
        const float* sx0 = (const float*)(ws + WS_SX0) + row0;
        float sxv[2][4];
#pragma unroll
        for (int ai = 0; ai < 2; ++ai)
#pragma unroll
            for (int m = 0; m < 4; ++m) sxv[ai][m] = sx0[ai * HALF + m * 16];
        if (pn >= 4 && pn < 12) {
#pragma unroll
            for (int ai = 0; ai < 2; ++ai)
#pragma unroll
                for (int m = 0; m < 4; ++m) { const float s = sxv[ai][m] * sw, s2 = s * s;
                    const f32x4 v0 = i2f(acc[ai][0][m][0]) * i2f(acc[ai][1][m][0]) * s2, v1 = i2f(acc[ai][0][m][1]) * i2f(acc[ai][1][m][1]) * s2;
                    u32x4 w; w.x = cvt_pk_bf16(v0[0], v0[1]); w.y = cvt_pk_bf16(v0[2], v0[3]); w.z = cvt_pk_bf16(v1[0], v1[1]); w.w = cvt_pk_bf16(v1[2], v1[3]);
                    *(u32x4*)((bf16_t*)(ws + WS_U) + (size_t)(row0 + ai * HALF + m * 16) * D + (pn - 4) * 128 + cw) = w; asm volatile("" ::: "memory"); }
            return;
        }
        size_t doff; int ldc = D, cb, mode = 0;
        if (pn < 4) { doff = WS_BG; cb = pn * 256; }
        else if (pn < 16) { doff = WS_Q; cb = (pn - 12) * 256; mode = 1; }
        else if (pn == 16) { doff = WS_K; cb = 0; ldc = 256; }
        else if (pn == 17) { doff = WS_V; cb = 0; ldc = 256; }
        else if (pn < 22) { doff = WS_GC; cb = (pn - 18) * 256; mode = 2; }
        else { doff = WS_GA; cb = (pn - 22) * 256; mode = 2; }
        bf16_t* dst = (bf16_t*)(ws + doff);
#pragma unroll
        for (int ai = 0; ai < 2; ++ai)
#pragma unroll
            for (int m = 0; m < 4; ++m) { bf16_t* rowp = dst + (size_t)(row0 + ai * HALF + m * 16) * ldc + cb + cw; const float s = sxv[ai][m] * sw * (mode == 1 ? QSCALE : 1.0f);
#pragma unroll
                for (int bj = 0; bj < 2; ++bj) { f32x4 v0 = i2f(acc[ai][bj][m][0]) * s, v1 = i2f(acc[ai][bj][m][1]) * s;
                    if (mode == 2) {
#pragma unroll
                        for (int j = 0; j < 4; ++j) { v0[j] = fast_sigmoid(v0[j]); v1[j] = fast_sigmoid(v1[j]); } }
                    u32x4 w; w.x = cvt_pk_bf16(v0[0], v0[1]); w.y = cvt_pk_bf16(v0[2], v0[3]); w.z = cvt_pk_bf16(v1[0], v1[1]); w.w = cvt_pk_bf16(v1[2], v1[3]);
                    *(u32x4*)(rowp + bj * HALF) = w; }
                asm volatile("" ::: "memory"); }
    }
};

struct EpiDual {
    static constexpr bool PERM = true; typedef f32x4 AccT;
    unsigned char* ws;
    __device__ __forceinline__ void operator()(AccRef acc, const Unit& u, int wr, int wc, int fr, int fq) const {
        const int row0 = u.om * BM + wr * 64 + fr, col0 = u.on * BM + wc * 32 + 8 * fq;
        const bf16_t* G = (const bf16_t*)(ws + (u.e == 0 ? WS_GC : WS_GA)); bf16_t* T1 = (bf16_t*)(ws + WS_T1); bf16_t* MG = (bf16_t*)(ws + WS_MG);
#pragma unroll
        for (int ai = 0; ai < 2; ++ai)
#pragma unroll
            for (int m = 0; m < 4; ++m) { const size_t ro = (size_t)(row0 + ai * HALF + m * 16) * D + col0;
#pragma unroll
                for (int bj = 0; bj < 2; ++bj) { const size_t o = ro + bj * HALF;
                    const u32x4 gw = *(const u32x4*)(G + o);
                    f32x4 g0 = {bflo(gw.x), bfhi(gw.x), bflo(gw.y), bfhi(gw.y)}, g1 = {bflo(gw.z), bfhi(gw.z), bflo(gw.w), bfhi(gw.w)};
                    f32x4 v0 = g0 * acc[ai][bj][m][0], v1 = g1 * acc[ai][bj][m][1];
                    if (u.e == 0) { u32x4 w; w.x = cvt_pk_bf16(v0[0], v0[1]); w.y = cvt_pk_bf16(v0[2], v0[3]); w.z = cvt_pk_bf16(v1[0], v1[1]); w.w = cvt_pk_bf16(v1[2], v1[3]); *(u32x4*)(T1 + o) = w; }
                    else { const u32x4 tw_ = *(const u32x4*)(T1 + o);
                        v0 = v0 + (f32x4){bflo(tw_.x), bfhi(tw_.x), bflo(tw_.y), bfhi(tw_.y)}; v1 = v1 + (f32x4){bflo(tw_.z), bfhi(tw_.z), bflo(tw_.w), bfhi(tw_.w)};
                        u32x4 w; w.x = cvt_pk_bf16(v0[0], v0[1]); w.y = cvt_pk_bf16(v0[2], v0[3]); w.z = cvt_pk_bf16(v1[0], v1[1]); w.w = cvt_pk_bf16(v1[2], v1[3]);
                        *(u32x4*)(MG + o) = w; } } }
    }
};

struct EpiResid {
    static constexpr bool PERM = false; typedef f32x4 AccT;
    const float* X; float* C;
    __device__ __forceinline__ void operator()(AccRef acc, const Unit& u, int wr, int wc, int fr, int fq) const {
        const int row0 = u.om * BM + wr * 64 + fr, col0 = u.on * BM + wc * 32 + 4 * fq;
#pragma unroll
        for (int ai = 0; ai < 2; ++ai)
#pragma unroll
            for (int m = 0; m < 4; ++m) { const size_t ro = (size_t)(row0 + ai * HALF + m * 16) * D + col0;
#pragma unroll
                for (int bj = 0; bj < 2; ++bj)
#pragma unroll
                    for (int n = 0; n < 2; ++n) { const size_t o = ro + bj * HALF + n * 16; *(f32x4*)(C + o) = *(const f32x4*)(X + o) * DN_ALPHA + acc[ai][bj][m][n]; } }
    }
};

struct EpiF32 {
    static constexpr bool PERM = false; typedef f32x4 AccT;
    float* C;
    __device__ __forceinline__ void operator()(AccRef acc, const Unit& u, int wr, int wc, int fr, int fq) const {
        const int row0 = u.om * BM + wr * 64 + fr, col0 = u.on * BM + wc * 32 + 4 * fq;
#pragma unroll
        for (int ai = 0; ai < 2; ++ai)
#pragma unroll
            for (int m = 0; m < 4; ++m) { const size_t ro = (size_t)(row0 + ai * HALF + m * 16) * D + col0;
#pragma unroll
                for (int bj = 0; bj < 2; ++bj)
#pragma unroll
                    for (int n = 0; n < 2; ++n) *(f32x4*)(C + ro + bj * HALF + n * 16) = acc[ai][bj][m][n]; }
    }
};
struct EpiF32I8 {
    static constexpr bool PERM = false; typedef i32x4 AccT;
    float* C; const float* sp; float sw;
    __device__ __forceinline__ void operator()(AccRefI acc, const Unit& u, int wr, int wc, int fr, int fq) const {
        const int row0 = u.om * BM + wr * 64 + fr, col0 = u.on * BM + wc * 32 + 4 * fq;
        float sv[2][4];
#pragma unroll
        for (int ai = 0; ai < 2; ++ai)
#pragma unroll
            for (int m = 0; m < 4; ++m) sv[ai][m] = sp[row0 + ai * HALF + m * 16] * sw;
#pragma unroll
        for (int ai = 0; ai < 2; ++ai)
#pragma unroll
            for (int m = 0; m < 4; ++m) { const size_t ro = (size_t)(row0 + ai * HALF + m * 16) * D + col0;
#pragma unroll
                for (int bj = 0; bj < 2; ++bj)
#pragma unroll
                    for (int n = 0; n < 2; ++n) *(f32x4*)(C + ro + bj * HALF + n * 16) = i2f(acc[ai][bj][m][n]) * sv[ai][m]; }
    }
};
__device__ __forceinline__ void ple_epilogue(AccRef acc, const Unit& u, int wr, int wc, int fr, int fq, const float* P2, bf16_t* PLE) {
    const int row0 = u.om * BM + wr * 64 + fr, col0 = u.on * BM + wc * 32 + 8 * fq;
#pragma unroll
    for (int ai = 0; ai < 2; ++ai)
#pragma unroll
        for (int m = 0; m < 4; ++m) { const size_t ro = (size_t)(row0 + ai * HALF + m * 16) * D + col0;
#pragma unroll
            for (int bj = 0; bj < 2; ++bj) { const size_t o = ro + bj * HALF; const f32x4 p0 = *(const f32x4*)(P2 + o), p1 = *(const f32x4*)(P2 + o + 4); const f32x4 a0 = acc[ai][bj][m][0], a1 = acc[ai][bj][m][1];
                u32x4 w; w.x = cvt_pk_bf16(fast_sigmoid(a0[0]) * p0[0], fast_sigmoid(a0[1]) * p0[1]); w.y = cvt_pk_bf16(fast_sigmoid(a0[2]) * p0[2], fast_sigmoid(a0[3]) * p0[3]);
                w.z = cvt_pk_bf16(fast_sigmoid(a1[0]) * p1[0], fast_sigmoid(a1[1]) * p1[1]); w.w = cvt_pk_bf16(fast_sigmoid(a1[2]) * p1[2], fast_sigmoid(a1[3]) * p1[3]);
                *(u32x4*)(PLE + o) = w; }
            if (m & 1) asm volatile("" ::: "memory"); }
}

struct EpiSwiglu {
    static constexpr bool PERM = true; typedef f32x4 AccT;
    bf16_t* H; const float* b_gu; const LAS unsigned* tw; unsigned char* ws;
    __device__ __forceinline__ void operator()(AccRef acc, const Unit& u, int wr, int wc, int fr, int fq) const {
        if (u.e < 0) { ple_epilogue(acc, u, wr, wc, fr, fq, (const float*)(ws + WS_P2), (bf16_t*)(ws + WS_PLE)); return; }
        const int trow0 = wr * 64 + fr, row0 = u.om * BM + trow0, cw = wc * 32 + 8 * fq, col0 = u.on * 128 + cw;
        const float* bg = b_gu + (size_t)u.e * 2048 + col0;
#pragma unroll
        for (int n = 0; n < 2; ++n) { const f32x4 bgn = *(const f32x4*)(bg + 4 * n), bun = *(const f32x4*)(bg + 1024 + 4 * n);
#pragma unroll
            for (int ai = 0; ai < 2; ++ai)
#pragma unroll
                for (int m = 0; m < 4; ++m) { const float w = bfhi(tw[u.slot * BM + trow0 + ai * HALF + m * 16]);
                    const f32x4 gt = acc[ai][0][m][n] + bgn, up = acc[ai][1][m][n] + bun; f32x4 hv;
#pragma unroll
                    for (int j = 0; j < 4; ++j) { const float gv = fminf(gt[j], 7.0f), uv = fminf(fmaxf(up[j], -7.0f), 7.0f); hv[j] = (uv + 1.0f) * gv * fast_sigmoid(1.702f * gv) * w; }
                    u32x2 o; o.x = cvt_pk_bf16(hv[0], hv[1]); o.y = cvt_pk_bf16(hv[2], hv[3]);
                    *(u32x2*)(H + (size_t)(row0 + ai * HALF + m * 16) * D + col0 + 4 * n) = o; } }
    }
};
struct EpiSwigluI8 {
    static constexpr bool PERM = true; typedef i32x4 AccT;
    bf16_t* H; const float* b_gu; const LAS unsigned* tw; unsigned char* ws;
    __device__ __forceinline__ void operator()(AccRefI acc, const Unit& u, int wr, int wc, int fr, int fq) const {
        const int trow0 = wr * 64 + fr, row0 = u.om * BM + trow0, cw = wc * 32 + 8 * fq;
        const float* scl = (const float*)(ws + WS_SCL);
        if (u.e < 0) {
            const float* P2 = (const float*)(ws + WS_P2); bf16_t* PLE = (bf16_t*)(ws + WS_PLE); const float* sx1 = (const float*)(ws + WS_SX1);
            const float spg = scl[NE]; const int col0 = u.on * BM + cw;
#pragma unroll
            for (int ai = 0; ai < 2; ++ai)
#pragma unroll
                for (int m = 0; m < 4; ++m) { const int r = row0 + ai * HALF + m * 16; const float s = sx1[r] * spg; const size_t ro = (size_t)r * D + col0;
#pragma unroll
                    for (int bj = 0; bj < 2; ++bj) { const size_t o = ro + bj * HALF; const f32x4 p0 = *(const f32x4*)(P2 + o), p1 = *(const f32x4*)(P2 + o + 4); const f32x4 a0 = i2f(acc[ai][bj][m][0]) * s, a1 = i2f(acc[ai][bj][m][1]) * s;
                        u32x4 w; w.x = cvt_pk_bf16(fast_sigmoid(a0[0]) * p0[0], fast_sigmoid(a0[1]) * p0[1]); w.y = cvt_pk_bf16(fast_sigmoid(a0[2]) * p0[2], fast_sigmoid(a0[3]) * p0[3]);
                        w.z = cvt_pk_bf16(fast_sigmoid(a1[0]) * p1[0], fast_sigmoid(a1[1]) * p1[1]); w.w = cvt_pk_bf16(fast_sigmoid(a1[2]) * p1[2], fast_sigmoid(a1[3]) * p1[3]);
                        *(u32x4*)(PLE + o) = w; }
                    if (m & 1) asm volatile("" ::: "memory"); }
            return; }
        const int col0 = u.on * 128 + cw;
        const float* bg = b_gu + (size_t)u.e * 2048 + col0; const float sg = scl[u.e];
        const float* lsx = (const float*)(ws + WS_LSX) + (size_t)u.e * LISTCAP + u.mt * BM + trow0;
        const f32x4 bg0 = *(const f32x4*)(bg), bg1 = *(const f32x4*)(bg + 4), bu0 = *(const f32x4*)(bg + 1024), bu1 = *(const f32x4*)(bg + 1028);
        unsigned char* H8 = (unsigned char*)H;
        float lsv[2][4];
#pragma unroll
        for (int ai = 0; ai < 2; ++ai)
#pragma unroll
            for (int m = 0; m < 4; ++m) lsv[ai][m] = lsx[ai * HALF + m * 16];
#pragma unroll
        for (int ai = 0; ai < 2; ++ai)
#pragma unroll
            for (int m = 0; m < 4; ++m) { const unsigned twv = tw[u.slot * BM + trow0 + ai * HALF + m * 16]; const float qh = bfhi(twv);
                const float s = (qh != 0.f ? lsv[ai][m] : 0.f) * sg;
                unsigned q8[2];
#pragma unroll
                for (int n = 0; n < 2; ++n) { const f32x4 gt = i2f(acc[ai][0][m][n]) * s + (n == 0 ? bg0 : bg1), up = i2f(acc[ai][1][m][n]) * s + (n == 0 ? bu0 : bu1); unsigned q = 0u;
#pragma unroll
                    for (int j = 0; j < 4; ++j) { const float gv = fminf(gt[j], 7.0f), uv = __builtin_amdgcn_fmed3f(up[j], -7.0f, 7.0f);
                        const float sg_ = __builtin_amdgcn_rcpf(1.0f + __builtin_amdgcn_exp2f((-1.702f * LOG2E) * gv));
                        const float hq = __builtin_fmaf(__builtin_fmaf(uv, gv, gv) * sg_, qh, 128.0f);
                        q = __builtin_amdgcn_cvt_pk_u8_f32(__builtin_amdgcn_fmed3f(__builtin_rintf(hq), 1.0f, 255.0f), j, q); }
                    q8[n] = q ^ 0x80808080u; }
                *(u32x2*)(H8 + (size_t)(row0 + ai * HALF + m * 16) * D + col0) = (u32x2){q8[0], q8[1]};
                if (m & 1) asm volatile("" ::: "memory"); }
    }
};
struct EpiDownI8 {
    static constexpr bool PERM = true; typedef i32x4 AccT;
    bf16_t* Y; unsigned char* ws; const LAS int* cntL;
    __device__ __forceinline__ void operator()(AccRefI acc, const Unit& u, int wr, int wc, int fr, int fq) const {
        const int trow0 = wr * 64 + fr, row0 = u.om * BM + trow0, cw = wc * 32 + 8 * fq;
        const float* scl = (const float*)(ws + WS_SCL);
        if (u.e < 0) {
            const float* P2 = (const float*)(ws + WS_P2); bf16_t* PLE = (bf16_t*)(ws + WS_PLE); const float* sx1 = (const float*)(ws + WS_SX1);
            const float spg = scl[NE]; const int col0 = u.on * BM + cw;
#pragma unroll
            for (int ai = 0; ai < 2; ++ai)
#pragma unroll
                for (int m = 0; m < 4; ++m) { const int r = row0 + ai * HALF + m * 16; const float s = sx1[r] * spg; const size_t ro = (size_t)r * D + col0;
#pragma unroll
                    for (int bj = 0; bj < 2; ++bj) { const size_t o = ro + bj * HALF; const f32x4 p0 = *(const f32x4*)(P2 + o), p1 = *(const f32x4*)(P2 + o + 4); const f32x4 a0 = i2f(acc[ai][bj][m][0]) * s, a1 = i2f(acc[ai][bj][m][1]) * s;
                        u32x4 w; w.x = cvt_pk_bf16(fast_sigmoid(a0[0]) * p0[0], fast_sigmoid(a0[1]) * p0[1]); w.y = cvt_pk_bf16(fast_sigmoid(a0[2]) * p0[2], fast_sigmoid(a0[3]) * p0[3]);
                        w.z = cvt_pk_bf16(fast_sigmoid(a1[0]) * p1[0], fast_sigmoid(a1[1]) * p1[1]); w.w = cvt_pk_bf16(fast_sigmoid(a1[2]) * p1[2], fast_sigmoid(a1[3]) * p1[3]);
                        *(u32x4*)(PLE + o) = w; }
                    if (m & 1) asm volatile("" ::: "memory"); }
            return; }
        const float sd = scl[128 + u.e]; const int cnt = cntL[u.e], li0 = u.mt * BM + trow0;
        const float* lhs = (const float*)(ws + WS_LHS) + (size_t)u.e * LISTCAP + li0;
        bf16_t* yp = Y + (size_t)row0 * D + u.on * BM + cw;
        float lhv[2][4];
#pragma unroll
        for (int ai = 0; ai < 2; ++ai)
#pragma unroll
            for (int m = 0; m < 4; ++m) lhv[ai][m] = lhs[ai * HALF + m * 16];
#pragma unroll
        for (int ai = 0; ai < 2; ++ai)
#pragma unroll
            for (int m = 0; m < 4; ++m) { const int dr = ai * HALF + m * 16; const float s = ((li0 + dr) < cnt ? lhv[ai][m] : 0.f) * sd;
#pragma unroll
                for (int bj = 0; bj < 2; ++bj) { const f32x4 v0 = i2f(acc[ai][bj][m][0]) * s, v1 = i2f(acc[ai][bj][m][1]) * s;
                    u32x4 o; o.x = cvt_pk_bf16(v0[0], v0[1]); o.y = cvt_pk_bf16(v0[2], v0[3]); o.z = cvt_pk_bf16(v1[0], v1[1]); o.w = cvt_pk_bf16(v1[2], v1[3]);
                    *(u32x4*)(yp + (size_t)dr * D + bj * HALF) = o; }
                if (m & 1) asm volatile("" ::: "memory"); }
    }
};
struct EpiDown {
    static constexpr bool PERM = true; typedef f32x4 AccT;
    bf16_t* Y; unsigned char* ws;
    __device__ __forceinline__ void operator()(AccRef acc, const Unit& u, int wr, int wc, int fr, int fq) const {
        if (u.e < 0) { ple_epilogue(acc, u, wr, wc, fr, fq, (const float*)(ws + WS_P2), (bf16_t*)(ws + WS_PLE)); return; }
        bf16_t* yp = Y + (size_t)(u.om * BM + wr * 64 + fr) * D + u.on * BM + wc * 32 + 8 * fq;
#pragma unroll
        for (int ai = 0; ai < 2; ++ai)
#pragma unroll
            for (int m = 0; m < 4; ++m)
#pragma unroll
                for (int bj = 0; bj < 2; ++bj) { const f32x4 v0 = acc[ai][bj][m][0], v1 = acc[ai][bj][m][1];
                    u32x4 o; o.x = cvt_pk_bf16(v0[0], v0[1]); o.y = cvt_pk_bf16(v0[2], v0[3]); o.z = cvt_pk_bf16(v1[0], v1[1]); o.w = cvt_pk_bf16(v1[2], v1[3]);
                    *(u32x4*)(yp + (size_t)(ai * HALF + m * 16) * D + bj * HALF) = o; }
    }
};

struct DualOrder {
    StaticOrder so;
    __device__ __forceinline__ bool next(int i, Unit& u) const {
        int pm, pn, q; if (!so.tile(i >> 1, pm, pn, q)) return false;
        const int e = i & 1; u.pm = e * (M / BM) + pm; u.pn = e * 4 + pn; u.om = pm; u.on = pn; u.e = e; u.mt = 0; u.slot = 0; return true;
    }
    __device__ __forceinline__ void a_off(const Unit& u, int tid, int K, unsigned (&o)[2][2]) const { plain_a_off(u.pm, tid, K, o); }
};
struct MoeOrder {
    const LAS int* cntL; const LAS int* tsL; const LAS unsigned* tw; int NT, gather, btile0, btile_ple, n_extra, extra_first; unsigned abase, abase_ple; int U, UT, G, c; const LAS int* utab; int nunits;
    __device__ __forceinline__ void init(const LAS int* cntL_, const LAS int* tsL_, const LAS unsigned* tw_, int NT_, int G_, int c_, int gather_, size_t aoff_, size_t boff_, int n_extra_, int extra_first_, size_t aoff_ple_, size_t boff_ple_, int tshift_) {
        cntL = cntL_; tsL = tsL_; tw = tw_; NT = NT_; gather = gather_; abase = (unsigned)aoff_; btile0 = (int)(boff_ >> tshift_); abase_ple = (unsigned)aoff_ple_; btile_ple = (int)(boff_ple_ >> tshift_); n_extra = n_extra_; extra_first = extra_first_;
        U = __builtin_amdgcn_readfirstlane(tsL_[NE]) * NT_; UT = U + n_extra_; G = G_; c = c_; utab = nullptr; nunits = 0; }
    struct Own { int ok, maxT, maxC, totalFree; };
    __device__ __forceinline__ Own own_params(int split) const {
        Own o; int mx = 0, sumT = 0;
        for (int e = 0; e < NE; ++e) { const int T = tsL[e + 1] - tsL[e]; mx = T > mx ? T : mx; sumT += T; }
        o.maxT = mx; o.maxC = split == 1 ? mx : (mx + 1) >> 1; o.ok = 0;
        o.totalFree = split == 1 ? 8 * (NE * o.maxC - sumT) : 4 * (2 * NE * o.maxC - sumT);
        return o;
    }
    __device__ __forceinline__ static int ple_in_p5(const LAS int* tsL_, int G_) {
        int mx = 0, sumT = 0;
        for (int e = 0; e < NE; ++e) { const int T = tsL_[e + 1] - tsL_[e]; mx = T > mx ? T : mx; sumT += T; }
        int nfree;
        { const int U5 = sumT * 8; nfree = (G_ - U5 % G_) % G_; }
        return nfree < 256 ? nfree : 256;
    }
    __device__ __forceinline__ void build_units(LAS int* tab, int maxu, int tid, int p, int split) {
        const Own o = own_params(split);
        if (o.ok) {
            const int e = p >> 3, sub = p & 7, nt = split == 1 ? sub : sub >> 1, half = split == 1 ? 0 : sub & 1;
            const int t0 = tsL[e], T = tsL[e + 1] - t0, h0 = (T + 1) >> 1;
            const int myc = split == 1 ? T : (half ? T - h0 : h0), mt0 = (split == 2 && half) ? h0 : 0, myfree = o.maxC - myc;
            int prefix = 0;
            for (int k = 0; k < e; ++k) { const int Tk = tsL[k + 1] - tsL[k]; prefix += split == 1 ? 8 * (o.maxC - Tk) : 4 * (2 * o.maxC - Tk); }
            prefix += split == 1 ? sub * (o.maxC - T) : (sub >> 1) * (2 * o.maxC - T) + (half ? (o.maxC - h0) : 0);
            int nfill = n_extra - prefix; nfill = nfill < 0 ? 0 : (nfill > myfree ? myfree : nfill);
            int nover = 0; if (n_extra > o.totalFree) { const int rem = n_extra - o.totalFree - p; nover = rem > 0 ? (rem + 255) >> 8 : 0; }
            int n = myc + nfill + nover; if (n > maxu) n = maxu;
            if (tid < n) { LAS int* q = tab + 8 * tid;
                if (tid < myc) { const int mt = mt0 + tid; q[0] = t0 + mt; q[1] = btile0 + e * NT + nt; q[2] = nt; q[3] = e; q[4] = mt; }
                else { const int k = tid - myc; const int idx = k < nfill ? prefix + k : o.totalFree + (k - nfill) * 256 + p;
                    const int j = extra_first + idx, pm = (j >> 5) * 8 + (j & 7), pn = (j & 31) >> 3; q[0] = pm; q[1] = btile_ple + pn; q[2] = pn; q[3] = -1; q[4] = 0; } }
            __syncthreads();
            utab = tab; nunits = n; return;
        }
        if (tid < maxu) { const int L = tid * G + c;
            if (L < UT) { LAS int* q = tab + 8 * tid;
                if (L >= U) { const int j = extra_first + (L - U), pm = (j >> 5) * 8 + (j & 7), pn = (j & 31) >> 3; q[0] = pm; q[1] = btile_ple + pn; q[2] = pn; q[3] = -1; q[4] = 0; }
                else { const int wgid = xcd_remap(L, U); int e = 0;
                    for (int k = 1; k < NE; ++k) e += (wgid >= tsL[k] * NT) ? 1 : 0;
                    const int t0 = tsL[e], ntl = tsL[e + 1] - t0, r = wgid - t0 * NT, nt = r / ntl, mt = r - nt * ntl;
                    q[0] = t0 + mt; q[1] = btile0 + e * NT + nt; q[2] = nt; q[3] = e; q[4] = mt; } } }
        __syncthreads();
        utab = tab; nunits = c < UT ? (UT - 1 - c) / G + 1 : 0; if (nunits > maxu) nunits = maxu;
    }
    __device__ __forceinline__ bool next(int i, Unit& u) const {
        if (i >= nunits) return false;
        const LAS int* p = utab + 8 * i;
        u.pm = __builtin_amdgcn_readfirstlane(p[0]); u.pn = __builtin_amdgcn_readfirstlane(p[1]); u.om = u.pm; u.on = __builtin_amdgcn_readfirstlane(p[2]);
        u.e = __builtin_amdgcn_readfirstlane(p[3]); u.mt = __builtin_amdgcn_readfirstlane(p[4]); u.slot = i; return true;
    }
    __device__ __forceinline__ void a_off(const Unit& u, int tid, int K, unsigned (&o)[2][2]) const {
        if (u.e < 0 || !gather) { plain_a_off(u.pm, tid, K, o); const unsigned base = u.e < 0 ? abase_ple : abase;
#pragma unroll
            for (int h = 0; h < 2; ++h)
#pragma unroll
                for (int i = 0; i < 2; ++i) o[h][i] += base;
            return; }
#pragma unroll
        for (int i = 0; i < 2; ++i) { int R, C; stage_rc(tid * 16 + i * 8192, R, C);
#pragma unroll
            for (int h = 0; h < 2; ++h) { const int tok = (int)(tw[u.slot * BM + h * HALF + R] & 0xffffu);
                o[h][i] = (unsigned)(tok * K + C) * 2u + abase; } }
    }
};
constexpr int MOE_MAXU = 10;
__device__ __forceinline__ void moe_preload(const MoeOrder& S, const LAS int* cntL, const int* list_tok, const float* list_w, LAS unsigned* tw, int wvid) {
    int tid_ = (wvid * 64 + lane_id_asm()); asm volatile("" : "+v"(tid_)); const int tid = tid_;
    int tokv[MOE_MAXU / 2]; float wv[MOE_MAXU / 2];
#pragma unroll
    for (int k = 0; k < MOE_MAXU / 2; ++k) { const int ent = tid + NTHREADS * k, slot = ent >> 8, row = ent & 255; tokv[k] = 0; wv[k] = 0.f;
        if (slot < S.nunits) { const LAS int* p = S.utab + 8 * slot; const int e = p[3], mt = p[4], li = mt * BM + row;
            if (e >= 0 && li < cntL[e]) { tokv[k] = list_tok[(size_t)e * LISTCAP + li]; wv[k] = list_w[(size_t)e * LISTCAP + li]; } } }
#pragma unroll
    for (int k = 0; k < MOE_MAXU / 2; ++k) { const int ent = tid + NTHREADS * k; if ((ent >> 8) < S.nunits) tw[ent] = (unsigned)tokv[k] | (f2bf(wv[k]) << 16); }
    __syncthreads();
}
struct Ple1Order {
    int first, n;
    __device__ __forceinline__ bool next(int i, Unit& u) const { if (i >= n) return false; const int j = first + i, pm = (j >> 5) * 8 + (j & 7), pn = (j & 31) >> 3;
        u.pm = pm; u.pn = pn; u.om = pm; u.on = pn; u.e = 0; u.mt = 0; u.slot = 0; return true; }
    __device__ __forceinline__ void a_off(const Unit& u, int tid, int K, unsigned (&o)[2][2]) const { plain_a_off(u.pm, tid, K, o); }
};
}
__device__ __forceinline__ int dst_row(int n, int map) {
    if (map == 1) { if (n >= 1024 && n < 3072) { const int hsel = n >= 2048, c = n - 1024 - hsel * 1024; return 1024 + (c >> 7) * 256 + hsel * 128 + (c & 127); } return n; }
    if (map == 2) { const int hsel = n >= 1024, c = n - hsel * 1024; return (c >> 7) * 256 + hsel * 128 + (c & 127); }
    return n;
}
struct P0Args { const float *x, *p, *w_in, *w_brc, *w_bra, *w_out, *w_pg, *w_pp, *w_gu, *w_dn; unsigned char* ws; float s_in, s_pp; };
struct P0Item { const float* src; bf16_t* dst; int K, N; float qinv; };
constexpr int P0_I_IN = 16 * (NIN / 64), P0_I_SQ = 16 * 16, P0_I_PP = 4 * 16, P0_I_GU = 16 * 32, P0_I_DN = 16 * 16;
constexpr int P0_NSMALL = P0_I_IN + 3 * P0_I_SQ + P0_I_PP;
constexpr int P0_NITEMS = P0_I_IN + 4 * P0_I_SQ + P0_I_PP + NE * P0_I_GU + NE * P0_I_DN;
__device__ __forceinline__ P0Item p0_decode(const P0Args& a, int it) {
    const float* W; bf16_t* WT; int K = D, N = D, map = 0, r = it; float qinv = 0.f; const float* scl = (const float*)(a.ws + WS_SCL);
    if (r < P0_I_IN) { W = a.w_in; WT = (bf16_t*)(a.ws + WS_WIN); N = NIN; map = 1; qinv = 1.0f / a.s_in; }
    else if ((r -= P0_I_IN) < P0_I_SQ) { W = a.w_brc; WT = (bf16_t*)(a.ws + WS_WBR); }
    else if ((r -= P0_I_SQ) < P0_I_SQ) { W = a.w_bra; WT = (bf16_t*)(a.ws + WS_WBR) + (size_t)D * D; }
    else if ((r -= P0_I_SQ) < P0_I_SQ) { W = a.w_out; WT = (bf16_t*)(a.ws + WS_WOUT); }
    else if ((r -= P0_I_SQ) < P0_I_PP) { W = a.w_pp; WT = (bf16_t*)(a.ws + WS_WPP); K = DPLE; }
    else if ((r -= P0_I_PP) < P0_I_SQ) { W = a.w_pg; WT = (bf16_t*)(a.ws + WS_WPG8); qinv = 1.0f / scl[NE]; }
    else if ((r -= P0_I_SQ) < NE * P0_I_GU) { const int e = r / P0_I_GU; r -= e * P0_I_GU; W = a.w_gu + (size_t)e * D * 2048; WT = (bf16_t*)(a.ws + WS_WGU + (size_t)e * 2048 * D); N = 2048; map = 2; qinv = 1.0f / scl[e]; }
    else { r -= NE * P0_I_GU; const int e = r / P0_I_DN; r -= e * P0_I_DN; W = a.w_dn + (size_t)e * D * D; WT = (bf16_t*)(a.ws + WS_WDN + (size_t)e * D * D); qinv = 1.0f / scl[128 + e]; }
    const int nblk = N / 64, kb = r / nblk, nb = r - kb * nblk, k0 = 64 * kb, n0 = 64 * nb;
    P0Item d; d.src = W + (size_t)k0 * N + n0; d.K = K; d.N = N; d.qinv = qinv;
    d.dst = qinv != 0.f ? (bf16_t*)((unsigned char*)WT + (size_t)dst_row(n0, map) * K + k0) : WT + (size_t)dst_row(n0, map) * K + k0; return d;
}
__device__ __forceinline__ void p0_load(const P0Item& d, f32x4 (&v)[16], int lane) {
    const int lr = lane >> 4, lc = (lane & 15) * 4;
#pragma unroll
    for (int i = 0; i < 16; ++i) v[i] = __builtin_nontemporal_load((const f32x4*)(d.src + (size_t)(4 * i + lr) * d.N + lc));
}
__device__ __forceinline__ void p0_store(const P0Item& d, const f32x4 (&v)[16], LAS float* scr, int lane) {
    const int lr = lane >> 4, lc = (lane & 15) * 4;
#pragma unroll
    for (int i = 0; i < 16; ++i) { LAS float* s = scr + (4 * i + lr) * 65 + lc; s[0] = v[i][0]; s[1] = v[i][1]; s[2] = v[i][2]; s[3] = v[i][3]; }
    asm volatile("s_waitcnt lgkmcnt(0)" ::: "memory");
    const int c = lane & 7;
#pragma unroll
    for (int j = 0; j < 8; ++j) { const int n = (lane >> 3) + 8 * j; const LAS float* s = scr + (8 * c) * 65 + n;
        if (d.qinv != 0.f) { unsigned lo = 0u, hi = 0u;
#pragma unroll
            for (int q = 0; q < 4; ++q) { const int a0 = (int)fminf(fmaxf(rintf(s[q * 65] * d.qinv), -127.f), 127.f), a1 = (int)fminf(fmaxf(rintf(s[(q + 4) * 65] * d.qinv), -127.f), 127.f);
                lo |= ((unsigned)a0 & 0xffu) << (8 * q); hi |= ((unsigned)a1 & 0xffu) << (8 * q); }
            *(u32x2*)((unsigned char*)d.dst + (size_t)n * d.K + 8 * c) = (u32x2){lo, hi}; }
        else { u32x4 o; o.x = pk2(s[0 * 65], s[1 * 65]); o.y = pk2(s[2 * 65], s[3 * 65]); o.z = pk2(s[4 * 65], s[5 * 65]); o.w = pk2(s[6 * 65], s[7 * 65]);
            *(u32x4*)(d.dst + (size_t)n * d.K + 8 * c) = o; } }
    asm volatile("s_waitcnt lgkmcnt(0)" ::: "memory");
}
constexpr int P0_FILL = 2, P0_FILL_SEAMS = 4;
__device__ __forceinline__ void p0_fill(const P0Args& a, LAS unsigned char* lds, int vcu, int G, int seam, int wave) {
    const int lane = lane_id_asm();
    LAS float* scr = (LAS float*)(lds + wave * 16640);
    const int base = P0_NSMALL + (((seam - 1) * G + vcu) * 7 + (wave - 1)) * P0_FILL;
    f32x4 va[16], vb[16];
    const P0Item da = p0_decode(a, base); p0_load(da, va, lane);
    if (P0_FILL >= 2) { const P0Item db = p0_decode(a, base + 1); p0_load(db, vb, lane); p0_store(da, va, scr, lane);
        if (P0_FILL >= 3) { const P0Item dc = p0_decode(a, base + 2); p0_load(dc, va, lane); p0_store(db, vb, scr, lane); p0_store(dc, va, scr, lane); }
        else p0_store(db, vb, scr, lane); }
    else p0_store(da, va, scr, lane);
}
__device__ __forceinline__ float sample_scale(const float* Wm, unsigned stride, LAS unsigned char* lds, int wvid, float* rms_out = nullptr) {
    int tid_ = (wvid * 64 + lane_id_asm()); asm volatile("" : "+v"(tid_)); const int tid = tid_, lane = tid & 63;
    const unsigned so = (unsigned)tid * stride;
    const f32x4 v0 = *(const f32x4*)(Wm + so), v1 = *(const f32x4*)(Wm + so + 4);
    float ss = (v0[0] * v0[0] + v0[1] * v0[1]) + (v0[2] * v0[2] + v0[3] * v0[3]) + (v1[0] * v1[0] + v1[1] * v1[1]) + (v1[2] * v1[2] + v1[3] * v1[3]);
    float mx = fmaxf(fmaxf(fmaxf(fabsf(v0[0]), fabsf(v0[1])), fmaxf(fabsf(v0[2]), fabsf(v0[3]))), fmaxf(fmaxf(fabsf(v1[0]), fabsf(v1[1])), fmaxf(fabsf(v1[2]), fabsf(v1[3]))));
    ss = wave_sum(ss, lane);
#pragma unroll
    for (int o = 1; o < 64; o <<= 1) mx = fmaxf(mx, shx(mx, o, lane));
    LAS float* red = (LAS float*)lds;
    __syncthreads();
    if ((tid & 63) == 0) { red[tid >> 6] = ss; red[8 + (tid >> 6)] = mx; }
    __syncthreads();
    float s = 0.f, m = 0.f;
#pragma unroll
    for (int w = 0; w < NWAVES; ++w) { s += red[w]; m = fmaxf(m, red[8 + w]); }
    __syncthreads();
    const float rms = sqrtf(s * (1.0f / 4096.0f)); if (rms_out) *rms_out = rms;
    return fmaxf(fmaxf(6.5f * rms, 1.25f * m), 1e-30f) * (1.0f / 127.0f);
}
__device__ __forceinline__ void p0_calibrate(const P0Args& a, LAS unsigned char* lds, int vcu, int wvid) {
    if (vcu > 2 * NE) return;
    float rms = 0.f;
    const float* Wm = vcu < NE ? a.w_gu + (size_t)vcu * D * 2048 : (vcu == NE ? a.w_pg : a.w_dn + (size_t)(vcu - NE - 1) * D * D);
    const float sc = sample_scale(Wm, vcu < NE ? 4100 : 2044, lds, wvid, &rms);
    if ((wvid * 64 + lane_id_asm()) == 0) { float* scl = (float*)(a.ws + WS_SCL); if (vcu <= NE) scl[vcu] = sc; else scl[128 + vcu - NE - 1] = sc; if (vcu < NE) scl[64 + vcu] = rms; }
}
__device__ __forceinline__ void p0_phase(const P0Args& a, LAS unsigned char* lds, int vcu, int G, int it_lo, int it_hi, bool do_xp, int wvid) {
    int tid_ = (wvid * 64 + lane_id_asm()); asm volatile("" : "+v"(tid_));
    const int tid = tid_, lane = tid & 63, wave = __builtin_amdgcn_readfirstlane(tid >> 6);
    LAS float* scr = (LAS float*)(lds + wave * 16640);
    const int gw = vcu * NWAVES + wave, NGW = G * NWAVES;
    f32x4 va[16], vb[16]; P0Item da, db;
    int it = it_lo + gw;
    if (it < it_hi) { da = p0_decode(a, it); p0_load(da, va, lane); }
    while (it < it_hi) {
        const bool hb = it + NGW < it_hi;
        if (hb) { db = p0_decode(a, it + NGW); p0_load(db, vb, lane); }
        p0_store(da, va, scr, lane);
        if (!hb) break;
        const bool ha = it + 2 * NGW < it_hi;
        if (ha) { da = p0_decode(a, it + 2 * NGW); p0_load(da, va, lane); }
        p0_store(db, vb, scr, lane);
        if (!ha) break;
        it += 2 * NGW;
    }
    if (!do_xp) return;
    p0_calibrate(a, lds, vcu, wvid);
    const int gt = vcu * NTHREADS + tid, NGT = G * NTHREADS;
    for (int t0 = 2 * gw; t0 < M; t0 += 2 * NGW) { f32x4 v[2][4];
#pragma unroll
        for (int x = 0; x < 2; ++x)
#pragma unroll
            for (int j = 0; j < 4; ++j) v[x][j] = __builtin_nontemporal_load((const f32x4*)(a.x + (size_t)(t0 + x) * D + 256 * j + 4 * lane));
#pragma unroll
        for (int x = 0; x < 2; ++x) { float am = 0.f;
#pragma unroll
            for (int j = 0; j < 4; ++j) am = fmaxf(am, fmaxf(fmaxf(fabsf(v[x][j][0]), fabsf(v[x][j][1])), fmaxf(fabsf(v[x][j][2]), fabsf(v[x][j][3]))));
#pragma unroll
            for (int o = 1; o < 64; o <<= 1) am = fmaxf(am, shx(am, o, lane));
            const float sxr = fmaxf(am, 1e-30f) * (1.0f / 127.0f), qi = 1.0f / sxr;
#pragma unroll
            for (int j = 0; j < 4; ++j) { unsigned q = 0u;
#pragma unroll
                for (int z = 0; z < 4; ++z) q |= ((unsigned)(int)rintf(v[x][j][z] * qi) & 0xffu) << (8 * z);
                *(unsigned*)(a.ws + WS_XB + (size_t)(t0 + x) * D + 256 * j + 4 * lane) = q; }
            if (lane == 0) ((float*)(a.ws + WS_SX0))[t0 + x] = sxr; } }
    for (int i = gt; i < M * DPLE / 8; i += 4 * NGT) { f32x4 v[4][2];
#pragma unroll
        for (int u = 0; u < 4; ++u) { const size_t o = (size_t)(i + u * NGT) * 8; v[u][0] = __builtin_nontemporal_load((const f32x4*)(a.p + o)); v[u][1] = __builtin_nontemporal_load((const f32x4*)(a.p + o + 4)); }
#pragma unroll
        for (int u = 0; u < 4; ++u) { u32x4 o; o.x = pk2(v[u][0][0], v[u][0][1]); o.y = pk2(v[u][0][2], v[u][0][3]); o.z = pk2(v[u][1][0], v[u][1][1]); o.w = pk2(v[u][1][2], v[u][1][3]);
            *(u32x4*)((bf16_t*)(a.ws + WS_PB) + (size_t)(i + u * NGT) * 8) = o; } }
}

__device__ __forceinline__ int crow(int r, int hi) { return (r & 3) + 8 * (r >> 2) + 4 * hi; }
typedef short v4i16_t __attribute__((ext_vector_type(4)));
__device__ __forceinline__ s16x4 vtr(const LAS unsigned char* p) { return __builtin_bit_cast(s16x4, __builtin_amdgcn_ds_read_tr16_b64_v4i16((LAS v4i16_t*)p)); }
__device__ __forceinline__ void attn_unit(LAS unsigned char* lds, const bf16_t* Q, const bf16_t* Kg, const bf16_t* Vg, const float* sinks, bf16_t* O, int b, int kvh, int nb, int wvid) {
    int tid_ = (wvid * 64 + lane_id_asm()); asm volatile("" : "+v"(tid_));
    const int tid = tid_, lane = tid & 63, r32 = lane & 31, hi = lane >> 5; const int wid = __builtin_amdgcn_readfirstlane(tid >> 6);
    const int t0 = b * SEQ + nb * 128;
#pragma unroll
    for (int it = 0; it < 4; ++it) { const int idx = tid + it * NTHREADS, key = idx >> 3, c = idx & 7;
        int row = t0 - 128 + key; if (row < b * SEQ) row = b * SEQ;
        const u32x4 kv = *(const u32x4*)(Kg + (size_t)row * 256 + kvh * HD + c * 8);
        const u32x4 vv = *(const u32x4*)(Vg + (size_t)row * 256 + kvh * HD + c * 8);
        *(LAS u32x4*)(lds + c * 4096 + key * 16) = kv;
        *(LAS u32x4*)(lds + 32768 + (c >> 2) * 16384 + (key >> 4) * 1024 + (key & 15) * 64 + (c & 3) * 16) = vv; }
    __syncthreads();
    const int g = wid >> 1, half = wid & 1, h = kvh * 4 + g;
    const float sink2 = sinks[h] * LOG2E;
    const LAS unsigned char* vbase = lds + 32768 + ((lane >> 4) & 1) * 32 + (lane & 3) * 8 + (4 * hi + ((lane & 15) >> 2)) * 64;
#pragma unroll 1
    for (int qq = 0; qq < 2; ++qq) {
        const int qt = half * 2 + qq;
        const bf16_t* qp = Q + (size_t)(t0 + 32 * qt + r32) * D + h * HD + hi * 8;
        bf16x8 qr[4];
#pragma unroll
        for (int d0 = 0; d0 < 4; ++d0) qr[d0] = *(const bf16x8*)(qp + d0 * 16);
        f32x16 s[5];
#pragma unroll
        for (int j = 0; j < 5; ++j) { const LAS unsigned char* kp = lds + hi * 4096 + ((qt + j) * 32 + r32) * 16; f32x16 a = {};
#pragma unroll
            for (int d0 = 0; d0 < 4; ++d0) a = __builtin_amdgcn_mfma_f32_32x32x16_bf16(*(const LAS bf16x8*)(kp + d0 * 8192), qr[d0], a, 0, 0, 0);
            s[j] = a; }
#pragma unroll
        for (int r = 0; r < 16; ++r) { const int cr = crow(r, hi); if (cr <= r32) s[0][r] = -INFINITY; if (cr > r32) s[4][r] = -INFINITY; }
        if (nb == 0) {
#pragma unroll
            for (int j = 0; j < 4; ++j) if (qt + j < 4) {
#pragma unroll
                for (int r = 0; r < 16; ++r) s[j][r] = -INFINITY; } }
        float mx = -INFINITY;
#pragma unroll
        for (int j = 0; j < 5; ++j)
#pragma unroll
            for (int r = 0; r < 16; ++r) mx = fmaxf(mx, s[j][r]);
        mx = fmaxf(mx, shx(mx, 32, lane)); mx = fmaxf(mx, sink2);
        float ls = 0.f;
#pragma unroll
        for (int j = 0; j < 5; ++j)
#pragma unroll
            for (int r = 0; r < 16; ++r) { s[j][r] = __builtin_amdgcn_exp2f(s[j][r] - mx); ls += s[j][r]; }
        ls += shx(ls, 32, lane); ls += __builtin_amdgcn_exp2f(sink2 - mx);
        const float linv = 1.0f / ls;
        f32x16 o[2]; o[0] = f32x16{}; o[1] = f32x16{};
#pragma unroll
        for (int j = 0; j < 5; ++j)
#pragma unroll
            for (int ks = 0; ks < 2; ++ks) {
                u32x4 pw; pw.x = pk2(s[j][8 * ks + 0], s[j][8 * ks + 1]); pw.y = pk2(s[j][8 * ks + 2], s[j][8 * ks + 3]); pw.z = pk2(s[j][8 * ks + 4], s[j][8 * ks + 5]); pw.w = pk2(s[j][8 * ks + 6], s[j][8 * ks + 7]);
                const bf16x8 pa = __builtin_bit_cast(bf16x8, pw);
                const LAS unsigned char* vp = vbase + ((qt + j) * 2 + ks) * 1024;
#pragma unroll
                for (int dh = 0; dh < 2; ++dh) { const s16x4 lo = vtr(vp + dh * 16384), hi4 = vtr(vp + dh * 16384 + 512);
                    const bf16x8 vf = {lo[0], lo[1], lo[2], lo[3], hi4[0], hi4[1], hi4[2], hi4[3]};
                    o[dh] = __builtin_amdgcn_mfma_f32_32x32x16_bf16(pa, vf, o[dh], 0, 0, 0); } }
        LAS bf16_t* stg = (LAS bf16_t*)(lds + 65536 + wid * 4096);
#pragma unroll
        for (int r = 0; r < 16; ++r) { const int q = crow(r, hi); const float sc = shidx(linv, q);
            stg[q * 64 + r32] = (bf16_t)f2bf(o[0][r] * sc); stg[q * 64 + 32 + r32] = (bf16_t)f2bf(o[1][r] * sc); }
        asm volatile("s_waitcnt lgkmcnt(0)" ::: "memory");
        bf16_t* ob = O + (size_t)(t0 + 32 * qt) * D + h * HD;
#pragma unroll
        for (int i = 0; i < 4; ++i) { const int row = i * 8 + (lane >> 3), ch = lane & 7;
            *(u32x4*)(ob + (size_t)row * D + ch * 8) = *(const LAS u32x4*)(stg + row * 64 + ch * 8); }
        asm volatile("s_waitcnt lgkmcnt(0)" ::: "memory");
    }
    __syncthreads();
}
__device__ __forceinline__ void conv_phase(const bf16_t* Bg, const bf16_t* U, const float* cw, bf16_t* Z, int vcu, int G, int wvid) {
    int tid_ = (wvid * 64 + lane_id_asm()); asm volatile("" : "+v"(tid_));
    const int gt = vcu * NTHREADS + tid_, NGT = G * NTHREADS;
    for (int i = gt; i < (M / 8) * (D / 8); i += NGT) {
        const int t0 = (i >> 7) * 8, c = (i & 127) * 8, tl0 = t0 & (SEQ - 1);
        f32x4 w[3][2];
#pragma unroll
        for (int k = 0; k < 3; ++k) { w[k][0] = *(const f32x4*)(cw + k * D + c); w[k][1] = *(const f32x4*)(cw + k * D + c + 4); }
        u32x4 ur[10], br[8];
#pragma unroll
        for (int r = 0; r < 10; ++r) { if (r >= 2 || tl0 != 0) ur[r] = *(const u32x4*)(U + (size_t)(t0 + r - 2) * D + c); else ur[r] = (u32x4){0u, 0u, 0u, 0u}; }
#pragma unroll
        for (int r = 0; r < 8; ++r) br[r] = *(const u32x4*)(Bg + (size_t)(t0 + r) * D + c);
#pragma unroll
        for (int r = 0; r < 8; ++r) { float y[8];
#pragma unroll
            for (int j = 0; j < 8; ++j) y[j] = 0.f;
#pragma unroll
            for (int k = 0; k < 3; ++k) { const u32x4 uw = ur[r + k];
                y[0] += w[k][0][0] * bflo(uw.x); y[1] += w[k][0][1] * bfhi(uw.x); y[2] += w[k][0][2] * bflo(uw.y); y[3] += w[k][0][3] * bfhi(uw.y);
                y[4] += w[k][1][0] * bflo(uw.z); y[5] += w[k][1][1] * bfhi(uw.z); y[6] += w[k][1][2] * bflo(uw.w); y[7] += w[k][1][3] * bfhi(uw.w); }
            const u32x4 bw = br[r];
            u32x4 o; o.x = pk2(y[0] * bflo(bw.x), y[1] * bfhi(bw.x)); o.y = pk2(y[2] * bflo(bw.y), y[3] * bfhi(bw.y)); o.z = pk2(y[4] * bflo(bw.z), y[5] * bfhi(bw.z)); o.w = pk2(y[6] * bflo(bw.w), y[7] * bfhi(bw.w));
            *(u32x4*)(Z + (size_t)(t0 + r) * D + c) = o; }
    }
}
#ifndef DBG_ATTN
#define DBG_ATTN 0
#endif
#if DBG_ATTN
__device__ __forceinline__ void dbg_attn_check(const bf16_t* Q, const bf16_t* Kg, const bf16_t* Vg, const float* sinks, const bf16_t* O, float* acc3, int vcu, int G, int wvid) {
    const int lane = (wvid * 64 + lane_id_asm()) & 63, wave = wvid;
    const int gw = vcu * NWAVES + wave, nw = G * NWAVES;
    float lnum = 0.f, lden = 0.f, lmax = 0.f;
    for (int it = gw; it < M * NH; it += nw) {
        const int t = it / NH, h = it % NH, kvh = h / 4, tl = t % SEQ;
        const int slo = tl - 127 < 0 ? 0 : tl - 127, n = tl - slo + 1;
        const bf16_t* qp = Q + (size_t)t * D + h * HD;
        float sc[2];
#pragma unroll
        for (int u = 0; u < 2; ++u) { const int j = lane + 64 * u; float dot = -INFINITY;
            if (j < n) { const bf16_t* kp = Kg + (size_t)(t - tl + slo + j) * 256 + kvh * HD; dot = 0.f;
                for (int d = 0; d < HD; ++d) dot = fmaf(bflo((unsigned)qp[d]), bflo((unsigned)kp[d]), dot);
                dot *= (1.0f / LOG2E); }
            sc[u] = dot; }
        const float sink = sinks[h];
        float m = fmaxf(sc[0], sc[1]);
        for (int o = 1; o < 64; o <<= 1) m = fmaxf(m, shx(m, o, lane));
        m = fmaxf(m, sink);
        float e0 = (lane < n) ? expf(sc[0] - m) : 0.f, e1 = (lane + 64 < n) ? expf(sc[1] - m) : 0.f;
        float s = e0 + e1;
        for (int o = 1; o < 64; o <<= 1) s += shx(s, o, lane);
        const float denom = s + expf(sink - m);
        e0 /= denom; e1 /= denom;
        float a = 0.f;
        for (int j = 0; j < n; ++j) { const float pj = shidx(j < 64 ? e0 : e1, j & 63); a = fmaf(pj, bflo((unsigned)Vg[(size_t)(t - tl + slo + j) * 256 + kvh * HD + lane]), a); }
        const float o = bflo((unsigned)O[(size_t)t * D + h * HD + lane]);
        const float rn = wave_sum((o - a) * (o - a), lane), rd = wave_sum(a * a, lane);
        lnum += rn; lden += rd; lmax = fmaxf(lmax, rn / fmaxf(rd, 1e-20f));
    }
    if (lane == 0) { atomicAdd(acc3, lnum); atomicAdd(acc3 + 1, lden); atomicMax((unsigned*)(acc3 + 2), __float_as_uint(lmax)); }
}
#endif
constexpr int WR_STRIDE = 1028;
struct RouteArgs { float* X1F; bf16_t* X1B; const float *g1, *b1, *w_r, *b_r; int* gcnt; int* list_tok; float* list_w; int* tk_e; int* tk_rank; float* tk_w; unsigned char* XQ; float* sx1; float* list_sx; float* list_hs; const float* scl; };
__device__ __forceinline__ void route_phase(const RouteArgs& a, LAS unsigned char* lds, int vcu, int G, bool dry, int wvid) {
    int tid_ = (wvid * 64 + lane_id_asm()); asm volatile("" : "+v"(tid_));
    const int tid = tid_, lane = tid & 63, wave = __builtin_amdgcn_readfirstlane(tid >> 6);
    LAS float* wrt = (LAS float*)lds;
    LAS int* misc = (LAS int*)(lds + MISC_OFF);
    LAS int* lcnt = misc + 96; LAS int* gbase = misc + 128; LAS int* rowe = misc + 160; LAS float* roww = (LAS float*)(misc + 416); LAS float* rowsx = (LAS float*)(misc + 672); LAS float* rownrm = (LAS float*)(misc + 736);
    for (int i = tid; i < D * NE; i += NTHREADS) { const int c = i >> 5, e = i & 31; wrt[e * WR_STRIDE + c] = a.w_r[i]; }
    if (tid < NE) lcnt[tid] = 0;
    __syncthreads();
    const int rows_per_wg = M / G;
    for (int rr = 2 * wave; rr < rows_per_wg; rr += 2 * NWAVES) {
        f32x4 v[2][4];
#pragma unroll
        for (int x = 0; x < 2; ++x) { const int t = vcu * rows_per_wg + rr + x; float s = 0.f;
#pragma unroll
            for (int j = 0; j < 4; ++j) { v[x][j] = *(const f32x4*)(a.X1F + (size_t)t * D + 256 * j + 4 * lane); s += (v[x][j][0] + v[x][j][1]) + (v[x][j][2] + v[x][j][3]); }
            const float mean = wave_sum(s, lane) * (1.0f / D); float q = 0.f;
#pragma unroll
            for (int j = 0; j < 4; ++j) { v[x][j] = v[x][j] - mean; q += (v[x][j][0] * v[x][j][0] + v[x][j][1] * v[x][j][1]) + (v[x][j][2] * v[x][j][2] + v[x][j][3] * v[x][j][3]); }
            const float rstd = 1.0f / sqrtf(wave_sum(q, lane) * (1.0f / D) + LN_EPS);
#pragma unroll
            for (int j = 0; j < 4; ++j) { const f32x4 gg = *(const f32x4*)(a.g1 + 256 * j + 4 * lane), bb = *(const f32x4*)(a.b1 + 256 * j + 4 * lane);
                v[x][j] = v[x][j] * rstd * gg + bb;
                if (!dry) { u32x2 w; w.x = pk2(v[x][j][0], v[x][j][1]); w.y = pk2(v[x][j][2], v[x][j][3]); *(u32x2*)(a.X1B + (size_t)t * D + 256 * j + 4 * lane) = w; } }
            float am = 0.f;
#pragma unroll
            for (int j = 0; j < 4; ++j) am = fmaxf(am, fmaxf(fmaxf(fabsf(v[x][j][0]), fabsf(v[x][j][1])), fmaxf(fabsf(v[x][j][2]), fabsf(v[x][j][3]))));
#pragma unroll
            for (int o = 1; o < 64; o <<= 1) am = fmaxf(am, shx(am, o, lane));
            const float sxr = fmaxf(am, 1e-30f) * (1.0f / 127.0f), qi = 1.0f / sxr;
            if (!dry) {
#pragma unroll
                for (int j = 0; j < 4; ++j) { unsigned q = 0u;
#pragma unroll
                    for (int z = 0; z < 4; ++z) q |= ((unsigned)(int)rintf(v[x][j][z] * qi) & 0xffu) << (8 * z);
                    *(unsigned*)(a.XQ + (size_t)t * D + 256 * j + 4 * lane) = q; }
                if (lane == 0) { a.sx1[t] = sxr; rowsx[rr + x] = sxr; } }
            { float ssq = 0.f;
#pragma unroll
              for (int j = 0; j < 4; ++j) ssq += (v[x][j][0] * v[x][j][0] + v[x][j][1] * v[x][j][1]) + (v[x][j][2] * v[x][j][2] + v[x][j][3] * v[x][j][3]);
              ssq = wave_sum(ssq, lane); if (lane == 0) rownrm[rr + x] = sqrtf(ssq); } }
        float pl[2][32];
#pragma unroll
        for (int e = 0; e < 32; ++e) { float a0 = 0.f, a1 = 0.f;
#pragma unroll
            for (int j = 0; j < 4; ++j) { const f32x4 w = *(const LAS f32x4*)(wrt + e * WR_STRIDE + 256 * j + 4 * lane);
                a0 += (v[0][j][0] * w[0] + v[0][j][1] * w[1]) + (v[0][j][2] * w[2] + v[0][j][3] * w[3]); a1 += (v[1][j][0] * w[0] + v[1][j][1] * w[1]) + (v[1][j][2] * w[2] + v[1][j][3] * w[3]); }
            pl[0][e] = a0; pl[1][e] = a1; }
#pragma unroll
        for (int o = 32, n = 16; o >= 2; o >>= 1, n >>= 1) { const bool up = (lane & o) != 0;
#pragma unroll
            for (int i = 0; i < 16; ++i) if (i < n) {
#pragma unroll
                for (int x = 0; x < 2; ++x) { const float send = up ? pl[x][i] : pl[x][i + n], keep = up ? pl[x][i + n] : pl[x][i]; pl[x][i] = keep + shx(send, o, lane); } } }
        const int myexp = lane >> 1; const float brv = a.b_r[myexp];
        float logit[2];
#pragma unroll
        for (int x = 0; x < 2; ++x) logit[x] = pl[x][0] + shx(pl[x][0], 1, lane) + brv;
        int se[2][4]; float sv[2][4];
#pragma unroll
        for (int k = 0; k < 4; ++k) { float bv[2]; int bi[2];
#pragma unroll
            for (int x = 0; x < 2; ++x) { bv[x] = logit[x]; bi[x] = myexp; }
#pragma unroll
            for (int o = 1; o < 64; o <<= 1) {
#pragma unroll
                for (int x = 0; x < 2; ++x) { const float ov = shx(bv[x], o, lane); const int oi = shxi(bi[x], o, lane); if (ov > bv[x] || (ov == bv[x] && oi < bi[x])) { bv[x] = ov; bi[x] = oi; } } }
#pragma unroll
            for (int x = 0; x < 2; ++x) { se[x][k] = bi[x]; sv[x][k] = bv[x]; if (myexp == bi[x]) logit[x] = -INFINITY; } }
#pragma unroll
        for (int x = 0; x < 2; ++x) { const float e1 = __expf(sv[x][1] - sv[x][0]), e2 = __expf(sv[x][2] - sv[x][0]), e3 = __expf(sv[x][3] - sv[x][0]);
            const float inv = 1.0f / (1.0f + e1 + e2 + e3);
            if (lane < 4) { const int e = lane == 0 ? se[x][0] : lane == 1 ? se[x][1] : lane == 2 ? se[x][2] : se[x][3];
                const float w = (lane == 0 ? 1.0f : lane == 1 ? e1 : lane == 2 ? e2 : e3) * inv;
                rowe[(rr + x) * 4 + lane] = e; roww[(rr + x) * 4 + lane] = w; } }
    }
    __syncthreads();
    if (dry) return;
    const int nent = rows_per_wg * 4;
    int my_e = 0, my_lr = 0;
    if (tid < nent) { my_e = rowe[tid]; my_lr = atomicAdd((int*)(lcnt + my_e), 1); }
    __syncthreads();
    if (tid < NE) gbase[tid] = atomicAdd(a.gcnt + tid, lcnt[tid]);
    __syncthreads();
    if (tid < nent) { const int t = vcu * rows_per_wg + (tid >> 2), rank = gbase[my_e] + my_lr;
        const float sig = rownrm[tid >> 2] * a.scl[64 + my_e], clip = fmaxf((1.0f + 3.5f * sig) * (3.5f * sig), 1e-20f);
        const float qh = bfhi(f2bf(127.0f / clip) << 16);
        a.list_tok[(size_t)my_e * LISTCAP + rank] = t; a.list_w[(size_t)my_e * LISTCAP + rank] = qh; a.list_sx[(size_t)my_e * LISTCAP + rank] = rowsx[tid >> 2];
        a.list_hs[(size_t)my_e * LISTCAP + rank] = roww[tid] / qh;
        a.tk_e[t * 4 + (tid & 3)] = my_e; a.tk_rank[t * 4 + (tid & 3)] = rank; a.tk_w[t * 4 + (tid & 3)] = roww[tid]; }
    __syncthreads();
}
__device__ __forceinline__ void build_tables(const int* gcnt, LAS unsigned char* lds, int wvid) {
    LAS int* misc = (LAS int*)(lds + MISC_OFF);
    const int tid = wvid * 64 + lane_id_asm();
    if (tid < NE) misc[tid] = __hip_atomic_load(gcnt + tid, __ATOMIC_RELAXED, __HIP_MEMORY_SCOPE_AGENT);
    __syncthreads();
    if (tid == 0) { int a = 0; for (int e = 0; e < NE; ++e) { misc[32 + e] = a; a += (misc[e] + 255) >> 8; } misc[32 + NE] = a; }
    __syncthreads();
}
struct FinalArgs { float dbg_scale; int pad_; const bf16_t* X1B; const bf16_t* PLE; const bf16_t* Y; const int* tk_e; const int* tk_rank; const float* tk_w; const float* b_down; const float *g2, *b2; float* out; };
__device__ __forceinline__ void final_phase(const FinalArgs& a, LAS unsigned char* lds, int vcu, int G, int wvid) {
    int tid_ = (wvid * 64 + lane_id_asm()); asm volatile("" : "+v"(tid_));
    const int tid = tid_, lane = tid & 63, wave = __builtin_amdgcn_readfirstlane(tid >> 6);
    const LAS int* ts = (const LAS int*)(lds + MISC_OFF) + 32;
    LAS float* bdl = (LAS float*)lds;
    for (int i = tid; i < NE * D / 4; i += NTHREADS) *(LAS f32x4*)(bdl + 4 * i) = *(const f32x4*)(a.b_down + 4 * i);
    __syncthreads();
    const int gw = vcu * NWAVES + wave, NGW = G * NWAVES;
    for (int t0 = 2 * gw; t0 < M; t0 += 2 * NGW) {
        size_t pos[2][4]; int ek[2][4]; float wk[2][4];
#pragma unroll
        for (int x = 0; x < 2; ++x)
#pragma unroll
            for (int k = 0; k < 4; ++k) { const int t = t0 + x, e = a.tk_e[t * 4 + k], rk = a.tk_rank[t * 4 + k]; pos[x][k] = ((size_t)ts[e] * 256 + rk) * D; ek[x][k] = e * D; wk[x][k] = a.tk_w[t * 4 + k]; }
        f32x4 v[2][4]; float s[2] = {0.f, 0.f};
#pragma unroll
        for (int x = 0; x < 2; ++x)
#pragma unroll
            for (int j = 0; j < 4; ++j) { const int c = 256 * j + 4 * lane; const size_t ro = (size_t)(t0 + x) * D + c;
                const u32x2 xw = *(const u32x2*)(a.X1B + ro), pw = *(const u32x2*)(a.PLE + ro);
                f32x4 xx = {bflo(xw.x) * DN_ALPHA + bflo(pw.x), bfhi(xw.x) * DN_ALPHA + bfhi(pw.x), bflo(xw.y) * DN_ALPHA + bflo(pw.y), bfhi(xw.y) * DN_ALPHA + bfhi(pw.y)};
#pragma unroll
                for (int k = 0; k < 4; ++k) { const u32x2 yw = *(const u32x2*)(a.Y + pos[x][k] + c); const f32x4 bd = *(const LAS f32x4*)(bdl + ek[x][k] + c);
                    xx[0] += bflo(yw.x) + wk[x][k] * bd[0]; xx[1] += bfhi(yw.x) + wk[x][k] * bd[1]; xx[2] += bflo(yw.y) + wk[x][k] * bd[2]; xx[3] += bfhi(yw.y) + wk[x][k] * bd[3]; }
                v[x][j] = xx; s[x] += (xx[0] + xx[1]) + (xx[2] + xx[3]); }
#pragma unroll
        for (int x = 0; x < 2; ++x) { const float mean = wave_sum(s[x], lane) * (1.0f / D); float q = 0.f;
#pragma unroll
            for (int j = 0; j < 4; ++j) { v[x][j] = v[x][j] - mean; q += (v[x][j][0] * v[x][j][0] + v[x][j][1] * v[x][j][1]) + (v[x][j][2] * v[x][j][2] + v[x][j][3] * v[x][j][3]); }
            const float rstd = 1.0f / sqrtf(wave_sum(q, lane) * (1.0f / D) + LN_EPS);
#pragma unroll
            for (int j = 0; j < 4; ++j) { const int c = 256 * j + 4 * lane; const f32x4 gg = *(const f32x4*)(a.g2 + c), bb = *(const f32x4*)(a.b2 + c);
                *(f32x4*)(a.out + (size_t)(t0 + x) * D + c) = (v[x][j] * rstd * gg + bb) * a.dbg_scale; } }
    }
}

#ifndef PROBE_STAMP
#define PROBE_STAMP -1
#endif
#define STAMP(k) do { if (PROBE_STAMP >= 0 && bx == 0 && (wvid * 64 + lane_id_asm()) == 0) __hip_atomic_store(WSP(unsigned long long, WS_CTL + 32768) + (k), (unsigned long long)__builtin_amdgcn_s_memrealtime(), __ATOMIC_RELAXED, __HIP_MEMORY_SCOPE_AGENT); } while (0)
#ifndef PROBE_REP
#define PROBE_REP 0
#endif
struct Args { const float* in[20]; float* out; unsigned char* ws; };
__global__ void __launch_bounds__(NTHREADS, 2) mega_fwd(Args args) {
    extern __shared__ __attribute__((aligned(16))) unsigned char lds_raw[];
    LAS unsigned char* lds = (LAS unsigned char*)lds_raw;
    cg::grid_group grid = cg::this_grid();
    const int G = gridDim.x, bx = blockIdx.x;
    const int wvid = __builtin_amdgcn_readfirstlane((int)threadIdx.x >> 6);
    const int vcu = (G % 8 == 0) ? (bx % 8) * (G / 8) + bx / 8 : bx;
    unsigned char* const ws = args.ws;
    const LAS int* cntL = (const LAS int*)(lds + MISC_OFF); const LAS int* tsL = cntL + 32;
    { volatile LAS unsigned* bst = (volatile LAS unsigned*)(lds + MISC_OFF) + BST_IDX;
      { int t_ = (wvid * 64 + lane_id_asm()); asm volatile("" : "+v"(t_)); if (t_ < 2) bst[t_] = 0u; }
      __syncthreads();
    }
    if (bx == 0) { const int t0_ = wvid * 64 + lane_id_asm(); for (int i_ = t0_; i_ < (int)(CTL_ZERO_BYTES / 16); i_ += NTHREADS) ((u32x4*)(ws + WS_CTL))[i_] = (u32x4){0u, 0u, 0u, 0u}; }
#define GRID_BAR() do { XcdBarrier b_; b_.bar = (unsigned*)(ws + WS_BAR); b_.x = xb_xcc_id(); b_.st = (volatile LAS unsigned*)(lds + MISC_OFF) + BST_IDX; b_.lead = ((wvid * 64 + lane_id_asm()) == 0); xcd_barrier(b_); if (PROBE_REP & 0x80000) xcd_barrier(b_); } while (0)
#define WSP(T, off) ((T*)(ws + (off)))
#define GRID_BAR_F(seam) do { XcdBarrier b_; b_.bar = (unsigned*)(ws + WS_BAR); b_.x = xb_xcc_id(); b_.st = (volatile LAS unsigned*)(lds + MISC_OFF) + BST_IDX; b_.lead = ((wvid * 64 + lane_id_asm()) == 0); \
    asm volatile("s_waitcnt vmcnt(0)" ::: "memory"); __syncthreads(); \
    if (wvid == 0) xcd_barrier_lead(b_); \
    else { P0Args a_{args.in[0], args.in[1], args.in[2], args.in[4], args.in[5], args.in[7], args.in[17], args.in[16], args.in[12], args.in[14], ws, 1.0f, 1.0f}; p0_fill(a_, lds, vcu, G, seam, wvid); } \
    __syncthreads(); } while (0)

    STAMP(0);
    {
      const float s_in = __builtin_bit_cast(float, __builtin_amdgcn_readfirstlane(__builtin_bit_cast(int, sample_scale(args.in[2], 13308, lds, wvid))));
      if ((wvid * 64 + lane_id_asm()) == 0) WSP(float, WS_SCL)[161] = s_in;
    _Pragma("unroll 1") for (int rep_ = 0; rep_ < ((PROBE_REP & 1) ? 2 : 1); ++rep_) { P0Args a{args.in[0], args.in[1], args.in[2], args.in[4], args.in[5], args.in[7], args.in[17], args.in[16], args.in[12], args.in[14], ws, s_in, 0.0f}; p0_phase(a, lds, vcu, G, 0, P0_NSMALL, true, wvid); } }
#if (PROBE_REP & 0x200000)
    { u32x4* z_ = (u32x4*)(ws + WS_R); const int gt_ = vcu * NTHREADS + wvid * 64 + lane_id_asm(); for (size_t i_ = gt_; i_ < (176 * MiB) / 16; i_ += (size_t)G * NTHREADS) z_[i_] = (u32x4){0u, 0u, 0u, 0u}; }
#endif
    grid.sync();
    (void)xcd_barrier_post((unsigned*)(ws + WS_BAR), (volatile LAS unsigned*)(lds + MISC_OFF) + BST_IDX, (wvid * 64 + lane_id_asm()) == 0);
    STAMP(1);
    _Pragma("unroll 1") for (int rep_ = 0; rep_ < ((PROBE_REP & 2) ? 2 : 1); ++rep_) { pg8::Gemm g{WSP(bf16_t, WS_XB), (const bf16_t*)(ws + WS_WIN), D / 2}; pg8::StaticOrder S; S.init(M / 256, NIN / 256, G, bx, 1);
      const float s_in1 = __builtin_bit_cast(float, __builtin_amdgcn_readfirstlane(__builtin_bit_cast(int, WSP(float, WS_SCL)[161])));
      pg8::EpiInProjI8 E{ws, s_in1};
      pg8::gemm_phase<pg8::EpiInProjI8, pg8::StaticOrder, true, 0, true>(lds, g, S, E, wvid); }
    { constexpr int U1 = (M / 256) * (NIN / 256); const int R1 = U1 % G, nidle = R1 ? G - R1 : G, per = 256 / nidle;
      if (R1 == 0 || bx >= R1) {
        pg8::Gemm g{WSP(bf16_t, WS_PB), (const bf16_t*)(ws + WS_WPP), DPLE}; pg8::Ple1Order S{(bx - R1) * per, per};
        pg8::EpiF32 E{WSP(float, WS_P2)};
        pg8::gemm_phase<pg8::EpiF32, pg8::Ple1Order, false>(lds, g, S, E, wvid); } }
    GRID_BAR_F(1);
    STAMP(2);
    if (PROBE_REP & 4096) { _Pragma("unroll 1") for (int k_ = 0; k_ < 8; ++k_) GRID_BAR(); }
    _Pragma("unroll 1") for (int rep_ = 0; rep_ < ((PROBE_REP & 4) ? 2 : 1); ++rep_) for (int it = vcu; it < BATCH * NKV * (SEQ / 128); it += G) { const int nb = it & 63, kvh = (it >> 6) & 3, b = it >> 8;
        attn_unit(lds, WSP(bf16_t, WS_Q), WSP(bf16_t, WS_K), WSP(bf16_t, WS_V), args.in[6], WSP(bf16_t, WS_ZO) + (size_t)M * D, b, kvh, nb, wvid); }
    _Pragma("unroll 1") for (int rep_ = 0; rep_ < ((PROBE_REP & 8) ? 2 : 1); ++rep_) conv_phase(WSP(bf16_t, WS_BG), WSP(bf16_t, WS_U), args.in[3], WSP(bf16_t, WS_ZO), vcu, G, wvid);
    GRID_BAR_F(2);
    STAMP(3);
#if DBG_ATTN
    dbg_attn_check(WSP(bf16_t, WS_Q), WSP(bf16_t, WS_K), WSP(bf16_t, WS_V), args.in[6], WSP(bf16_t, WS_ZO) + (size_t)M * D, WSP(float, WS_CTL) + 64, vcu, G, wvid);
#endif
    _Pragma("unroll 1") for (int rep_ = 0; rep_ < ((PROBE_REP & 16) ? 2 : 1); ++rep_) { pg8::Gemm g{WSP(bf16_t, WS_ZO), (const bf16_t*)(ws + WS_WBR), D}; pg8::DualOrder S; S.so.init(M / 256, D / 256, G, bx);
      pg8::EpiDual E{ws};
      pg8::gemm_phase<pg8::EpiDual, pg8::DualOrder, true>(lds, g, S, E, wvid); }
    GRID_BAR_F(3);
    STAMP(4);
    _Pragma("unroll 1") for (int rep_ = 0; rep_ < ((PROBE_REP & 32) ? 2 : 1); ++rep_) { pg8::Gemm g{WSP(bf16_t, WS_MG), (const bf16_t*)(ws + WS_WOUT), D}; pg8::StaticOrder S; S.init(M / 256, D / 256, G, bx);
      pg8::EpiResid E{args.in[0], WSP(float, WS_X1F)};
      pg8::gemm_phase<pg8::EpiResid, pg8::StaticOrder, false>(lds, g, S, E, wvid); }
    GRID_BAR_F(4);
    STAMP(5);
    { P0Args a{args.in[0], args.in[1], args.in[2], args.in[4], args.in[5], args.in[7], args.in[17], args.in[16], args.in[12], args.in[14], ws, 1.0f, 1.0f}; p0_phase(a, lds, vcu, G, P0_NSMALL + P0_FILL_SEAMS * G * 7 * P0_FILL, P0_NITEMS, false, wvid); __syncthreads();
      if (PROBE_REP & 0x40000) { p0_phase(a, lds, vcu, G, P0_NSMALL, P0_NITEMS, false, wvid); __syncthreads(); } }
    _Pragma("unroll 1") for (int rep_ = ((PROBE_REP & 64) ? 0 : 1); rep_ < 2; ++rep_) { RouteArgs a{WSP(float, WS_X1F), WSP(bf16_t, WS_X1B), args.in[8], args.in[9], args.in[10], args.in[11], WSP(int, WS_CTL), WSP(int, WS_LTOK), WSP(float, WS_LW), WSP(int, WS_TKE), WSP(int, WS_TKR), WSP(float, WS_TKW), ws + WS_XQ, WSP(float, WS_SX1), WSP(float, WS_LSX), WSP(float, WS_LHS), WSP(float, WS_SCL)}; route_phase(a, lds, vcu, G, rep_ == 0, wvid); }
    GRID_BAR();
    STAMP(6);
    build_tables(WSP(int, WS_CTL), lds, wvid);
    { const int nx5_ = __builtin_amdgcn_readfirstlane(pg8::MoeOrder::ple_in_p5(tsL, G));
      pg8::MoeOrder S; S.init(cntL, tsL, (const LAS unsigned*)(lds + TW_OFF), 8, G, bx, 1, WS_XQ, WS_WGU, nx5_, 0, WS_XQ, WS_WPG8, 18); S.build_units((LAS int*)(lds + UTAB_OFF), 12, wvid * 64 + lane_id_asm(), vcu, 1);
      pg8::moe_preload(S, cntL, WSP(int, WS_LTOK), WSP(float, WS_LW), (LAS unsigned*)(lds + TW_OFF), wvid);
      _Pragma("unroll 1") for (int rep_ = 0; rep_ < ((PROBE_REP & 128) ? 2 : 1); ++rep_) { pg8::Gemm g{(const bf16_t*)ws, (const bf16_t*)ws, D / 2};
        pg8::EpiSwigluI8 E{WSP(bf16_t, WS_H), args.in[13], (const LAS unsigned*)(lds + TW_OFF), ws};
        pg8::gemm_phase<pg8::EpiSwigluI8, pg8::MoeOrder, true, 0, true>(lds, g, S, E, wvid);
#if (PROBE_REP & 0x400000)
        pg8::gemm_phase<pg8::EpiSwigluI8, pg8::MoeOrder, true, 1, true>(lds, g, S, E, wvid);
#endif
#if (PROBE_REP & 0x800000)
        pg8::gemm_phase<pg8::EpiSwigluI8, pg8::MoeOrder, true, 2, true>(lds, g, S, E, wvid);
#endif
        } }
    GRID_BAR();
    STAMP(7);
    _Pragma("unroll 1") for (int rep_ = 0; rep_ < ((PROBE_REP & 1024) ? 2 : 1); ++rep_) { pg8::Gemm g{(const bf16_t*)ws, (const bf16_t*)ws, D / 2};
      const int nx5_ = __builtin_amdgcn_readfirstlane(pg8::MoeOrder::ple_in_p5(tsL, G));
      pg8::MoeOrder S; S.init(cntL, tsL, (const LAS unsigned*)(lds + TW_OFF), 4, G, bx, 0, WS_H, WS_WDN, 256 - nx5_, nx5_, WS_XQ, WS_WPG8, 18); S.build_units((LAS int*)(lds + UTAB_OFF), 12, wvid * 64 + lane_id_asm(), vcu, 2);
      pg8::EpiDownI8 E{WSP(bf16_t, WS_Y), ws, cntL};
      pg8::gemm_phase<pg8::EpiDownI8, pg8::MoeOrder, true, 0, true>(lds, g, S, E, wvid); }
    STAMP(8);
    GRID_BAR();
    _Pragma("unroll 1") for (int rep_ = 0; rep_ < ((PROBE_REP & 2048) ? 2 : 1); ++rep_) { float dbgs_ = 1.0f;
      if (PROBE_STAMP >= 0) { const unsigned long long* st_ = WSP(unsigned long long, WS_CTL + 32768); const float dt_us = (float)(long long)(__hip_atomic_load(st_ + PROBE_STAMP + 1, __ATOMIC_RELAXED, __HIP_MEMORY_SCOPE_AGENT) - __hip_atomic_load(st_ + PROBE_STAMP, __ATOMIC_RELAXED, __HIP_MEMORY_SCOPE_AGENT)) * 0.01f; dbgs_ = 1.0f + sqrtf(dt_us * 1e-6f); }
#if DBG_ATTN
      { const float* a3 = WSP(float, WS_CTL) + 64; const float num = __hip_atomic_load(a3, __ATOMIC_RELAXED, __HIP_MEMORY_SCOPE_AGENT), den = __hip_atomic_load(a3 + 1, __ATOMIC_RELAXED, __HIP_MEMORY_SCOPE_AGENT), mx = __hip_atomic_load(a3 + 2, __ATOMIC_RELAXED, __HIP_MEMORY_SCOPE_AGENT);
        dbgs_ = 1.0f + sqrtf(100.0f * (DBG_ATTN == 1 ? num / den : mx)); }
#endif
      FinalArgs a{dbgs_, 0, WSP(bf16_t, WS_X1B), WSP(bf16_t, WS_PLE), WSP(bf16_t, WS_Y), WSP(int, WS_TKE), WSP(int, WS_TKR), WSP(float, WS_TKW), args.in[15], args.in[18], args.in[19], args.out}; final_phase(a, lds, vcu, G, wvid); }
}

extern "C" void kernel_launch(void* const* d_in, const int* in_sizes, int n_in, void* d_out, int out_size, void* d_ws, size_t ws_size, hipStream_t stream) {
    static int grid = 0;
    if (grid == 0) {
        if (n_in != 20 || out_size != M * D || ws_size < WS_END) { fprintf(stderr, "kernel_launch: unexpected sizes (n_in %d, out %d, ws %zu < %zu)\n", n_in, out_size, ws_size, (size_t)WS_END); grid = -1; return; }
        int dev = 0, cus = 0, per_cu = 0;
        if (hipGetDevice(&dev) != hipSuccess || hipDeviceGetAttribute(&cus, hipDeviceAttributeMultiprocessorCount, dev) != hipSuccess) { grid = -1; return; }
        if (hipFuncSetAttribute((const void*)mega_fwd, hipFuncAttributeMaxDynamicSharedMemorySize, LDS_BYTES) != hipSuccess) { fprintf(stderr, "kernel_launch: hipFuncSetAttribute failed\n"); grid = -1; return; }
        if (hipOccupancyMaxActiveBlocksPerMultiprocessor(&per_cu, (const void*)mega_fwd, NTHREADS, LDS_BYTES) != hipSuccess || per_cu < 1) { fprintf(stderr, "kernel_launch: occupancy query says %d blocks per CU\n", per_cu); grid = -1; return; }
        grid = cus;
        if (grid != 256) fprintf(stderr, "kernel_launch: note: %d CUs (built and tuned for 256)\n", grid);
    }
    if (grid < 0) return;
    Args a{};
    for (int i = 0; i < 20; ++i) a.in[i] = (const float*)d_in[i];
    a.out = (float*)d_out; a.ws = (unsigned char*)d_ws;
    void* kargs[] = {&a};
    const hipError_t e = hipLaunchCooperativeKernel((const void*)mega_fwd, dim3(grid), dim3(NTHREADS), kargs, LDS_BYTES, stream);
    if (e != hipSuccess) fprintf(stderr, "kernel_launch: cooperative launch failed: %s (grid %d)\n", hipGetErrorString(e), grid);
}
```

```cpp
#include <hip/hip_runtime.h>
#include <hip/hip_cooperative_groups.h>
#include <cstdio>
#include <cstdint>
namespace cg = cooperative_groups;

#define LAS __attribute__((address_space(3)))
typedef unsigned short bf16_t;
typedef short bf16x8 __attribute__((ext_vector_type(8)));
typedef short s16x4 __attribute__((ext_vector_type(4)));
typedef float f32x4 __attribute__((ext_vector_type(4)));
typedef float f32x16 __attribute__((ext_vector_type(16)));
typedef unsigned u32x4 __attribute__((ext_vector_type(4)));
typedef unsigned u32x2 __attribute__((ext_vector_type(2)));

constexpr int BATCH = 2, SEQ = 8192, M = BATCH * SEQ, D = 1024, NIN = 6656, NE = 32, DPLE = 256, NH = 16, HD = 64, NKV = 4;
constexpr float DN_ALPHA = 1.189207115002721f, LN_EPS = 1e-5f, LOG2E = 1.4426950408889634f;
constexpr float QSCALE = 0.125f * LOG2E;
constexpr int LISTCAP = M;
constexpr int MAXTILES = (M * 4) / 256 + NE;
constexpr int NWAVES = 8, NTHREADS = 512;

constexpr size_t MiB = 1u << 20;
constexpr size_t WS_CTL = 0;
constexpr size_t WS_BAR = 16384, CTL_ZERO_BYTES = 65536;
constexpr size_t WS_TKE = 1 * MiB, WS_TKR = 2 * MiB, WS_TKW = 3 * MiB;
constexpr size_t WS_LTOK = 4 * MiB, WS_LW = 6 * MiB;
constexpr size_t WS_WIN = 8 * MiB;
constexpr size_t WS_WBR = 22 * MiB;
constexpr size_t WS_WOUT = 26 * MiB, WS_WPG = 28 * MiB;
constexpr size_t WS_WPP = 30 * MiB;
constexpr size_t WS_WGU = 32 * MiB;
constexpr size_t WS_WDN = 160 * MiB;
constexpr size_t WS_XB = 224 * MiB;
constexpr size_t WS_PB = 256 * MiB;
constexpr size_t WS_X1F = 264 * MiB;
constexpr size_t WS_X1B = 328 * MiB;
constexpr size_t WS_P2 = 360 * MiB;
constexpr size_t WS_PLE = 424 * MiB;
constexpr size_t WS_R = 456 * MiB;
constexpr size_t WS_BG = WS_R, WS_U = WS_R + 32 * MiB, WS_Q = WS_R + 64 * MiB, WS_K = WS_R + 96 * MiB, WS_V = WS_R + 104 * MiB;
constexpr size_t WS_GC = WS_R + 112 * MiB, WS_GA = WS_R + 144 * MiB;
constexpr size_t WS_ZO = WS_R + 176 * MiB;
constexpr size_t WS_T1 = WS_R + 240 * MiB;
constexpr size_t WS_MG = WS_R + 304 * MiB;
constexpr size_t WS_H = WS_R;
constexpr size_t WS_Y = WS_R + 144 * MiB;
constexpr size_t WS_XQ = WS_R + 336 * MiB;
constexpr size_t WS_LSX = WS_XQ + 16 * MiB;
constexpr size_t WS_SX1 = WS_LSX + 2 * MiB;
constexpr size_t WS_SX0 = WS_SX1 + 1 * MiB;
constexpr size_t WS_SP = WS_SX0 + 512 * 1024;
constexpr size_t WS_LHS = WS_SX0 + 1 * MiB;
constexpr size_t WS_END = WS_LHS + 2 * MiB;
constexpr size_t WS_SCL = 65536;
constexpr size_t WS_WPG8 = 31 * MiB;
typedef int i32x4 __attribute__((ext_vector_type(4)));

constexpr int LDS_BYTES = 147456;
constexpr int MISC_OFF = 135168;
constexpr int BST_IDX = 66, TW_OFF = MISC_OFF + 512, UTAB_OFF = TW_OFF + 10240;
constexpr int BST_IDX_ = 0;

__device__ __forceinline__ int lane_id_asm() { int l; asm volatile("v_mbcnt_lo_u32_b32 %0, -1, 0\n\tv_mbcnt_hi_u32_b32 %0, -1, %0" : "=v"(l)); return l; }
__device__ __forceinline__ unsigned f2bf(float f) { unsigned u = __builtin_bit_cast(unsigned, f); return (u + 0x7fffu + ((u >> 16) & 1u)) >> 16; }
__device__ __forceinline__ unsigned pk2(float lo, float hi) { return f2bf(lo) | (f2bf(hi) << 16); }
__device__ __forceinline__ float bflo(unsigned w) { return __builtin_bit_cast(float, w << 16); }
__device__ __forceinline__ float bfhi(unsigned w) { return __builtin_bit_cast(float, w & 0xffff0000u); }
__device__ __forceinline__ float fast_sigmoid(float v) { return __builtin_amdgcn_rcpf(1.0f + __builtin_amdgcn_exp2f(-LOG2E * v)); }
__device__ __forceinline__ float shx(float v, int o, int lane) { return __builtin_bit_cast(float, __builtin_amdgcn_ds_bpermute((lane ^ o) << 2, __builtin_bit_cast(int, v))); }
__device__ __forceinline__ int shxi(int v, int o, int lane) { return __builtin_amdgcn_ds_bpermute((lane ^ o) << 2, v); }
__device__ __forceinline__ float shidx(float v, int src) { return __builtin_bit_cast(float, __builtin_amdgcn_ds_bpermute(src << 2, __builtin_bit_cast(int, v))); }
__device__ __forceinline__ float wave_sum(float v, int lane) {
#pragma unroll
    for (int o = 1; o < 64; o <<= 1) v += shx(v, o, lane);
    return v;
}

#define XB_TMO      128
#define XB_XCNT(j)  (256  + 64 * (j))
#define XB_XSUB(j)  (1280 + 64 * (j))
#define XB_XGEN(j)  (2304 + 64 * (j))
#define XB_TOP      3328
#define XB_TOPGEN   3392
#define XCD_BAR_WORDS 3456
#define XB_SPIN_CAP (1u << 18)

__device__ __forceinline__ unsigned xb_ld(unsigned* p)              { return __hip_atomic_load(p, __ATOMIC_RELAXED, __HIP_MEMORY_SCOPE_AGENT); }
__device__ __forceinline__ unsigned xb_add(unsigned* p, unsigned v) { return __hip_atomic_fetch_add(p, v, __ATOMIC_RELAXED, __HIP_MEMORY_SCOPE_AGENT); }
__device__ __forceinline__ unsigned xb_xcc_id() { return (unsigned)__builtin_amdgcn_s_getreg((3 << 11) | 20) & 0xFu; }
#define XB_SPIN(cond, bar) do { unsigned _sp = 0; while (cond) { __builtin_amdgcn_s_sleep(1); \
    if ((++_sp & 255u) == 0u) { if (xb_ld(&(bar)[XB_TMO])) break; if (_sp > XB_SPIN_CAP) { atomicAdd(&(bar)[XB_TMO], 1u); break; } } } } while (0)

struct XcdBarrier {
    bool lead;
    unsigned* bar; unsigned x;
    volatile LAS unsigned* st;
};

__device__ __forceinline__ XcdBarrier xcd_barrier_post(unsigned* bar, volatile LAS unsigned* st, bool lead) {
    XcdBarrier b; b.bar = bar; b.x = xb_xcc_id(); b.st = st; b.lead = lead;
    if (lead) (void)xb_add(&bar[XB_XCNT(b.x)], 1u);
    return b;
}
__device__ __forceinline__ void xcd_barrier_complete(unsigned* bar, unsigned x, unsigned& nloc, unsigned& nx) {
    const unsigned G = gridDim.x * gridDim.y * gridDim.z;
    unsigned sum, cnt, mine, sp = 0u;
    for (;;) {
        sum = 0u; cnt = 0u; mine = 0u;
#pragma unroll
        for (unsigned j = 0; j < 16; ++j) { const unsigned c = xb_ld(&bar[XB_XCNT(j)]); sum += c; cnt += (c > 0u) ? 1u : 0u; mine = (j == x) ? c : mine; }
        if (sum == G) break;
        __builtin_amdgcn_s_sleep(1);
        if ((++sp & 255u) == 0u) { if (xb_ld(&bar[XB_TMO])) break; if (sp > XB_SPIN_CAP) { atomicAdd(&bar[XB_TMO], 1u); break; } }
    }
    nloc = mine > 0u ? mine : 1u; nx = cnt > 0u ? cnt : 1u;
}

__device__ __forceinline__ void xcd_barrier_lead(const XcdBarrier& b);
__device__ __forceinline__ void xcd_barrier(const XcdBarrier& b) {
    asm volatile("s_waitcnt vmcnt(0)" ::: "memory");
    __syncthreads();
    xcd_barrier_lead(b);
    __syncthreads();
}
__device__ __forceinline__ void xcd_barrier_lead(const XcdBarrier& b) {
    if (b.lead) {
        unsigned* bar = b.bar;
        __builtin_amdgcn_s_waitcnt(0);
        unsigned nloc = b.st[0], nx = b.st[1];
        if (nloc == 0u) { xcd_barrier_complete(bar, b.x, nloc, nx); b.st[0] = nloc; b.st[1] = nx; }
        const unsigned old = xb_add(&bar[XB_XSUB(b.x)], 1u);
        const unsigned gen = old / nloc;
        if (old + 1u == (gen + 1u) * nloc) {
            __builtin_amdgcn_fence(__ATOMIC_RELEASE, "agent");
            asm volatile("s_waitcnt vmcnt(0)" ::: "memory");
            const unsigned og = xb_add(&bar[XB_TOP], 1u);
            const unsigned tg = og / nx;
            if (og + 1u == (tg + 1u) * nx) xb_add(&bar[XB_TOPGEN], 1u);
            else XB_SPIN(xb_ld(&bar[XB_TOPGEN]) == tg, bar);
            __builtin_amdgcn_fence(__ATOMIC_ACQUIRE, "agent");
            xb_add(&bar[XB_XGEN(b.x)], 1u);
            asm volatile("s_waitcnt vmcnt(0)" ::: "memory");
        } else {
            XB_SPIN(xb_ld(&bar[XB_XGEN(b.x)]) == gen, bar);
            __builtin_amdgcn_fence(__ATOMIC_ACQUIRE, "agent");
            asm volatile("s_waitcnt vmcnt(0)" ::: "memory");
        }
    }
}

namespace pg8 {
constexpr int BM = 256, BK = 64, HALF = 128, HTB = HALF * BK * 2  , STAGE_BYTES = 8 * HTB, NXCD = 8, WGM = 8;
__host__ __device__ __forceinline__ int lds_byte(int r, int c) { const int st = (r >> 4) * 2 + (c >> 5), rr = r & 15, cc = c & 31, ob = rr * 64 + cc * 2; return st * 1024 + (ob ^ (((ob >> 9) & 1) << 5)); }
__host__ __device__ __forceinline__ void stage_rc(int b, int& R, int& C) { const int st = b / 1024, sb = b % 1024, swz = sb ^ (((sb >> 9) & 1) << 5); R = (st >> 1) * 16 + swz / 64; C = (st & 1) * 32 + (swz % 64) / 2; }
__host__ __device__ __forceinline__ int perm32(int rho) { const int n = rho >> 4, i = rho & 15; return 8 * (i >> 2) + 4 * n + (i & 3); }

struct Unit { int pm, pn, om, on, e, mt, slot; };
struct Gemm { const bf16_t* A; const bf16_t* Bt; int K; };

__device__ __forceinline__ int xcd_remap(int L, int nwg) { const int q = nwg / NXCD, r = nwg % NXCD, xcd = L % NXCD, off = L / NXCD; return (xcd < r ? xcd * (q + 1) : r * (q + 1) + (xcd - r) * q) + off; }

__device__ __forceinline__ void plain_a_off(int pm, int tid, int K, unsigned (&o)[2][2]) {
#pragma unroll
    for (int i = 0; i < 2; ++i) { int R, C; stage_rc(tid * 16 + i * 8192, R, C);
#pragma unroll
        for (int h = 0; h < 2; ++h) o[h][i] = (unsigned)((pm * BM + h * HALF + R) * K + C) * 2u; }
}
struct StaticOrder {
    int nM, nN, nwg, G, c;
    __device__ void init(int nM_, int nN_, int G_, int c_, int = 1) { nM = nM_; nN = nN_; nwg = nM * nN; G = G_; c = c_; }
    __device__ __forceinline__ bool tile(int i, int& pm, int& pn, int& q) const {
        const int L = i * G + c; if (L >= nwg) return false;
        q = 0xF; const int wgid = xcd_remap(L, nwg);
        const int nig = WGM * nN, gid = wgid / nig, fm = gid * WGM, gsz = (nM - fm) < WGM ? (nM - fm) : WGM;
        pm = fm + ((wgid % nig) % gsz); pn = (wgid % nig) / gsz; return true;
    }
    __device__ __forceinline__ bool next(int i, Unit& u) const { int pm, pn, q; if (!tile(i, pm, pn, q)) return false; u.pm = pm; u.pn = pn; u.om = pm; u.on = pn; u.e = 0; u.mt = 0; u.slot = 0; return true; }
    __device__ __forceinline__ void a_off(const Unit& u, int tid, int K, unsigned (&o)[2][2]) const { plain_a_off(u.pm, tid, K, o); }
};

__device__ __forceinline__ unsigned cvt_pk_bf16(float lo, float hi) { unsigned r; asm volatile("v_cvt_pk_bf16_f32 %0, %1, %2" : "=v"(r) : "v"(lo), "v"(hi)); return r; }

template <class Epi, class Sched, bool ALIGN_EPI, int DRY = 0, bool I8 = false>
__device__ __forceinline__ void gemm_phase(LAS unsigned char* lds, const Gemm g, const Sched& S, const Epi& E, int wvid) {
    int tid_ = (wvid * 64 + lane_id_asm()); asm volatile("" : "+v"(tid_));
    const int tid = tid_, wid = __builtin_amdgcn_readfirstlane(tid >> 6), lane = tid & 63, wr = wid >> 2, wc = wid & 3, fr = lane & 15, fq = lane >> 4;
    const int K = g.K, nt = K / BK;
    unsigned voffB[2];
#pragma unroll
    for (int i = 0; i < 2; ++i) { int R, C; stage_rc(tid * 16 + i * 8192, R, C); const int Rb = Epi::PERM ? ((R & ~31) + perm32(R & 31)) : R;
        voffB[i] = (unsigned)(Rb * K + C) * 2u; }
    constexpr unsigned kstep = BK * 2;
    const unsigned hstep = (unsigned)HALF * K * 2;
    const unsigned tstep = 2 * hstep;
    const unsigned ldsw = (unsigned)wid * 1024u;
    const int aoff = lds_byte(wr * 64 + fr, fq * 8), boff = lds_byte(wc * 32 + fr, fq * 8);
#define PG8_SA(b, h) (((b) * 2 + (h)) * HTB)
#define PG8_SB(b, h) ((4 + (b) * 2 + (h)) * HTB)
#define PG8_STAGE(bufoff, gbase, voff) do { _Pragma("unroll") for (int _i = 0; _i < 2; ++_i) \
        __builtin_amdgcn_global_load_lds((const unsigned*)((const char*)(gbase) + (voff)[_i]), (LAS unsigned*)(lds + (bufoff) + ldsw + _i * 8192), 16, 0, 0); } while (0)
#define PG8_LDA(dst, b, h) do { _Pragma("unroll") for (int m = 0; m < 4; ++m) _Pragma("unroll") for (int k = 0; k < 2; ++k) dst[m][k] = *(const LAS bf16x8*)(lds + PG8_SA(b, h) + aoff + m * 2048 + k * 1024); } while (0)
#define PG8_LDB(dst, b, h) do { _Pragma("unroll") for (int n = 0; n < 2; ++n) _Pragma("unroll") for (int k = 0; k < 2; ++k) dst[n][k] = *(const LAS bf16x8*)(lds + PG8_SB(b, h) + boff + n * 2048 + k * 1024); } while (0)
#define PG8_MMA(ai, bj, At, Bt) do { if constexpr (DRY == 1) { _Pragma("unroll") for (int m = 0; m < 4; ++m) _Pragma("unroll") for (int k = 0; k < 2; ++k) asm volatile("" :: "v"(At[m][k])); _Pragma("unroll") for (int n = 0; n < 2; ++n) _Pragma("unroll") for (int k = 0; k < 2; ++k) asm volatile("" :: "v"(Bt[n][k])); break; } __builtin_amdgcn_s_setprio(1); _Pragma("unroll") for (int m = 0; m < 4; ++m) _Pragma("unroll") for (int n = 0; n < 2; ++n) _Pragma("unroll") for (int k = 0; k < 2; ++k) \
        { if constexpr (I8) acc[ai][bj][m][n] = __builtin_bit_cast(AccT, __builtin_amdgcn_mfma_i32_16x16x64_i8(__builtin_bit_cast(i32x4, Bt[n][k]), __builtin_bit_cast(i32x4, At[m][k]), __builtin_bit_cast(i32x4, acc[ai][bj][m][n]), 0, 0, 0)); \
          else acc[ai][bj][m][n] = __builtin_bit_cast(AccT, __builtin_amdgcn_mfma_f32_16x16x32_bf16(Bt[n][k], At[m][k], __builtin_bit_cast(f32x4, acc[ai][bj][m][n]), 0, 0, 0)); } __builtin_amdgcn_s_setprio(0); } while (0)
#define PG8_WAIT_V(n) asm volatile("s_waitcnt vmcnt(" #n ")" ::: "memory")
#define PG8_WAIT_L(n) asm volatile("s_waitcnt lgkmcnt(" #n ")" ::: "memory")
#define PG8_BAR __builtin_amdgcn_s_barrier()
#define PG8_SCHED __builtin_amdgcn_sched_barrier(0)
    Unit cur, nxt; int ui = 0;
    if (!S.next(0, cur)) return;
    typedef typename Epi::AccT AccT;
    AccT acc[2][2][4][2];
#pragma unroll
    for (int a = 0; a < 2; ++a)
#pragma unroll
        for (int b = 0; b < 2; ++b)
#pragma unroll
            for (int m = 0; m < 4; ++m)
#pragma unroll
                for (int n = 0; n < 2; ++n) acc[a][b][m][n] = AccT{};
    bf16x8 At[4][2], B0[2][2], B1[2][2];
    unsigned aC[2][2];
    S.a_off(cur, tid, K, aC);
    const char* const Ab = (const char*)g.A;
    const char* cB = (const char*)g.Bt + (size_t)cur.pn * tstep;
    PG8_STAGE(PG8_SB(0, 0), cB, voffB); PG8_STAGE(PG8_SB(0, 1), cB + hstep, voffB); PG8_STAGE(PG8_SA(0, 0), Ab, aC[0]); PG8_STAGE(PG8_SA(0, 1), Ab, aC[1]);
    if (wr == 1) PG8_BAR;
    PG8_WAIT_V(2); PG8_BAR;
    PG8_STAGE(PG8_SB(1, 0), cB + kstep, voffB); PG8_STAGE(PG8_SA(1, 0), Ab + kstep, aC[0]); PG8_STAGE(PG8_SB(1, 1), cB + hstep + kstep, voffB);
    PG8_WAIT_V(6); PG8_BAR;
    for (;;) {
        const bool has_next = S.next(ui + 1, nxt);
        const char* nB = has_next ? (const char*)g.Bt + (size_t)nxt.pn * tstep : cB;
        for (int t = 0; t < nt; t += 2) {
            const bool last = (t == nt - 2);
            const char* a1 = Ab + (size_t)(t + 1) * kstep;
            const char* a2 = last ? Ab : Ab + (size_t)(t + 2) * kstep; const char* b2 = last ? nB : cB + (size_t)(t + 2) * kstep;
            const char* a3 = a2 + kstep; const char* b3 = b2 + kstep;
            PG8_LDB(B0, 0, 0); PG8_LDB(B1, 0, 1); PG8_SCHED; PG8_LDA(At, 0, 0); PG8_STAGE(PG8_SA(1, 1), a1, aC[1]);
            if (last && has_next) S.a_off(nxt, tid, K, aC);
            PG8_WAIT_V(8); PG8_WAIT_L(0); PG8_BAR; PG8_MMA(0, 0, At, B0); PG8_MMA(0, 1, At, B1); PG8_BAR; PG8_SCHED;
            PG8_LDA(At, 0, 1); PG8_STAGE(PG8_SB(0, 0), b2, voffB); PG8_STAGE(PG8_SB(0, 1), b2 + hstep, voffB); PG8_STAGE(PG8_SA(0, 0), a2, aC[0]);
            PG8_WAIT_V(8); PG8_WAIT_L(0); PG8_BAR; PG8_MMA(1, 0, At, B0); PG8_MMA(1, 1, At, B1); PG8_BAR; PG8_SCHED;
            PG8_LDB(B0, 1, 0); PG8_LDB(B1, 1, 1); PG8_SCHED; PG8_LDA(At, 1, 0); PG8_STAGE(PG8_SA(0, 1), a2, aC[1]);
            PG8_WAIT_V(8); PG8_WAIT_L(0); PG8_BAR; PG8_MMA(0, 0, At, B0); PG8_MMA(0, 1, At, B1); PG8_BAR; PG8_SCHED;
            PG8_LDA(At, 1, 1); PG8_STAGE(PG8_SB(1, 0), b3, voffB); PG8_STAGE(PG8_SB(1, 1), b3 + hstep, voffB); PG8_STAGE(PG8_SA(1, 0), a3, aC[0]);
            PG8_WAIT_V(8); PG8_WAIT_L(0); PG8_BAR; PG8_MMA(1, 0, At, B0); PG8_MMA(1, 1, At, B1); PG8_BAR; PG8_SCHED;
        }
        if constexpr (ALIGN_EPI) { if (wr == 0) PG8_BAR; }
        if constexpr (DRY == 0) E(acc, cur, wr, wc, fr, fq); else { _Pragma("unroll") for (int a = 0; a < 2; ++a) _Pragma("unroll") for (int b = 0; b < 2; ++b) _Pragma("unroll") for (int m = 0; m < 4; ++m) _Pragma("unroll") for (int n = 0; n < 2; ++n) asm volatile("" :: "v"(acc[a][b][m][n])); }
        if (!has_next) break;
#pragma unroll
        for (int a = 0; a < 2; ++a)
#pragma unroll
            for (int b = 0; b < 2; ++b)
#pragma unroll
                for (int m = 0; m < 4; ++m)
#pragma unroll
                    for (int n = 0; n < 2; ++n) acc[a][b][m][n] = AccT{};
        cur = nxt; cB = nB; ++ui;
        if constexpr (ALIGN_EPI) { if (wr == 1) PG8_BAR; }
    }
    PG8_WAIT_V(0);
    if constexpr (!ALIGN_EPI) { if (wr == 0) PG8_BAR; }
    PG8_BAR;
#undef PG8_SA
#undef PG8_SB
#undef PG8_STAGE
#undef PG8_LDA
#undef PG8_LDB
#undef PG8_MMA
#undef PG8_WAIT_V
#undef PG8_WAIT_L
#undef PG8_BAR
#undef PG8_SCHED
}
}
namespace pg8 {
typedef const f32x4 (&AccRef)[2][2][4][2];
typedef const i32x4 (&AccRefI)[2][2][4][2];
__device__ __forceinline__ f32x4 i2f(const i32x4 v) { return (f32x4){(float)v[0], (float)v[1], (float)v[2], (float)v[3]}; }

struct EpiInProj {
    static constexpr bool PERM = true; typedef f32x4 AccT;
    unsigned char* ws;
    __device__ __forceinline__ void operator()(AccRef acc, const Unit& u, int wr, int wc, int fr, int fq) const {
        const int pn = u.on, row0 = u.om * BM + wr * 64 + fr, cw = wc * 32 + 8 * fq;
        if (pn >= 4 && pn < 12) {
#pragma unroll
            for (int ai = 0; ai < 2; ++ai)
#pragma unroll
                for (int m = 0; m < 4; ++m) { const f32x4 v0 = acc[ai][0][m][0] * acc[ai][1][m][0], v1 = acc[ai][0][m][1] * acc[ai][1][m][1];
                    u32x4 w; w.x = cvt_pk_bf16(v0[0], v0[1]); w.y = cvt_pk_bf16(v0[2], v0[3]); w.z = cvt_pk_bf16(v1[0], v1[1]); w.w = cvt_pk_bf16(v1[2], v1[3]);
                    *(u32x4*)((bf16_t*)(ws + WS_U) + (size_t)(row0 + ai * HALF + m * 16) * D + (pn - 4) * 128 + cw) = w; }
            return;
        }
        size_t doff; int ldc = D, cb, mode = 0;
        if (pn < 4) { doff = WS_BG; cb = pn * 256; }
        else if (pn < 16) { doff = WS_Q; cb = (pn - 12) * 256; mode = 1; }
        else if (pn == 16) { doff = WS_K; cb = 0; ldc = 256; }
        else if (pn == 17) { doff = WS_V; cb = 0; ldc = 256; }
        else if (pn < 22) { doff = WS_GC; cb = (pn - 18) * 256; mode = 2; }
        else { doff = WS_GA; cb = (pn - 22) * 256; mode = 2; }
        bf16_t* dst = (bf16_t*)(ws + doff);
#pragma unroll
        for (int ai = 0; ai < 2; ++ai)
#pragma unroll
            for (int m = 0; m < 4; ++m) { bf16_t* rowp = dst + (size_t)(row0 + ai * HALF + m * 16) * ldc + cb + cw;
#pragma unroll
                for (int bj = 0; bj < 2; ++bj) { f32x4 v0 = acc[ai][bj][m][0], v1 = acc[ai][bj][m][1];
                    if (mode == 1) { v0 = v0 * QSCALE; v1 = v1 * QSCALE; }
                    if (mode == 2) {
#pragma unroll
                        for (int j = 0; j < 4; ++j) { v0[j] = fast_sigmoid(v0[j]); v1[j] = fast_sigmoid(v1[j]); } }
                    u32x4 w; w.x = cvt_pk_bf16(v0[0], v0[1]); w.y = cvt_pk_bf16(v0[2], v0[3]); w.z = cvt_pk_bf16(v1[0], v1[1]); w.w = cvt_pk_bf16(v1[2], v1[3]);
                    *(u32x4*)(rowp + bj * HALF) = w; } }
    }
};

struct EpiInProjI8 {
    static constexpr bool PERM = true; typedef i32x4 AccT;
    unsigned char* ws; float sw;
    __device__ __forceinline__ void operator()(AccRefI acc, const Unit& u, int wr, int wc, int fr, int fq) const {
        const int pn = u.on, row0 = u.om * BM + wr * 64 + fr, cw = wc * 32 + 8 * fq;
        const float* sx0 = (const float*)(ws + WS_SX0) + row0;
        float sxv[2][4];
#pragma unroll
        for (int ai = 0; ai < 2; ++ai)
#pragma unroll
            for (int m = 0; m < 4; ++m) sxv[ai][m] = sx0[ai * HALF + m * 16];
        if (pn >= 4 && pn < 12) {
#pragma unroll
            for (int ai = 0; ai < 2; ++ai)
#pragma unroll
                for (int m = 0; m < 4; ++m) { const float s = sxv[ai][m] * sw, s2 = s * s;
                    const f32x4 v0 = i2f(acc[ai][0][m][0]) * i2f(acc[ai][1][m][0]) * s2, v1 = i2f(acc[ai][0][m][1]) * i2f(acc[ai][1][m][1]) * s2;
                    u32x4 w; w.x = cvt_pk_bf16(v0[0], v0[1]); w.y = cvt_pk_bf16(v0[2], v0[3]); w.z = cvt_pk_bf16(v1[0], v1[1]); w.w = cvt_pk_bf16(v1[2], v1[3]);
                    *(u32x4*)((bf16_t*)(ws + WS_U) + (size_t)(row0 + ai * HALF + m * 16) * D + (pn - 4) * 128 + cw) = w; asm volatile("" ::: "memory"); }
            return;
        }
        size_t doff; int ldc = D, cb, mode = 0;
        if (pn < 4) { doff = WS_BG; cb = pn * 256; }
        else if (pn < 16) { doff = WS_Q; cb = (pn - 12) * 256; mode = 1; }
        else if (pn == 16) { doff = WS_K; cb = 0; ldc = 256; }
        else if (pn == 17) { doff = WS_V; cb = 0; ldc = 256; }
        else if (pn < 22) { doff = WS_GC; cb = (pn - 18) * 256; mode = 2; }
        else { doff = WS_GA; cb = (pn - 22) * 256; mode = 2; }
        bf16_t* dst = (bf16_t*)(ws + doff);
#pragma unroll
        for (int ai = 0; ai < 2; ++ai)
#pragma unroll
            for (int m = 0; m < 4; ++m) { bf16_t* rowp = dst + (size_t)(row0 + ai * HALF + m * 16) * ldc + cb + cw; const float s = sxv[ai][m] * sw * (mode == 1 ? QSCALE : 1.0f);
#pragma unroll
                for (int bj = 0; bj < 2; ++bj) { f32x4 v0 = i2f(acc[ai][bj][m][0]) * s, v1 = i2f(acc[ai][bj][m][1]) * s;
                    if (mode == 2) {
#pragma unroll
                        for (int j = 0; j < 4; ++j) { v0[j] = fast_sigmoid(v0[j]); v1[j] = fast_sigmoid(v1[j]); } }
                    u32x4 w; w.x = cvt_pk_bf16(v0[0], v0[1]); w.y = cvt_pk_bf16(v0[2], v0[3]); w.z = cvt_pk_bf16(v1[0], v1[1]); w.w = cvt_pk_bf16(v1[2], v1[3]);
                    *(u32x4*)(rowp + bj * HALF) = w; }
                asm volatile("" ::: "memory"); }
    }
};

struct EpiDual {
    static constexpr bool PERM = true; typedef f32x4 AccT;
    unsigned char* ws;
    __device__ __forceinline__ void operator()(AccRef acc, const Unit& u, int wr, int wc, int fr, int fq) const {
        const int row0 = u.om * BM + wr * 64 + fr, col0 = u.on * BM + wc * 32 + 8 * fq;
        const bf16_t* G = (const bf16_t*)(ws + (u.e == 0 ? WS_GC : WS_GA)); bf16_t* T1 = (bf16_t*)(ws + WS_T1); bf16_t* MG = (bf16_t*)(ws + WS_MG);
#pragma unroll
        for (int ai = 0; ai < 2; ++ai)
#pragma unroll
            for (int m = 0; m < 4; ++m) { const size_t ro = (size_t)(row0 + ai * HALF + m * 16) * D + col0;
#pragma unroll
                for (int bj = 0; bj < 2; ++bj) { const size_t o = ro + bj * HALF;
                    const u32x4 gw = *(const u32x4*)(G + o);
                    f32x4 g0 = {bflo(gw.x), bfhi(gw.x), bflo(gw.y), bfhi(gw.y)}, g1 = {bflo(gw.z), bfhi(gw.z), bflo(gw.w), bfhi(gw.w)};
                    f32x4 v0 = g0 * acc[ai][bj][m][0], v1 = g1 * acc[ai][bj][m][1];
                    if (u.e == 0) { u32x4 w; w.x = cvt_pk_bf16(v0[0], v0[1]); w.y = cvt_pk_bf16(v0[2], v0[3]); w.z = cvt_pk_bf16(v1[0], v1[1]); w.w = cvt_pk_bf16(v1[2], v1[3]); *(u32x4*)(T1 + o) = w; }
                    else { const u32x4 tw_ = *(const u32x4*)(T1 + o);
                        v0 = v0 + (f32x4){bflo(tw_.x), bfhi(tw_.x), bflo(tw_.y), bfhi(tw_.y)}; v1 = v1 + (f32x4){bflo(tw_.z), bfhi(tw_.z), bflo(tw_.w), bfhi(tw_.w)};
                        u32x4 w; w.x = cvt_pk_bf16(v0[0], v0[1]); w.y = cvt_pk_bf16(v0[2], v0[3]); w.z = cvt_pk_bf16(v1[0], v1[1]); w.w = cvt_pk_bf16(v1[2], v1[3]);
                        *(u32x4*)(MG + o) = w; } } }
    }
};

struct EpiResid {
    static constexpr bool PERM = false; typedef f32x4 AccT;
    const float* X; float* C;
    __device__ __forceinline__ void operator()(AccRef acc, const Unit& u, int wr, int wc, int fr, int fq) const {
        const int row0 = u.om * BM + wr * 64 + fr, col0 = u.on * BM + wc * 32 + 4 * fq;
#pragma unroll
        for (int ai = 0; ai < 2; ++ai)
#pragma unroll
            for (int m = 0; m < 4; ++m) { const size_t ro = (size_t)(row0 + ai * HALF + m * 16) * D + col0;
#pragma unroll
                for (int bj = 0; bj < 2; ++bj)
#pragma unroll
                    for (int n = 0; n < 2; ++n) { const size_t o = ro + bj * HALF + n * 16; *(f32x4*)(C + o) = *(const f32x4*)(X + o) * DN_ALPHA + acc[ai][bj][m][n]; } }
    }
};

struct EpiF32 {
    static constexpr bool PERM = false; typedef f32x4 AccT;
    float* C;
    __device__ __forceinline__ void operator()(AccRef acc, const Unit& u, int wr, int wc, int fr, int fq) const {
        const int row0 = u.om * BM + wr * 64 + fr, col0 = u.on * BM + wc * 32 + 4 * fq;
#pragma unroll
        for (int ai = 0; ai < 2; ++ai)
#pragma unroll
            for (int m = 0; m < 4; ++m) { const size_t ro = (size_t)(row0 + ai * HALF + m * 16) * D + col0;
#pragma unroll
                for (int bj = 0; bj < 2; ++bj)
#pragma unroll
                    for (int n = 0; n < 2; ++n) *(f32x4*)(C + ro + bj * HALF + n * 16) = acc[ai][bj][m][n]; }
    }
};
struct EpiF32I8 {
    static constexpr bool PERM = false; typedef i32x4 AccT;
    float* C; const float* sp; float sw;
    __device__ __forceinline__ void operator()(AccRefI acc, const Unit& u, int wr, int wc, int fr, int fq) const {
        const int row0 = u.om * BM + wr * 64 + fr, col0 = u.on * BM + wc * 32 + 4 * fq;
        float sv[2][4];
#pragma unroll
        for (int ai = 0; ai < 2; ++ai)
#pragma unroll
            for (int m = 0; m < 4; ++m) sv[ai][m] = sp[row0 + ai * HALF + m * 16] * sw;
#pragma unroll
        for (int ai = 0; ai < 2; ++ai)
#pragma unroll
            for (int m = 0; m < 4; ++m) { const size_t ro = (size_t)(row0 + ai * HALF + m * 16) * D + col0;
#pragma unroll
                for (int bj = 0; bj < 2; ++bj)
#pragma unroll
                    for (int n = 0; n < 2; ++n) *(f32x4*)(C + ro + bj * HALF + n * 16) = i2f(acc[ai][bj][m][n]) * sv[ai][m]; }
    }
};
__device__ __forceinline__ void ple_epilogue(AccRef acc, const Unit& u, int wr, int wc, int fr, int fq, const float* P2, bf16_t* PLE) {
    const int row0 = u.om * BM + wr * 64 + fr, col0 = u.on * BM + wc * 32 + 8 * fq;
#pragma unroll
    for (int ai = 0; ai < 2; ++ai)
#pragma unroll
        for (int m = 0; m < 4; ++m) { const size_t ro = (size_t)(row0 + ai * HALF + m * 16) * D + col0;
#pragma unroll
            for (int bj = 0; bj < 2; ++bj) { const size_t o = ro + bj * HALF; const f32x4 p0 = *(const f32x4*)(P2 + o), p1 = *(const f32x4*)(P2 + o + 4); const f32x4 a0 = acc[ai][bj][m][0], a1 = acc[ai][bj][m][1];
                u32x4 w; w.x = cvt_pk_bf16(fast_sigmoid(a0[0]) * p0[0], fast_sigmoid(a0[1]) * p0[1]); w.y = cvt_pk_bf16(fast_sigmoid(a0[2]) * p0[2], fast_sigmoid(a0[3]) * p0[3]);
                w.z = cvt_pk_bf16(fast_sigmoid(a1[0]) * p1[0], fast_sigmoid(a1[1]) * p1[1]); w.w = cvt_pk_bf16(fast_sigmoid(a1[2]) * p1[2], fast_sigmoid(a1[3]) * p1[3]);
                *(u32x4*)(PLE + o) = w; }
            if (m & 1) asm volatile("" ::: "memory"); }
}

struct EpiSwiglu {
    static constexpr bool PERM = true; typedef f32x4 AccT;
    bf16_t* H; const float* b_gu; const LAS unsigned* tw; unsigned char* ws;
    __device__ __forceinline__ void operator()(AccRef acc, const Unit& u, int wr, int wc, int fr, int fq) const {
        if (u.e < 0) { ple_epilogue(acc, u, wr, wc, fr, fq, (const float*)(ws + WS_P2), (bf16_t*)(ws + WS_PLE)); return; }
        const int trow0 = wr * 64 + fr, row0 = u.om * BM + trow0, cw = wc * 32 + 8 * fq, col0 = u.on * 128 + cw;
        const float* bg = b_gu + (size_t)u.e * 2048 + col0;
#pragma unroll
        for (int n = 0; n < 2; ++n) { const f32x4 bgn = *(const f32x4*)(bg + 4 * n), bun = *(const f32x4*)(bg + 1024 + 4 * n);
#pragma unroll
            for (int ai = 0; ai < 2; ++ai)
#pragma unroll
                for (int m = 0; m < 4; ++m) { const float w = bfhi(tw[u.slot * BM + trow0 + ai * HALF + m * 16]);
                    const f32x4 gt = acc[ai][0][m][n] + bgn, up = acc[ai][1][m][n] + bun; f32x4 hv;
#pragma unroll
                    for (int j = 0; j < 4; ++j) { const float gv = fminf(gt[j], 7.0f), uv = fminf(fmaxf(up[j], -7.0f), 7.0f); hv[j] = (uv + 1.0f) * gv * fast_sigmoid(1.702f * gv) * w; }
                    u32x2 o; o.x = cvt_pk_bf16(hv[0], hv[1]); o.y = cvt_pk_bf16(hv[2], hv[3]);
                    *(u32x2*)(H + (size_t)(row0 + ai * HALF + m * 16) * D + col0 + 4 * n) = o; } }
    }
};
struct EpiSwigluI8 {
    static constexpr bool PERM = true; typedef i32x4 AccT;
    bf16_t* H; const float* b_gu; const LAS unsigned* tw; unsigned char* ws;
    __device__ __forceinline__ void operator()(AccRefI acc, const Unit& u, int wr, int wc, int fr, int fq) const {
        const int trow0 = wr * 64 + fr, row0 = u.om * BM + trow0, cw = wc * 32 + 8 * fq;
        const float* scl = (const float*)(ws + WS_SCL);
        if (u.e < 0) {
            const float* P2 = (const float*)(ws + WS_P2); bf16_t* PLE = (bf16_t*)(ws + WS_PLE); const float* sx1 = (const float*)(ws + WS_SX1);
            const float spg = scl[NE]; const int col0 = u.on * BM + cw;
#pragma unroll
            for (int ai = 0; ai < 2; ++ai)
#pragma unroll
                for (int m = 0; m < 4; ++m) { const int r = row0 + ai * HALF + m * 16; const float s = sx1[r] * spg; const size_t ro = (size_t)r * D + col0;
#pragma unroll
                    for (int bj = 0; bj < 2; ++bj) { const size_t o = ro + bj * HALF; const f32x4 p0 = *(const f32x4*)(P2 + o), p1 = *(const f32x4*)(P2 + o + 4); const f32x4 a0 = i2f(acc[ai][bj][m][0]) * s, a1 = i2f(acc[ai][bj][m][1]) * s;
                        u32x4 w; w.x = cvt_pk_bf16(fast_sigmoid(a0[0]) * p0[0], fast_sigmoid(a0[1]) * p0[1]); w.y = cvt_pk_bf16(fast_sigmoid(a0[2]) * p0[2], fast_sigmoid(a0[3]) * p0[3]);
                        w.z = cvt_pk_bf16(fast_sigmoid(a1[0]) * p1[0], fast_sigmoid(a1[1]) * p1[1]); w.w = cvt_pk_bf16(fast_sigmoid(a1[2]) * p1[2], fast_sigmoid(a1[3]) * p1[3]);
                        *(u32x4*)(PLE + o) = w; }
                    if (m & 1) asm volatile("" ::: "memory"); }
            return; }
        const int col0 = u.on * 128 + cw;
        const float* bg = b_gu + (size_t)u.e * 2048 + col0; const float sg = scl[u.e];
        const float* lsx = (const float*)(ws + WS_LSX) + (size_t)u.e * LISTCAP + u.mt * BM + trow0;
        const f32x4 bg0 = *(const f32x4*)(bg), bg1 = *(const f32x4*)(bg + 4), bu0 = *(const f32x4*)(bg + 1024), bu1 = *(const f32x4*)(bg + 1028);
        unsigned char* H8 = (unsigned char*)H;
        float lsv[2][4];
#pragma unroll
        for (int ai = 0; ai < 2; ++ai)
#pragma unroll
            for (int m = 0; m < 4; ++m) lsv[ai][m] = lsx[ai * HALF + m * 16];
#pragma unroll
        for (int ai = 0; ai < 2; ++ai)
#pragma unroll
            for (int m = 0; m < 4; ++m) { const unsigned twv = tw[u.slot * BM + trow0 + ai * HALF + m * 16]; const float qh = bfhi(twv);
                const float s = (qh != 0.f ? lsv[ai][m] : 0.f) * sg;
                unsigned q8[2];
#pragma unroll
                for (int n = 0; n < 2; ++n) { const f32x4 gt = i2f(acc[ai][0][m][n]) * s + (n == 0 ? bg0 : bg1), up = i2f(acc[ai][1][m][n]) * s + (n == 0 ? bu0 : bu1); unsigned q = 0u;
#pragma unroll
                    for (int j = 0; j < 4; ++j) { const float gv = fminf(gt[j], 7.0f), uv = __builtin_amdgcn_fmed3f(up[j], -7.0f, 7.0f);
                        const float sg_ = __builtin_amdgcn_rcpf(1.0f + __builtin_amdgcn_exp2f((-1.702f * LOG2E) * gv));
                        const float hq = __builtin_fmaf(__builtin_fmaf(uv, gv, gv) * sg_, qh, 128.0f);
                        q = __builtin_amdgcn_cvt_pk_u8_f32(__builtin_amdgcn_fmed3f(__builtin_rintf(hq), 1.0f, 255.0f), j, q); }
                    q8[n] = q ^ 0x80808080u; }
                *(u32x2*)(H8 + (size_t)(row0 + ai * HALF + m * 16) * D + col0) = (u32x2){q8[0], q8[1]};
                if (m & 1) asm volatile("" ::: "memory"); }
    }
};
struct EpiDownI8 {
    static constexpr bool PERM = true; typedef i32x4 AccT;
    bf16_t* Y; unsigned char* ws; const LAS int* cntL;
    __device__ __forceinline__ void operator()(AccRefI acc, const Unit& u, int wr, int wc, int fr, int fq) const {
        const int trow0 = wr * 64 + fr, row0 = u.om * BM + trow0, cw = wc * 32 + 8 * fq;
        const float* scl = (const float*)(ws + WS_SCL);
        if (u.e < 0) {
            const float* P2 = (const float*)(ws + WS_P2); bf16_t* PLE = (bf16_t*)(ws + WS_PLE); const float* sx1 = (const float*)(ws + WS_SX1);
            const float spg = scl[NE]; const int col0 = u.on * BM + cw;
#pragma unroll
            for (int ai = 0; ai < 2; ++ai)
#pragma unroll
                for (int m = 0; m < 4; ++m) { const int r = row0 + ai * HALF + m * 16; const float s = sx1[r] * spg; const size_t ro = (size_t)r * D + col0;
#pragma unroll
                    for (int bj = 0; bj < 2; ++bj) { const size_t o = ro + bj * HALF; const f32x4 p0 = *(const f32x4*)(P2 + o), p1 = *(const f32x4*)(P2 + o + 4); const f32x4 a0 = i2f(acc[ai][bj][m][0]) * s, a1 = i2f(acc[ai][bj][m][1]) * s;
                        u32x4 w; w.x = cvt_pk_bf16(fast_sigmoid(a0[0]) * p0[0], fast_sigmoid(a0[1]) * p0[1]); w.y = cvt_pk_bf16(fast_sigmoid(a0[2]) * p0[2], fast_sigmoid(a0[3]) * p0[3]);
                        w.z = cvt_pk_bf16(fast_sigmoid(a1[0]) * p1[0], fast_sigmoid(a1[1]) * p1[1]); w.w = cvt_pk_bf16(fast_sigmoid(a1[2]) * p1[2], fast_sigmoid(a1[3]) * p1[3]);
                        *(u32x4*)(PLE + o) = w; }
                    if (m & 1) asm volatile("" ::: "memory"); }
            return; }
        const float sd = scl[128 + u.e]; const int cnt = cntL[u.e], li0 = u.mt * BM + trow0;
        const float* lhs = (const float*)(ws + WS_LHS) + (size_t)u.e * LISTCAP + li0;
        bf16_t* yp = Y + (size_t)row0 * D + u.on * BM + cw;
        float lhv[2][4];
#pragma unroll
        for (int ai = 0; ai < 2; ++ai)
#pragma unroll
            for (int m = 0; m < 4; ++m) lhv[ai][m] = lhs[ai * HALF + m * 16];
#pragma unroll
        for (int ai = 0; ai < 2; ++ai)
#pragma unroll
            for (int m = 0; m < 4; ++m) { const int dr = ai * HALF + m * 16; const float s = ((li0 + dr) < cnt ? lhv[ai][m] : 0.f) * sd;
#pragma unroll
                for (int bj = 0; bj < 2; ++bj) { const f32x4 v0 = i2f(acc[ai][bj][m][0]) * s, v1 = i2f(acc[ai][bj][m][1]) * s;
                    u32x4 o; o.x = cvt_pk_bf16(v0[0], v0[1]); o.y = cvt_pk_bf16(v0[2], v0[3]); o.z = cvt_pk_bf16(v1[0], v1[1]); o.w = cvt_pk_bf16(v1[2], v1[3]);
                    *(u32x4*)(yp + (size_t)dr * D + bj * HALF) = o; }
                if (m & 1) asm volatile("" ::: "memory"); }
    }
};
struct EpiDown {
    static constexpr bool PERM = true; typedef f32x4 AccT;
    bf16_t* Y; unsigned char* ws;
    __device__ __forceinline__ void operator()(AccRef acc, const Unit& u, int wr, int wc, int fr, int fq) const {
        if (u.e < 0) { ple_epilogue(acc, u, wr, wc, fr, fq, (const float*)(ws + WS_P2), (bf16_t*)(ws + WS_PLE)); return; }
        bf16_t* yp = Y + (size_t)(u.om * BM + wr * 64 + fr) * D + u.on * BM + wc * 32 + 8 * fq;
#pragma unroll
        for (int ai = 0; ai < 2; ++ai)
#pragma unroll
            for (int m = 0; m < 4; ++m)
#pragma unroll
                for (int bj = 0; bj < 2; ++bj) { const f32x4 v0 = acc[ai][bj][m][0], v1 = acc[ai][bj][m][1];
                    u32x4 o; o.x = cvt_pk_bf16(v0[0], v0[1]); o.y = cvt_pk_bf16(v0[2], v0[3]); o.z = cvt_pk_bf16(v1[0], v1[1]); o.w = cvt_pk_bf16(v1[2], v1[3]);
                    *(u32x4*)(yp + (size_t)(ai * HALF + m * 16) * D + bj * HALF) = o; }
    }
};

struct DualOrder {
    StaticOrder so;
    __device__ __forceinline__ bool next(int i, Unit& u) const {
        int pm, pn, q; if (!so.tile(i >> 1, pm, pn, q)) return false;
        const int e = i & 1; u.pm = e * (M / BM) + pm; u.pn = e * 4 + pn; u.om = pm; u.on = pn; u.e = e; u.mt = 0; u.slot = 0; return true;
    }
    __device__ __forceinline__ void a_off(const Unit& u, int tid, int K, unsigned (&o)[2][2]) const { plain_a_off(u.pm, tid, K, o); }
};
struct MoeOrder {
    const LAS int* cntL; const LAS int* tsL; const LAS unsigned* tw; int NT, gather, btile0, btile_ple, n_extra, extra_first; unsigned abase, abase_ple; int U, UT, G, c; const LAS int* utab; int nunits;
    __device__ __forceinline__ void init(const LAS int* cntL_, const LAS int* tsL_, const LAS unsigned* tw_, int NT_, int G_, int c_, int gather_, size_t aoff_, size_t boff_, int n_extra_, int extra_first_, size_t aoff_ple_, size_t boff_ple_, int tshift_) {
        cntL = cntL_; tsL = tsL_; tw = tw_; NT = NT_; gather = gather_; abase = (unsigned)aoff_; btile0 = (int)(boff_ >> tshift_); abase_ple = (unsigned)aoff_ple_; btile_ple = (int)(boff_ple_ >> tshift_); n_extra = n_extra_; extra_first = extra_first_;
        U = __builtin_amdgcn_readfirstlane(tsL_[NE]) * NT_; UT = U + n_extra_; G = G_; c = c_; utab = nullptr; nunits = 0; }
    struct Own { int ok, maxT, maxC, totalFree; };
    __device__ __forceinline__ Own own_params(int split) const {
        Own o; int mx = 0, sumT = 0;
        for (int e = 0; e < NE; ++e) { const int T = tsL[e + 1] - tsL[e]; mx = T > mx ? T : mx; sumT += T; }
        o.maxT = mx; o.maxC = split == 1 ? mx : (mx + 1) >> 1; o.ok = 0;
        o.totalFree = split == 1 ? 8 * (NE * o.maxC - sumT) : 4 * (2 * NE * o.maxC - sumT);
        return o;
    }
    __device__ __forceinline__ static int ple_in_p5(const LAS int* tsL_, int G_) {
        int mx = 0, sumT = 0;
        for (int e = 0; e < NE; ++e) { const int T = tsL_[e + 1] - tsL_[e]; mx = T > mx ? T : mx; sumT += T; }
        int nfree;
        { const int U5 = sumT * 8; nfree = (G_ - U5 % G_) % G_; }
        return nfree < 256 ? nfree : 256;
    }
    __device__ __forceinline__ void build_units(LAS int* tab, int maxu, int tid, int p, int split) {
        const Own o = own_params(split);
        if (o.ok) {
            const int e = p >> 3, sub = p & 7, nt = split == 1 ? sub : sub >> 1, half = split == 1 ? 0 : sub & 1;
            const int t0 = tsL[e], T = tsL[e + 1] - t0, h0 = (T + 1) >> 1;
            const int myc = split == 1 ? T : (half ? T - h0 : h0), mt0 = (split == 2 && half) ? h0 : 0, myfree = o.maxC - myc;
            int prefix = 0;
            for (int k = 0; k < e; ++k) { const int Tk = tsL[k + 1] - tsL[k]; prefix += split == 1 ? 8 * (o.maxC - Tk) : 4 * (2 * o.maxC - Tk); }
            prefix += split == 1 ? sub * (o.maxC - T) : (sub >> 1) * (2 * o.maxC - T) + (half ? (o.maxC - h0) : 0);
            int nfill = n_extra - prefix; nfill = nfill < 0 ? 0 : (nfill > myfree ? myfree : nfill);
            int nover = 0; if (n_extra > o.totalFree) { const int rem = n_extra - o.totalFree - p; nover = rem > 0 ? (rem + 255) >> 8 : 0; }
            int n = myc + nfill + nover; if (n > maxu) n = maxu;
            if (tid < n) { LAS int* q = tab + 8 * tid;
                if (tid < myc) { const int mt = mt0 + tid; q[0] = t0 + mt; q[1] = btile0 + e * NT + nt; q[2] = nt; q[3] = e; q[4] = mt; }
                else { const int k = tid - myc; const int idx = k < nfill ? prefix + k : o.totalFree + (k - nfill) * 256 + p;
                    const int j = extra_first + idx, pm = (j >> 5) * 8 + (j & 7), pn = (j & 31) >> 3; q[0] = pm; q[1] = btile_ple + pn; q[2] = pn; q[3] = -1; q[4] = 0; } }
            __syncthreads();
            utab = tab; nunits = n; return;
        }
        if (tid < maxu) { const int L = tid * G + c;
            if (L < UT) { LAS int* q = tab + 8 * tid;
                if (L >= U) { const int j = extra_first + (L - U), pm = (j >> 5) * 8 + (j & 7), pn = (j & 31) >> 3; q[0] = pm; q[1] = btile_ple + pn; q[2] = pn; q[3] = -1; q[4] = 0; }
                else { const int wgid = xcd_remap(L, U); int e = 0;
                    for (int k = 1; k < NE; ++k) e += (wgid >= tsL[k] * NT) ? 1 : 0;
                    const int t0 = tsL[e], ntl = tsL[e + 1] - t0, r = wgid - t0 * NT, nt = r / ntl, mt = r - nt * ntl;
                    q[0] = t0 + mt; q[1] = btile0 + e * NT + nt; q[2] = nt; q[3] = e; q[4] = mt; } } }
        __syncthreads();
        utab = tab; nunits = c < UT ? (UT - 1 - c) / G + 1 : 0; if (nunits > maxu) nunits = maxu;
    }
    __device__ __forceinline__ bool next(int i, Unit& u) const {
        if (i >= nunits) return false;
        const LAS int* p = utab + 8 * i;
        u.pm = __builtin_amdgcn_readfirstlane(p[0]); u.pn = __builtin_amdgcn_readfirstlane(p[1]); u.om = u.pm; u.on = __builtin_amdgcn_readfirstlane(p[2]);
        u.e = __builtin_amdgcn_readfirstlane(p[3]); u.mt = __builtin_amdgcn_readfirstlane(p[4]); u.slot = i; return true;
    }
    __device__ __forceinline__ void a_off(const Unit& u, int tid, int K, unsigned (&o)[2][2]) const {
        if (u.e < 0 || !gather) { plain_a_off(u.pm, tid, K, o); const unsigned base = u.e < 0 ? abase_ple : abase;
#pragma unroll
            for (int h = 0; h < 2; ++h)
#pragma unroll
                for (int i = 0; i < 2; ++i) o[h][i] += base;
            return; }
#pragma unroll
        for (int i = 0; i < 2; ++i) { int R, C; stage_rc(tid * 16 + i * 8192, R, C);
#pragma unroll
            for (int h = 0; h < 2; ++h) { const int tok = (int)(tw[u.slot * BM + h * HALF + R] & 0xffffu);
                o[h][i] = (unsigned)(tok * K + C) * 2u + abase; } }
    }
};
constexpr int MOE_MAXU = 10;
__device__ __forceinline__ void moe_preload(const MoeOrder& S, const LAS int* cntL, const int* list_tok, const float* list_w, LAS unsigned* tw, int wvid) {
    int tid_ = (wvid * 64 + lane_id_asm()); asm volatile("" : "+v"(tid_)); const int tid = tid_;
    int tokv[MOE_MAXU / 2]; float wv[MOE_MAXU / 2];
#pragma unroll
    for (int k = 0; k < MOE_MAXU / 2; ++k) { const int ent = tid + NTHREADS * k, slot = ent >> 8, row = ent & 255; tokv[k] = 0; wv[k] = 0.f;
        if (slot < S.nunits) { const LAS int* p = S.utab + 8 * slot; const int e = p[3], mt = p[4], li = mt * BM + row;
            if (e >= 0 && li < cntL[e]) { tokv[k] = list_tok[(size_t)e * LISTCAP + li]; wv[k] = list_w[(size_t)e * LISTCAP + li]; } } }
#pragma unroll
    for (int k = 0; k < MOE_MAXU / 2; ++k) { const int ent = tid + NTHREADS * k; if ((ent >> 8) < S.nunits) tw[ent] = (unsigned)tokv[k] | (f2bf(wv[k]) << 16); }
    __syncthreads();
}
struct Ple1Order {
    int first, n;
    __device__ __forceinline__ bool next(int i, Unit& u) const { if (i >= n) return false; const int j = first + i, pm = (j >> 5) * 8 + (j & 7), pn = (j & 31) >> 3;
        u.pm = pm; u.pn = pn; u.om = pm; u.on = pn; u.e = 0; u.mt = 0; u.slot = 0; return true; }
    __device__ __forceinline__ void a_off(const Unit& u, int tid, int K, unsigned (&o)[2][2]) const { plain_a_off(u.pm, tid, K, o); }
};
}
__device__ __forceinline__ int dst_row(int n, int map) {
    if (map == 1) { if (n >= 1024 && n < 3072) { const int hsel = n >= 2048, c = n - 1024 - hsel * 1024; return 1024 + (c >> 7) * 256 + hsel * 128 + (c & 127); } return n; }
    if (map == 2) { const int hsel = n >= 1024, c = n - hsel * 1024; return (c >> 7) * 256 + hsel * 128 + (c & 127); }
    return n;
}
struct P0Args { const float *x, *p, *w_in, *w_brc, *w_bra, *w_out, *w_pg, *w_pp, *w_gu, *w_dn; unsigned char* ws; float s_in, s_pp; };
struct P0Item { const float* src; bf16_t* dst; int K, N; float qinv; };
constexpr int P0_I_IN = 16 * (NIN / 64), P0_I_SQ = 16 * 16, P0_I_PP = 4 * 16, P0_I_GU = 16 * 32, P0_I_DN = 16 * 16;
constexpr int P0_NSMALL = P0_I_IN + 3 * P0_I_SQ + P0_I_PP;
constexpr int P0_NITEMS = P0_I_IN + 4 * P0_I_SQ + P0_I_PP + NE * P0_I_GU + NE * P0_I_DN;
__device__ __forceinline__ P0Item p0_decode(const P0Args& a, int it) {
    const float* W; bf16_t* WT; int K = D, N = D, map = 0, r = it; float qinv = 0.f; const float* scl = (const float*)(a.ws + WS_SCL);
    if (r < P0_I_IN) { W = a.w_in; WT = (bf16_t*)(a.ws + WS_WIN); N = NIN; map = 1; qinv = 1.0f / a.s_in; }
    else if ((r -= P0_I_IN) < P0_I_SQ) { W = a.w_brc; WT = (bf16_t*)(a.ws + WS_WBR); }
    else if ((r -= P0_I_SQ) < P0_I_SQ) { W = a.w_bra; WT = (bf16_t*)(a.ws + WS_WBR) + (size_t)D * D; }
    else if ((r -= P0_I_SQ) < P0_I_SQ) { W = a.w_out; WT = (bf16_t*)(a.ws + WS_WOUT); }
    else if ((r -= P0_I_SQ) < P0_I_PP) { W = a.w_pp; WT = (bf16_t*)(a.ws + WS_WPP); K = DPLE; }
    else if ((r -= P0_I_PP) < P0_I_SQ) { W = a.w_pg; WT = (bf16_t*)(a.ws + WS_WPG8); qinv = 1.0f / scl[NE]; }
    else if ((r -= P0_I_SQ) < NE * P0_I_GU) { const int e = r / P0_I_GU; r -= e * P0_I_GU; W = a.w_gu + (size_t)e * D * 2048; WT = (bf16_t*)(a.ws + WS_WGU + (size_t)e * 2048 * D); N = 2048; map = 2; qinv = 1.0f / scl[e]; }
    else { r -= NE * P0_I_GU; const int e = r / P0_I_DN; r -= e * P0_I_DN; W = a.w_dn + (size_t)e * D * D; WT = (bf16_t*)(a.ws + WS_WDN + (size_t)e * D * D); qinv = 1.0f / scl[128 + e]; }
    const int nblk = N / 64, kb = r / nblk, nb = r - kb * nblk, k0 = 64 * kb, n0 = 64 * nb;
    P0Item d; d.src = W + (size_t)k0 * N + n0; d.K = K; d.N = N; d.qinv = qinv;
    d.dst = qinv != 0.f ? (bf16_t*)((unsigned char*)WT + (size_t)dst_row(n0, map) * K + k0) : WT + (size_t)dst_row(n0, map) * K + k0; return d;
}
__device__ __forceinline__ void p0_load(const P0Item& d, f32x4 (&v)[16], int lane) {
    const int lr = lane >> 4, lc = (lane & 15) * 4;
#pragma unroll
    for (int i = 0; i < 16; ++i) v[i] = __builtin_nontemporal_load((const f32x4*)(d.src + (size_t)(4 * i + lr) * d.N + lc));
}
__device__ __forceinline__ void p0_store(const P0Item& d, const f32x4 (&v)[16], LAS float* scr, int lane) {
    const int lr = lane >> 4, lc = (lane & 15) * 4;
#pragma unroll
    for (int i = 0; i < 16; ++i) { LAS float* s = scr + (4 * i + lr) * 65 + lc; s[0] = v[i][0]; s[1] = v[i][1]; s[2] = v[i][2]; s[3] = v[i][3]; }
    asm volatile("s_waitcnt lgkmcnt(0)" ::: "memory");
    const int c = lane & 7;
#pragma unroll
    for (int j = 0; j < 8; ++j) { const int n = (lane >> 3) + 8 * j; const LAS float* s = scr + (8 * c) * 65 + n;
        if (d.qinv != 0.f) { unsigned lo = 0u, hi = 0u;
#pragma unroll
            for (int q = 0; q < 4; ++q) { const int a0 = (int)fminf(fmaxf(rintf(s[q * 65] * d.qinv), -127.f), 127.f), a1 = (int)fminf(fmaxf(rintf(s[(q + 4) * 65] * d.qinv), -127.f), 127.f);
                lo |= ((unsigned)a0 & 0xffu) << (8 * q); hi |= ((unsigned)a1 & 0xffu) << (8 * q); }
            *(u32x2*)((unsigned char*)d.dst + (size_t)n * d.K + 8 * c) = (u32x2){lo, hi}; }
        else { u32x4 o; o.x = pk2(s[0 * 65], s[1 * 65]); o.y = pk2(s[2 * 65], s[3 * 65]); o.z = pk2(s[4 * 65], s[5 * 65]); o.w = pk2(s[6 * 65], s[7 * 65]);
            *(u32x4*)(d.dst + (size_t)n * d.K + 8 * c) = o; } }
    asm volatile("s_waitcnt lgkmcnt(0)" ::: "memory");
}
constexpr int P0_FILL = 2, P0_FILL_SEAMS = 4;
__device__ __forceinline__ void p0_fill(const P0Args& a, LAS unsigned char* lds, int vcu, int G, int seam, int wave) {
    const int lane = lane_id_asm();
    LAS float* scr = (LAS float*)(lds + wave * 16640);
    const int base = seam <= P0_FILL_SEAMS ? P0_NSMALL + (((seam - 1) * G + vcu) * 7 + (wave - 1)) * P0_FILL : P0_NITEMS - G * 7 * P0_FILL + (vcu * 7 + (wave - 1)) * P0_FILL;
    f32x4 va[16], vb[16];
    const P0Item da = p0_decode(a, base); p0_load(da, va, lane);
    if (P0_FILL >= 2) { const P0Item db = p0_decode(a, base + 1); p0_load(db, vb, lane); p0_store(da, va, scr, lane);
        if (P0_FILL >= 3) { const P0Item dc = p0_decode(a, base + 2); p0_load(dc, va, lane); p0_store(db, vb, scr, lane); p0_store(dc, va, scr, lane); }
        else p0_store(db, vb, scr, lane); }
    else p0_store(da, va, scr, lane);
}
__device__ __forceinline__ float sample_scale(const float* Wm, unsigned stride, LAS unsigned char* lds, int wvid, float* rms_out = nullptr) {
    int tid_ = (wvid * 64 + lane_id_asm()); asm volatile("" : "+v"(tid_)); const int tid = tid_, lane = tid & 63;
    const unsigned so = (unsigned)tid * stride;
    const f32x4 v0 = *(const f32x4*)(Wm + so), v1 = *(const f32x4*)(Wm + so + 4);
    float ss = (v0[0] * v0[0] + v0[1] * v0[1]) + (v0[2] * v0[2] + v0[3] * v0[3]) + (v1[0] * v1[0] + v1[1] * v1[1]) + (v1[2] * v1[2] + v1[3] * v1[3]);
    float mx = fmaxf(fmaxf(fmaxf(fabsf(v0[0]), fabsf(v0[1])), fmaxf(fabsf(v0[2]), fabsf(v0[3]))), fmaxf(fmaxf(fabsf(v1[0]), fabsf(v1[1])), fmaxf(fabsf(v1[2]), fabsf(v1[3]))));
    ss = wave_sum(ss, lane);
#pragma unroll
    for (int o = 1; o < 64; o <<= 1) mx = fmaxf(mx, shx(mx, o, lane));
    LAS float* red = (LAS float*)lds;
    __syncthreads();
    if ((tid & 63) == 0) { red[tid >> 6] = ss; red[8 + (tid >> 6)] = mx; }
    __syncthreads();
    float s = 0.f, m = 0.f;
#pragma unroll
    for (int w = 0; w < NWAVES; ++w) { s += red[w]; m = fmaxf(m, red[8 + w]); }
    __syncthreads();
    const float rms = sqrtf(s * (1.0f / 4096.0f)); if (rms_out) *rms_out = rms;
    return fmaxf(fmaxf(6.5f * rms, 1.25f * m), 1e-30f) * (1.0f / 127.0f);
}
__device__ __forceinline__ void p0_calibrate(const P0Args& a, LAS unsigned char* lds, int vcu, int wvid) {
    if (vcu > 2 * NE) return;
    float rms = 0.f;
    const float* Wm = vcu < NE ? a.w_gu + (size_t)vcu * D * 2048 : (vcu == NE ? a.w_pg : a.w_dn + (size_t)(vcu - NE - 1) * D * D);
    const float sc = sample_scale(Wm, vcu < NE ? 4100 : 2044, lds, wvid, &rms);
    if ((wvid * 64 + lane_id_asm()) == 0) { float* scl = (float*)(a.ws + WS_SCL); if (vcu <= NE) scl[vcu] = sc; else scl[128 + vcu - NE - 1] = sc; if (vcu < NE) scl[64 + vcu] = rms; }
}
__device__ __forceinline__ void p0_phase(const P0Args& a, LAS unsigned char* lds, int vcu, int G, int it_lo, int it_hi, bool do_xp, int wvid) {
    int tid_ = (wvid * 64 + lane_id_asm()); asm volatile("" : "+v"(tid_));
    const int tid = tid_, lane = tid & 63, wave = __builtin_amdgcn_readfirstlane(tid >> 6);
    LAS float* scr = (LAS float*)(lds + wave * 16640);
    const int gw = vcu * NWAVES + wave, NGW = G * NWAVES;
    f32x4 va[16], vb[16]; P0Item da, db;
    int it = it_lo + gw;
    if (it < it_hi) { da = p0_decode(a, it); p0_load(da, va, lane); }
    while (it < it_hi) {
        const bool hb = it + NGW < it_hi;
        if (hb) { db = p0_decode(a, it + NGW); p0_load(db, vb, lane); }
        p0_store(da, va, scr, lane);
        if (!hb) break;
        const bool ha = it + 2 * NGW < it_hi;
        if (ha) { da = p0_decode(a, it + 2 * NGW); p0_load(da, va, lane); }
        p0_store(db, vb, scr, lane);
        if (!ha) break;
        it += 2 * NGW;
    }
    if (!do_xp) return;
    p0_calibrate(a, lds, vcu, wvid);
    const int gt = vcu * NTHREADS + tid, NGT = G * NTHREADS;
    for (int t0 = 2 * gw; t0 < M; t0 += 2 * NGW) { f32x4 v[2][4];
#pragma unroll
        for (int x = 0; x < 2; ++x)
#pragma unroll
            for (int j = 0; j < 4; ++j) v[x][j] = __builtin_nontemporal_load((const f32x4*)(a.x + (size_t)(t0 + x) * D + 256 * j + 4 * lane));
#pragma unroll
        for (int x = 0; x < 2; ++x) { float am = 0.f;
#pragma unroll
            for (int j = 0; j < 4; ++j) am = fmaxf(am, fmaxf(fmaxf(fabsf(v[x][j][0]), fabsf(v[x][j][1])), fmaxf(fabsf(v[x][j][2]), fabsf(v[x][j][3]))));
#pragma unroll
            for (int o = 1; o < 64; o <<= 1) am = fmaxf(am, shx(am, o, lane));
            const float sxr = fmaxf(am, 1e-30f) * (1.0f / 127.0f), qi = 1.0f / sxr;
#pragma unroll
            for (int j = 0; j < 4; ++j) { unsigned q = 0u;
#pragma unroll
                for (int z = 0; z < 4; ++z) q |= ((unsigned)(int)rintf(v[x][j][z] * qi) & 0xffu) << (8 * z);
                *(unsigned*)(a.ws + WS_XB + (size_t)(t0 + x) * D + 256 * j + 4 * lane) = q; }
            if (lane == 0) ((float*)(a.ws + WS_SX0))[t0 + x] = sxr; } }
    for (int i = gt; i < M * DPLE / 8; i += 4 * NGT) { f32x4 v[4][2];
#pragma unroll
        for (int u = 0; u < 4; ++u) { const size_t o = (size_t)(i + u * NGT) * 8; v[u][0] = __builtin_nontemporal_load((const f32x4*)(a.p + o)); v[u][1] = __builtin_nontemporal_load((const f32x4*)(a.p + o + 4)); }
#pragma unroll
        for (int u = 0; u < 4; ++u) { u32x4 o; o.x = pk2(v[u][0][0], v[u][0][1]); o.y = pk2(v[u][0][2], v[u][0][3]); o.z = pk2(v[u][1][0], v[u][1][1]); o.w = pk2(v[u][1][2], v[u][1][3]);
            *(u32x4*)((bf16_t*)(a.ws + WS_PB) + (size_t)(i + u * NGT) * 8) = o; } }
}

__device__ __forceinline__ int crow(int r, int hi) { return (r & 3) + 8 * (r >> 2) + 4 * hi; }
typedef short v4i16_t __attribute__((ext_vector_type(4)));
__device__ __forceinline__ s16x4 vtr(const LAS unsigned char* p) { return __builtin_bit_cast(s16x4, __builtin_amdgcn_ds_read_tr16_b64_v4i16((LAS v4i16_t*)p)); }
__device__ __forceinline__ void attn_unit(LAS unsigned char* lds, const bf16_t* Q, const bf16_t* Kg, const bf16_t* Vg, const float* sinks, bf16_t* O, int b, int kvh, int nb, int wvid) {
    int tid_ = (wvid * 64 + lane_id_asm()); asm volatile("" : "+v"(tid_));
    const int tid = tid_, lane = tid & 63, r32 = lane & 31, hi = lane >> 5; const int wid = __builtin_amdgcn_readfirstlane(tid >> 6);
    const int t0 = b * SEQ + nb * 128;
#pragma unroll
    for (int it = 0; it < 4; ++it) { const int idx = tid + it * NTHREADS, key = idx >> 3, c = idx & 7;
        int row = t0 - 128 + key; if (row < b * SEQ) row = b * SEQ;
        const u32x4 kv = *(const u32x4*)(Kg + (size_t)row * 256 + kvh * HD + c * 8);
        const u32x4 vv = *(const u32x4*)(Vg + (size_t)row * 256 + kvh * HD + c * 8);
        *(LAS u32x4*)(lds + c * 4096 + key * 16) = kv;
        *(LAS u32x4*)(lds + 32768 + (c >> 2) * 16384 + (key >> 4) * 1024 + (key & 15) * 64 + (c & 3) * 16) = vv; }
    __syncthreads();
    const int g = wid >> 1, half = wid & 1, h = kvh * 4 + g;
    const float sink2 = sinks[h] * LOG2E;
    const LAS unsigned char* vbase = lds + 32768 + ((lane >> 4) & 1) * 32 + (lane & 3) * 8 + (4 * hi + ((lane & 15) >> 2)) * 64;
#pragma unroll 1
    for (int qq = 0; qq < 2; ++qq) {
        const int qt = half * 2 + qq;
        const bf16_t* qp = Q + (size_t)(t0 + 32 * qt + r32) * D + h * HD + hi * 8;
        bf16x8 qr[4];
#pragma unroll
        for (int d0 = 0; d0 < 4; ++d0) qr[d0] = *(const bf16x8*)(qp + d0 * 16);
        f32x16 s[5];
#pragma unroll
        for (int j = 0; j < 5; ++j) { const LAS unsigned char* kp = lds + hi * 4096 + ((qt + j) * 32 + r32) * 16; f32x16 a = {};
#pragma unroll
            for (int d0 = 0; d0 < 4; ++d0) a = __builtin_amdgcn_mfma_f32_32x32x16_bf16(*(const LAS bf16x8*)(kp + d0 * 8192), qr[d0], a, 0, 0, 0);
            s[j] = a; }
#pragma unroll
        for (int r = 0; r < 16; ++r) { const int cr = crow(r, hi); if (cr <= r32) s[0][r] = -INFINITY; if (cr > r32) s[4][r] = -INFINITY; }
        if (nb == 0) {
#pragma unroll
            for (int j = 0; j < 4; ++j) if (qt + j < 4) {
#pragma unroll
                for (int r = 0; r < 16; ++r) s[j][r] = -INFINITY; } }
        float mx = -INFINITY;
#pragma unroll
        for (int j = 0; j < 5; ++j)
#pragma unroll
            for (int r = 0; r < 16; ++r) mx = fmaxf(mx, s[j][r]);
        mx = fmaxf(mx, shx(mx, 32, lane)); mx = fmaxf(mx, sink2);
        float ls = 0.f;
#pragma unroll
        for (int j = 0; j < 5; ++j)
#pragma unroll
            for (int r = 0; r < 16; ++r) { s[j][r] = __builtin_amdgcn_exp2f(s[j][r] - mx); ls += s[j][r]; }
        ls += shx(ls, 32, lane); ls += __builtin_amdgcn_exp2f(sink2 - mx);
        const float linv = 1.0f / ls;
        f32x16 o[2]; o[0] = f32x16{}; o[1] = f32x16{};
#pragma unroll
        for (int j = 0; j < 5; ++j)
#pragma unroll
            for (int ks = 0; ks < 2; ++ks) {
                u32x4 pw; pw.x = pk2(s[j][8 * ks + 0], s[j][8 * ks + 1]); pw.y = pk2(s[j][8 * ks + 2], s[j][8 * ks + 3]); pw.z = pk2(s[j][8 * ks + 4], s[j][8 * ks + 5]); pw.w = pk2(s[j][8 * ks + 6], s[j][8 * ks + 7]);
                const bf16x8 pa = __builtin_bit_cast(bf16x8, pw);
                const LAS unsigned char* vp = vbase + ((qt + j) * 2 + ks) * 1024;
#pragma unroll
                for (int dh = 0; dh < 2; ++dh) { const s16x4 lo = vtr(vp + dh * 16384), hi4 = vtr(vp + dh * 16384 + 512);
                    const bf16x8 vf = {lo[0], lo[1], lo[2], lo[3], hi4[0], hi4[1], hi4[2], hi4[3]};
                    o[dh] = __builtin_amdgcn_mfma_f32_32x32x16_bf16(pa, vf, o[dh], 0, 0, 0); } }
        LAS bf16_t* stg = (LAS bf16_t*)(lds + 65536 + wid * 4096);
#pragma unroll
        for (int r = 0; r < 16; ++r) { const int q = crow(r, hi); const float sc = shidx(linv, q);
            stg[q * 64 + r32] = (bf16_t)f2bf(o[0][r] * sc); stg[q * 64 + 32 + r32] = (bf16_t)f2bf(o[1][r] * sc); }
        asm volatile("s_waitcnt lgkmcnt(0)" ::: "memory");
        bf16_t* ob = O + (size_t)(t0 + 32 * qt) * D + h * HD;
#pragma unroll
        for (int i = 0; i < 4; ++i) { const int row = i * 8 + (lane >> 3), ch = lane & 7;
            *(u32x4*)(ob + (size_t)row * D + ch * 8) = *(const LAS u32x4*)(stg + row * 64 + ch * 8); }
        asm volatile("s_waitcnt lgkmcnt(0)" ::: "memory");
    }
    __syncthreads();
}
__device__ __forceinline__ void conv_phase(const bf16_t* Bg, const bf16_t* U, const float* cw, bf16_t* Z, int vcu, int G, int wvid) {
    int tid_ = (wvid * 64 + lane_id_asm()); asm volatile("" : "+v"(tid_));
    const int gt = vcu * NTHREADS + tid_, NGT = G * NTHREADS;
    for (int i = gt; i < (M / 8) * (D / 8); i += NGT) {
        const int t0 = (i >> 7) * 8, c = (i & 127) * 8, tl0 = t0 & (SEQ - 1);
        f32x4 w[3][2];
#pragma unroll
        for (int k = 0; k < 3; ++k) { w[k][0] = *(const f32x4*)(cw + k * D + c); w[k][1] = *(const f32x4*)(cw + k * D + c + 4); }
        u32x4 ur[10], br[8];
#pragma unroll
        for (int r = 0; r < 10; ++r) { if (r >= 2 || tl0 != 0) ur[r] = *(const u32x4*)(U + (size_t)(t0 + r - 2) * D + c); else ur[r] = (u32x4){0u, 0u, 0u, 0u}; }
#pragma unroll
        for (int r = 0; r < 8; ++r) br[r] = *(const u32x4*)(Bg + (size_t)(t0 + r) * D + c);
#pragma unroll
        for (int r = 0; r < 8; ++r) { float y[8];
#pragma unroll
            for (int j = 0; j < 8; ++j) y[j] = 0.f;
#pragma unroll
            for (int k = 0; k < 3; ++k) { const u32x4 uw = ur[r + k];
                y[0] += w[k][0][0] * bflo(uw.x); y[1] += w[k][0][1] * bfhi(uw.x); y[2] += w[k][0][2] * bflo(uw.y); y[3] += w[k][0][3] * bfhi(uw.y);
                y[4] += w[k][1][0] * bflo(uw.z); y[5] += w[k][1][1] * bfhi(uw.z); y[6] += w[k][1][2] * bflo(uw.w); y[7] += w[k][1][3] * bfhi(uw.w); }
            const u32x4 bw = br[r];
            u32x4 o; o.x = pk2(y[0] * bflo(bw.x), y[1] * bfhi(bw.x)); o.y = pk2(y[2] * bflo(bw.y), y[3] * bfhi(bw.y)); o.z = pk2(y[4] * bflo(bw.z), y[5] * bfhi(bw.z)); o.w = pk2(y[6] * bflo(bw.w), y[7] * bfhi(bw.w));
            *(u32x4*)(Z + (size_t)(t0 + r) * D + c) = o; }
    }
}
#ifndef DBG_ATTN
#define DBG_ATTN 0
#endif
#if DBG_ATTN
__device__ __forceinline__ void dbg_attn_check(const bf16_t* Q, const bf16_t* Kg, const bf16_t* Vg, const float* sinks, const bf16_t* O, float* acc3, int vcu, int G, int wvid) {
    const int lane = (wvid * 64 + lane_id_asm()) & 63, wave = wvid;
    const int gw = vcu * NWAVES + wave, nw = G * NWAVES;
    float lnum = 0.f, lden = 0.f, lmax = 0.f;
    for (int it = gw; it < M * NH; it += nw) {
        const int t = it / NH, h = it % NH, kvh = h / 4, tl = t % SEQ;
        const int slo = tl - 127 < 0 ? 0 : tl - 127, n = tl - slo + 1;
        const bf16_t* qp = Q + (size_t)t * D + h * HD;
        float sc[2];
#pragma unroll
        for (int u = 0; u < 2; ++u) { const int j = lane + 64 * u; float dot = -INFINITY;
            if (j < n) { const bf16_t* kp = Kg + (size_t)(t - tl + slo + j) * 256 + kvh * HD; dot = 0.f;
                for (int d = 0; d < HD; ++d) dot = fmaf(bflo((unsigned)qp[d]), bflo((unsigned)kp[d]), dot);
                dot *= (1.0f / LOG2E); }
            sc[u] = dot; }
        const float sink = sinks[h];
        float m = fmaxf(sc[0], sc[1]);
        for (int o = 1; o < 64; o <<= 1) m = fmaxf(m, shx(m, o, lane));
        m = fmaxf(m, sink);
        float e0 = (lane < n) ? expf(sc[0] - m) : 0.f, e1 = (lane + 64 < n) ? expf(sc[1] - m) : 0.f;
        float s = e0 + e1;
        for (int o = 1; o < 64; o <<= 1) s += shx(s, o, lane);
        const float denom = s + expf(sink - m);
        e0 /= denom; e1 /= denom;
        float a = 0.f;
        for (int j = 0; j < n; ++j) { const float pj = shidx(j < 64 ? e0 : e1, j & 63); a = fmaf(pj, bflo((unsigned)Vg[(size_t)(t - tl + slo + j) * 256 + kvh * HD + lane]), a); }
        const float o = bflo((unsigned)O[(size_t)t * D + h * HD + lane]);
        const float rn = wave_sum((o - a) * (o - a), lane), rd = wave_sum(a * a, lane);
        lnum += rn; lden += rd; lmax = fmaxf(lmax, rn / fmaxf(rd, 1e-20f));
    }
    if (lane == 0) { atomicAdd(acc3, lnum); atomicAdd(acc3 + 1, lden); atomicMax((unsigned*)(acc3 + 2), __float_as_uint(lmax)); }
}
#endif
constexpr int WR_STRIDE = 1028;
struct RouteArgs { float* X1F; bf16_t* X1B; const float *g1, *b1, *w_r, *b_r; int* gcnt; int* list_tok; float* list_w; int* tk_e; int* tk_rank; float* tk_w; unsigned char* XQ; float* sx1; float* list_sx; float* list_hs; const float* scl; };
__device__ __forceinline__ void route_phase(const RouteArgs& a, LAS unsigned char* lds, int vcu, int G, bool dry, int wvid) {
    int tid_ = (wvid * 64 + lane_id_asm()); asm volatile("" : "+v"(tid_));
    const int tid = tid_, lane = tid & 63, wave = __builtin_amdgcn_readfirstlane(tid >> 6);
    LAS float* wrt = (LAS float*)lds;
    LAS int* misc = (LAS int*)(lds + MISC_OFF);
    LAS int* lcnt = misc + 96; LAS int* gbase = misc + 128; LAS int* rowe = misc + 160; LAS float* roww = (LAS float*)(misc + 416); LAS float* rowsx = (LAS float*)(misc + 672); LAS float* rownrm = (LAS float*)(misc + 736);
    for (int i = tid; i < D * NE; i += NTHREADS) { const int c = i >> 5, e = i & 31; wrt[e * WR_STRIDE + c] = a.w_r[i]; }
    if (tid < NE) lcnt[tid] = 0;
    __syncthreads();
    const int rows_per_wg = M / G;
    for (int rr = 2 * wave; rr < rows_per_wg; rr += 2 * NWAVES) {
        f32x4 v[2][4];
#pragma unroll
        for (int x = 0; x < 2; ++x) { const int t = vcu * rows_per_wg + rr + x; float s = 0.f;
#pragma unroll
            for (int j = 0; j < 4; ++j) { v[x][j] = *(const f32x4*)(a.X1F + (size_t)t * D + 256 * j + 4 * lane); s += (v[x][j][0] + v[x][j][1]) + (v[x][j][2] + v[x][j][3]); }
            const float mean = wave_sum(s, lane) * (1.0f / D); float q = 0.f;
#pragma unroll
            for (int j = 0; j < 4; ++j) { v[x][j] = v[x][j] - mean; q += (v[x][j][0] * v[x][j][0] + v[x][j][1] * v[x][j][1]) + (v[x][j][2] * v[x][j][2] + v[x][j][3] * v[x][j][3]); }
            const float rstd = 1.0f / sqrtf(wave_sum(q, lane) * (1.0f / D) + LN_EPS);
#pragma unroll
            for (int j = 0; j < 4; ++j) { const f32x4 gg = *(const f32x4*)(a.g1 + 256 * j + 4 * lane), bb = *(const f32x4*)(a.b1 + 256 * j + 4 * lane);
                v[x][j] = v[x][j] * rstd * gg + bb;
                if (!dry) { u32x2 w; w.x = pk2(v[x][j][0], v[x][j][1]); w.y = pk2(v[x][j][2], v[x][j][3]); *(u32x2*)(a.X1B + (size_t)t * D + 256 * j + 4 * lane) = w; } }
            float am = 0.f;
#pragma unroll
            for (int j = 0; j < 4; ++j) am = fmaxf(am, fmaxf(fmaxf(fabsf(v[x][j][0]), fabsf(v[x][j][1])), fmaxf(fabsf(v[x][j][2]), fabsf(v[x][j][3]))));
#pragma unroll
            for (int o = 1; o < 64; o <<= 1) am = fmaxf(am, shx(am, o, lane));
            const float sxr = fmaxf(am, 1e-30f) * (1.0f / 127.0f), qi = 1.0f / sxr;
            if (!dry) {
#pragma unroll
                for (int j = 0; j < 4; ++j) { unsigned q = 0u;
#pragma unroll
                    for (int z = 0; z < 4; ++z) q |= ((unsigned)(int)rintf(v[x][j][z] * qi) & 0xffu) << (8 * z);
                    *(unsigned*)(a.XQ + (size_t)t * D + 256 * j + 4 * lane) = q; }
                if (lane == 0) { a.sx1[t] = sxr; rowsx[rr + x] = sxr; } }
            { float ssq = 0.f;
#pragma unroll
              for (int j = 0; j < 4; ++j) ssq += (v[x][j][0] * v[x][j][0] + v[x][j][1] * v[x][j][1]) + (v[x][j][2] * v[x][j][2] + v[x][j][3] * v[x][j][3]);
              ssq = wave_sum(ssq, lane); if (lane == 0) rownrm[rr + x] = sqrtf(ssq); } }
        float pl[2][32];
#pragma unroll
        for (int e = 0; e < 32; ++e) { float a0 = 0.f, a1 = 0.f;
#pragma unroll
            for (int j = 0; j < 4; ++j) { const f32x4 w = *(const LAS f32x4*)(wrt + e * WR_STRIDE + 256 * j + 4 * lane);
                a0 += (v[0][j][0] * w[0] + v[0][j][1] * w[1]) + (v[0][j][2] * w[2] + v[0][j][3] * w[3]); a1 += (v[1][j][0] * w[0] + v[1][j][1] * w[1]) + (v[1][j][2] * w[2] + v[1][j][3] * w[3]); }
            pl[0][e] = a0; pl[1][e] = a1; }
#pragma unroll
        for (int o = 32, n = 16; o >= 2; o >>= 1, n >>= 1) { const bool up = (lane & o) != 0;
#pragma unroll
            for (int i = 0; i < 16; ++i) if (i < n) {
#pragma unroll
                for (int x = 0; x < 2; ++x) { const float send = up ? pl[x][i] : pl[x][i + n], keep = up ? pl[x][i + n] : pl[x][i]; pl[x][i] = keep + shx(send, o, lane); } } }
        const int myexp = lane >> 1; const float brv = a.b_r[myexp];
        float logit[2];
#pragma unroll
        for (int x = 0; x < 2; ++x) logit[x] = pl[x][0] + shx(pl[x][0], 1, lane) + brv;
        int se[2][4]; float sv[2][4];
#pragma unroll
        for (int k = 0; k < 4; ++k) { float bv[2]; int bi[2];
#pragma unroll
            for (int x = 0; x < 2; ++x) { bv[x] = logit[x]; bi[x] = myexp; }
#pragma unroll
            for (int o = 1; o < 64; o <<= 1) {
#pragma unroll
                for (int x = 0; x < 2; ++x) { const float ov = shx(bv[x], o, lane); const int oi = shxi(bi[x], o, lane); if (ov > bv[x] || (ov == bv[x] && oi < bi[x])) { bv[x] = ov; bi[x] = oi; } } }
#pragma unroll
            for (int x = 0; x < 2; ++x) { se[x][k] = bi[x]; sv[x][k] = bv[x]; if (myexp == bi[x]) logit[x] = -INFINITY; } }
#pragma unroll
        for (int x = 0; x < 2; ++x) { const float e1 = __expf(sv[x][1] - sv[x][0]), e2 = __expf(sv[x][2] - sv[x][0]), e3 = __expf(sv[x][3] - sv[x][0]);
            const float inv = 1.0f / (1.0f + e1 + e2 + e3);
            if (lane < 4) { const int e = lane == 0 ? se[x][0] : lane == 1 ? se[x][1] : lane == 2 ? se[x][2] : se[x][3];
                const float w = (lane == 0 ? 1.0f : lane == 1 ? e1 : lane == 2 ? e2 : e3) * inv;
                rowe[(rr + x) * 4 + lane] = e; roww[(rr + x) * 4 + lane] = w; } }
    }
    __syncthreads();
    if (dry) return;
    const int nent = rows_per_wg * 4;
    int my_e = 0, my_lr = 0;
    if (tid < nent) { my_e = rowe[tid]; my_lr = atomicAdd((int*)(lcnt + my_e), 1); }
    __syncthreads();
    if (tid < NE) gbase[tid] = atomicAdd(a.gcnt + tid, lcnt[tid]);
    __syncthreads();
    if (tid < nent) { const int t = vcu * rows_per_wg + (tid >> 2), rank = gbase[my_e] + my_lr;
        const float sig = rownrm[tid >> 2] * a.scl[64 + my_e], clip = fmaxf((1.0f + 3.5f * sig) * (3.5f * sig), 1e-20f);
        const float qh = bfhi(f2bf(127.0f / clip) << 16);
        a.list_tok[(size_t)my_e * LISTCAP + rank] = t; a.list_w[(size_t)my_e * LISTCAP + rank] = qh; a.list_sx[(size_t)my_e * LISTCAP + rank] = rowsx[tid >> 2];
        a.list_hs[(size_t)my_e * LISTCAP + rank] = roww[tid] / qh;
        a.tk_e[t * 4 + (tid & 3)] = my_e; a.tk_rank[t * 4 + (tid & 3)] = rank; a.tk_w[t * 4 + (tid & 3)] = roww[tid]; }
    __syncthreads();
}
__device__ __forceinline__ void build_tables(const int* gcnt, LAS unsigned char* lds, int wvid) {
    LAS int* misc = (LAS int*)(lds + MISC_OFF);
    const int tid = wvid * 64 + lane_id_asm();
    if (tid < NE) misc[tid] = __hip_atomic_load(gcnt + tid, __ATOMIC_RELAXED, __HIP_MEMORY_SCOPE_AGENT);
    __syncthreads();
    if (tid == 0) { int a = 0; for (int e = 0; e < NE; ++e) { misc[32 + e] = a; a += (misc[e] + 255) >> 8; } misc[32 + NE] = a; }
    __syncthreads();
}
struct FinalArgs { float dbg_scale; int pad_; const bf16_t* X1B; const bf16_t* PLE; const bf16_t* Y; const int* tk_e; const int* tk_rank; const float* tk_w; const float* b_down; const float *g2, *b2; float* out; };
__device__ __forceinline__ void final_phase(const FinalArgs& a, LAS unsigned char* lds, int vcu, int G, int wvid) {
    int tid_ = (wvid * 64 + lane_id_asm()); asm volatile("" : "+v"(tid_));
    const int tid = tid_, lane = tid & 63, wave = __builtin_amdgcn_readfirstlane(tid >> 6);
    const LAS int* ts = (const LAS int*)(lds + MISC_OFF) + 32;
    LAS float* bdl = (LAS float*)lds;
    for (int i = tid; i < NE * D / 4; i += NTHREADS) *(LAS f32x4*)(bdl + 4 * i) = *(const f32x4*)(a.b_down + 4 * i);
    __syncthreads();
    const int gw = vcu * NWAVES + wave, NGW = G * NWAVES;
    for (int t0 = 2 * gw; t0 < M; t0 += 2 * NGW) {
        size_t pos[2][4]; int ek[2][4]; float wk[2][4];
#pragma unroll
        for (int x = 0; x < 2; ++x)
#pragma unroll
            for (int k = 0; k < 4; ++k) { const int t = t0 + x, e = a.tk_e[t * 4 + k], rk = a.tk_rank[t * 4 + k]; pos[x][k] = ((size_t)ts[e] * 256 + rk) * D; ek[x][k] = e * D; wk[x][k] = a.tk_w[t * 4 + k]; }
        f32x4 v[2][4]; float s[2] = {0.f, 0.f};
#pragma unroll
        for (int x = 0; x < 2; ++x)
#pragma unroll
            for (int j = 0; j < 4; ++j) { const int c = 256 * j + 4 * lane; const size_t ro = (size_t)(t0 + x) * D + c;
                const u32x2 xw = *(const u32x2*)(a.X1B + ro), pw = *(const u32x2*)(a.PLE + ro);
                f32x4 xx = {bflo(xw.x) * DN_ALPHA + bflo(pw.x), bfhi(xw.x) * DN_ALPHA + bfhi(pw.x), bflo(xw.y) * DN_ALPHA + bflo(pw.y), bfhi(xw.y) * DN_ALPHA + bfhi(pw.y)};
#pragma unroll
                for (int k = 0; k < 4; ++k) { const u32x2 yw = *(const u32x2*)(a.Y + pos[x][k] + c); const f32x4 bd = *(const LAS f32x4*)(bdl + ek[x][k] + c);
                    xx[0] += bflo(yw.x) + wk[x][k] * bd[0]; xx[1] += bfhi(yw.x) + wk[x][k] * bd[1]; xx[2] += bflo(yw.y) + wk[x][k] * bd[2]; xx[3] += bfhi(yw.y) + wk[x][k] * bd[3]; }
                v[x][j] = xx; s[x] += (xx[0] + xx[1]) + (xx[2] + xx[3]); }
#pragma unroll
        for (int x = 0; x < 2; ++x) { const float mean = wave_sum(s[x], lane) * (1.0f / D); float q = 0.f;
#pragma unroll
            for (int j = 0; j < 4; ++j) { v[x][j] = v[x][j] - mean; q += (v[x][j][0] * v[x][j][0] + v[x][j][1] * v[x][j][1]) + (v[x][j][2] * v[x][j][2] + v[x][j][3] * v[x][j][3]); }
            const float rstd = 1.0f / sqrtf(wave_sum(q, lane) * (1.0f / D) + LN_EPS);
#pragma unroll
            for (int j = 0; j < 4; ++j) { const int c = 256 * j + 4 * lane; const f32x4 gg = *(const f32x4*)(a.g2 + c), bb = *(const f32x4*)(a.b2 + c);
                *(f32x4*)(a.out + (size_t)(t0 + x) * D + c) = (v[x][j] * rstd * gg + bb) * a.dbg_scale; } }
    }
}

#ifndef PROBE_STAMP
#define PROBE_STAMP -1
#endif
#define STAMP(k) do { if (PROBE_STAMP >= 0 && bx == 0 && (wvid * 64 + lane_id_asm()) == 0) __hip_atomic_store(WSP(unsigned long long, WS_CTL + 32768) + (k), (unsigned long long)__builtin_amdgcn_s_memrealtime(), __ATOMIC_RELAXED, __HIP_MEMORY_SCOPE_AGENT); } while (0)
#ifndef PROBE_REP
#define PROBE_REP 0
#endif
struct Args { const float* in[20]; float* out; unsigned char* ws; };
__global__ void __launch_bounds__(NTHREADS, 2) mega_fwd(Args args) {
    extern __shared__ __attribute__((aligned(16))) unsigned char lds_raw[];
    LAS unsigned char* lds = (LAS unsigned char*)lds_raw;
    cg::grid_group grid = cg::this_grid();
    const int G = gridDim.x, bx = blockIdx.x;
    const int wvid = __builtin_amdgcn_readfirstlane((int)threadIdx.x >> 6);
    const int vcu = (G % 8 == 0) ? (bx % 8) * (G / 8) + bx / 8 : bx;
    unsigned char* const ws = args.ws;
    const LAS int* cntL = (const LAS int*)(lds + MISC_OFF); const LAS int* tsL = cntL + 32;
    { volatile LAS unsigned* bst = (volatile LAS unsigned*)(lds + MISC_OFF) + BST_IDX;
      { int t_ = (wvid * 64 + lane_id_asm()); asm volatile("" : "+v"(t_)); if (t_ < 2) bst[t_] = 0u; }
      __syncthreads();
    }
    if (bx == 0) { const int t0_ = wvid * 64 + lane_id_asm(); for (int i_ = t0_; i_ < (int)(CTL_ZERO_BYTES / 16); i_ += NTHREADS) ((u32x4*)(ws + WS_CTL))[i_] = (u32x4){0u, 0u, 0u, 0u}; }
#define GRID_BAR() do { XcdBarrier b_; b_.bar = (unsigned*)(ws + WS_BAR); b_.x = xb_xcc_id(); b_.st = (volatile LAS unsigned*)(lds + MISC_OFF) + BST_IDX; b_.lead = ((wvid * 64 + lane_id_asm()) == 0); xcd_barrier(b_); if (PROBE_REP & 0x80000) xcd_barrier(b_); } while (0)
#define WSP(T, off) ((T*)(ws + (off)))
#define GRID_BAR_F(seam) do { XcdBarrier b_; b_.bar = (unsigned*)(ws + WS_BAR); b_.x = xb_xcc_id(); b_.st = (volatile LAS unsigned*)(lds + MISC_OFF) + BST_IDX; b_.lead = ((wvid * 64 + lane_id_asm()) == 0); \
    asm volatile("s_waitcnt vmcnt(0)" ::: "memory"); __syncthreads(); \
    if (wvid == 0) xcd_barrier_lead(b_); \
    else { P0Args a_{args.in[0], args.in[1], args.in[2], args.in[4], args.in[5], args.in[7], args.in[17], args.in[16], args.in[12], args.in[14], ws, 1.0f, 1.0f}; p0_fill(a_, lds, vcu, G, seam, wvid); } \
    __syncthreads(); } while (0)

    STAMP(0);
    {
      const float s_in = __builtin_bit_cast(float, __builtin_amdgcn_readfirstlane(__builtin_bit_cast(int, sample_scale(args.in[2], 13308, lds, wvid))));
      if ((wvid * 64 + lane_id_asm()) == 0) WSP(float, WS_SCL)[161] = s_in;
    _Pragma("unroll 1") for (int rep_ = 0; rep_ < ((PROBE_REP & 1) ? 2 : 1); ++rep_) { P0Args a{args.in[0], args.in[1], args.in[2], args.in[4], args.in[5], args.in[7], args.in[17], args.in[16], args.in[12], args.in[14], ws, s_in, 0.0f}; p0_phase(a, lds, vcu, G, 0, P0_NSMALL, true, wvid); } }
#if (PROBE_REP & 0x200000)
    { u32x4* z_ = (u32x4*)(ws + WS_R); const int gt_ = vcu * NTHREADS + wvid * 64 + lane_id_asm(); for (size_t i_ = gt_; i_ < (176 * MiB) / 16; i_ += (size_t)G * NTHREADS) z_[i_] = (u32x4){0u, 0u, 0u, 0u}; }
#endif
    grid.sync();
    (void)xcd_barrier_post((unsigned*)(ws + WS_BAR), (volatile LAS unsigned*)(lds + MISC_OFF) + BST_IDX, (wvid * 64 + lane_id_asm()) == 0);
    STAMP(1);
    _Pragma("unroll 1") for (int rep_ = 0; rep_ < ((PROBE_REP & 2) ? 2 : 1); ++rep_) { pg8::Gemm g{WSP(bf16_t, WS_XB), (const bf16_t*)(ws + WS_WIN), D / 2}; pg8::StaticOrder S; S.init(M / 256, NIN / 256, G, bx, 1);
      const float s_in1 = __builtin_bit_cast(float, __builtin_amdgcn_readfirstlane(__builtin_bit_cast(int, WSP(float, WS_SCL)[161])));
      pg8::EpiInProjI8 E{ws, s_in1};
      pg8::gemm_phase<pg8::EpiInProjI8, pg8::StaticOrder, true, 0, true>(lds, g, S, E, wvid); }
    { constexpr int U1 = (M / 256) * (NIN / 256); const int R1 = U1 % G, nidle = R1 ? G - R1 : G, per = 256 / nidle;
      if (R1 == 0 || bx >= R1) {
        pg8::Gemm g{WSP(bf16_t, WS_PB), (const bf16_t*)(ws + WS_WPP), DPLE}; pg8::Ple1Order S{(bx - R1) * per, per};
        pg8::EpiF32 E{WSP(float, WS_P2)};
        pg8::gemm_phase<pg8::EpiF32, pg8::Ple1Order, false>(lds, g, S, E, wvid); } }
    GRID_BAR_F(1);
    STAMP(2);
    if (PROBE_REP & 4096) { _Pragma("unroll 1") for (int k_ = 0; k_ < 8; ++k_) GRID_BAR(); }
    _Pragma("unroll 1") for (int rep_ = 0; rep_ < ((PROBE_REP & 4) ? 2 : 1); ++rep_) for (int it = vcu; it < BATCH * NKV * (SEQ / 128); it += G) { const int nb = it & 63, kvh = (it >> 6) & 3, b = it >> 8;
        attn_unit(lds, WSP(bf16_t, WS_Q), WSP(bf16_t, WS_K), WSP(bf16_t, WS_V), args.in[6], WSP(bf16_t, WS_ZO) + (size_t)M * D, b, kvh, nb, wvid); }
    _Pragma("unroll 1") for (int rep_ = 0; rep_ < ((PROBE_REP & 8) ? 2 : 1); ++rep_) conv_phase(WSP(bf16_t, WS_BG), WSP(bf16_t, WS_U), args.in[3], WSP(bf16_t, WS_ZO), vcu, G, wvid);
    GRID_BAR_F(2);
    STAMP(3);
#if DBG_ATTN
    dbg_attn_check(WSP(bf16_t, WS_Q), WSP(bf16_t, WS_K), WSP(bf16_t, WS_V), args.in[6], WSP(bf16_t, WS_ZO) + (size_t)M * D, WSP(float, WS_CTL) + 64, vcu, G, wvid);
#endif
    _Pragma("unroll 1") for (int rep_ = 0; rep_ < ((PROBE_REP & 16) ? 2 : 1); ++rep_) { pg8::Gemm g{WSP(bf16_t, WS_ZO), (const bf16_t*)(ws + WS_WBR), D}; pg8::DualOrder S; S.so.init(M / 256, D / 256, G, bx);
      pg8::EpiDual E{ws};
      pg8::gemm_phase<pg8::EpiDual, pg8::DualOrder, true>(lds, g, S, E, wvid); }
    GRID_BAR_F(3);
    STAMP(4);
    _Pragma("unroll 1") for (int rep_ = 0; rep_ < ((PROBE_REP & 32) ? 2 : 1); ++rep_) { pg8::Gemm g{WSP(bf16_t, WS_MG), (const bf16_t*)(ws + WS_WOUT), D}; pg8::StaticOrder S; S.init(M / 256, D / 256, G, bx);
      pg8::EpiResid E{args.in[0], WSP(float, WS_X1F)};
      pg8::gemm_phase<pg8::EpiResid, pg8::StaticOrder, false>(lds, g, S, E, wvid); }
    GRID_BAR_F(4);
    STAMP(5);
    { P0Args a{args.in[0], args.in[1], args.in[2], args.in[4], args.in[5], args.in[7], args.in[17], args.in[16], args.in[12], args.in[14], ws, 1.0f, 1.0f}; p0_phase(a, lds, vcu, G, P0_NSMALL + P0_FILL_SEAMS * G * 7 * P0_FILL, P0_NITEMS - G * 7 * P0_FILL, false, wvid); __syncthreads();
      if (PROBE_REP & 0x40000) { p0_phase(a, lds, vcu, G, P0_NSMALL, P0_NITEMS, false, wvid); __syncthreads(); } }
    _Pragma("unroll 1") for (int rep_ = ((PROBE_REP & 64) ? 0 : 1); rep_ < 2; ++rep_) { RouteArgs a{WSP(float, WS_X1F), WSP(bf16_t, WS_X1B), args.in[8], args.in[9], args.in[10], args.in[11], WSP(int, WS_CTL), WSP(int, WS_LTOK), WSP(float, WS_LW), WSP(int, WS_TKE), WSP(int, WS_TKR), WSP(float, WS_TKW), ws + WS_XQ, WSP(float, WS_SX1), WSP(float, WS_LSX), WSP(float, WS_LHS), WSP(float, WS_SCL)}; route_phase(a, lds, vcu, G, rep_ == 0, wvid); }
    GRID_BAR_F(5);
    STAMP(6);
    build_tables(WSP(int, WS_CTL), lds, wvid);
    { const int nx5_ = __builtin_amdgcn_readfirstlane(pg8::MoeOrder::ple_in_p5(tsL, G));
      pg8::MoeOrder S; S.init(cntL, tsL, (const LAS unsigned*)(lds + TW_OFF), 8, G, bx, 1, WS_XQ, WS_WGU, nx5_, 0, WS_XQ, WS_WPG8, 18); S.build_units((LAS int*)(lds + UTAB_OFF), 12, wvid * 64 + lane_id_asm(), vcu, 1);
      pg8::moe_preload(S, cntL, WSP(int, WS_LTOK), WSP(float, WS_LW), (LAS unsigned*)(lds + TW_OFF), wvid);
      _Pragma("unroll 1") for (int rep_ = 0; rep_ < ((PROBE_REP & 128) ? 2 : 1); ++rep_) { pg8::Gemm g{(const bf16_t*)ws, (const bf16_t*)ws, D / 2};
        pg8::EpiSwigluI8 E{WSP(bf16_t, WS_H), args.in[13], (const LAS unsigned*)(lds + TW_OFF), ws};
        pg8::gemm_phase<pg8::EpiSwigluI8, pg8::MoeOrder, true, 0, true>(lds, g, S, E, wvid);
#if (PROBE_REP & 0x400000)
        pg8::gemm_phase<pg8::EpiSwigluI8, pg8::MoeOrder, true, 1, true>(lds, g, S, E, wvid);
#endif
#if (PROBE_REP & 0x800000)
        pg8::gemm_phase<pg8::EpiSwigluI8, pg8::MoeOrder, true, 2, true>(lds, g, S, E, wvid);
#endif
        } }
    GRID_BAR();
    STAMP(7);
    _Pragma("unroll 1") for (int rep_ = 0; rep_ < ((PROBE_REP & 1024) ? 2 : 1); ++rep_) { pg8::Gemm g{(const bf16_t*)ws, (const bf16_t*)ws, D / 2};
      const int nx5_ = __builtin_amdgcn_readfirstlane(pg8::MoeOrder::ple_in_p5(tsL, G));
      pg8::MoeOrder S; S.init(cntL, tsL, (const LAS unsigned*)(lds + TW_OFF), 4, G, bx, 0, WS_H, WS_WDN, 256 - nx5_, nx5_, WS_XQ, WS_WPG8, 18); S.build_units((LAS int*)(lds + UTAB_OFF), 12, wvid * 64 + lane_id_asm(), vcu, 2);
      pg8::EpiDownI8 E{WSP(bf16_t, WS_Y), ws, cntL};
      pg8::gemm_phase<pg8::EpiDownI8, pg8::MoeOrder, true, 0, true>(lds, g, S, E, wvid); }
    STAMP(8);
    GRID_BAR();
    _Pragma("unroll 1") for (int rep_ = 0; rep_ < ((PROBE_REP & 2048) ? 2 : 1); ++rep_) { float dbgs_ = 1.0f;
      if (PROBE_STAMP >= 0) { const unsigned long long* st_ = WSP(unsigned long long, WS_CTL + 32768); const float dt_us = (float)(long long)(__hip_atomic_load(st_ + PROBE_STAMP + 1, __ATOMIC_RELAXED, __HIP_MEMORY_SCOPE_AGENT) - __hip_atomic_load(st_ + PROBE_STAMP, __ATOMIC_RELAXED, __HIP_MEMORY_SCOPE_AGENT)) * 0.01f; dbgs_ = 1.0f + sqrtf(dt_us * 1e-6f); }
#if DBG_ATTN
      { const float* a3 = WSP(float, WS_CTL) + 64; const float num = __hip_atomic_load(a3, __ATOMIC_RELAXED, __HIP_MEMORY_SCOPE_AGENT), den = __hip_atomic_load(a3 + 1, __ATOMIC_RELAXED, __HIP_MEMORY_SCOPE_AGENT), mx = __hip_atomic_load(a3 + 2, __ATOMIC_RELAXED, __HIP_MEMORY_SCOPE_AGENT);
        dbgs_ = 1.0f + sqrtf(100.0f * (DBG_ATTN == 1 ? num / den : mx)); }
#endif
      FinalArgs a{dbgs_, 0, WSP(bf16_t, WS_X1B), WSP(bf16_t, WS_PLE), WSP(bf16_t, WS_Y), WSP(int, WS_TKE), WSP(int, WS_TKR), WSP(float, WS_TKW), args.in[15], args.in[18], args.in[19], args.out}; final_phase(a, lds, vcu, G, wvid); }
}

extern "C" void kernel_launch(void* const* d_in, const int* in_sizes, int n_in, void* d_out, int out_size, void* d_ws, size_t ws_size, hipStream_t stream) {
    static int grid = 0;
    if (grid == 0) {
        if (n_in != 20 || out_size != M * D || ws_size < WS_END) { fprintf(stderr, "kernel_launch: unexpected sizes (n_in %d, out %d, ws %zu < %zu)\n", n_in, out_size, ws_size, (size_t)WS_END); grid = -1; return; }
        int dev = 0, cus = 0, per_cu = 0;
        if (hipGetDevice(&dev) != hipSuccess || hipDeviceGetAttribute(&cus, hipDeviceAttributeMultiprocessorCount, dev) != hipSuccess) { grid = -1; return; }
        if (hipFuncSetAttribute((const void*)mega_fwd, hipFuncAttributeMaxDynamicSharedMemorySize, LDS_BYTES) != hipSuccess) { fprintf(stderr, "kernel_launch: hipFuncSetAttribute failed\n"); grid = -1; return; }
        if (hipOccupancyMaxActiveBlocksPerMultiprocessor(&per_cu, (const void*)mega_fwd, NTHREADS, LDS_BYTES) != hipSuccess || per_cu < 1) { fprintf(stderr, "kernel_launch: occupancy query says %d blocks per CU\n", per_cu); grid = -1; return; }
        grid = cus;
        if (grid != 256) fprintf(stderr, "kernel_launch: note: %d CUs (built and tuned for 256)\n", grid);
    }
    if (grid < 0) return;
    Args a{};
    for (int i = 0; i < 20; ++i) a.in[i] = (const float*)d_in[i];
    a.out = (float*)d_out; a.ws = (unsigned char*)d_ws;
    void* kargs[] = {&a};
    const hipError_t e = hipLaunchCooperativeKernel((const void*)mega_fwd, dim3(grid), dim3(NTHREADS), kargs, LDS_BYTES, stream);
    if (e != hipSuccess) fprintf(stderr, "kernel_launch: cooperative launch failed: %s (grid %d)\n", hipGetErrorString(e), grid);
}
```

```cpp
#include <hip/hip_runtime.h>
#include <hip/hip_cooperative_groups.h>
#include <cstdio>
#include <cstdint>
namespace cg = cooperative_groups;

#define LAS __attribute__((address_space(3)))
typedef unsigned short bf16_t;
typedef short bf16x8 __attribute__((ext_vector_type(8)));
typedef short s16x4 __attribute__((ext_vector_type(4)));
typedef float f32x4 __attribute__((ext_vector_type(4)));
typedef float f32x16 __attribute__((ext_vector_type(16)));
typedef unsigned u32x4 __attribute__((ext_vector_type(4)));
typedef unsigned u32x2 __attribute__((ext_vector_type(2)));

constexpr int BATCH = 2, SEQ = 8192, M = BATCH * SEQ, D = 1024, NIN = 6656, NE = 32, DPLE = 256, NH = 16, HD = 64, NKV = 4;
constexpr float DN_ALPHA = 1.189207115002721f, LN_EPS = 1e-5f, LOG2E = 1.4426950408889634f;
constexpr float QSCALE = 0.125f * LOG2E;
constexpr int LISTCAP = M;
constexpr int MAXTILES = (M * 4) / 256 + NE;
constexpr int NWAVES = 8, NTHREADS = 512;

constexpr size_t MiB = 1u << 20;
constexpr size_t WS_CTL = 0;
constexpr size_t WS_BAR = 16384, CTL_ZERO_BYTES = 65536;
constexpr size_t WS_TKE = 1 * MiB, WS_TKR = 2 * MiB, WS_TKW = 3 * MiB;
constexpr size_t WS_LTOK = 4 * MiB, WS_LW = 6 * MiB;
constexpr size_t WS_WIN = 8 * MiB;
constexpr size_t WS_WBR = 22 * MiB;
constexpr size_t WS_WOUT = 26 * MiB, WS_WPG = 28 * MiB;
constexpr size_t WS_WPP = 30 * MiB;
constexpr size_t WS_WGU = 32 * MiB;
constexpr size_t WS_WDN = 160 * MiB;
constexpr size_t WS_XB = 224 * MiB;
constexpr size_t WS_PB = 256 * MiB;
constexpr size_t WS_X1F = 264 * MiB;
constexpr size_t WS_X1B = 328 * MiB;
constexpr size_t WS_P2 = 360 * MiB;
constexpr size_t WS_PLE = 424 * MiB;
constexpr size_t WS_R = 456 * MiB;
constexpr size_t WS_BG = WS_R, WS_U = WS_R + 32 * MiB, WS_Q = WS_R + 64 * MiB, WS_K = WS_R + 96 * MiB, WS_V = WS_R + 104 * MiB;
constexpr size_t WS_GC = WS_R + 112 * MiB, WS_GA = WS_R + 144 * MiB;
constexpr size_t WS_ZO = WS_R + 176 * MiB;
constexpr size_t WS_T1 = WS_R + 240 * MiB;
constexpr size_t WS_MG = WS_R + 304 * MiB;
constexpr size_t WS_H = WS_R;
constexpr size_t WS_Y = WS_R + 144 * MiB;
constexpr size_t WS_XQ = WS_R + 336 * MiB;
constexpr size_t WS_LSX = WS_XQ + 16 * MiB;
constexpr size_t WS_SX1 = WS_LSX + 2 * MiB;
constexpr size_t WS_SX0 = WS_SX1 + 1 * MiB;
constexpr size_t WS_SP = WS_SX0 + 512 * 1024;
constexpr size_t WS_LHS = WS_SX0 + 1 * MiB;
constexpr size_t WS_END = WS_LHS + 2 * MiB;
constexpr size_t WS_SCL = 65536;
constexpr size_t WS_WPG8 = 31 * MiB;
typedef int i32x4 __attribute__((ext_vector_type(4)));

constexpr int LDS_BYTES = 147456;
constexpr int MISC_OFF = 135168;
constexpr int BST_IDX = 66, TW_OFF = MISC_OFF + 512, UTAB_OFF = TW_OFF + 10240;
constexpr int BST_IDX_ = 0;

__device__ __forceinline__ int lane_id_asm() { int l; asm volatile("v_mbcnt_lo_u32_b32 %0, -1, 0\n\tv_mbcnt_hi_u32_b32 %0, -1, %0" : "=v"(l)); return l; }
__device__ __forceinline__ unsigned f2bf(float f) { unsigned u = __builtin_bit_cast(unsigned, f); return (u + 0x7fffu + ((u >> 16) & 1u)) >> 16; }
__device__ __forceinline__ unsigned pk2(float lo, float hi) { return f2bf(lo) | (f2bf(hi) << 16); }
__device__ __forceinline__ float bflo(unsigned w) { return __builtin_bit_cast(float, w << 16); }
__device__ __forceinline__ float bfhi(unsigned w) { return __builtin_bit_cast(float, w & 0xffff0000u); }
__device__ __forceinline__ float fast_sigmoid(float v) { return __builtin_amdgcn_rcpf(1.0f + __builtin_amdgcn_exp2f(-LOG2E * v)); }
__device__ __forceinline__ float shx(float v, int o, int lane) { return __builtin_bit_cast(float, __builtin_amdgcn_ds_bpermute((lane ^ o) << 2, __builtin_bit_cast(int, v))); }
__device__ __forceinline__ int shxi(int v, int o, int lane) { return __builtin_amdgcn_ds_bpermute((lane ^ o) << 2, v); }
__device__ __forceinline__ float shidx(float v, int src) { return __builtin_bit_cast(float, __builtin_amdgcn_ds_bpermute(src << 2, __builtin_bit_cast(int, v))); }
__device__ __forceinline__ float wave_sum(float v, int lane) {
#pragma unroll
    for (int o = 1; o < 64; o <<= 1) v += shx(v, o, lane);
    return v;
}

#define XB_TMO      128
#define XB_XCNT(j)  (256  + 64 * (j))
#define XB_XSUB(j)  (1280 + 64 * (j))
#define XB_XGEN(j)  (2304 + 64 * (j))
#define XB_TOP      3328
#define XB_TOPGEN   3392
#define XCD_BAR_WORDS 3456
#define XB_SPIN_CAP (1u << 18)

__device__ __forceinline__ unsigned xb_ld(unsigned* p)              { return __hip_atomic_load(p, __ATOMIC_RELAXED, __HIP_MEMORY_SCOPE_AGENT); }
__device__ __forceinline__ unsigned xb_add(unsigned* p, unsigned v) { return __hip_atomic_fetch_add(p, v, __ATOMIC_RELAXED, __HIP_MEMORY_SCOPE_AGENT); }
__device__ __forceinline__ unsigned xb_xcc_id() { return (unsigned)__builtin_amdgcn_s_getreg((3 << 11) | 20) & 0xFu; }
#define XB_SPIN(cond, bar) do { unsigned _sp = 0; while (cond) { __builtin_amdgcn_s_sleep(1); \
    if ((++_sp & 255u) == 0u) { if (xb_ld(&(bar)[XB_TMO])) break; if (_sp > XB_SPIN_CAP) { atomicAdd(&(bar)[XB_TMO], 1u); break; } } } } while (0)

struct XcdBarrier {
    bool lead;
    unsigned* bar; unsigned x;
    volatile LAS unsigned* st;
};

__device__ __forceinline__ XcdBarrier xcd_barrier_post(unsigned* bar, volatile LAS unsigned* st, bool lead) {
    XcdBarrier b; b.bar = bar; b.x = xb_xcc_id(); b.st = st; b.lead = lead;
    if (lead) (void)xb_add(&bar[XB_XCNT(b.x)], 1u);
    return b;
}
__device__ __forceinline__ void xcd_barrier_complete(unsigned* bar, unsigned x, unsigned& nloc, unsigned& nx) {
    const unsigned G = gridDim.x * gridDim.y * gridDim.z;
    unsigned sum, cnt, mine, sp = 0u;
    for (;;) {
        sum = 0u; cnt = 0u; mine = 0u;
#pragma unroll
        for (unsigned j = 0; j < 16; ++j) { const unsigned c = xb_ld(&bar[XB_XCNT(j)]); sum += c; cnt += (c > 0u) ? 1u : 0u; mine = (j == x) ? c : mine; }
        if (sum == G) break;
        __builtin_amdgcn_s_sleep(1);
        if ((++sp & 255u) == 0u) { if (xb_ld(&bar[XB_TMO])) break; if (sp > XB_SPIN_CAP) { atomicAdd(&bar[XB_TMO], 1u); break; } }
    }
    nloc = mine > 0u ? mine : 1u; nx = cnt > 0u ? cnt : 1u;
}

__device__ __forceinline__ void xcd_barrier_lead(const XcdBarrier& b);
__device__ __forceinline__ void xcd_barrier(const XcdBarrier& b) {
    asm volatile("s_waitcnt vmcnt(0)" ::: "memory");
    __syncthreads();
    xcd_barrier_lead(b);
    __syncthreads();
}
__device__ __forceinline__ void xcd_barrier_lead(const XcdBarrier& b) {
    if (b.lead) {
        unsigned* bar = b.bar;
        __builtin_amdgcn_s_waitcnt(0);
        unsigned nloc = b.st[0], nx = b.st[1];
        if (nloc == 0u) { xcd_barrier_complete(bar, b.x, nloc, nx); b.st[0] = nloc; b.st[1] = nx; }
        const unsigned old = xb_add(&bar[XB_XSUB(b.x)], 1u);
        const unsigned gen = old / nloc;
        if (old + 1u == (gen + 1u) * nloc) {
            __builtin_amdgcn_fence(__ATOMIC_RELEASE, "agent");
            asm volatile("s_waitcnt vmcnt(0)" ::: "memory");
            const unsigned og = xb_add(&bar[XB_TOP], 1u);
            const unsigned tg = og / nx;
            if (og + 1u == (tg + 1u) * nx) xb_add(&bar[XB_TOPGEN], 1u);
            else XB_SPIN(xb_ld(&bar[XB_TOPGEN]) == tg, bar);
            __builtin_amdgcn_fence(__ATOMIC_ACQUIRE, "agent");
            xb_add(&bar[XB_XGEN(b.x)], 1u);
            asm volatile("s_waitcnt vmcnt(0)" ::: "memory");
        } else {
            XB_SPIN(xb_ld(&bar[XB_XGEN(b.x)]) == gen, bar);
            __builtin_amdgcn_fence(__ATOMIC_ACQUIRE, "agent");
            asm volatile("s_waitcnt vmcnt(0)" ::: "memory");
        }
    }
}

namespace pg8 {
constexpr int BM = 256, BK = 64, HALF = 128, HTB = HALF * BK * 2  , STAGE_BYTES = 8 * HTB, NXCD = 8, WGM = 8;
__host__ __device__ __forceinline__ int lds_byte(int r, int c) { const int st = (r >> 4) * 2 + (c >> 5), rr = r & 15, cc = c & 31, ob = rr * 64 + cc * 2; return st * 1024 + (ob ^ (((ob >> 9) & 1) << 5)); }
__host__ __device__ __forceinline__ void stage_rc(int b, int& R, int& C) { const int st = b / 1024, sb = b % 1024, swz = sb ^ (((sb >> 9) & 1) << 5); R = (st >> 1) * 16 + swz / 64; C = (st & 1) * 32 + (swz % 64) / 2; }
__host__ __device__ __forceinline__ int perm32(int rho) { const int n = rho >> 4, i = rho & 15; return 8 * (i >> 2) + 4 * n + (i & 3); }

struct Unit { int pm, pn, om, on, e, mt, slot; };
struct Gemm { const bf16_t* A; const bf16_t* Bt; int K; };

__device__ __forceinline__ int xcd_remap(int L, int nwg) { const int q = nwg / NXCD, r = nwg % NXCD, xcd = L % NXCD, off = L / NXCD; return (xcd < r ? xcd * (q + 1) : r * (q + 1) + (xcd - r) * q) + off; }

__device__ __forceinline__ void plain_a_off(int pm, int tid, int K, unsigned (&o)[2][2]) {
#pragma unroll
    for (int i = 0; i < 2; ++i) { int R, C; stage_rc(tid * 16 + i * 8192, R, C);
#pragma unroll
        for (int h = 0; h < 2; ++h) o[h][i] = (unsigned)((pm * BM + h * HALF + R) * K + C) * 2u; }
}
struct StaticOrder {
    int nM, nN, nwg, G, c;
    __device__ void init(int nM_, int nN_, int G_, int c_, int = 1) { nM = nM_; nN = nN_; nwg = nM * nN; G = G_; c = c_; }
    __device__ __forceinline__ bool tile(int i, int& pm, int& pn, int& q) const {
        const int L = i * G + c; if (L >= nwg) return false;
        q = 0xF; const int wgid = xcd_remap(L, nwg);
        const int nig = WGM * nN, gid = wgid / nig, fm = gid * WGM, gsz = (nM - fm) < WGM ? (nM - fm) : WGM;
        pm = fm + ((wgid % nig) % gsz); pn = (wgid % nig) / gsz; return true;
    }
    __device__ __forceinline__ bool next(int i, Unit& u) const { int pm, pn, q; if (!tile(i, pm, pn, q)) return false; u.pm = pm; u.pn = pn; u.om = pm; u.on = pn; u.e = 0; u.mt = 0; u.slot = 0; return true; }
    __device__ __forceinline__ void a_off(const Unit& u, int tid, int K, unsigned (&o)[2][2]) const { plain_a_off(u.pm, tid, K, o); }
};

__device__ __forceinline__ unsigned cvt_pk_bf16(float lo, float hi) { unsigned r; asm volatile("v_cvt_pk_bf16_f32 %0, %1, %2" : "=v"(r) : "v"(lo), "v"(hi)); return r; }

template <class Epi, class Sched, bool ALIGN_EPI, int DRY = 0, bool I8 = false>
__device__ __forceinline__ void gemm_phase(LAS unsigned char* lds, const Gemm g, const Sched& S, const Epi& E, int wvid) {
    int tid_ = (wvid * 64 + lane_id_asm()); asm volatile("" : "+v"(tid_));
    const int tid = tid_, wid = __builtin_amdgcn_readfirstlane(tid >> 6), lane = tid & 63, wr = wid >> 2, wc = wid & 3, fr = lane & 15, fq = lane >> 4;
    const int K = g.K, nt = K / BK;
    unsigned voffB[2];
#pragma unroll
    for (int i = 0; i < 2; ++i) { int R, C; stage_rc(tid * 16 + i * 8192, R, C); const int Rb = Epi::PERM ? ((R & ~31) + perm32(R & 31)) : R;
        voffB[i] = (unsigned)(Rb * K + C) * 2u; }
    constexpr unsigned kstep = BK * 2;
    const unsigned hstep = (unsigned)HALF * K * 2;
    const unsigned tstep = 2 * hstep;
    const unsigned ldsw = (unsigned)wid * 1024u;
    const int aoff = lds_byte(wr * 64 + fr, fq * 8), boff = lds_byte(wc * 32 + fr, fq * 8);
#define PG8_SA(b, h) (((b) * 2 + (h)) * HTB)
#define PG8_SB(b, h) ((4 + (b) * 2 + (h)) * HTB)
#define PG8_STAGE(bufoff, gbase, voff) do { _Pragma("unroll") for (int _i = 0; _i < 2; ++_i) \
        __builtin_amdgcn_global_load_lds((const unsigned*)((const char*)(gbase) + (voff)[_i]), (LAS unsigned*)(lds + (bufoff) + ldsw + _i * 8192), 16, 0, 0); } while (0)
#define PG8_LDA(dst, b, h) do { _Pragma("unroll") for (int m = 0; m < 4; ++m) _Pragma("unroll") for (int k = 0; k < 2; ++k) dst[m][k] = *(const LAS bf16x8*)(lds + PG8_SA(b, h) + aoff + m * 2048 + k * 1024); } while (0)
#define PG8_LDB(dst, b, h) do { _Pragma("unroll") for (int n = 0; n < 2; ++n) _Pragma("unroll") for (int k = 0; k < 2; ++k) dst[n][k] = *(const LAS bf16x8*)(lds + PG8_SB(b, h) + boff + n * 2048 + k * 1024); } while (0)
#define PG8_MMA(ai, bj, At, Bt) do { if constexpr (DRY == 1) { _Pragma("unroll") for (int m = 0; m < 4; ++m) _Pragma("unroll") for (int k = 0; k < 2; ++k) asm volatile("" :: "v"(At[m][k])); _Pragma("unroll") for (int n = 0; n < 2; ++n) _Pragma("unroll") for (int k = 0; k < 2; ++k) asm volatile("" :: "v"(Bt[n][k])); break; } __builtin_amdgcn_s_setprio(1); _Pragma("unroll") for (int m = 0; m < 4; ++m) _Pragma("unroll") for (int n = 0; n < 2; ++n) _Pragma("unroll") for (int k = 0; k < 2; ++k) \
        { if constexpr (I8) acc[ai][bj][m][n] = __builtin_bit_cast(AccT, __builtin_amdgcn_mfma_i32_16x16x64_i8(__builtin_bit_cast(i32x4, Bt[n][k]), __builtin_bit_cast(i32x4, At[m][k]), __builtin_bit_cast(i32x4, acc[ai][bj][m][n]), 0, 0, 0)); \
          else acc[ai][bj][m][n] = __builtin_bit_cast(AccT, __builtin_amdgcn_mfma_f32_16x16x32_bf16(Bt[n][k], At[m][k], __builtin_bit_cast(f32x4, acc[ai][bj][m][n]), 0, 0, 0)); } __builtin_amdgcn_s_setprio(0); } while (0)
#define PG8_WAIT_V(n) asm volatile("s_waitcnt vmcnt(" #n ")" ::: "memory")
#define PG8_WAIT_L(n) asm volatile("s_waitcnt lgkmcnt(" #n ")" ::: "memory")
#define PG8_BAR __builtin_amdgcn_s_barrier()
#define PG8_SCHED __builtin_amdgcn_sched_barrier(0)
    Unit cur, nxt; int ui = 0;
    if (!S.next(0, cur)) return;
    typedef typename Epi::AccT AccT;
    AccT acc[2][2][4][2];
#pragma unroll
    for (int a = 0; a < 2; ++a)
#pragma unroll
        for (int b = 0; b < 2; ++b)
#pragma unroll
            for (int m = 0; m < 4; ++m)
#pragma unroll
                for (int n = 0; n < 2; ++n) acc[a][b][m][n] = AccT{};
    bf16x8 At[4][2], B0[2][2], B1[2][2];
    unsigned aC[2][2];
    S.a_off(cur, tid, K, aC);
    const char* const Ab = (const char*)g.A;
    const char* cB = (const char*)g.Bt + (size_t)cur.pn * tstep;
    PG8_STAGE(PG8_SB(0, 0), cB, voffB); PG8_STAGE(PG8_SB(0, 1), cB + hstep, voffB); PG8_STAGE(PG8_SA(0, 0), Ab, aC[0]); PG8_STAGE(PG8_SA(0, 1), Ab, aC[1]);
    if (wr == 1) PG8_BAR;
    PG8_WAIT_V(2); PG8_BAR;
    PG8_STAGE(PG8_SB(1, 0), cB + kstep, voffB); PG8_STAGE(PG8_SA(1, 0), Ab + kstep, aC[0]); PG8_STAGE(PG8_SB(1, 1), cB + hstep + kstep, voffB);
    PG8_WAIT_V(6); PG8_BAR;
    for (;;) {
        const bool has_next = S.next(ui + 1, nxt);
        const char* nB = has_next ? (const char*)g.Bt + (size_t)nxt.pn * tstep : cB;
        for (int t = 0; t < nt; t += 2) {
            const bool last = (t == nt - 2);
            const char* a1 = Ab + (size_t)(t + 1) * kstep;
            const char* a2 = last ? Ab : Ab + (size_t)(t + 2) * kstep; const char* b2 = last ? nB : cB + (size_t)(t + 2) * kstep;
            const char* a3 = a2 + kstep; const char* b3 = b2 + kstep;
            PG8_LDB(B0, 0, 0); PG8_LDB(B1, 0, 1); PG8_SCHED; PG8_LDA(At, 0, 0); PG8_STAGE(PG8_SA(1, 1), a1, aC[1]);
            if (last && has_next) S.a_off(nxt, tid, K, aC);
            PG8_WAIT_V(8); PG8_WAIT_L(0); PG8_BAR; PG8_MMA(0, 0, At, B0); PG8_MMA(0, 1, At, B1); PG8_BAR; PG8_SCHED;
            PG8_LDA(At, 0, 1); PG8_STAGE(PG8_SB(0, 0), b2, voffB); PG8_STAGE(PG8_SB(0, 1), b2 + hstep, voffB); PG8_STAGE(PG8_SA(0, 0), a2, aC[0]);
            PG8_WAIT_V(8); PG8_WAIT_L(0); PG8_BAR; PG8_MMA(1, 0, At, B0); PG8_MMA(1, 1, At, B1); PG8_BAR; PG8_SCHED;
            PG8_LDB(B0, 1, 0); PG8_LDB(B1, 1, 1); PG8_SCHED; PG8_LDA(At, 1, 0); PG8_STAGE(PG8_SA(0, 1), a2, aC[1]);
            PG8_WAIT_V(8); PG8_WAIT_L(0); PG8_BAR; PG8_MMA(0, 0, At, B0); PG8_MMA(0, 1, At, B1); PG8_BAR; PG8_SCHED;
            PG8_LDA(At, 1, 1); PG8_STAGE(PG8_SB(1, 0), b3, voffB); PG8_STAGE(PG8_SB(1, 1), b3 + hstep, voffB); PG8_STAGE(PG8_SA(1, 0), a3, aC[0]);
            PG8_WAIT_V(8); PG8_WAIT_L(0); PG8_BAR; PG8_MMA(1, 0, At, B0); PG8_MMA(1, 1, At, B1); PG8_BAR; PG8_SCHED;
        }
        if constexpr (ALIGN_EPI) { if (wr == 0) PG8_BAR; }
        if constexpr (DRY == 0) E(acc, cur, wr, wc, fr, fq); else { _Pragma("unroll") for (int a = 0; a < 2; ++a) _Pragma("unroll") for (int b = 0; b < 2; ++b) _Pragma("unroll") for (int m = 0; m < 4; ++m) _Pragma("unroll") for (int n = 0; n < 2; ++n) asm volatile("" :: "v"(acc[a][b][m][n])); }
        if (!has_next) break;
#pragma unroll
        for (int a = 0; a < 2; ++a)
#pragma unroll
            for (int b = 0; b < 2; ++b)
#pragma unroll
                for (int m = 0; m < 4; ++m)
#pragma unroll
                    for (int n = 0; n < 2; ++n) acc[a][b][m][n] = AccT{};
        cur = nxt; cB = nB; ++ui;
        if constexpr (ALIGN_EPI) { if (wr == 1) PG8_BAR; }
    }
    PG8_WAIT_V(0);
    if constexpr (!ALIGN_EPI) { if (wr == 0) PG8_BAR; }
    PG8_BAR;
#undef PG8_SA
#undef PG8_SB
#undef PG8_STAGE
#undef PG8_LDA
#undef PG8_LDB
#undef PG8_MMA
#undef PG8_WAIT_V
#undef PG8_WAIT_L
#undef PG8_BAR
#undef PG8_SCHED
}
}
namespace pg8 {
typedef const f32x4 (&AccRef)[2][2][4][2];
typedef const i32x4 (&AccRefI)[2][2][4][2];
__device__ __forceinline__ f32x4 i2f(const i32x4 v) { return (f32x4){(float)v[0], (float)v[1], (float)v[2], (float)v[3]}; }

struct EpiInProj {
    static constexpr bool PERM = true; typedef f32x4 AccT;
    unsigned char* ws;
    __device__ __forceinline__ void operator()(AccRef acc, const Unit& u, int wr, int wc, int fr, int fq) const {
        const int pn = u.on, row0 = u.om * BM + wr * 64 + fr, cw = wc * 32 + 8 * fq;
        if (pn >= 4 && pn < 12) {
#pragma unroll
            for (int ai = 0; ai < 2; ++ai)
#pragma unroll
                for (int m = 0; m < 4; ++m) { const f32x4 v0 = acc[ai][0][m][0] * acc[ai][1][m][0], v1 = acc[ai][0][m][1] * acc[ai][1][m][1];
                    u32x4 w; w.x = cvt_pk_bf16(v0[0], v0[1]); w.y = cvt_pk_bf16(v0[2], v0[3]); w.z = cvt_pk_bf16(v1[0], v1[1]); w.w = cvt_pk_bf16(v1[2], v1[3]);
                    *(u32x4*)((bf16_t*)(ws + WS_U) + (size_t)(row0 + ai * HALF + m * 16) * D + (pn - 4) * 128 + cw) = w; }
            return;
        }
        size_t doff; int ldc = D, cb, mode = 0;
        if (pn < 4) { doff = WS_BG; cb = pn * 256; }
        else if (pn < 16) { doff = WS_Q; cb = (pn - 12) * 256; mode = 1; }
        else if (pn == 16) { doff = WS_K; cb = 0; ldc = 256; }
        else if (pn == 17) { doff = WS_V; cb = 0; ldc = 256; }
        else if (pn < 22) { doff = WS_GC; cb = (pn - 18) * 256; mode = 2; }
        else { doff = WS_GA; cb = (pn - 22) * 256; mode = 2; }
        bf16_t* dst = (bf16_t*)(ws + doff);
#pragma unroll
        for (int ai = 0; ai < 2; ++ai)
#pragma unroll
            for (int m = 0; m < 4; ++m) { bf16_t* rowp = dst + (size_t)(row0 + ai * HALF + m * 16) * ldc + cb + cw;
#pragma unroll
                for (int bj = 0; bj < 2; ++bj) { f32x4 v0 = acc[ai][bj][m][0], v1 = acc[ai][bj][m][1];
                    if (mode == 1) { v0 = v0 * QSCALE; v1 = v1 * QSCALE; }
                    if (mode == 2) {
#pragma unroll
                        for (int j = 0; j < 4; ++j) { v0[j] = fast_sigmoid(v0[j]); v1[j] = fast_sigmoid(v1[j]); } }
                    u32x4 w; w.x = cvt_pk_bf16(v0[0], v0[1]); w.y = cvt_pk_bf16(v0[2], v0[3]); w.z = cvt_pk_bf16(v1[0], v1[1]); w.w = cvt_pk_bf16(v1[2], v1[3]);
                    *(u32x4*)(rowp + bj * HALF) = w; } }
    }
};

struct EpiInProjI8 {
    static constexpr bool PERM = true; typedef i32x4 AccT;
    unsigned char* ws; float sw;
    __device__ __forceinline__ void operator()(AccRefI acc, const Unit& u, int wr, int wc, int fr, int fq) const {
        const int pn = u.on, row0 = u.om * BM + wr * 64 + fr, cw = wc * 32 + 8 * fq;
        const float* sx0 = (const float*)(ws + WS_SX0) + row0;
        float sxv[2][4];
#pragma unroll
        for (int ai = 0; ai < 2; ++ai)
#pragma unroll
            for (int m = 0; m < 4; ++m) sxv[ai][m] = sx0[ai * HALF + m * 16];
        if (pn >= 4 && pn < 12) {
#pragma unroll
            for (int ai = 0; ai < 2; ++ai)
#pragma unroll
                for (int m = 0; m < 4; ++m) { const float s = sxv[ai][m] * sw, s2 = s * s;
                    const f32x4 v0 = i2f(acc[ai][0][m][0]) * i2f(acc[ai][1][m][0]) * s2, v1 = i2f(acc[ai][0][m][1]) * i2f(acc[ai][1][m][1]) * s2;
                    u32x4 w; w.x = cvt_pk_bf16(v0[0], v0[1]); w.y = cvt_pk_bf16(v0[2], v0[3]); w.z = cvt_pk_bf16(v1[0], v1[1]); w.w = cvt_pk_bf16(v1[2], v1[3]);
                    *(u32x4*)((bf16_t*)(ws + WS_U) + (size_t)(row0 + ai * HALF + m * 16) * D + (pn - 4) * 128 + cw) = w; asm volatile("" ::: "memory"); }
            return;
        }
        size_t doff; int ldc = D, cb, mode = 0;
        if (pn < 4) { doff = WS_BG; cb = pn * 256; }
        else if (pn < 16) { doff = WS_Q; cb = (pn - 12) * 256; mode = 1; }
        else if (pn == 16) { doff = WS_K; cb = 0; ldc = 256; }
        else if (pn == 17) { doff = WS_V; cb = 0; ldc = 256; }
        else if (pn < 22) { doff = WS_GC; cb = (pn - 18) * 256; mode = 2; }
        else { doff = WS_GA; cb = (pn - 22) * 256; mode = 2; }
        bf16_t* dst = (bf16_t*)(ws + doff);
#pragma unroll
        for (int ai = 0; ai < 2; ++ai)
#pragma unroll
            for (int m = 0; m < 4; ++m) { bf16_t* rowp = dst + (size_t)(row0 + ai * HALF + m * 16) * ldc + cb + cw; const float s = sxv[ai][m] * sw * (mode == 1 ? QSCALE : 1.0f);
#pragma unroll
                for (int bj = 0; bj < 2; ++bj) { f32x4 v0 = i2f(acc[ai][bj][m][0]) * s, v1 = i2f(acc[ai][bj][m][1]) * s;
                    if (mode == 2) {
#pragma unroll
                        for (int j = 0; j < 4; ++j) { v0[j] = fast_sigmoid(v0[j]); v1[j] = fast_sigmoid(v1[j]); } }
                    u32x4 w; w.x = cvt_pk_bf16(v0[0], v0[1]); w.y = cvt_pk_bf16(v0[2], v0[3]); w.z = cvt_pk_bf16(v1[0], v1[1]); w.w = cvt_pk_bf16(v1[2], v1[3]);
                    *(u32x4*)(rowp + bj * HALF) = w; }
                asm volatile("" ::: "memory"); }
    }
};

struct EpiDual {
    static constexpr bool PERM = true; typedef f32x4 AccT;
    unsigned char* ws;
    __device__ __forceinline__ void operator()(AccRef acc, const Unit& u, int wr, int wc, int fr, int fq) const {
        const int row0 = u.om * BM + wr * 64 + fr, col0 = u.on * BM + wc * 32 + 8 * fq;
        const bf16_t* G = (const bf16_t*)(ws + (u.e == 0 ? WS_GC : WS_GA)); bf16_t* T1 = (bf16_t*)(ws + WS_T1); bf16_t* MG = (bf16_t*)(ws + WS_MG);
#pragma unroll
        for (int ai = 0; ai < 2; ++ai)
#pragma unroll
            for (int m = 0; m < 4; ++m) { const size_t ro = (size_t)(row0 + ai * HALF + m * 16) * D + col0;
#pragma unroll
                for (int bj = 0; bj < 2; ++bj) { const size_t o = ro + bj * HALF;
                    const u32x4 gw = *(const u32x4*)(G + o);
                    f32x4 g0 = {bflo(gw.x), bfhi(gw.x), bflo(gw.y), bfhi(gw.y)}, g1 = {bflo(gw.z), bfhi(gw.z), bflo(gw.w), bfhi(gw.w)};
                    f32x4 v0 = g0 * acc[ai][bj][m][0], v1 = g1 * acc[ai][bj][m][1];
                    if (u.e == 0) { u32x4 w; w.x = cvt_pk_bf16(v0[0], v0[1]); w.y = cvt_pk_bf16(v0[2], v0[3]); w.z = cvt_pk_bf16(v1[0], v1[1]); w.w = cvt_pk_bf16(v1[2], v1[3]); *(u32x4*)(T1 + o) = w; }
                    else { const u32x4 tw_ = *(const u32x4*)(T1 + o);
                        v0 = v0 + (f32x4){bflo(tw_.x), bfhi(tw_.x), bflo(tw_.y), bfhi(tw_.y)}; v1 = v1 + (f32x4){bflo(tw_.z), bfhi(tw_.z), bflo(tw_.w), bfhi(tw_.w)};
                        u32x4 w; w.x = cvt_pk_bf16(v0[0], v0[1]); w.y = cvt_pk_bf16(v0[2], v0[3]); w.z = cvt_pk_bf16(v1[0], v1[1]); w.w = cvt_pk_bf16(v1[2], v1[3]);
                        *(u32x4*)(MG + o) = w; } } }
    }
};

struct EpiResid {
    static constexpr bool PERM = false; typedef f32x4 AccT;
    const float* X; float* C;
    __device__ __forceinline__ void operator()(AccRef acc, const Unit& u, int wr, int wc, int fr, int fq) const {
        const int row0 = u.om * BM + wr * 64 + fr, col0 = u.on * BM + wc * 32 + 4 * fq;
#pragma unroll
        for (int ai = 0; ai < 2; ++ai)
#pragma unroll
            for (int m = 0; m < 4; ++m) { const size_t ro = (size_t)(row0 + ai * HALF + m * 16) * D + col0;
#pragma unroll
                for (int bj = 0; bj < 2; ++bj)
#pragma unroll
                    for (int n = 0; n < 2; ++n) { const size_t o = ro + bj * HALF + n * 16; *(f32x4*)(C + o) = *(const f32x4*)(X + o) * DN_ALPHA + acc[ai][bj][m][n]; } }
    }
};

struct EpiF32 {
    static constexpr bool PERM = false; typedef f32x4 AccT;
    float* C;
    __device__ __forceinline__ void operator()(AccRef acc, const Unit& u, int wr, int wc, int fr, int fq) const {
        const int row0 = u.om * BM + wr * 64 + fr, col0 = u.on * BM + wc * 32 + 4 * fq;
#pragma unroll
        for (int ai = 0; ai < 2; ++ai)
#pragma unroll
            for (int m = 0; m < 4; ++m) { const size_t ro = (size_t)(row0 + ai * HALF + m * 16) * D + col0;
#pragma unroll
                for (int bj = 0; bj < 2; ++bj)
#pragma unroll
                    for (int n = 0; n < 2; ++n) *(f32x4*)(C + ro + bj * HALF + n * 16) = acc[ai][bj][m][n]; }
    }
};
struct EpiF32I8 {
    static constexpr bool PERM = false; typedef i32x4 AccT;
    float* C; const float* sp; float sw;
    __device__ __forceinline__ void operator()(AccRefI acc, const Unit& u, int wr, int wc, int fr, int fq) const {
        const int row0 = u.om * BM + wr * 64 + fr, col0 = u.on * BM + wc * 32 + 4 * fq;
        float sv[2][4];
#pragma unroll
        for (int ai = 0; ai < 2; ++ai)
#pragma unroll
            for (int m = 0; m < 4; ++m) sv[ai][m] = sp[row0 + ai * HALF + m * 16] * sw;
#pragma unroll
        for (int ai = 0; ai < 2; ++ai)
#pragma unroll
            for (int m = 0; m < 4; ++m) { const size_t ro = (size_t)(row0 + ai * HALF + m * 16) * D + col0;
#pragma unroll
                for (int bj = 0; bj < 2; ++bj)
#pragma unroll
                    for (int n = 0; n < 2; ++n) *(f32x4*)(C + ro + bj * HALF + n * 16) = i2f(acc[ai][bj][m][n]) * sv[ai][m]; }
    }
};
__device__ __forceinline__ void ple_epilogue(AccRef acc, const Unit& u, int wr, int wc, int fr, int fq, const float* P2, bf16_t* PLE) {
    const int row0 = u.om * BM + wr * 64 + fr, col0 = u.on * BM + wc * 32 + 8 * fq;
#pragma unroll
    for (int ai = 0; ai < 2; ++ai)
#pragma unroll
        for (int m = 0; m < 4; ++m) { const size_t ro = (size_t)(row0 + ai * HALF + m * 16) * D + col0;
#pragma unroll
            for (int bj = 0; bj < 2; ++bj) { const size_t o = ro + bj * HALF; const f32x4 p0 = *(const f32x4*)(P2 + o), p1 = *(const f32x4*)(P2 + o + 4); const f32x4 a0 = acc[ai][bj][m][0], a1 = acc[ai][bj][m][1];
                u32x4 w; w.x = cvt_pk_bf16(fast_sigmoid(a0[0]) * p0[0], fast_sigmoid(a0[1]) * p0[1]); w.y = cvt_pk_bf16(fast_sigmoid(a0[2]) * p0[2], fast_sigmoid(a0[3]) * p0[3]);
                w.z = cvt_pk_bf16(fast_sigmoid(a1[0]) * p1[0], fast_sigmoid(a1[1]) * p1[1]); w.w = cvt_pk_bf16(fast_sigmoid(a1[2]) * p1[2], fast_sigmoid(a1[3]) * p1[3]);
                *(u32x4*)(PLE + o) = w; }
            if (m & 1) asm volatile("" ::: "memory"); }
}

struct EpiSwiglu {
    static constexpr bool PERM = true; typedef f32x4 AccT;
    bf16_t* H; const float* b_gu; const LAS unsigned* tw; unsigned char* ws;
    __device__ __forceinline__ void operator()(AccRef acc, const Unit& u, int wr, int wc, int fr, int fq) const {
        if (u.e < 0) { ple_epilogue(acc, u, wr, wc, fr, fq, (const float*)(ws + WS_P2), (bf16_t*)(ws + WS_PLE)); return; }
        const int trow0 = wr * 64 + fr, row0 = u.om * BM + trow0, cw = wc * 32 + 8 * fq, col0 = u.on * 128 + cw;
        const float* bg = b_gu + (size_t)u.e * 2048 + col0;
#pragma unroll
        for (int n = 0; n < 2; ++n) { const f32x4 bgn = *(const f32x4*)(bg + 4 * n), bun = *(const f32x4*)(bg + 1024 + 4 * n);
#pragma unroll
            for (int ai = 0; ai < 2; ++ai)
#pragma unroll
                for (int m = 0; m < 4; ++m) { const float w = bfhi(tw[u.slot * BM + trow0 + ai * HALF + m * 16]);
                    const f32x4 gt = acc[ai][0][m][n] + bgn, up = acc[ai][1][m][n] + bun; f32x4 hv;
#pragma unroll
                    for (int j = 0; j < 4; ++j) { const float gv = fminf(gt[j], 7.0f), uv = fminf(fmaxf(up[j], -7.0f), 7.0f); hv[j] = (uv + 1.0f) * gv * fast_sigmoid(1.702f * gv) * w; }
                    u32x2 o; o.x = cvt_pk_bf16(hv[0], hv[1]); o.y = cvt_pk_bf16(hv[2], hv[3]);
                    *(u32x2*)(H + (size_t)(row0 + ai * HALF + m * 16) * D + col0 + 4 * n) = o; } }
    }
};
struct EpiSwigluI8 {
    static constexpr bool PERM = true; typedef i32x4 AccT;
    bf16_t* H; const float* b_gu; const LAS unsigned* tw; unsigned char* ws;
    __device__ __forceinline__ void operator()(AccRefI acc, const Unit& u, int wr, int wc, int fr, int fq) const {
        const int trow0 = wr * 64 + fr, row0 = u.om * BM + trow0, cw = wc * 32 + 8 * fq;
        const float* scl = (const float*)(ws + WS_SCL);
        if (u.e < 0) {
            const float* P2 = (const float*)(ws + WS_P2); bf16_t* PLE = (bf16_t*)(ws + WS_PLE); const float* sx1 = (const float*)(ws + WS_SX1);
            const float spg = scl[NE]; const int col0 = u.on * BM + cw;
#pragma unroll
            for (int ai = 0; ai < 2; ++ai)
#pragma unroll
                for (int m = 0; m < 4; ++m) { const int r = row0 + ai * HALF + m * 16; const float s = sx1[r] * spg; const size_t ro = (size_t)r * D + col0;
#pragma unroll
                    for (int bj = 0; bj < 2; ++bj) { const size_t o = ro + bj * HALF; const f32x4 p0 = *(const f32x4*)(P2 + o), p1 = *(const f32x4*)(P2 + o + 4); const f32x4 a0 = i2f(acc[ai][bj][m][0]) * s, a1 = i2f(acc[ai][bj][m][1]) * s;
                        u32x4 w; w.x = cvt_pk_bf16(fast_sigmoid(a0[0]) * p0[0], fast_sigmoid(a0[1]) * p0[1]); w.y = cvt_pk_bf16(fast_sigmoid(a0[2]) * p0[2], fast_sigmoid(a0[3]) * p0[3]);
                        w.z = cvt_pk_bf16(fast_sigmoid(a1[0]) * p1[0], fast_sigmoid(a1[1]) * p1[1]); w.w = cvt_pk_bf16(fast_sigmoid(a1[2]) * p1[2], fast_sigmoid(a1[3]) * p1[3]);
                        *(u32x4*)(PLE + o) = w; }
                    if (m & 1) asm volatile("" ::: "memory"); }
            return; }
        const int col0 = u.on * 128 + cw;
        const float* bg = b_gu + (size_t)u.e * 2048 + col0; const float sg = scl[u.e];
        const float* lsx = (const float*)(ws + WS_LSX) + (size_t)u.e * LISTCAP + u.mt * BM + trow0;
        const f32x4 bg0 = *(const f32x4*)(bg), bg1 = *(const f32x4*)(bg + 4), bu0 = *(const f32x4*)(bg + 1024), bu1 = *(const f32x4*)(bg + 1028);
        unsigned char* H8 = (unsigned char*)H;
        float lsv[2][4];
#pragma unroll
        for (int ai = 0; ai < 2; ++ai)
#pragma unroll
            for (int m = 0; m < 4; ++m) lsv[ai][m] = lsx[ai * HALF + m * 16];
#pragma unroll
        for (int ai = 0; ai < 2; ++ai)
#pragma unroll
            for (int m = 0; m < 4; ++m) { const unsigned twv = tw[u.slot * BM + trow0 + ai * HALF + m * 16]; const float qh = bfhi(twv);
                const float s = (qh != 0.f ? lsv[ai][m] : 0.f) * sg;
                unsigned q8[2];
#pragma unroll
                for (int n = 0; n < 2; ++n) { const f32x4 gt = i2f(acc[ai][0][m][n]) * s + (n == 0 ? bg0 : bg1), up = i2f(acc[ai][1][m][n]) * s + (n == 0 ? bu0 : bu1); unsigned q = 0u;
#pragma unroll
                    for (int j = 0; j < 4; ++j) { const float gv = fminf(gt[j], 7.0f), uv = __builtin_amdgcn_fmed3f(up[j], -7.0f, 7.0f);
                        const float sg_ = __builtin_amdgcn_rcpf(1.0f + __builtin_amdgcn_exp2f((-1.702f * LOG2E) * gv));
                        const float hq = __builtin_fmaf(__builtin_fmaf(uv, gv, gv) * sg_, qh, 128.0f);
                        q = __builtin_amdgcn_cvt_pk_u8_f32(__builtin_amdgcn_fmed3f(__builtin_rintf(hq), 1.0f, 255.0f), j, q); }
                    q8[n] = q ^ 0x80808080u; }
                *(u32x2*)(H8 + (size_t)(row0 + ai * HALF + m * 16) * D + col0) = (u32x2){q8[0], q8[1]};
                if (m & 1) asm volatile("" ::: "memory"); }
    }
};
struct EpiDownI8 {
    static constexpr bool PERM = true; typedef i32x4 AccT;
    bf16_t* Y; unsigned char* ws; const LAS int* cntL;
    __device__ __forceinline__ void operator()(AccRefI acc, const Unit& u, int wr, int wc, int fr, int fq) const {
        const int trow0 = wr * 64 + fr, row0 = u.om * BM + trow0, cw = wc * 32 + 8 * fq;
        const float* scl = (const float*)(ws + WS_SCL);
        if (u.e < 0) {
            const float* P2 = (const float*)(ws + WS_P2); bf16_t* PLE = (bf16_t*)(ws + WS_PLE); const float* sx1 = (const float*)(ws + WS_SX1);
            const float spg = scl[NE]; const int col0 = u.on * BM + cw;
#pragma unroll
            for (int ai = 0; ai < 2; ++ai)
#pragma unroll
                for (int m = 0; m < 4; ++m) { const int r = row0 + ai * HALF + m * 16; const float s = sx1[r] * spg; const size_t ro = (size_t)r * D + col0;
#pragma unroll
                    for (int bj = 0; bj < 2; ++bj) { const size_t o = ro + bj * HALF; const f32x4 p0 = *(const f32x4*)(P2 + o), p1 = *(const f32x4*)(P2 + o + 4); const f32x4 a0 = i2f(acc[ai][bj][m][0]) * s, a1 = i2f(acc[ai][bj][m][1]) * s;
                        u32x4 w; w.x = cvt_pk_bf16(fast_sigmoid(a0[0]) * p0[0], fast_sigmoid(a0[1]) * p0[1]); w.y = cvt_pk_bf16(fast_sigmoid(a0[2]) * p0[2], fast_sigmoid(a0[3]) * p0[3]);
                        w.z = cvt_pk_bf16(fast_sigmoid(a1[0]) * p1[0], fast_sigmoid(a1[1]) * p1[1]); w.w = cvt_pk_bf16(fast_sigmoid(a1[2]) * p1[2], fast_sigmoid(a1[3]) * p1[3]);
                        *(u32x4*)(PLE + o) = w; }
                    if (m & 1) asm volatile("" ::: "memory"); }
            return; }
        const float sd = scl[128 + u.e]; const int cnt = cntL[u.e], li0 = u.mt * BM + trow0;
        const float* lhs = (const float*)(ws + WS_LHS) + (size_t)u.e * LISTCAP + li0;
        bf16_t* yp = Y + (size_t)row0 * D + u.on * BM + cw;
        float lhv[2][4];
#pragma unroll
        for (int ai = 0; ai < 2; ++ai)
#pragma unroll
            for (int m = 0; m < 4; ++m) lhv[ai][m] = lhs[ai * HALF + m * 16];
#pragma unroll
        for (int ai = 0; ai < 2; ++ai)
#pragma unroll
            for (int m = 0; m < 4; ++m) { const int dr = ai * HALF + m * 16; const float s = ((li0 + dr) < cnt ? lhv[ai][m] : 0.f) * sd;
#pragma unroll
                for (int bj = 0; bj < 2; ++bj) { const f32x4 v0 = i2f(acc[ai][bj][m][0]) * s, v1 = i2f(acc[ai][bj][m][1]) * s;
                    u32x4 o; o.x = cvt_pk_bf16(v0[0], v0[1]); o.y = cvt_pk_bf16(v0[2], v0[3]); o.z = cvt_pk_bf16(v1[0], v1[1]); o.w = cvt_pk_bf16(v1[2], v1[3]);
                    *(u32x4*)(yp + (size_t)dr * D + bj * HALF) = o; }
                if (m & 1) asm volatile("" ::: "memory"); }
    }
};
struct EpiDown {
    static constexpr bool PERM = true; typedef f32x4 AccT;
    bf16_t* Y; unsigned char* ws;
    __device__ __forceinline__ void operator()(AccRef acc, const Unit& u, int wr, int wc, int fr, int fq) const {
        if (u.e < 0) { ple_epilogue(acc, u, wr, wc, fr, fq, (const float*)(ws + WS_P2), (bf16_t*)(ws + WS_PLE)); return; }
        bf16_t* yp = Y + (size_t)(u.om * BM + wr * 64 + fr) * D + u.on * BM + wc * 32 + 8 * fq;
#pragma unroll
        for (int ai = 0; ai < 2; ++ai)
#pragma unroll
            for (int m = 0; m < 4; ++m)
#pragma unroll
                for (int bj = 0; bj < 2; ++bj) { const f32x4 v0 = acc[ai][bj][m][0], v1 = acc[ai][bj][m][1];
                    u32x4 o; o.x = cvt_pk_bf16(v0[0], v0[1]); o.y = cvt_pk_bf16(v0[2], v0[3]); o.z = cvt_pk_bf16(v1[0], v1[1]); o.w = cvt_pk_bf16(v1[2], v1[3]);
                    *(u32x4*)(yp + (size_t)(ai * HALF + m * 16) * D + bj * HALF) = o; }
    }
};

struct DualOrder {
    StaticOrder so;
    __device__ __forceinline__ bool next(int i, Unit& u) const {
        int pm, pn, q; if (!so.tile(i >> 1, pm, pn, q)) return false;
        const int e = i & 1; u.pm = e * (M / BM) + pm; u.pn = e * 4 + pn; u.om = pm; u.on = pn; u.e = e; u.mt = 0; u.slot = 0; return true;
    }
    __device__ __forceinline__ void a_off(const Unit& u, int tid, int K, unsigned (&o)[2][2]) const { plain_a_off(u.pm, tid, K, o); }
};
struct MoeOrder {
    const LAS int* cntL; const LAS int* tsL; const LAS unsigned* tw; int NT, gather, btile0, btile_ple, n_extra, extra_first; unsigned abase, abase_ple; int U, UT, G, c; const LAS int* utab; int nunits;
    __device__ __forceinline__ void init(const LAS int* cntL_, const LAS int* tsL_, const LAS unsigned* tw_, int NT_, int G_, int c_, int gather_, size_t aoff_, size_t boff_, int n_extra_, int extra_first_, size_t aoff_ple_, size_t boff_ple_, int tshift_) {
        cntL = cntL_; tsL = tsL_; tw = tw_; NT = NT_; gather = gather_; abase = (unsigned)aoff_; btile0 = (int)(boff_ >> tshift_); abase_ple = (unsigned)aoff_ple_; btile_ple = (int)(boff_ple_ >> tshift_); n_extra = n_extra_; extra_first = extra_first_;
        U = __builtin_amdgcn_readfirstlane(tsL_[NE]) * NT_; UT = U + n_extra_; G = G_; c = c_; utab = nullptr; nunits = 0; }
    struct Own { int ok, maxT, maxC, totalFree; };
    __device__ __forceinline__ Own own_params(int split) const {
        Own o; int mx = 0, sumT = 0;
        for (int e = 0; e < NE; ++e) { const int T = tsL[e + 1] - tsL[e]; mx = T > mx ? T : mx; sumT += T; }
        o.maxT = mx; o.maxC = split == 1 ? mx : (mx + 1) >> 1; o.ok = 0;
        o.totalFree = split == 1 ? 8 * (NE * o.maxC - sumT) : 4 * (2 * NE * o.maxC - sumT);
        return o;
    }
    __device__ __forceinline__ static int ple_in_p5(const LAS int* tsL_, int G_) {
        int mx = 0, sumT = 0;
        for (int e = 0; e < NE; ++e) { const int T = tsL_[e + 1] - tsL_[e]; mx = T > mx ? T : mx; sumT += T; }
        int nfree;
        { const int U5 = sumT * 8; nfree = (G_ - U5 % G_) % G_; }
        return nfree < 256 ? nfree : 256;
    }
    __device__ __forceinline__ void build_units(LAS int* tab, int maxu, int tid, int p, int split) {
        const Own o = own_params(split);
        if (o.ok) {
            const int e = p >> 3, sub = p & 7, nt = split == 1 ? sub : sub >> 1, half = split == 1 ? 0 : sub & 1;
            const int t0 = tsL[e], T = tsL[e + 1] - t0, h0 = (T + 1) >> 1;
            const int myc = split == 1 ? T : (half ? T - h0 : h0), mt0 = (split == 2 && half) ? h0 : 0, myfree = o.maxC - myc;
            int prefix = 0;
            for (int k = 0; k < e; ++k) { const int Tk = tsL[k + 1] - tsL[k]; prefix += split == 1 ? 8 * (o.maxC - Tk) : 4 * (2 * o.maxC - Tk); }
            prefix += split == 1 ? sub * (o.maxC - T) : (sub >> 1) * (2 * o.maxC - T) + (half ? (o.maxC - h0) : 0);
            int nfill = n_extra - prefix; nfill = nfill < 0 ? 0 : (nfill > myfree ? myfree : nfill);
            int nover = 0; if (n_extra > o.totalFree) { const int rem = n_extra - o.totalFree - p; nover = rem > 0 ? (rem + 255) >> 8 : 0; }
            int n = myc + nfill + nover; if (n > maxu) n = maxu;
            if (tid < n) { LAS int* q = tab + 8 * tid;
                if (tid < myc) { const int mt = mt0 + tid; q[0] = t0 + mt; q[1] = btile0 + e * NT + nt; q[2] = nt; q[3] = e; q[4] = mt; }
                else { const int k = tid - myc; const int idx = k < nfill ? prefix + k : o.totalFree + (k - nfill) * 256 + p;
                    const int j = extra_first + idx, pm = (j >> 5) * 8 + (j & 7), pn = (j & 31) >> 3; q[0] = pm; q[1] = btile_ple + pn; q[2] = pn; q[3] = -1; q[4] = 0; } }
            __syncthreads();
            utab = tab; nunits = n; return;
        }
        if (tid < maxu) { const int L = tid * G + c;
            if (L < UT) { LAS int* q = tab + 8 * tid;
                if (L >= U) { const int j = extra_first + (L - U), pm = (j >> 5) * 8 + (j & 7), pn = (j & 31) >> 3; q[0] = pm; q[1] = btile_ple + pn; q[2] = pn; q[3] = -1; q[4] = 0; }
                else { const int wgid = xcd_remap(L, U); int e = 0;
                    for (int k = 1; k < NE; ++k) e += (wgid >= tsL[k] * NT) ? 1 : 0;
                    const int t0 = tsL[e], ntl = tsL[e + 1] - t0, r = wgid - t0 * NT, nt = r / ntl, mt = r - nt * ntl;
                    q[0] = t0 + mt; q[1] = btile0 + e * NT + nt; q[2] = nt; q[3] = e; q[4] = mt; } } }
        __syncthreads();
        utab = tab; nunits = c < UT ? (UT - 1 - c) / G + 1 : 0; if (nunits > maxu) nunits = maxu;
    }
    __device__ __forceinline__ bool next(int i, Unit& u) const {
        if (i >= nunits) return false;
        const LAS int* p = utab + 8 * i;
        u.pm = __builtin_amdgcn_readfirstlane(p[0]); u.pn = __builtin_amdgcn_readfirstlane(p[1]); u.om = u.pm; u.on = __builtin_amdgcn_readfirstlane(p[2]);
        u.e = __builtin_amdgcn_readfirstlane(p[3]); u.mt = __builtin_amdgcn_readfirstlane(p[4]); u.slot = i; return true;
    }
    __device__ __forceinline__ void a_off(const Unit& u, int tid, int K, unsigned (&o)[2][2]) const {
        if (u.e < 0 || !gather) { plain_a_off(u.pm, tid, K, o); const unsigned base = u.e < 0 ? abase_ple : abase;
#pragma unroll
            for (int h = 0; h < 2; ++h)
#pragma unroll
                for (int i = 0; i < 2; ++i) o[h][i] += base;
            return; }
#pragma unroll
        for (int i = 0; i < 2; ++i) { int R, C; stage_rc(tid * 16 + i * 8192, R, C);
#pragma unroll
            for (int h = 0; h < 2; ++h) { const int tok = (int)(tw[u.slot * BM + h * HALF + R] & 0xffffu);
                o[h][i] = (unsigned)(tok * K + C) * 2u + abase; } }
    }
};
constexpr int MOE_MAXU = 10;
__device__ __forceinline__ void moe_preload(const MoeOrder& S, const LAS int* cntL, const int* list_tok, const float* list_w, LAS unsigned* tw, int wvid) {
    int tid_ = (wvid * 64 + lane_id_asm()); asm volatile("" : "+v"(tid_)); const int tid = tid_;
    int tokv[MOE_MAXU / 2]; float wv[MOE_MAXU / 2];
#pragma unroll
    for (int k = 0; k < MOE_MAXU / 2; ++k) { const int ent = tid + NTHREADS * k, slot = ent >> 8, row = ent & 255; tokv[k] = 0; wv[k] = 0.f;
        if (slot < S.nunits) { const LAS int* p = S.utab + 8 * slot; const int e = p[3], mt = p[4], li = mt * BM + row;
            if (e >= 0 && li < cntL[e]) { tokv[k] = list_tok[(size_t)e * LISTCAP + li]; wv[k] = list_w[(size_t)e * LISTCAP + li]; } } }
#pragma unroll
    for (int k = 0; k < MOE_MAXU / 2; ++k) { const int ent = tid + NTHREADS * k; if ((ent >> 8) < S.nunits) tw[ent] = (unsigned)tokv[k] | (f2bf(wv[k]) << 16); }
    __syncthreads();
}
struct Ple1Order {
    int first, n;
    __device__ __forceinline__ bool next(int i, Unit& u) const { if (i >= n) return false; const int j = first + i, pm = (j >> 5) * 8 + (j & 7), pn = (j & 31) >> 3;
        u.pm = pm; u.pn = pn; u.om = pm; u.on = pn; u.e = 0; u.mt = 0; u.slot = 0; return true; }
    __device__ __forceinline__ void a_off(const Unit& u, int tid, int K, unsigned (&o)[2][2]) const { plain_a_off(u.pm, tid, K, o); }
};
}
__device__ __forceinline__ int dst_row(int n, int map) {
    if (map == 1) { if (n >= 1024 && n < 3072) { const int hsel = n >= 2048, c = n - 1024 - hsel * 1024; return 1024 + (c >> 7) * 256 + hsel * 128 + (c & 127); } return n; }
    if (map == 2) { const int hsel = n >= 1024, c = n - hsel * 1024; return (c >> 7) * 256 + hsel * 128 + (c & 127); }
    return n;
}
struct P0Args { const float *x, *p, *w_in, *w_brc, *w_bra, *w_out, *w_pg, *w_pp, *w_gu, *w_dn; unsigned char* ws; float s_in, s_pp; };
struct P0Item { const float* src; bf16_t* dst; int K, N; float qinv; };
constexpr int P0_I_IN = 16 * (NIN / 64), P0_I_SQ = 16 * 16, P0_I_PP = 4 * 16, P0_I_GU = 16 * 32, P0_I_DN = 16 * 16;
constexpr int P0_NSMALL = P0_I_IN + 3 * P0_I_SQ + P0_I_PP;
constexpr int P0_NITEMS = P0_I_IN + 4 * P0_I_SQ + P0_I_PP + NE * P0_I_GU + NE * P0_I_DN;
__device__ __forceinline__ P0Item p0_decode(const P0Args& a, int it) {
    const float* W; bf16_t* WT; int K = D, N = D, map = 0, r = it; float qinv = 0.f; const float* scl = (const float*)(a.ws + WS_SCL);
    if (r < P0_I_IN) { W = a.w_in; WT = (bf16_t*)(a.ws + WS_WIN); N = NIN; map = 1; qinv = 1.0f / a.s_in; }
    else if ((r -= P0_I_IN) < P0_I_SQ) { W = a.w_brc; WT = (bf16_t*)(a.ws + WS_WBR); }
    else if ((r -= P0_I_SQ) < P0_I_SQ) { W = a.w_bra; WT = (bf16_t*)(a.ws + WS_WBR) + (size_t)D * D; }
    else if ((r -= P0_I_SQ) < P0_I_SQ) { W = a.w_out; WT = (bf16_t*)(a.ws + WS_WOUT); }
    else if ((r -= P0_I_SQ) < P0_I_PP) { W = a.w_pp; WT = (bf16_t*)(a.ws + WS_WPP); K = DPLE; }
    else if ((r -= P0_I_PP) < P0_I_SQ) { W = a.w_pg; WT = (bf16_t*)(a.ws + WS_WPG8); qinv = 1.0f / scl[NE]; }
    else if ((r -= P0_I_SQ) < NE * P0_I_GU) { const int e = r / P0_I_GU; r -= e * P0_I_GU; W = a.w_gu + (size_t)e * D * 2048; WT = (bf16_t*)(a.ws + WS_WGU + (size_t)e * 2048 * D); N = 2048; map = 2; qinv = 1.0f / scl[e]; }
    else { r -= NE * P0_I_GU; const int e = r / P0_I_DN; r -= e * P0_I_DN; W = a.w_dn + (size_t)e * D * D; WT = (bf16_t*)(a.ws + WS_WDN + (size_t)e * D * D); qinv = 1.0f / scl[128 + e]; }
    const int nblk = N / 64, kb = r / nblk, nb = r - kb * nblk, k0 = 64 * kb, n0 = 64 * nb;
    P0Item d; d.src = W + (size_t)k0 * N + n0; d.K = K; d.N = N; d.qinv = qinv;
    d.dst = qinv != 0.f ? (bf16_t*)((unsigned char*)WT + (size_t)dst_row(n0, map) * K + k0) : WT + (size_t)dst_row(n0, map) * K + k0; return d;
}
__device__ __forceinline__ void p0_load(const P0Item& d, f32x4 (&v)[16], int lane) {
    const int lr = lane >> 4, lc = (lane & 15) * 4;
#pragma unroll
    for (int i = 0; i < 16; ++i) v[i] = __builtin_nontemporal_load((const f32x4*)(d.src + (size_t)(4 * i + lr) * d.N + lc));
}
__device__ __forceinline__ void p0_store(const P0Item& d, const f32x4 (&v)[16], LAS float* scr, int lane) {
    const int lr = lane >> 4, lc = (lane & 15) * 4;
#pragma unroll
    for (int i = 0; i < 16; ++i) { LAS float* s = scr + (4 * i + lr) * 65 + lc; s[0] = v[i][0]; s[1] = v[i][1]; s[2] = v[i][2]; s[3] = v[i][3]; }
    asm volatile("s_waitcnt lgkmcnt(0)" ::: "memory");
    const int c = lane & 7;
#pragma unroll
    for (int j = 0; j < 8; ++j) { const int n = (lane >> 3) + 8 * j; const LAS float* s = scr + (8 * c) * 65 + n;
        if (d.qinv != 0.f) { unsigned lo = 0u, hi = 0u;
#pragma unroll
            for (int q = 0; q < 4; ++q) { const int a0 = (int)fminf(fmaxf(rintf(s[q * 65] * d.qinv), -127.f), 127.f), a1 = (int)fminf(fmaxf(rintf(s[(q + 4) * 65] * d.qinv), -127.f), 127.f);
                lo |= ((unsigned)a0 & 0xffu) << (8 * q); hi |= ((unsigned)a1 & 0xffu) << (8 * q); }
            *(u32x2*)((unsigned char*)d.dst + (size_t)n * d.K + 8 * c) = (u32x2){lo, hi}; }
        else { u32x4 o; o.x = pk2(s[0 * 65], s[1 * 65]); o.y = pk2(s[2 * 65], s[3 * 65]); o.z = pk2(s[4 * 65], s[5 * 65]); o.w = pk2(s[6 * 65], s[7 * 65]);
            *(u32x4*)(d.dst + (size_t)n * d.K + 8 * c) = o; } }
    asm volatile("s_waitcnt lgkmcnt(0)" ::: "memory");
}
constexpr int P0_FILL = 2, P0_FILL_SEAMS = 4;
__device__ __forceinline__ void p0_fill(const P0Args& a, LAS unsigned char* lds, int vcu, int G, int seam, int wave) {
    const int lane = lane_id_asm();
    LAS float* scr = (LAS float*)(lds + wave * 16640);
    const int base = seam <= P0_FILL_SEAMS ? P0_NSMALL + (((seam - 1) * G + vcu) * 7 + (wave - 1)) * P0_FILL : P0_NITEMS - G * 7 * P0_FILL + (vcu * 7 + (wave - 1)) * P0_FILL;
    f32x4 va[16], vb[16];
    const P0Item da = p0_decode(a, base); p0_load(da, va, lane);
    if (P0_FILL >= 2) { const P0Item db = p0_decode(a, base + 1); p0_load(db, vb, lane); p0_store(da, va, scr, lane);
        if (P0_FILL >= 3) { const P0Item dc = p0_decode(a, base + 2); p0_load(dc, va, lane); p0_store(db, vb, scr, lane); p0_store(dc, va, scr, lane); }
        else p0_store(db, vb, scr, lane); }
    else p0_store(da, va, scr, lane);
}
__device__ __forceinline__ float sample_scale(const float* Wm, unsigned stride, LAS unsigned char* lds, int wvid, float* rms_out = nullptr) {
    int tid_ = (wvid * 64 + lane_id_asm()); asm volatile("" : "+v"(tid_)); const int tid = tid_, lane = tid & 63;
    const unsigned so = (unsigned)tid * stride;
    const f32x4 v0 = *(const f32x4*)(Wm + so), v1 = *(const f32x4*)(Wm + so + 4);
    float ss = (v0[0] * v0[0] + v0[1] * v0[1]) + (v0[2] * v0[2] + v0[3] * v0[3]) + (v1[0] * v1[0] + v1[1] * v1[1]) + (v1[2] * v1[2] + v1[3] * v1[3]);
    float mx = fmaxf(fmaxf(fmaxf(fabsf(v0[0]), fabsf(v0[1])), fmaxf(fabsf(v0[2]), fabsf(v0[3]))), fmaxf(fmaxf(fabsf(v1[0]), fabsf(v1[1])), fmaxf(fabsf(v1[2]), fabsf(v1[3]))));
    ss = wave_sum(ss, lane);
#pragma unroll
    for (int o = 1; o < 64; o <<= 1) mx = fmaxf(mx, shx(mx, o, lane));
    LAS float* red = (LAS float*)lds;
    __syncthreads();
    if ((tid & 63) == 0) { red[tid >> 6] = ss; red[8 + (tid >> 6)] = mx; }
    __syncthreads();
    float s = 0.f, m = 0.f;
#pragma unroll
    for (int w = 0; w < NWAVES; ++w) { s += red[w]; m = fmaxf(m, red[8 + w]); }
    __syncthreads();
    const float rms = sqrtf(s * (1.0f / 4096.0f)); if (rms_out) *rms_out = rms;
    return fmaxf(fmaxf(6.5f * rms, 1.25f * m), 1e-30f) * (1.0f / 127.0f);
}
__device__ __forceinline__ void p0_calibrate(const P0Args& a, LAS unsigned char* lds, int vcu, int wvid) {
    if (vcu > 2 * NE) return;
    float rms = 0.f;
    const float* Wm = vcu < NE ? a.w_gu + (size_t)vcu * D * 2048 : (vcu == NE ? a.w_pg : a.w_dn + (size_t)(vcu - NE - 1) * D * D);
    const float sc = sample_scale(Wm, vcu < NE ? 4100 : 2044, lds, wvid, &rms);
    if ((wvid * 64 + lane_id_asm()) == 0) { float* scl = (float*)(a.ws + WS_SCL); if (vcu <= NE) scl[vcu] = sc; else scl[128 + vcu - NE - 1] = sc; if (vcu < NE) scl[64 + vcu] = rms; }
}
__device__ __forceinline__ void p0_phase(const P0Args& a, LAS unsigned char* lds, int vcu, int G, int it_lo, int it_hi, bool do_xp, int wvid) {
    int tid_ = (wvid * 64 + lane_id_asm()); asm volatile("" : "+v"(tid_));
    const int tid = tid_, lane = tid & 63, wave = __builtin_amdgcn_readfirstlane(tid >> 6);
    LAS float* scr = (LAS float*)(lds + wave * 16640);
    const int gw = vcu * NWAVES + wave, NGW = G * NWAVES;
    f32x4 va[16], vb[16]; P0Item da, db;
    int it = it_lo + gw;
    if (it < it_hi) { da = p0_decode(a, it); p0_load(da, va, lane); }
    while (it < it_hi) {
        const bool hb = it + NGW < it_hi;
        if (hb) { db = p0_decode(a, it + NGW); p0_load(db, vb, lane); }
        p0_store(da, va, scr, lane);
        if (!hb) break;
        const bool ha = it + 2 * NGW < it_hi;
        if (ha) { da = p0_decode(a, it + 2 * NGW); p0_load(da, va, lane); }
        p0_store(db, vb, scr, lane);
        if (!ha) break;
        it += 2 * NGW;
    }
    if (!do_xp) return;
    p0_calibrate(a, lds, vcu, wvid);
    const int gt = vcu * NTHREADS + tid, NGT = G * NTHREADS;
    for (int t0 = 2 * gw; t0 < M; t0 += 2 * NGW) { f32x4 v[2][4];
#pragma unroll
        for (int x = 0; x < 2; ++x)
#pragma unroll
            for (int j = 0; j < 4; ++j) v[x][j] = __builtin_nontemporal_load((const f32x4*)(a.x + (size_t)(t0 + x) * D + 256 * j + 4 * lane));
#pragma unroll
        for (int x = 0; x < 2; ++x) { float am = 0.f;
#pragma unroll
            for (int j = 0; j < 4; ++j) am = fmaxf(am, fmaxf(fmaxf(fabsf(v[x][j][0]), fabsf(v[x][j][1])), fmaxf(fabsf(v[x][j][2]), fabsf(v[x][j][3]))));
#pragma unroll
            for (int o = 1; o < 64; o <<= 1) am = fmaxf(am, shx(am, o, lane));
            const float sxr = fmaxf(am, 1e-30f) * (1.0f / 127.0f), qi = 1.0f / sxr;
#pragma unroll
            for (int j = 0; j < 4; ++j) { unsigned q = 0u;
#pragma unroll
                for (int z = 0; z < 4; ++z) q |= ((unsigned)(int)rintf(v[x][j][z] * qi) & 0xffu) << (8 * z);
                *(unsigned*)(a.ws + WS_XB + (size_t)(t0 + x) * D + 256 * j + 4 * lane) = q; }
            if (lane == 0) ((float*)(a.ws + WS_SX0))[t0 + x] = sxr; } }
    for (int i = gt; i < M * DPLE / 8; i += 4 * NGT) { f32x4 v[4][2];
#pragma unroll
        for (int u = 0; u < 4; ++u) { const size_t o = (size_t)(i + u * NGT) * 8; v[u][0] = __builtin_nontemporal_load((const f32x4*)(a.p + o)); v[u][1] = __builtin_nontemporal_load((const f32x4*)(a.p + o + 4)); }
#pragma unroll
        for (int u = 0; u < 4; ++u) { u32x4 o; o.x = pk2(v[u][0][0], v[u][0][1]); o.y = pk2(v[u][0][2], v[u][0][3]); o.z = pk2(v[u][1][0], v[u][1][1]); o.w = pk2(v[u][1][2], v[u][1][3]);
            *(u32x4*)((bf16_t*)(a.ws + WS_PB) + (size_t)(i + u * NGT) * 8) = o; } }
}

__device__ __forceinline__ int crow(int r, int hi) { return (r & 3) + 8 * (r >> 2) + 4 * hi; }
typedef short v4i16_t __attribute__((ext_vector_type(4)));
__device__ __forceinline__ s16x4 vtr(const LAS unsigned char* p) { return __builtin_bit_cast(s16x4, __builtin_amdgcn_ds_read_tr16_b64_v4i16((LAS v4i16_t*)p)); }
__device__ __forceinline__ void attn_unit(LAS unsigned char* lds, const bf16_t* Q, const bf16_t* Kg, const bf16_t* Vg, const float* sinks, bf16_t* O, int b, int kvh, int nb, int wvid) {
    int tid_ = (wvid * 64 + lane_id_asm()); asm volatile("" : "+v"(tid_));
    const int tid = tid_, lane = tid & 63, r32 = lane & 31, hi = lane >> 5; const int wid = __builtin_amdgcn_readfirstlane(tid >> 6);
    const int t0 = b * SEQ + nb * 128;
#pragma unroll
    for (int it = 0; it < 4; ++it) { const int idx = tid + it * NTHREADS, key = idx >> 3, c = idx & 7;
        int row = t0 - 128 + key; if (row < b * SEQ) row = b * SEQ;
        const u32x4 kv = *(const u32x4*)(Kg + (size_t)row * 256 + kvh * HD + c * 8);
        const u32x4 vv = *(const u32x4*)(Vg + (size_t)row * 256 + kvh * HD + c * 8);
        *(LAS u32x4*)(lds + c * 4096 + key * 16) = kv;
        *(LAS u32x4*)(lds + 32768 + (c >> 2) * 16384 + (key >> 4) * 1024 + (key & 15) * 64 + (c & 3) * 16) = vv; }
    __syncthreads();
    const int g = wid >> 1, half = wid & 1, h = kvh * 4 + g;
    const float sink2 = sinks[h] * LOG2E;
    const LAS unsigned char* vbase = lds + 32768 + ((lane >> 4) & 1) * 32 + (lane & 3) * 8 + (4 * hi + ((lane & 15) >> 2)) * 64;
#pragma unroll 1
    for (int qq = 0; qq < 2; ++qq) {
        const int qt = half * 2 + qq;
        const bf16_t* qp = Q + (size_t)(t0 + 32 * qt + r32) * D + h * HD + hi * 8;
        bf16x8 qr[4];
#pragma unroll
        for (int d0 = 0; d0 < 4; ++d0) qr[d0] = *(const bf16x8*)(qp + d0 * 16);
        f32x16 s[5];
#pragma unroll
        for (int j = 0; j < 5; ++j) { const LAS unsigned char* kp = lds + hi * 4096 + ((qt + j) * 32 + r32) * 16; f32x16 a = {};
#pragma unroll
            for (int d0 = 0; d0 < 4; ++d0) a = __builtin_amdgcn_mfma_f32_32x32x16_bf16(*(const LAS bf16x8*)(kp + d0 * 8192), qr[d0], a, 0, 0, 0);
            s[j] = a; }
#pragma unroll
        for (int r = 0; r < 16; ++r) { const int cr = crow(r, hi); if (cr <= r32) s[0][r] = -INFINITY; if (cr > r32) s[4][r] = -INFINITY; }
        if (nb == 0) {
#pragma unroll
            for (int j = 0; j < 4; ++j) if (qt + j < 4) {
#pragma unroll
                for (int r = 0; r < 16; ++r) s[j][r] = -INFINITY; } }
        float mx = -INFINITY;
#pragma unroll
        for (int j = 0; j < 5; ++j)
#pragma unroll
            for (int r = 0; r < 16; ++r) mx = fmaxf(mx, s[j][r]);
        mx = fmaxf(mx, shx(mx, 32, lane)); mx = fmaxf(mx, sink2);
        float ls = 0.f;
#pragma unroll
        for (int j = 0; j < 5; ++j)
#pragma unroll
            for (int r = 0; r < 16; ++r) { s[j][r] = __builtin_amdgcn_exp2f(s[j][r] - mx); ls += s[j][r]; }
        ls += shx(ls, 32, lane); ls += __builtin_amdgcn_exp2f(sink2 - mx);
        const float linv = 1.0f / ls;
        f32x16 o[2]; o[0] = f32x16{}; o[1] = f32x16{};
#pragma unroll
        for (int j = 0; j < 5; ++j)
#pragma unroll
            for (int ks = 0; ks < 2; ++ks) {
                u32x4 pw; pw.x = pk2(s[j][8 * ks + 0], s[j][8 * ks + 1]); pw.y = pk2(s[j][8 * ks + 2], s[j][8 * ks + 3]); pw.z = pk2(s[j][8 * ks + 4], s[j][8 * ks + 5]); pw.w = pk2(s[j][8 * ks + 6], s[j][8 * ks + 7]);
                const bf16x8 pa = __builtin_bit_cast(bf16x8, pw);
                const LAS unsigned char* vp = vbase + ((qt + j) * 2 + ks) * 1024;
#pragma unroll
                for (int dh = 0; dh < 2; ++dh) { const s16x4 lo = vtr(vp + dh * 16384), hi4 = vtr(vp + dh * 16384 + 512);
                    const bf16x8 vf = {lo[0], lo[1], lo[2], lo[3], hi4[0], hi4[1], hi4[2], hi4[3]};
                    o[dh] = __builtin_amdgcn_mfma_f32_32x32x16_bf16(pa, vf, o[dh], 0, 0, 0); } }
        LAS bf16_t* stg = (LAS bf16_t*)(lds + 65536 + wid * 4096);
#pragma unroll
        for (int r = 0; r < 16; ++r) { const int q = crow(r, hi); const float sc = shidx(linv, q);
            stg[q * 64 + r32] = (bf16_t)f2bf(o[0][r] * sc); stg[q * 64 + 32 + r32] = (bf16_t)f2bf(o[1][r] * sc); }
        asm volatile("s_waitcnt lgkmcnt(0)" ::: "memory");
        bf16_t* ob = O + (size_t)(t0 + 32 * qt) * D + h * HD;
#pragma unroll
        for (int i = 0; i < 4; ++i) { const int row = i * 8 + (lane >> 3), ch = lane & 7;
            *(u32x4*)(ob + (size_t)row * D + ch * 8) = *(const LAS u32x4*)(stg + row * 64 + ch * 8); }
        asm volatile("s_waitcnt lgkmcnt(0)" ::: "memory");
    }
    __syncthreads();
}
__device__ __forceinline__ void conv_phase(const bf16_t* Bg, const bf16_t* U, const float* cw, bf16_t* Z, int vcu, int G, int wvid) {
    int tid_ = (wvid * 64 + lane_id_asm()); asm volatile("" : "+v"(tid_));
    const int gt = vcu * NTHREADS + tid_, NGT = G * NTHREADS;
    for (int i = gt; i < (M / 8) * (D / 8); i += NGT) {
        const int t0 = (i >> 7) * 8, c = (i & 127) * 8, tl0 = t0 & (SEQ - 1);
        f32x4 w[3][2];
#pragma unroll
        for (int k = 0; k < 3; ++k) { w[k][0] = *(const f32x4*)(cw + k * D + c); w[k][1] = *(const f32x4*)(cw + k * D + c + 4); }
        u32x4 ur[10], br[8];
#pragma unroll
        for (int r = 0; r < 10; ++r) { if (r >= 2 || tl0 != 0) ur[r] = *(const u32x4*)(U + (size_t)(t0 + r - 2) * D + c); else ur[r] = (u32x4){0u, 0u, 0u, 0u}; }
#pragma unroll
        for (int r = 0; r < 8; ++r) br[r] = *(const u32x4*)(Bg + (size_t)(t0 + r) * D + c);
#pragma unroll
        for (int r = 0; r < 8; ++r) { float y[8];
#pragma unroll
            for (int j = 0; j < 8; ++j) y[j] = 0.f;
#pragma unroll
            for (int k = 0; k < 3; ++k) { const u32x4 uw = ur[r + k];
                y[0] += w[k][0][0] * bflo(uw.x); y[1] += w[k][0][1] * bfhi(uw.x); y[2] += w[k][0][2] * bflo(uw.y); y[3] += w[k][0][3] * bfhi(uw.y);
                y[4] += w[k][1][0] * bflo(uw.z); y[5] += w[k][1][1] * bfhi(uw.z); y[6] += w[k][1][2] * bflo(uw.w); y[7] += w[k][1][3] * bfhi(uw.w); }
            const u32x4 bw = br[r];
            u32x4 o; o.x = pk2(y[0] * bflo(bw.x), y[1] * bfhi(bw.x)); o.y = pk2(y[2] * bflo(bw.y), y[3] * bfhi(bw.y)); o.z = pk2(y[4] * bflo(bw.z), y[5] * bfhi(bw.z)); o.w = pk2(y[6] * bflo(bw.w), y[7] * bfhi(bw.w));
            *(u32x4*)(Z + (size_t)(t0 + r) * D + c) = o; }
    }
}
#ifndef DBG_ATTN
#define DBG_ATTN 0
#endif
#if DBG_ATTN
__device__ __forceinline__ void dbg_attn_check(const bf16_t* Q, const bf16_t* Kg, const bf16_t* Vg, const float* sinks, const bf16_t* O, float* acc3, int vcu, int G, int wvid) {
    const int lane = (wvid * 64 + lane_id_asm()) & 63, wave = wvid;
    const int gw = vcu * NWAVES + wave, nw = G * NWAVES;
    float lnum = 0.f, lden = 0.f, lmax = 0.f;
    for (int it = gw; it < M * NH; it += nw) {
        const int t = it / NH, h = it % NH, kvh = h / 4, tl = t % SEQ;
        const int slo = tl - 127 < 0 ? 0 : tl - 127, n = tl - slo + 1;
        const bf16_t* qp = Q + (size_t)t * D + h * HD;
        float sc[2];
#pragma unroll
        for (int u = 0; u < 2; ++u) { const int j = lane + 64 * u; float dot = -INFINITY;
            if (j < n) { const bf16_t* kp = Kg + (size_t)(t - tl + slo + j) * 256 + kvh * HD; dot = 0.f;
                for (int d = 0; d < HD; ++d) dot = fmaf(bflo((unsigned)qp[d]), bflo((unsigned)kp[d]), dot);
                dot *= (1.0f / LOG2E); }
            sc[u] = dot; }
        const float sink = sinks[h];
        float m = fmaxf(sc[0], sc[1]);
        for (int o = 1; o < 64; o <<= 1) m = fmaxf(m, shx(m, o, lane));
        m = fmaxf(m, sink);
        float e0 = (lane < n) ? expf(sc[0] - m) : 0.f, e1 = (lane + 64 < n) ? expf(sc[1] - m) : 0.f;
        float s = e0 + e1;
        for (int o = 1; o < 64; o <<= 1) s += shx(s, o, lane);
        const float denom = s + expf(sink - m);
        e0 /= denom; e1 /= denom;
        float a = 0.f;
        for (int j = 0; j < n; ++j) { const float pj = shidx(j < 64 ? e0 : e1, j & 63); a = fmaf(pj, bflo((unsigned)Vg[(size_t)(t - tl + slo + j) * 256 + kvh * HD + lane]), a); }
        const float o = bflo((unsigned)O[(size_t)t * D + h * HD + lane]);
        const float rn = wave_sum((o - a) * (o - a), lane), rd = wave_sum(a * a, lane);
        lnum += rn; lden += rd; lmax = fmaxf(lmax, rn / fmaxf(rd, 1e-20f));
    }
    if (lane == 0) { atomicAdd(acc3, lnum); atomicAdd(acc3 + 1, lden); atomicMax((unsigned*)(acc3 + 2), __float_as_uint(lmax)); }
}
#endif
constexpr int WR_STRIDE = 1028;
struct RouteArgs { float* X1F; bf16_t* X1B; const float *g1, *b1, *w_r, *b_r; int* gcnt; int* list_tok; float* list_w; int* tk_e; int* tk_rank; float* tk_w; unsigned char* XQ; float* sx1; float* list_sx; float* list_hs; const float* scl; };
__device__ __forceinline__ void route_phase(const RouteArgs& a, LAS unsigned char* lds, int vcu, int G, bool dry, int wvid) {
    int tid_ = (wvid * 64 + lane_id_asm()); asm volatile("" : "+v"(tid_));
    const int tid = tid_, lane = tid & 63, wave = __builtin_amdgcn_readfirstlane(tid >> 6);
    LAS float* wrt = (LAS float*)lds;
    LAS int* misc = (LAS int*)(lds + MISC_OFF);
    LAS int* lcnt = misc + 96; LAS int* gbase = misc + 128; LAS int* rowe = misc + 160; LAS float* roww = (LAS float*)(misc + 416); LAS float* rowsx = (LAS float*)(misc + 672); LAS float* rownrm = (LAS float*)(misc + 736);
    for (int i = tid; i < D * NE; i += NTHREADS) { const int c = i >> 5, e = i & 31; wrt[e * WR_STRIDE + c] = a.w_r[i]; }
    if (tid < NE) lcnt[tid] = 0;
    __syncthreads();
    const int rows_per_wg = M / G;
    for (int rr = 2 * wave; rr < rows_per_wg; rr += 2 * NWAVES) {
        f32x4 v[2][4];
#pragma unroll
        for (int x = 0; x < 2; ++x) { const int t = vcu * rows_per_wg + rr + x; float s = 0.f;
#pragma unroll
            for (int j = 0; j < 4; ++j) { v[x][j] = *(const f32x4*)(a.X1F + (size_t)t * D + 256 * j + 4 * lane); s += (v[x][j][0] + v[x][j][1]) + (v[x][j][2] + v[x][j][3]); }
            const float mean = wave_sum(s, lane) * (1.0f / D); float q = 0.f;
#pragma unroll
            for (int j = 0; j < 4; ++j) { v[x][j] = v[x][j] - mean; q += (v[x][j][0] * v[x][j][0] + v[x][j][1] * v[x][j][1]) + (v[x][j][2] * v[x][j][2] + v[x][j][3] * v[x][j][3]); }
            const float rstd = 1.0f / sqrtf(wave_sum(q, lane) * (1.0f / D) + LN_EPS);
#pragma unroll
            for (int j = 0; j < 4; ++j) { const f32x4 gg = *(const f32x4*)(a.g1 + 256 * j + 4 * lane), bb = *(const f32x4*)(a.b1 + 256 * j + 4 * lane);
                v[x][j] = v[x][j] * rstd * gg + bb;
                if (!dry) { u32x2 w; w.x = pk2(v[x][j][0], v[x][j][1]); w.y = pk2(v[x][j][2], v[x][j][3]); *(u32x2*)(a.X1B + (size_t)t * D + 256 * j + 4 * lane) = w; } }
            float am = 0.f;
#pragma unroll
            for (int j = 0; j < 4; ++j) am = fmaxf(am, fmaxf(fmaxf(fabsf(v[x][j][0]), fabsf(v[x][j][1])), fmaxf(fabsf(v[x][j][2]), fabsf(v[x][j][3]))));
#pragma unroll
            for (int o = 1; o < 64; o <<= 1) am = fmaxf(am, shx(am, o, lane));
            const float sxr = fmaxf(am, 1e-30f) * (1.0f / 127.0f), qi = 1.0f / sxr;
            if (!dry) {
#pragma unroll
                for (int j = 0; j < 4; ++j) { unsigned q = 0u;
#pragma unroll
                    for (int z = 0; z < 4; ++z) q |= ((unsigned)(int)rintf(v[x][j][z] * qi) & 0xffu) << (8 * z);
                    *(unsigned*)(a.XQ + (size_t)t * D + 256 * j + 4 * lane) = q; }
                if (lane == 0) { a.sx1[t] = sxr; rowsx[rr + x] = sxr; } }
            { float ssq = 0.f;
#pragma unroll
              for (int j = 0; j < 4; ++j) ssq += (v[x][j][0] * v[x][j][0] + v[x][j][1] * v[x][j][1]) + (v[x][j][2] * v[x][j][2] + v[x][j][3] * v[x][j][3]);
              ssq = wave_sum(ssq, lane); if (lane == 0) rownrm[rr + x] = sqrtf(ssq); } }
        float pl[2][32];
#pragma unroll
        for (int e = 0; e < 32; ++e) { float a0 = 0.f, a1 = 0.f;
#pragma unroll
            for (int j = 0; j < 4; ++j) { const f32x4 w = *(const LAS f32x4*)(wrt + e * WR_STRIDE + 256 * j + 4 * lane);
                a0 += (v[0][j][0] * w[0] + v[0][j][1] * w[1]) + (v[0][j][2] * w[2] + v[0][j][3] * w[3]); a1 += (v[1][j][0] * w[0] + v[1][j][1] * w[1]) + (v[1][j][2] * w[2] + v[1][j][3] * w[3]); }
            pl[0][e] = a0; pl[1][e] = a1; }
#pragma unroll
        for (int o = 32, n = 16; o >= 2; o >>= 1, n >>= 1) { const bool up = (lane & o) != 0;
#pragma unroll
            for (int i = 0; i < 16; ++i) if (i < n) {
#pragma unroll
                for (int x = 0; x < 2; ++x) { const float send = up ? pl[x][i] : pl[x][i + n], keep = up ? pl[x][i + n] : pl[x][i]; pl[x][i] = keep + shx(send, o, lane); } } }
        const int myexp = lane >> 1; const float brv = a.b_r[myexp];
        float logit[2];
#pragma unroll
        for (int x = 0; x < 2; ++x) logit[x] = pl[x][0] + shx(pl[x][0], 1, lane) + brv;
        int se[2][4]; float sv[2][4];
#pragma unroll
        for (int k = 0; k < 4; ++k) { float bv[2]; int bi[2];
#pragma unroll
            for (int x = 0; x < 2; ++x) { bv[x] = logit[x]; bi[x] = myexp; }
#pragma unroll
            for (int o = 1; o < 64; o <<= 1) {
#pragma unroll
                for (int x = 0; x < 2; ++x) { const float ov = shx(bv[x], o, lane); const int oi = shxi(bi[x], o, lane); if (ov > bv[x] || (ov == bv[x] && oi < bi[x])) { bv[x] = ov; bi[x] = oi; } } }
#pragma unroll
            for (int x = 0; x < 2; ++x) { se[x][k] = bi[x]; sv[x][k] = bv[x]; if (myexp == bi[x]) logit[x] = -INFINITY; } }
#pragma unroll
        for (int x = 0; x < 2; ++x) { const float e1 = __expf(sv[x][1] - sv[x][0]), e2 = __expf(sv[x][2] - sv[x][0]), e3 = __expf(sv[x][3] - sv[x][0]);
            const float inv = 1.0f / (1.0f + e1 + e2 + e3);
            if (lane < 4) { const int e = lane == 0 ? se[x][0] : lane == 1 ? se[x][1] : lane == 2 ? se[x][2] : se[x][3];
                const float w = (lane == 0 ? 1.0f : lane == 1 ? e1 : lane == 2 ? e2 : e3) * inv;
                rowe[(rr + x) * 4 + lane] = e; roww[(rr + x) * 4 + lane] = w; } }
    }
    __syncthreads();
    if (dry) return;
    const int nent = rows_per_wg * 4;
    int my_e = 0, my_lr = 0;
    if (tid < nent) { my_e = rowe[tid]; my_lr = atomicAdd((int*)(lcnt + my_e), 1); }
    __syncthreads();
    if (tid < NE) gbase[tid] = atomicAdd(a.gcnt + tid, lcnt[tid]);
    __syncthreads();
    if (tid < nent) { const int t = vcu * rows_per_wg + (tid >> 2), rank = gbase[my_e] + my_lr;
        const float sig = rownrm[tid >> 2] * a.scl[64 + my_e], clip = fmaxf((1.0f + 3.5f * sig) * (3.5f * sig), 1e-20f);
        const float qh = bfhi(f2bf(127.0f / clip) << 16);
        a.list_tok[(size_t)my_e * LISTCAP + rank] = t; a.list_w[(size_t)my_e * LISTCAP + rank] = qh; a.list_sx[(size_t)my_e * LISTCAP + rank] = rowsx[tid >> 2];
        a.list_hs[(size_t)my_e * LISTCAP + rank] = roww[tid] / qh;
        a.tk_e[t * 4 + (tid & 3)] = my_e; a.tk_rank[t * 4 + (tid & 3)] = rank; a.tk_w[t * 4 + (tid & 3)] = roww[tid]; }
    __syncthreads();
}
__device__ __forceinline__ void build_tables(const int* gcnt, LAS unsigned char* lds, int wvid) {
    LAS int* misc = (LAS int*)(lds + MISC_OFF);
    const int tid = wvid * 64 + lane_id_asm();
    if (tid < NE) misc[tid] = __hip_atomic_load(gcnt + tid, __ATOMIC_RELAXED, __HIP_MEMORY_SCOPE_AGENT);
    __syncthreads();
    if (tid == 0) { int a = 0; for (int e = 0; e < NE; ++e) { misc[32 + e] = a; a += (misc[e] + 255) >> 8; } misc[32 + NE] = a; }
    __syncthreads();
}
struct FinalArgs { float dbg_scale; int pad_; const bf16_t* X1B; const bf16_t* PLE; const bf16_t* Y; const int* tk_e; const int* tk_rank; const float* tk_w; const float* b_down; const float *g2, *b2; float* out; };
__device__ __forceinline__ void final_phase(const FinalArgs& a, LAS unsigned char* lds, int vcu, int G, int wvid) {
    int tid_ = (wvid * 64 + lane_id_asm()); asm volatile("" : "+v"(tid_));
    const int tid = tid_, lane = tid & 63, wave = __builtin_amdgcn_readfirstlane(tid >> 6);
    const LAS int* ts = (const LAS int*)(lds + MISC_OFF) + 32;
    LAS float* bdl = (LAS float*)lds;
    for (int i = tid; i < NE * D / 4; i += NTHREADS) *(LAS f32x4*)(bdl + 4 * i) = *(const f32x4*)(a.b_down + 4 * i);
    __syncthreads();
    const int gw = vcu * NWAVES + wave, NGW = G * NWAVES;
    for (int t0 = 2 * gw; t0 < M; t0 += 2 * NGW) {
        size_t pos[2][4]; int ek[2][4]; float wk[2][4];
#pragma unroll
        for (int x = 0; x < 2; ++x)
#pragma unroll
            for (int k = 0; k < 4; ++k) { const int t = t0 + x, e = a.tk_e[t * 4 + k], rk = a.tk_rank[t * 4 + k]; pos[x][k] = ((size_t)ts[e] * 256 + rk) * D; ek[x][k] = e * D; wk[x][k] = a.tk_w[t * 4 + k]; }
        f32x4 v[2][4]; float s[2] = {0.f, 0.f};
#pragma unroll
        for (int x = 0; x < 2; ++x)
#pragma unroll
            for (int j = 0; j < 4; ++j) { const int c = 256 * j + 4 * lane; const size_t ro = (size_t)(t0 + x) * D + c;
                const u32x2 xw = *(const u32x2*)(a.X1B + ro), pw = *(const u32x2*)(a.PLE + ro);
                f32x4 xx = {bflo(xw.x) * DN_ALPHA + bflo(pw.x), bfhi(xw.x) * DN_ALPHA + bfhi(pw.x), bflo(xw.y) * DN_ALPHA + bflo(pw.y), bfhi(xw.y) * DN_ALPHA + bfhi(pw.y)};
#pragma unroll
                for (int k = 0; k < 4; ++k) { const u32x2 yw = *(const u32x2*)(a.Y + pos[x][k] + c); const f32x4 bd = *(const LAS f32x4*)(bdl + ek[x][k] + c);
                    xx[0] += bflo(yw.x) + wk[x][k] * bd[0]; xx[1] += bfhi(yw.x) + wk[x][k] * bd[1]; xx[2] += bflo(yw.y) + wk[x][k] * bd[2]; xx[3] += bfhi(yw.y) + wk[x][k] * bd[3]; }
                v[x][j] = xx; s[x] += (xx[0] + xx[1]) + (xx[2] + xx[3]); }
#pragma unroll
        for (int x = 0; x < 2; ++x) { const float mean = wave_sum(s[x], lane) * (1.0f / D); float q = 0.f;
#pragma unroll
            for (int j = 0; j < 4; ++j) { v[x][j] = v[x][j] - mean; q += (v[x][j][0] * v[x][j][0] + v[x][j][1] * v[x][j][1]) + (v[x][j][2] * v[x][j][2] + v[x][j][3] * v[x][j][3]); }
            const float rstd = 1.0f / sqrtf(wave_sum(q, lane) * (1.0f / D) + LN_EPS);
#pragma unroll
            for (int j = 0; j < 4; ++j) { const int c = 256 * j + 4 * lane; const f32x4 gg = *(const f32x4*)(a.g2 + c), bb = *(const f32x4*)(a.b2 + c);
                *(f32x4*)(a.out + (size_t)(t0 + x) * D + c) = (v[x][j] * rstd * gg + bb) * a.dbg_scale; } }
    }
}

#ifndef PROBE_STAMP
#define PROBE_STAMP -1
#endif
#define STAMP(k) do { if (PROBE_STAMP >= 0 && bx == 0 && (wvid * 64 + lane_id_asm()) == 0) __hip_atomic_store(WSP(unsigned long long, WS_CTL + 32768) + (k), (unsigned long long)__builtin_amdgcn_s_memrealtime(), __ATOMIC_RELAXED, __HIP_MEMORY_SCOPE_AGENT); } while (0)
#define PROBE_SCALE 2.5e-5f
#ifndef PROBE_REP
#define PROBE_REP 0
#endif
struct Args { const float* in[20]; float* out; unsigned char* ws; };
__global__ void __launch_bounds__(NTHREADS, 2) mega_fwd(Args args) {
    extern __shared__ __attribute__((aligned(16))) unsigned char lds_raw[];
    LAS unsigned char* lds = (LAS unsigned char*)lds_raw;
    cg::grid_group grid = cg::this_grid();
    const int G = gridDim.x, bx = blockIdx.x;
    const int wvid = __builtin_amdgcn_readfirstlane((int)threadIdx.x >> 6);
    const int vcu = (G % 8 == 0) ? (bx % 8) * (G / 8) + bx / 8 : bx;
    unsigned char* const ws = args.ws;
    const LAS int* cntL = (const LAS int*)(lds + MISC_OFF); const LAS int* tsL = cntL + 32;
    { volatile LAS unsigned* bst = (volatile LAS unsigned*)(lds + MISC_OFF) + BST_IDX;
      { int t_ = (wvid * 64 + lane_id_asm()); asm volatile("" : "+v"(t_)); if (t_ < 2) bst[t_] = 0u; }
      __syncthreads();
    }
    if (bx == 0) { const int t0_ = wvid * 64 + lane_id_asm(); for (int i_ = t0_; i_ < (int)(CTL_ZERO_BYTES / 16); i_ += NTHREADS) ((u32x4*)(ws + WS_CTL))[i_] = (u32x4){0u, 0u, 0u, 0u}; }
#define GRID_BAR() do { XcdBarrier b_; b_.bar = (unsigned*)(ws + WS_BAR); b_.x = xb_xcc_id(); b_.st = (volatile LAS unsigned*)(lds + MISC_OFF) + BST_IDX; b_.lead = ((wvid * 64 + lane_id_asm()) == 0); xcd_barrier(b_); if (PROBE_REP & 0x80000) xcd_barrier(b_); } while (0)
#define WSP(T, off) ((T*)(ws + (off)))
#define GRID_BAR_F(seam) do { XcdBarrier b_; b_.bar = (unsigned*)(ws + WS_BAR); b_.x = xb_xcc_id(); b_.st = (volatile LAS unsigned*)(lds + MISC_OFF) + BST_IDX; b_.lead = ((wvid * 64 + lane_id_asm()) == 0); \
    asm volatile("s_waitcnt vmcnt(0)" ::: "memory"); __syncthreads(); \
    if (wvid == 0) xcd_barrier_lead(b_); \
    else { P0Args a_{args.in[0], args.in[1], args.in[2], args.in[4], args.in[5], args.in[7], args.in[17], args.in[16], args.in[12], args.in[14], ws, 1.0f, 1.0f}; p0_fill(a_, lds, vcu, G, seam, wvid); } \
    __syncthreads(); } while (0)

    STAMP(0);
    {
      const float s_in = __builtin_bit_cast(float, __builtin_amdgcn_readfirstlane(__builtin_bit_cast(int, sample_scale(args.in[2], 13308, lds, wvid))));
      if ((wvid * 64 + lane_id_asm()) == 0) WSP(float, WS_SCL)[161] = s_in;
    _Pragma("unroll 1") for (int rep_ = 0; rep_ < ((PROBE_REP & 1) ? 2 : 1); ++rep_) { P0Args a{args.in[0], args.in[1], args.in[2], args.in[4], args.in[5], args.in[7], args.in[17], args.in[16], args.in[12], args.in[14], ws, s_in, 0.0f}; p0_phase(a, lds, vcu, G, 0, P0_NSMALL, true, wvid); } }
#if (PROBE_REP & 0x200000)
    { u32x4* z_ = (u32x4*)(ws + WS_R); const int gt_ = vcu * NTHREADS + wvid * 64 + lane_id_asm(); for (size_t i_ = gt_; i_ < (176 * MiB) / 16; i_ += (size_t)G * NTHREADS) z_[i_] = (u32x4){0u, 0u, 0u, 0u}; }
#endif
    grid.sync();
    (void)xcd_barrier_post((unsigned*)(ws + WS_BAR), (volatile LAS unsigned*)(lds + MISC_OFF) + BST_IDX, (wvid * 64 + lane_id_asm()) == 0);
    STAMP(1);
    { constexpr int U1 = (M / 256) * (NIN / 256); const int R1 = U1 % G, nidle = R1 ? G - R1 : G, per = 256 / nidle;
      if (R1 == 0 || bx >= R1) {
        pg8::Gemm g{WSP(bf16_t, WS_PB), (const bf16_t*)(ws + WS_WPP), DPLE}; pg8::Ple1Order S{(bx - R1) * per, per};
        pg8::EpiF32 E{WSP(float, WS_P2)};
        pg8::gemm_phase<pg8::EpiF32, pg8::Ple1Order, false>(lds, g, S, E, wvid); } }
    _Pragma("unroll 1") for (int rep_ = 0; rep_ < ((PROBE_REP & 2) ? 2 : 1); ++rep_) { pg8::Gemm g{WSP(bf16_t, WS_XB), (const bf16_t*)(ws + WS_WIN), D / 2}; pg8::StaticOrder S; S.init(M / 256, NIN / 256, G, bx, 1);
      const float s_in1 = __builtin_bit_cast(float, __builtin_amdgcn_readfirstlane(__builtin_bit_cast(int, WSP(float, WS_SCL)[161])));
      pg8::EpiInProjI8 E{ws, s_in1};
      pg8::gemm_phase<pg8::EpiInProjI8, pg8::StaticOrder, true, 0, true>(lds, g, S, E, wvid);
#if (PROBE_REP & 0x1000000)
      pg8::gemm_phase<pg8::EpiInProjI8, pg8::StaticOrder, true, 1, true>(lds, g, S, E, wvid);
#endif
#if (PROBE_REP & 0x2000000)
      pg8::gemm_phase<pg8::EpiInProjI8, pg8::StaticOrder, true, 2, true>(lds, g, S, E, wvid);
#endif
      }
    GRID_BAR_F(1);
    STAMP(2);
    if (PROBE_REP & 4096) { _Pragma("unroll 1") for (int k_ = 0; k_ < 8; ++k_) GRID_BAR(); }
    _Pragma("unroll 1") for (int rep_ = 0; rep_ < ((PROBE_REP & 4) ? 2 : 1); ++rep_) for (int it = vcu; it < BATCH * NKV * (SEQ / 128); it += G) { const int nb = it & 63, kvh = (it >> 6) & 3, b = it >> 8;
        attn_unit(lds, WSP(bf16_t, WS_Q), WSP(bf16_t, WS_K), WSP(bf16_t, WS_V), args.in[6], WSP(bf16_t, WS_ZO) + (size_t)M * D, b, kvh, nb, wvid); }
    _Pragma("unroll 1") for (int rep_ = 0; rep_ < ((PROBE_REP & 8) ? 2 : 1); ++rep_) conv_phase(WSP(bf16_t, WS_BG), WSP(bf16_t, WS_U), args.in[3], WSP(bf16_t, WS_ZO), vcu, G, wvid);
    GRID_BAR_F(2);
    STAMP(3);
#if DBG_ATTN
    dbg_attn_check(WSP(bf16_t, WS_Q), WSP(bf16_t, WS_K), WSP(bf16_t, WS_V), args.in[6], WSP(bf16_t, WS_ZO) + (size_t)M * D, WSP(float, WS_CTL) + 64, vcu, G, wvid);
#endif
    _Pragma("unroll 1") for (int rep_ = 0; rep_ < ((PROBE_REP & 16) ? 2 : 1); ++rep_) { pg8::Gemm g{WSP(bf16_t, WS_ZO), (const bf16_t*)(ws + WS_WBR), D}; pg8::DualOrder S; S.so.init(M / 256, D / 256, G, bx);
      pg8::EpiDual E{ws};
      pg8::gemm_phase<pg8::EpiDual, pg8::DualOrder, true>(lds, g, S, E, wvid); }
    GRID_BAR_F(3);
    STAMP(4);
    _Pragma("unroll 1") for (int rep_ = 0; rep_ < ((PROBE_REP & 32) ? 2 : 1); ++rep_) { pg8::Gemm g{WSP(bf16_t, WS_MG), (const bf16_t*)(ws + WS_WOUT), D}; pg8::StaticOrder S; S.init(M / 256, D / 256, G, bx);
      pg8::EpiResid E{args.in[0], WSP(float, WS_X1F)};
      pg8::gemm_phase<pg8::EpiResid, pg8::StaticOrder, false>(lds, g, S, E, wvid); }
    GRID_BAR_F(4);
    STAMP(5);
    { P0Args a{args.in[0], args.in[1], args.in[2], args.in[4], args.in[5], args.in[7], args.in[17], args.in[16], args.in[12], args.in[14], ws, 1.0f, 1.0f}; p0_phase(a, lds, vcu, G, P0_NSMALL + P0_FILL_SEAMS * G * 7 * P0_FILL, P0_NITEMS - G * 7 * P0_FILL, false, wvid); __syncthreads();
      if (PROBE_REP & 0x40000) { p0_phase(a, lds, vcu, G, P0_NSMALL, P0_NITEMS, false, wvid); __syncthreads(); } }
    _Pragma("unroll 1") for (int rep_ = ((PROBE_REP & 64) ? 0 : 1); rep_ < 2; ++rep_) { RouteArgs a{WSP(float, WS_X1F), WSP(bf16_t, WS_X1B), args.in[8], args.in[9], args.in[10], args.in[11], WSP(int, WS_CTL), WSP(int, WS_LTOK), WSP(float, WS_LW), WSP(int, WS_TKE), WSP(int, WS_TKR), WSP(float, WS_TKW), ws + WS_XQ, WSP(float, WS_SX1), WSP(float, WS_LSX), WSP(float, WS_LHS), WSP(float, WS_SCL)}; route_phase(a, lds, vcu, G, rep_ == 0, wvid); }
    GRID_BAR_F(5);
    STAMP(6);
    build_tables(WSP(int, WS_CTL), lds, wvid);
    { const int nx5_ = __builtin_amdgcn_readfirstlane(pg8::MoeOrder::ple_in_p5(tsL, G));
      pg8::MoeOrder S; S.init(cntL, tsL, (const LAS unsigned*)(lds + TW_OFF), 8, G, bx, 1, WS_XQ, WS_WGU, nx5_, 0, WS_XQ, WS_WPG8, 18); S.build_units((LAS int*)(lds + UTAB_OFF), 12, wvid * 64 + lane_id_asm(), vcu, 1);
      pg8::moe_preload(S, cntL, WSP(int, WS_LTOK), WSP(float, WS_LW), (LAS unsigned*)(lds + TW_OFF), wvid);
      _Pragma("unroll 1") for (int rep_ = 0; rep_ < ((PROBE_REP & 128) ? 2 : 1); ++rep_) { pg8::Gemm g{(const bf16_t*)ws, (const bf16_t*)ws, D / 2};
        pg8::EpiSwigluI8 E{WSP(bf16_t, WS_H), args.in[13], (const LAS unsigned*)(lds + TW_OFF), ws};
        pg8::gemm_phase<pg8::EpiSwigluI8, pg8::MoeOrder, true, 0, true>(lds, g, S, E, wvid);
#if (PROBE_REP & 0x400000)
        pg8::gemm_phase<pg8::EpiSwigluI8, pg8::MoeOrder, true, 1, true>(lds, g, S, E, wvid);
#endif
#if (PROBE_REP & 0x800000)
        pg8::gemm_phase<pg8::EpiSwigluI8, pg8::MoeOrder, true, 2, true>(lds, g, S, E, wvid);
#endif
        } }
    GRID_BAR();
    STAMP(7);
    _Pragma("unroll 1") for (int rep_ = 0; rep_ < ((PROBE_REP & 1024) ? 2 : 1); ++rep_) { pg8::Gemm g{(const bf16_t*)ws, (const bf16_t*)ws, D / 2};
      const int nx5_ = __builtin_amdgcn_readfirstlane(pg8::MoeOrder::ple_in_p5(tsL, G));
      pg8::MoeOrder S; S.init(cntL, tsL, (const LAS unsigned*)(lds + TW_OFF), 4, G, bx, 0, WS_H, WS_WDN, 256 - nx5_, nx5_, WS_XQ, WS_WPG8, 18); S.build_units((LAS int*)(lds + UTAB_OFF), 12, wvid * 64 + lane_id_asm(), vcu, 2);
      pg8::EpiDownI8 E{WSP(bf16_t, WS_Y), ws, cntL};
      pg8::gemm_phase<pg8::EpiDownI8, pg8::MoeOrder, true, 0, true>(lds, g, S, E, wvid); }
    STAMP(8);
    GRID_BAR();
    STAMP(9);
    _Pragma("unroll 1") for (int rep_ = 0; rep_ < ((PROBE_REP & 2048) ? 2 : 1); ++rep_) { float dbgs_ = 1.0f;
      if (PROBE_STAMP >= 0) { const unsigned long long* st_ = WSP(unsigned long long, WS_CTL + 32768); const float dt_us = (float)(long long)(__hip_atomic_load(st_ + PROBE_STAMP + 1, __ATOMIC_RELAXED, __HIP_MEMORY_SCOPE_AGENT) - __hip_atomic_load(st_ + PROBE_STAMP, __ATOMIC_RELAXED, __HIP_MEMORY_SCOPE_AGENT)) * 0.01f; dbgs_ = 1.0f + sqrtf(dt_us * PROBE_SCALE); }
#if DBG_ATTN
      { const float* a3 = WSP(float, WS_CTL) + 64; const float num = __hip_atomic_load(a3, __ATOMIC_RELAXED, __HIP_MEMORY_SCOPE_AGENT), den = __hip_atomic_load(a3 + 1, __ATOMIC_RELAXED, __HIP_MEMORY_SCOPE_AGENT), mx = __hip_atomic_load(a3 + 2, __ATOMIC_RELAXED, __HIP_MEMORY_SCOPE_AGENT);
        dbgs_ = 1.0f + sqrtf(100.0f * (DBG_ATTN == 1 ? num / den : mx)); }
#endif
      FinalArgs a{dbgs_, 0, WSP(bf16_t, WS_X1B), WSP(bf16_t, WS_PLE), WSP(bf16_t, WS_Y), WSP(int, WS_TKE), WSP(int, WS_TKR), WSP(float, WS_TKW), args.in[15], args.in[18], args.in[19], args.out}; final_phase(a, lds, vcu, G, wvid); }
}

extern "C" void kernel_launch(void* const* d_in, const int* in_sizes, int n_in, void* d_out, int out_size, void* d_ws, size_t ws_size, hipStream_t stream) {
    static int grid = 0;
    if (grid == 0) {
        if (n_in != 20 || out_size != M * D || ws_size < WS_END) { fprintf(stderr, "kernel_launch: unexpected sizes (n_in %d, out %d, ws %zu < %zu)\n", n_in, out_size, ws_size, (size_t)WS_END); grid = -1; return; }
        int dev = 0, cus = 0, per_cu = 0;
        if (hipGetDevice(&dev) != hipSuccess || hipDeviceGetAttribute(&cus, hipDeviceAttributeMultiprocessorCount, dev) != hipSuccess) { grid = -1; return; }
        if (hipFuncSetAttribute((const void*)mega_fwd, hipFuncAttributeMaxDynamicSharedMemorySize, LDS_BYTES) != hipSuccess) { fprintf(stderr, "kernel_launch: hipFuncSetAttribute failed\n"); grid = -1; return; }
        if (hipOccupancyMaxActiveBlocksPerMultiprocessor(&per_cu, (const void*)mega_fwd, NTHREADS, LDS_BYTES) != hipSuccess || per_cu < 1) { fprintf(stderr, "kernel_launch: occupancy query says %d blocks per CU\n", per_cu); grid = -1; return; }
        grid = cus;
        if (grid != 256) fprintf(stderr, "kernel_launch: note: %d CUs (built and tuned for 256)\n", grid);
    }
    if (grid < 0) return;
    Args a{};
    for (int i = 0; i < 20; ++i) a.in[i] = (const float*)d_in[i];
    a.out = (float*)d_out; a.ws = (unsigned char*)d_ws;
    void* kargs[] = {&a};
    const hipError_t e = hipLaunchCooperativeKernel((const void*)mega_fwd, dim3(grid), dim3(NTHREADS), kargs, LDS_BYTES, stream);
    if (e != hipSuccess) fprintf(stderr, "kernel_launch: cooperative launch failed: %s (grid %d)\n", hipGetErrorString(e), grid);
}
```

```cpp
#include <hip/hip_runtime.h>
#include <hip/hip_cooperative_groups.h>
#include <cstdio>
#include <cstdint>
namespace cg = cooperative_groups;

#define LAS __attribute__((address_space(3)))
typedef unsigned short bf16_t;
typedef short bf16x8 __attribute__((ext_vector_type(8)));
typedef short s16x4 __attribute__((ext_vector_type(4)));
typedef float f32x4 __attribute__((ext_vector_type(4)));
typedef float f32x16 __attribute__((ext_vector_type(16)));
typedef unsigned u32x4 __attribute__((ext_vector_type(4)));
typedef unsigned u32x2 __attribute__((ext_vector_type(2)));

constexpr int BATCH = 2, SEQ = 8192, M = BATCH * SEQ, D = 1024, NIN = 6656, NE = 32, DPLE = 256, NH = 16, HD = 64, NKV = 4;
constexpr float DN_ALPHA = 1.189207115002721f, LN_EPS = 1e-5f, LOG2E = 1.4426950408889634f;
constexpr float QSCALE = 0.125f * LOG2E;
constexpr int LISTCAP = M;
constexpr int MAXTILES = (M * 4) / 256 + NE;
constexpr int NWAVES = 8, NTHREADS = 512;

constexpr size_t MiB = 1u << 20;
constexpr size_t WS_CTL = 0;
constexpr size_t WS_BAR = 16384, CTL_ZERO_BYTES = 65536;
constexpr size_t WS_TKE = 1 * MiB, WS_TKR = 2 * MiB, WS_TKW = 3 * MiB;
constexpr size_t WS_LTOK = 4 * MiB, WS_LW = 6 * MiB;
constexpr size_t WS_WIN = 8 * MiB;
constexpr size_t WS_WBR = 22 * MiB;
constexpr size_t WS_WOUT = 26 * MiB, WS_WPG = 28 * MiB;
constexpr size_t WS_WPP = 30 * MiB;
constexpr size_t WS_WGU = 32 * MiB;
constexpr size_t WS_WDN = 160 * MiB;
constexpr size_t WS_XB = 224 * MiB;
constexpr size_t WS_PB = 256 * MiB;
constexpr size_t WS_X1F = 264 * MiB;
constexpr size_t WS_X1B = 328 * MiB;
constexpr size_t WS_P2 = 360 * MiB;
constexpr size_t WS_PLE = 424 * MiB;
constexpr size_t WS_R = 456 * MiB;
constexpr size_t WS_BG = WS_R, WS_U = WS_R + 32 * MiB, WS_Q = WS_R + 64 * MiB, WS_K = WS_R + 96 * MiB, WS_V = WS_R + 104 * MiB;
constexpr size_t WS_GC = WS_R + 112 * MiB, WS_GA = WS_R + 144 * MiB;
constexpr size_t WS_ZO = WS_R + 176 * MiB;
constexpr size_t WS_T1 = WS_R + 240 * MiB;
constexpr size_t WS_MG = WS_R + 304 * MiB;
constexpr size_t WS_H = WS_R;
constexpr size_t WS_Y = WS_R + 144 * MiB;
constexpr size_t WS_XQ = WS_R + 336 * MiB;
constexpr size_t WS_LSX = WS_XQ + 16 * MiB;
constexpr size_t WS_SX1 = WS_LSX + 2 * MiB;
constexpr size_t WS_SX0 = WS_SX1 + 1 * MiB;
constexpr size_t WS_SP = WS_SX0 + 512 * 1024;
constexpr size_t WS_LHS = WS_SX0 + 1 * MiB;
constexpr size_t WS_END = WS_LHS + 2 * MiB;
constexpr size_t WS_SCL = 65536;
constexpr size_t WS_WPG8 = 31 * MiB;
typedef int i32x4 __attribute__((ext_vector_type(4)));

constexpr int LDS_BYTES = 147456;
constexpr int MISC_OFF = 135168;
constexpr int BST_IDX = 66, TW_OFF = MISC_OFF + 512, UTAB_OFF = TW_OFF + 10240;
constexpr int BST_IDX_ = 0;

#ifndef PROBE_STAMP
#define PROBE_STAMP -1
#endif
__device__ __forceinline__ int lane_id_asm() { int l; asm volatile("v_mbcnt_lo_u32_b32 %0, -1, 0\n\tv_mbcnt_hi_u32_b32 %0, -1, %0" : "=v"(l)); return l; }
__device__ __forceinline__ unsigned f2bf(float f) { unsigned u = __builtin_bit_cast(unsigned, f); return (u + 0x7fffu + ((u >> 16) & 1u)) >> 16; }
__device__ __forceinline__ unsigned pk2(float lo, float hi) { return f2bf(lo) | (f2bf(hi) << 16); }
__device__ __forceinline__ float bflo(unsigned w) { return __builtin_bit_cast(float, w << 16); }
__device__ __forceinline__ float bfhi(unsigned w) { return __builtin_bit_cast(float, w & 0xffff0000u); }
__device__ __forceinline__ float fast_sigmoid(float v) { return __builtin_amdgcn_rcpf(1.0f + __builtin_amdgcn_exp2f(-LOG2E * v)); }
__device__ __forceinline__ float shx(float v, int o, int lane) { return __builtin_bit_cast(float, __builtin_amdgcn_ds_bpermute((lane ^ o) << 2, __builtin_bit_cast(int, v))); }
__device__ __forceinline__ int shxi(int v, int o, int lane) { return __builtin_amdgcn_ds_bpermute((lane ^ o) << 2, v); }
__device__ __forceinline__ float shidx(float v, int src) { return __builtin_bit_cast(float, __builtin_amdgcn_ds_bpermute(src << 2, __builtin_bit_cast(int, v))); }
__device__ __forceinline__ float wave_sum(float v, int lane) {
#pragma unroll
    for (int o = 1; o < 64; o <<= 1) v += shx(v, o, lane);
    return v;
}

#define DPPF(old, src, ctrl, rm, bm) __builtin_bit_cast(float, __builtin_amdgcn_update_dpp(__builtin_bit_cast(int, (float)(old)), __builtin_bit_cast(int, (float)(src)), ctrl, rm, bm, false))
__device__ __forceinline__ float wave_sum_u(float v) {
    v += DPPF(0.f, v, 0x111, 0xf, 0xf); v += DPPF(0.f, v, 0x112, 0xf, 0xf); v += DPPF(0.f, v, 0x114, 0xf, 0xf); v += DPPF(0.f, v, 0x118, 0xf, 0xf);
    v += DPPF(0.f, v, 0x142, 0xa, 0xf); v += DPPF(0.f, v, 0x143, 0xc, 0xf);
    return __builtin_bit_cast(float, __builtin_amdgcn_readlane(__builtin_bit_cast(int, v), 63));
}
__device__ __forceinline__ float wave_max_u(float v) {
    v = fmaxf(v, DPPF(v, v, 0x111, 0xf, 0xf)); v = fmaxf(v, DPPF(v, v, 0x112, 0xf, 0xf)); v = fmaxf(v, DPPF(v, v, 0x114, 0xf, 0xf)); v = fmaxf(v, DPPF(v, v, 0x118, 0xf, 0xf));
    v = fmaxf(v, DPPF(v, v, 0x142, 0xa, 0xf)); v = fmaxf(v, DPPF(v, v, 0x143, 0xc, 0xf));
    return __builtin_bit_cast(float, __builtin_amdgcn_readlane(__builtin_bit_cast(int, v), 63));
}
#define XB_TMO      128
#define XB_XCNT(j)  (256  + 64 * (j))
#define XB_XSUB(j)  (1280 + 64 * (j))
#define XB_XGEN(j)  (2304 + 64 * (j))
#define XB_TOP      3328
#define XB_TOPGEN   3392
#define XCD_BAR_WORDS 3456
#define XB_SPIN_CAP (1u << 18)

__device__ __forceinline__ unsigned xb_ld(unsigned* p)              { return __hip_atomic_load(p, __ATOMIC_RELAXED, __HIP_MEMORY_SCOPE_AGENT); }
__device__ __forceinline__ unsigned xb_add(unsigned* p, unsigned v) { return __hip_atomic_fetch_add(p, v, __ATOMIC_RELAXED, __HIP_MEMORY_SCOPE_AGENT); }
__device__ __forceinline__ unsigned xb_xcc_id() { return (unsigned)__builtin_amdgcn_s_getreg((3 << 11) | 20) & 0xFu; }
#define XB_SPIN(cond, bar) do { unsigned _sp = 0; while (cond) { __builtin_amdgcn_s_sleep(1); \
    if ((++_sp & 255u) == 0u) { if (xb_ld(&(bar)[XB_TMO])) break; if (_sp > XB_SPIN_CAP) { atomicAdd(&(bar)[XB_TMO], 1u); break; } } } } while (0)

struct XcdBarrier {
    bool lead;
    unsigned* bar; unsigned x;
    volatile LAS unsigned* st;
};

__device__ __forceinline__ XcdBarrier xcd_barrier_post(unsigned* bar, volatile LAS unsigned* st, bool lead) {
    XcdBarrier b; b.bar = bar; b.x = xb_xcc_id(); b.st = st; b.lead = lead;
    if (lead) (void)xb_add(&bar[XB_XCNT(b.x)], 1u);
    return b;
}
__device__ __forceinline__ void xcd_barrier_complete(unsigned* bar, unsigned x, unsigned& nloc, unsigned& nx) {
    const unsigned G = gridDim.x * gridDim.y * gridDim.z;
    unsigned sum, cnt, mine, sp = 0u;
    for (;;) {
        sum = 0u; cnt = 0u; mine = 0u;
#pragma unroll
        for (unsigned j = 0; j < 16; ++j) { const unsigned c = xb_ld(&bar[XB_XCNT(j)]); sum += c; cnt += (c > 0u) ? 1u : 0u; mine = (j == x) ? c : mine; }
        if (sum == G) break;
        __builtin_amdgcn_s_sleep(1);
        if ((++sp & 255u) == 0u) { if (xb_ld(&bar[XB_TMO])) break; if (sp > XB_SPIN_CAP) { atomicAdd(&bar[XB_TMO], 1u); break; } }
    }
    nloc = mine > 0u ? mine : 1u; nx = cnt > 0u ? cnt : 1u;
}

__device__ __forceinline__ void xcd_barrier_lead(const XcdBarrier& b);
__device__ __forceinline__ void xcd_barrier(const XcdBarrier& b) {
    asm volatile("s_waitcnt vmcnt(0)" ::: "memory");
    __syncthreads();
    xcd_barrier_lead(b);
    __syncthreads();
}
__device__ __forceinline__ void xcd_barrier_lead(const XcdBarrier& b) {
    if (b.lead) {
        unsigned* bar = b.bar;
        __builtin_amdgcn_s_waitcnt(0);
        unsigned nloc = b.st[0], nx = b.st[1];
        if (nloc == 0u) { xcd_barrier_complete(bar, b.x, nloc, nx); b.st[0] = nloc; b.st[1] = nx; }
        const unsigned old = xb_add(&bar[XB_XSUB(b.x)], 1u);
        const unsigned gen = old / nloc;
        if (old + 1u == (gen + 1u) * nloc) {
            __builtin_amdgcn_fence(__ATOMIC_RELEASE, "agent");
            asm volatile("s_waitcnt vmcnt(0)" ::: "memory");
            const unsigned og = xb_add(&bar[XB_TOP], 1u);
            const unsigned tg = og / nx;
            if (og + 1u == (tg + 1u) * nx) xb_add(&bar[XB_TOPGEN], 1u);
            else XB_SPIN(xb_ld(&bar[XB_TOPGEN]) == tg, bar);
            __builtin_amdgcn_fence(__ATOMIC_ACQUIRE, "agent");
            xb_add(&bar[XB_XGEN(b.x)], 1u);
            asm volatile("s_waitcnt vmcnt(0)" ::: "memory");
        } else {
            XB_SPIN(xb_ld(&bar[XB_XGEN(b.x)]) == gen, bar);
            __builtin_amdgcn_fence(__ATOMIC_ACQUIRE, "agent");
            asm volatile("s_waitcnt vmcnt(0)" ::: "memory");
        }
    }
}

namespace pg8 {
constexpr int BM = 256, BK = 64, HALF = 128, HTB = HALF * BK * 2  , STAGE_BYTES = 8 * HTB, NXCD = 8, WGM = 8;
__host__ __device__ __forceinline__ int lds_byte(int r, int c) { const int st = (r >> 4) * 2 + (c >> 5), rr = r & 15, cc = c & 31, ob = rr * 64 + cc * 2; return st * 1024 + (ob ^ (((ob >> 9) & 1) << 5)); }
__host__ __device__ __forceinline__ void stage_rc(int b, int& R, int& C) { const int st = b / 1024, sb = b % 1024, swz = sb ^ (((sb >> 9) & 1) << 5); R = (st >> 1) * 16 + swz / 64; C = (st & 1) * 32 + (swz % 64) / 2; }
__host__ __device__ __forceinline__ int perm32(int rho) { const int n = rho >> 4, i = rho & 15; return 8 * (i >> 2) + 4 * n + (i & 3); }

struct Unit { int pm, pn, om, on, e, mt, slot; };
struct Gemm { const bf16_t* A; const bf16_t* Bt; int K; };

__device__ __forceinline__ int xcd_remap(int L, int nwg) { const int q = nwg / NXCD, r = nwg % NXCD, xcd = L % NXCD, off = L / NXCD; return (xcd < r ? xcd * (q + 1) : r * (q + 1) + (xcd - r) * q) + off; }

__device__ __forceinline__ void plain_a_off(int pm, int tid, int K, unsigned (&o)[2][2]) {
#pragma unroll
    for (int i = 0; i < 2; ++i) { int R, C; stage_rc(tid * 16 + i * 8192, R, C);
#pragma unroll
        for (int h = 0; h < 2; ++h) o[h][i] = (unsigned)((pm * BM + h * HALF + R) * K + C) * 2u; }
}
struct StaticOrder {
    int nM, nN, nwg, G, c;
    __device__ void init(int nM_, int nN_, int G_, int c_, int = 1) { nM = nM_; nN = nN_; nwg = nM * nN; G = G_; c = c_; }
    __device__ __forceinline__ bool tile(int i, int& pm, int& pn, int& q) const {
        const int L = i * G + c; if (L >= nwg) return false;
        q = 0xF; const int wgid = xcd_remap(L, nwg);
        const int nig = WGM * nN, gid = wgid / nig, fm = gid * WGM, gsz = (nM - fm) < WGM ? (nM - fm) : WGM;
        pm = fm + ((wgid % nig) % gsz); pn = (wgid % nig) / gsz; return true;
    }
    __device__ __forceinline__ bool next(int i, Unit& u) const { int pm, pn, q; if (!tile(i, pm, pn, q)) return false; u.pm = pm; u.pn = pn; u.om = pm; u.on = pn; u.e = 0; u.mt = 0; u.slot = 0; return true; }
    __device__ __forceinline__ void a_off(const Unit& u, int tid, int K, unsigned (&o)[2][2]) const { plain_a_off(u.pm, tid, K, o); }
};

__device__ __forceinline__ unsigned cvt_pk_bf16(float lo, float hi) { unsigned r; asm volatile("v_cvt_pk_bf16_f32 %0, %1, %2" : "=v"(r) : "v"(lo), "v"(hi)); return r; }

template <class Epi, class Sched, bool ALIGN_EPI, int DRY = 0, bool I8 = false>
__device__ __forceinline__ void gemm_phase(LAS unsigned char* lds, const Gemm g, const Sched& S, const Epi& E, int wvid) {
    int tid_ = (wvid * 64 + lane_id_asm()); asm volatile("" : "+v"(tid_));
    const int tid = tid_, wid = __builtin_amdgcn_readfirstlane(tid >> 6), lane = tid & 63, wr = wid >> 2, wc = wid & 3, fr = lane & 15, fq = lane >> 4;
    const int K = g.K, nt = K / BK;
    unsigned voffB[2];
#pragma unroll
    for (int i = 0; i < 2; ++i) { int R, C; stage_rc(tid * 16 + i * 8192, R, C); const int Rb = Epi::PERM ? ((R & ~31) + perm32(R & 31)) : R;
        voffB[i] = (unsigned)(Rb * K + C) * 2u; }
    constexpr unsigned kstep = BK * 2;
    const unsigned hstep = (unsigned)HALF * K * 2;
    const unsigned tstep = 2 * hstep;
    const unsigned ldsw = (unsigned)wid * 1024u;
    const int aoff = lds_byte(wr * 64 + fr, fq * 8), boff = lds_byte(wc * 32 + fr, fq * 8);
#define PG8_SA(b, h) (((b) * 2 + (h)) * HTB)
#define PG8_SB(b, h) ((4 + (b) * 2 + (h)) * HTB)
#define PG8_STAGE(bufoff, gbase, voff) do { _Pragma("unroll") for (int _i = 0; _i < 2; ++_i) \
        __builtin_amdgcn_global_load_lds((const unsigned*)((const char*)(gbase) + (voff)[_i]), (LAS unsigned*)(lds + (bufoff) + ldsw + _i * 8192), 16, 0, 0); } while (0)
#define PG8_LDA(dst, b, h) do { _Pragma("unroll") for (int m = 0; m < 4; ++m) _Pragma("unroll") for (int k = 0; k < 2; ++k) dst[m][k] = *(const LAS bf16x8*)(lds + PG8_SA(b, h) + aoff + m * 2048 + k * 1024); } while (0)
#define PG8_LDB(dst, b, h) do { _Pragma("unroll") for (int n = 0; n < 2; ++n) _Pragma("unroll") for (int k = 0; k < 2; ++k) dst[n][k] = *(const LAS bf16x8*)(lds + PG8_SB(b, h) + boff + n * 2048 + k * 1024); } while (0)
#define PG8_MMA(ai, bj, At, Bt) do { if constexpr (DRY == 1) { _Pragma("unroll") for (int m = 0; m < 4; ++m) _Pragma("unroll") for (int k = 0; k < 2; ++k) asm volatile("" :: "v"(At[m][k])); _Pragma("unroll") for (int n = 0; n < 2; ++n) _Pragma("unroll") for (int k = 0; k < 2; ++k) asm volatile("" :: "v"(Bt[n][k])); break; } __builtin_amdgcn_s_setprio(1); _Pragma("unroll") for (int m = 0; m < 4; ++m) _Pragma("unroll") for (int n = 0; n < 2; ++n) _Pragma("unroll") for (int k = 0; k < 2; ++k) \
        { if constexpr (I8) acc[ai][bj][m][n] = __builtin_bit_cast(AccT, __builtin_amdgcn_mfma_i32_16x16x64_i8(__builtin_bit_cast(i32x4, Bt[n][k]), __builtin_bit_cast(i32x4, At[m][k]), __builtin_bit_cast(i32x4, acc[ai][bj][m][n]), 0, 0, 0)); \
          else acc[ai][bj][m][n] = __builtin_bit_cast(AccT, __builtin_amdgcn_mfma_f32_16x16x32_bf16(Bt[n][k], At[m][k], __builtin_bit_cast(f32x4, acc[ai][bj][m][n]), 0, 0, 0)); } __builtin_amdgcn_s_setprio(0); } while (0)
#define PG8_WAIT_V(n) asm volatile("s_waitcnt vmcnt(" #n ")" ::: "memory")
#define PG8_WAIT_L(n) asm volatile("s_waitcnt lgkmcnt(" #n ")" ::: "memory")
#define PG8_BAR __builtin_amdgcn_s_barrier()
#define PG8_SCHED __builtin_amdgcn_sched_barrier(0)
    Unit cur, nxt; int ui = 0;
    if (!S.next(0, cur)) return;
#define GSTAMP(j) do { if (PROBE_STAMP >= 16 && blockIdx.x == 0 && tid == 0) { LAS int* m_ = (LAS int*)(lds + MISC_OFF); unsigned long long* st_ = (unsigned long long*)(*(LAS unsigned long long*)(m_ + 68)); \
        __hip_atomic_store(st_ + 16 + 4 * m_[70] + (j), (unsigned long long)__builtin_amdgcn_s_memrealtime(), __ATOMIC_RELAXED, __HIP_MEMORY_SCOPE_AGENT); if ((j) == 3) m_[70] += 1; } } while (0)
    GSTAMP(0);
    typedef typename Epi::AccT AccT;
    AccT acc[2][2][4][2];
#pragma unroll
    for (int a = 0; a < 2; ++a)
#pragma unroll
        for (int b = 0; b < 2; ++b)
#pragma unroll
            for (int m = 0; m < 4; ++m)
#pragma unroll
                for (int n = 0; n < 2; ++n) acc[a][b][m][n] = AccT{};
    bf16x8 At[4][2], B0[2][2], B1[2][2];
    unsigned aC[2][2];
    S.a_off(cur, tid, K, aC);
    const char* const Ab = (const char*)g.A;
    const char* cB = (const char*)g.Bt + (size_t)cur.pn * tstep;
    PG8_STAGE(PG8_SB(0, 0), cB, voffB); PG8_STAGE(PG8_SB(0, 1), cB + hstep, voffB); PG8_STAGE(PG8_SA(0, 0), Ab, aC[0]); PG8_STAGE(PG8_SA(0, 1), Ab, aC[1]);
    if (wr == 1) PG8_BAR;
    PG8_WAIT_V(2); PG8_BAR;
    PG8_STAGE(PG8_SB(1, 0), cB + kstep, voffB); PG8_STAGE(PG8_SA(1, 0), Ab + kstep, aC[0]); PG8_STAGE(PG8_SB(1, 1), cB + hstep + kstep, voffB);
    PG8_WAIT_V(6); PG8_BAR;
    for (;;) {
        const bool has_next = S.next(ui + 1, nxt);
        const char* nB = has_next ? (const char*)g.Bt + (size_t)nxt.pn * tstep : cB;
        for (int t = 0; t < nt; t += 2) {
            const bool last = (t == nt - 2);
            const char* a1 = Ab + (size_t)(t + 1) * kstep;
            const char* a2 = last ? Ab : Ab + (size_t)(t + 2) * kstep; const char* b2 = last ? nB : cB + (size_t)(t + 2) * kstep;
            const char* a3 = a2 + kstep; const char* b3 = b2 + kstep;
            PG8_LDB(B0, 0, 0); PG8_LDB(B1, 0, 1); PG8_SCHED; PG8_LDA(At, 0, 0); PG8_STAGE(PG8_SA(1, 1), a1, aC[1]);
            if (last && has_next) S.a_off(nxt, tid, K, aC);
            PG8_WAIT_V(8); PG8_WAIT_L(0); PG8_BAR; PG8_MMA(0, 0, At, B0); PG8_MMA(0, 1, At, B1); PG8_BAR; PG8_SCHED;
            PG8_LDA(At, 0, 1); PG8_STAGE(PG8_SB(0, 0), b2, voffB); PG8_STAGE(PG8_SB(0, 1), b2 + hstep, voffB); PG8_STAGE(PG8_SA(0, 0), a2, aC[0]);
            PG8_WAIT_V(8); PG8_WAIT_L(0); PG8_BAR; PG8_MMA(1, 0, At, B0); PG8_MMA(1, 1, At, B1); PG8_BAR; PG8_SCHED;
            PG8_LDB(B0, 1, 0); PG8_LDB(B1, 1, 1); PG8_SCHED; PG8_LDA(At, 1, 0); PG8_STAGE(PG8_SA(0, 1), a2, aC[1]);
            PG8_WAIT_V(8); PG8_WAIT_L(0); PG8_BAR; PG8_MMA(0, 0, At, B0); PG8_MMA(0, 1, At, B1); PG8_BAR; PG8_SCHED;
            PG8_LDA(At, 1, 1); PG8_STAGE(PG8_SB(1, 0), b3, voffB); PG8_STAGE(PG8_SB(1, 1), b3 + hstep, voffB); PG8_STAGE(PG8_SA(1, 0), a3, aC[0]);
            PG8_WAIT_V(8); PG8_WAIT_L(0); PG8_BAR; PG8_MMA(1, 0, At, B0); PG8_MMA(1, 1, At, B1); PG8_BAR; PG8_SCHED;
        }
        if constexpr (ALIGN_EPI) { if (wr == 0) PG8_BAR; }
        if (ui == 0) GSTAMP(1);
        if constexpr (DRY == 0) E(acc, cur, wr, wc, fr, fq); else { _Pragma("unroll") for (int a = 0; a < 2; ++a) _Pragma("unroll") for (int b = 0; b < 2; ++b) _Pragma("unroll") for (int m = 0; m < 4; ++m) _Pragma("unroll") for (int n = 0; n < 2; ++n) asm volatile("" :: "v"(acc[a][b][m][n])); }
        if (ui == 0) GSTAMP(2);
        if (!has_next) break;
#pragma unroll
        for (int a = 0; a < 2; ++a)
#pragma unroll
            for (int b = 0; b < 2; ++b)
#pragma unroll
                for (int m = 0; m < 4; ++m)
#pragma unroll
                    for (int n = 0; n < 2; ++n) acc[a][b][m][n] = AccT{};
        cur = nxt; cB = nB; ++ui;
        if constexpr (ALIGN_EPI) { if (wr == 1) PG8_BAR; }
    }
    PG8_WAIT_V(0);
    if constexpr (!ALIGN_EPI) { if (wr == 0) PG8_BAR; }
    PG8_BAR;
    GSTAMP(3);
#undef GSTAMP
#undef PG8_SA
#undef PG8_SB
#undef PG8_STAGE
#undef PG8_LDA
#undef PG8_LDB
#undef PG8_MMA
#undef PG8_WAIT_V
#undef PG8_WAIT_L
#undef PG8_BAR
#undef PG8_SCHED
}
}
namespace pg8 {
typedef const f32x4 (&AccRef)[2][2][4][2];
typedef const i32x4 (&AccRefI)[2][2][4][2];
__device__ __forceinline__ f32x4 i2f(const i32x4 v) { return (f32x4){(float)v[0], (float)v[1], (float)v[2], (float)v[3]}; }

struct EpiInProj {
    static constexpr bool PERM = true; typedef f32x4 AccT;
    unsigned char* ws;
    __device__ __forceinline__ void operator()(AccRef acc, const Unit& u, int wr, int wc, int fr, int fq) const {
        const int pn = u.on, row0 = u.om * BM + wr * 64 + fr, cw = wc * 32 + 8 * fq;
        if (pn >= 4 && pn < 12) {
#pragma unroll
            for (int ai = 0; ai < 2; ++ai)
#pragma unroll
                for (int m = 0; m < 4; ++m) { const f32x4 v0 = acc[ai][0][m][0] * acc[ai][1][m][0], v1 = acc[ai][0][m][1] * acc[ai][1][m][1];
                    u32x4 w; w.x = cvt_pk_bf16(v0[0], v0[1]); w.y = cvt_pk_bf16(v0[2], v0[3]); w.z = cvt_pk_bf16(v1[0], v1[1]); w.w = cvt_pk_bf16(v1[2], v1[3]);
                    *(u32x4*)((bf16_t*)(ws + WS_U) + (size_t)(row0 + ai * HALF + m * 16) * D + (pn - 4) * 128 + cw) = w; }
            return;
        }
        size_t doff; int ldc = D, cb, mode = 0;
        if (pn < 4) { doff = WS_BG; cb = pn * 256; }
        else if (pn < 16) { doff = WS_Q; cb = (pn - 12) * 256; mode = 1; }
        else if (pn == 16) { doff = WS_K; cb = 0; ldc = 256; }
        else if (pn == 17) { doff = WS_V; cb = 0; ldc = 256; }
        else if (pn < 22) { doff = WS_GC; cb = (pn - 18) * 256; mode = 2; }
        else { doff = WS_GA; cb = (pn - 22) * 256; mode = 2; }
        bf16_t* dst = (bf16_t*)(ws + doff);
#pragma unroll
        for (int ai = 0; ai < 2; ++ai)
#pragma unroll
            for (int m = 0; m < 4; ++m) { bf16_t* rowp = dst + (size_t)(row0 + ai * HALF + m * 16) * ldc + cb + cw;
#pragma unroll
                for (int bj = 0; bj < 2; ++bj) { f32x4 v0 = acc[ai][bj][m][0], v1 = acc[ai][bj][m][1];
                    if (mode == 1) { v0 = v0 * QSCALE; v1 = v1 * QSCALE; }
                    if (mode == 2) {
#pragma unroll
                        for (int j = 0; j < 4; ++j) { v0[j] = fast_sigmoid(v0[j]); v1[j] = fast_sigmoid(v1[j]); } }
                    u32x4 w; w.x = cvt_pk_bf16(v0[0], v0[1]); w.y = cvt_pk_bf16(v0[2], v0[3]); w.z = cvt_pk_bf16(v1[0], v1[1]); w.w = cvt_pk_bf16(v1[2], v1[3]);
                    *(u32x4*)(rowp + bj * HALF) = w; } }
    }
};

struct EpiInProjI8 {
    static constexpr bool PERM = true; typedef i32x4 AccT;
    unsigned char* ws; float sw;
    __device__ __forceinline__ void operator()(AccRefI acc, const Unit& u, int wr, int wc, int fr, int fq) const {
        const int pn = u.on, row0 = u.om * BM + wr * 64 + fr, cw = wc * 32 + 8 * fq;
        const float* sx0 = (const float*)(ws + WS_SX0) + row0;
        float sxv[2][4];
#pragma unroll
        for (int ai = 0; ai < 2; ++ai)
#pragma unroll
            for (int m = 0; m < 4; ++m) sxv[ai][m] = sx0[ai * HALF + m * 16];
        if (pn >= 4 && pn < 12) {
#pragma unroll
            for (int ai = 0; ai < 2; ++ai)
#pragma unroll
                for (int m = 0; m < 4; ++m) { const float s = sxv[ai][m] * sw, s2 = s * s;
                    const f32x4 v0 = i2f(acc[ai][0][m][0]) * i2f(acc[ai][1][m][0]) * s2, v1 = i2f(acc[ai][0][m][1]) * i2f(acc[ai][1][m][1]) * s2;
                    u32x4 w; w.x = cvt_pk_bf16(v0[0], v0[1]); w.y = cvt_pk_bf16(v0[2], v0[3]); w.z = cvt_pk_bf16(v1[0], v1[1]); w.w = cvt_pk_bf16(v1[2], v1[3]);
                    *(u32x4*)((bf16_t*)(ws + WS_U) + (size_t)(row0 + ai * HALF + m * 16) * D + (pn - 4) * 128 + cw) = w; asm volatile("" ::: "memory"); }
            return;
        }
        size_t doff; int ldc = D, cb, mode = 0;
        if (pn < 4) { doff = WS_BG; cb = pn * 256; }
        else if (pn < 16) { doff = WS_Q; cb = (pn - 12) * 256; mode = 1; }
        else if (pn == 16) { doff = WS_K; cb = 0; ldc = 256; }
        else if (pn == 17) { doff = WS_V; cb = 0; ldc = 256; }
        else if (pn < 22) { doff = WS_GC; cb = (pn - 18) * 256; mode = 2; }
        else { doff = WS_GA; cb = (pn - 22) * 256; mode = 2; }
        bf16_t* dst = (bf16_t*)(ws + doff);
#pragma unroll
        for (int ai = 0; ai < 2; ++ai)
#pragma unroll
            for (int m = 0; m < 4; ++m) { bf16_t* rowp = dst + (size_t)(row0 + ai * HALF + m * 16) * ldc + cb + cw; const float s = sxv[ai][m] * sw * (mode == 1 ? QSCALE : 1.0f);
#pragma unroll
                for (int bj = 0; bj < 2; ++bj) { f32x4 v0 = i2f(acc[ai][bj][m][0]) * s, v1 = i2f(acc[ai][bj][m][1]) * s;
                    if (mode == 2) {
#pragma unroll
                        for (int j = 0; j < 4; ++j) { v0[j] = fast_sigmoid(v0[j]); v1[j] = fast_sigmoid(v1[j]); } }
                    u32x4 w; w.x = cvt_pk_bf16(v0[0], v0[1]); w.y = cvt_pk_bf16(v0[2], v0[3]); w.z = cvt_pk_bf16(v1[0], v1[1]); w.w = cvt_pk_bf16(v1[2], v1[3]);
                    *(u32x4*)(rowp + bj * HALF) = w; }
                asm volatile("" ::: "memory"); }
    }
};

struct EpiDual {
    static constexpr bool PERM = true; typedef f32x4 AccT;
    unsigned char* ws;
    __device__ __forceinline__ void operator()(AccRef acc, const Unit& u, int wr, int wc, int fr, int fq) const {
        const int row0 = u.om * BM + wr * 64 + fr, col0 = u.on * BM + wc * 32 + 8 * fq;
        const bf16_t* G = (const bf16_t*)(ws + (u.e == 0 ? WS_GC : WS_GA)); bf16_t* T1 = (bf16_t*)(ws + WS_T1); bf16_t* MG = (bf16_t*)(ws + WS_MG);
#pragma unroll
        for (int ai = 0; ai < 2; ++ai)
#pragma unroll
            for (int m = 0; m < 4; ++m) { const size_t ro = (size_t)(row0 + ai * HALF + m * 16) * D + col0;
#pragma unroll
                for (int bj = 0; bj < 2; ++bj) { const size_t o = ro + bj * HALF;
                    const u32x4 gw = *(const u32x4*)(G + o);
                    f32x4 g0 = {bflo(gw.x), bfhi(gw.x), bflo(gw.y), bfhi(gw.y)}, g1 = {bflo(gw.z), bfhi(gw.z), bflo(gw.w), bfhi(gw.w)};
                    f32x4 v0 = g0 * acc[ai][bj][m][0], v1 = g1 * acc[ai][bj][m][1];
                    if (u.e == 0) { u32x4 w; w.x = cvt_pk_bf16(v0[0], v0[1]); w.y = cvt_pk_bf16(v0[2], v0[3]); w.z = cvt_pk_bf16(v1[0], v1[1]); w.w = cvt_pk_bf16(v1[2], v1[3]); *(u32x4*)(T1 + o) = w; }
                    else { const u32x4 tw_ = *(const u32x4*)(T1 + o);
                        v0 = v0 + (f32x4){bflo(tw_.x), bfhi(tw_.x), bflo(tw_.y), bfhi(tw_.y)}; v1 = v1 + (f32x4){bflo(tw_.z), bfhi(tw_.z), bflo(tw_.w), bfhi(tw_.w)};
                        u32x4 w; w.x = cvt_pk_bf16(v0[0], v0[1]); w.y = cvt_pk_bf16(v0[2], v0[3]); w.z = cvt_pk_bf16(v1[0], v1[1]); w.w = cvt_pk_bf16(v1[2], v1[3]);
                        *(u32x4*)(MG + o) = w; } } }
    }
};

struct EpiResid {
    static constexpr bool PERM = true; typedef f32x4 AccT;
    bf16_t* T;
    __device__ __forceinline__ void operator()(AccRef acc, const Unit& u, int wr, int wc, int fr, int fq) const {
        bf16_t* tp = T + (size_t)(u.om * BM + wr * 64 + fr) * D + u.on * BM + wc * 32 + 8 * fq;
#pragma unroll
        for (int ai = 0; ai < 2; ++ai)
#pragma unroll
            for (int m = 0; m < 4; ++m)
#pragma unroll
                for (int bj = 0; bj < 2; ++bj) { const f32x4 v0 = acc[ai][bj][m][0], v1 = acc[ai][bj][m][1];
                    u32x4 o; o.x = cvt_pk_bf16(v0[0], v0[1]); o.y = cvt_pk_bf16(v0[2], v0[3]); o.z = cvt_pk_bf16(v1[0], v1[1]); o.w = cvt_pk_bf16(v1[2], v1[3]);
                    *(u32x4*)(tp + (size_t)(ai * HALF + m * 16) * D + bj * HALF) = o; }
    }
};

struct EpiF32 {
    static constexpr bool PERM = false; typedef f32x4 AccT;
    float* C;
    __device__ __forceinline__ void operator()(AccRef acc, const Unit& u, int wr, int wc, int fr, int fq) const {
        const int row0 = u.om * BM + wr * 64 + fr, col0 = u.on * BM + wc * 32 + 4 * fq;
#pragma unroll
        for (int ai = 0; ai < 2; ++ai)
#pragma unroll
            for (int m = 0; m < 4; ++m) { const size_t ro = (size_t)(row0 + ai * HALF + m * 16) * D + col0;
#pragma unroll
                for (int bj = 0; bj < 2; ++bj)
#pragma unroll
                    for (int n = 0; n < 2; ++n) *(f32x4*)(C + ro + bj * HALF + n * 16) = acc[ai][bj][m][n]; }
    }
};
struct EpiF32I8 {
    static constexpr bool PERM = false; typedef i32x4 AccT;
    float* C; const float* sp; float sw;
    __device__ __forceinline__ void operator()(AccRefI acc, const Unit& u, int wr, int wc, int fr, int fq) const {
        const int row0 = u.om * BM + wr * 64 + fr, col0 = u.on * BM + wc * 32 + 4 * fq;
        float sv[2][4];
#pragma unroll
        for (int ai = 0; ai < 2; ++ai)
#pragma unroll
            for (int m = 0; m < 4; ++m) sv[ai][m] = sp[row0 + ai * HALF + m * 16] * sw;
#pragma unroll
        for (int ai = 0; ai < 2; ++ai)
#pragma unroll
            for (int m = 0; m < 4; ++m) { const size_t ro = (size_t)(row0 + ai * HALF + m * 16) * D + col0;
#pragma unroll
                for (int bj = 0; bj < 2; ++bj)
#pragma unroll
                    for (int n = 0; n < 2; ++n) *(f32x4*)(C + ro + bj * HALF + n * 16) = i2f(acc[ai][bj][m][n]) * sv[ai][m]; }
    }
};
__device__ __forceinline__ void ple_epilogue(AccRef acc, const Unit& u, int wr, int wc, int fr, int fq, const float* P2, bf16_t* PLE) {
    const int row0 = u.om * BM + wr * 64 + fr, col0 = u.on * BM + wc * 32 + 8 * fq;
#pragma unroll
    for (int ai = 0; ai < 2; ++ai)
#pragma unroll
        for (int m = 0; m < 4; ++m) { const size_t ro = (size_t)(row0 + ai * HALF + m * 16) * D + col0;
#pragma unroll
            for (int bj = 0; bj < 2; ++bj) { const size_t o = ro + bj * HALF; const f32x4 p0 = *(const f32x4*)(P2 + o), p1 = *(const f32x4*)(P2 + o + 4); const f32x4 a0 = acc[ai][bj][m][0], a1 = acc[ai][bj][m][1];
                u32x4 w; w.x = cvt_pk_bf16(fast_sigmoid(a0[0]) * p0[0], fast_sigmoid(a0[1]) * p0[1]); w.y = cvt_pk_bf16(fast_sigmoid(a0[2]) * p0[2], fast_sigmoid(a0[3]) * p0[3]);
                w.z = cvt_pk_bf16(fast_sigmoid(a1[0]) * p1[0], fast_sigmoid(a1[1]) * p1[1]); w.w = cvt_pk_bf16(fast_sigmoid(a1[2]) * p1[2], fast_sigmoid(a1[3]) * p1[3]);
                *(u32x4*)(PLE + o) = w; }
            if (m & 1) asm volatile("" ::: "memory"); }
}

struct EpiSwiglu {
    static constexpr bool PERM = true; typedef f32x4 AccT;
    bf16_t* H; const float* b_gu; const LAS unsigned* tw; unsigned char* ws;
    __device__ __forceinline__ void operator()(AccRef acc, const Unit& u, int wr, int wc, int fr, int fq) const {
        if (u.e < 0) { ple_epilogue(acc, u, wr, wc, fr, fq, (const float*)(ws + WS_P2), (bf16_t*)(ws + WS_PLE)); return; }
        const int trow0 = wr * 64 + fr, row0 = u.om * BM + trow0, cw = wc * 32 + 8 * fq, col0 = u.on * 128 + cw;
        const float* bg = b_gu + (size_t)u.e * 2048 + col0;
#pragma unroll
        for (int n = 0; n < 2; ++n) { const f32x4 bgn = *(const f32x4*)(bg + 4 * n), bun = *(const f32x4*)(bg + 1024 + 4 * n);
#pragma unroll
            for (int ai = 0; ai < 2; ++ai)
#pragma unroll
                for (int m = 0; m < 4; ++m) { const float w = bfhi(tw[u.slot * BM + trow0 + ai * HALF + m * 16]);
                    const f32x4 gt = acc[ai][0][m][n] + bgn, up = acc[ai][1][m][n] + bun; f32x4 hv;
#pragma unroll
                    for (int j = 0; j < 4; ++j) { const float gv = fminf(gt[j], 7.0f), uv = fminf(fmaxf(up[j], -7.0f), 7.0f); hv[j] = (uv + 1.0f) * gv * fast_sigmoid(1.702f * gv) * w; }
                    u32x2 o; o.x = cvt_pk_bf16(hv[0], hv[1]); o.y = cvt_pk_bf16(hv[2], hv[3]);
                    *(u32x2*)(H + (size_t)(row0 + ai * HALF + m * 16) * D + col0 + 4 * n) = o; } }
    }
};
struct EpiSwigluI8 {
    static constexpr bool PERM = true; typedef i32x4 AccT;
    bf16_t* H; const float* b_gu; const LAS unsigned* tw; unsigned char* ws;
    __device__ __forceinline__ void operator()(AccRefI acc, const Unit& u, int wr, int wc, int fr, int fq) const {
        const int trow0 = wr * 64 + fr, row0 = u.om * BM + trow0, cw = wc * 32 + 8 * fq;
        const float* scl = (const float*)(ws + WS_SCL);
        if (u.e < 0) {
            const float* P2 = (const float*)(ws + WS_P2); bf16_t* PLE = (bf16_t*)(ws + WS_PLE); const float* sx1 = (const float*)(ws + WS_SX1);
            const float spg = scl[NE]; const int col0 = u.on * BM + cw;
#pragma unroll
            for (int ai = 0; ai < 2; ++ai)
#pragma unroll
                for (int m = 0; m < 4; ++m) { const int r = row0 + ai * HALF + m * 16; const float s = sx1[r] * spg; const size_t ro = (size_t)r * D + col0;
#pragma unroll
                    for (int bj = 0; bj < 2; ++bj) { const size_t o = ro + bj * HALF; const f32x4 p0 = *(const f32x4*)(P2 + o), p1 = *(const f32x4*)(P2 + o + 4); const f32x4 a0 = i2f(acc[ai][bj][m][0]) * s, a1 = i2f(acc[ai][bj][m][1]) * s;
                        u32x4 w; w.x = cvt_pk_bf16(fast_sigmoid(a0[0]) * p0[0], fast_sigmoid(a0[1]) * p0[1]); w.y = cvt_pk_bf16(fast_sigmoid(a0[2]) * p0[2], fast_sigmoid(a0[3]) * p0[3]);
                        w.z = cvt_pk_bf16(fast_sigmoid(a1[0]) * p1[0], fast_sigmoid(a1[1]) * p1[1]); w.w = cvt_pk_bf16(fast_sigmoid(a1[2]) * p1[2], fast_sigmoid(a1[3]) * p1[3]);
                        *(u32x4*)(PLE + o) = w; }
                    if (m & 1) asm volatile("" ::: "memory"); }
            return; }
        const int col0 = u.on * 128 + cw;
        const float* bg = b_gu + (size_t)u.e * 2048 + col0; const float sg = scl[u.e];
        const float* lsx = (const float*)(ws + WS_LSX) + (size_t)u.e * LISTCAP + u.mt * BM + trow0;
        const f32x4 bg0 = *(const f32x4*)(bg), bg1 = *(const f32x4*)(bg + 4), bu0 = *(const f32x4*)(bg + 1024), bu1 = *(const f32x4*)(bg + 1028);
        unsigned char* H8 = (unsigned char*)H;
        float lsv[2][4];
#pragma unroll
        for (int ai = 0; ai < 2; ++ai)
#pragma unroll
            for (int m = 0; m < 4; ++m) lsv[ai][m] = lsx[ai * HALF + m * 16];
#pragma unroll
        for (int ai = 0; ai < 2; ++ai)
#pragma unroll
            for (int m = 0; m < 4; ++m) { const unsigned twv = tw[u.slot * BM + trow0 + ai * HALF + m * 16]; const float qh = bfhi(twv);
                const float s = (qh != 0.f ? lsv[ai][m] : 0.f) * sg;
                unsigned q8[2];
#pragma unroll
                for (int n = 0; n < 2; ++n) { const f32x4 gt = i2f(acc[ai][0][m][n]) * s + (n == 0 ? bg0 : bg1), up = i2f(acc[ai][1][m][n]) * s + (n == 0 ? bu0 : bu1); unsigned q = 0u;
#pragma unroll
                    for (int j = 0; j < 4; ++j) { const float gv = fminf(gt[j], 7.0f), uv = __builtin_amdgcn_fmed3f(up[j], -7.0f, 7.0f);
                        const float sg_ = __builtin_amdgcn_rcpf(1.0f + __builtin_amdgcn_exp2f((-1.702f * LOG2E) * gv));
                        const float hq = __builtin_fmaf(__builtin_fmaf(uv, gv, gv) * sg_, qh, 128.0f);
                        q = __builtin_amdgcn_cvt_pk_u8_f32(__builtin_amdgcn_fmed3f(__builtin_rintf(hq), 1.0f, 255.0f), j, q); }
                    q8[n] = q ^ 0x80808080u; }
                *(u32x2*)(H8 + (size_t)(row0 + ai * HALF + m * 16) * D + col0) = (u32x2){q8[0], q8[1]};
                if (m & 1) asm volatile("" ::: "memory"); }
    }
};
struct EpiDownI8 {
    static constexpr bool PERM = true; typedef i32x4 AccT;
    bf16_t* Y; unsigned char* ws; const LAS int* cntL;
    __device__ __forceinline__ void operator()(AccRefI acc, const Unit& u, int wr, int wc, int fr, int fq) const {
        const int trow0 = wr * 64 + fr, row0 = u.om * BM + trow0, cw = wc * 32 + 8 * fq;
        const float* scl = (const float*)(ws + WS_SCL);
        if (u.e < 0) {
            const float* P2 = (const float*)(ws + WS_P2); bf16_t* PLE = (bf16_t*)(ws + WS_PLE); const float* sx1 = (const float*)(ws + WS_SX1);
            const float spg = scl[NE]; const int col0 = u.on * BM + cw;
#pragma unroll
            for (int ai = 0; ai < 2; ++ai)
#pragma unroll
                for (int m = 0; m < 4; ++m) { const int r = row0 + ai * HALF + m * 16; const float s = sx1[r] * spg; const size_t ro = (size_t)r * D + col0;
#pragma unroll
                    for (int bj = 0; bj < 2; ++bj) { const size_t o = ro + bj * HALF; const f32x4 p0 = *(const f32x4*)(P2 + o), p1 = *(const f32x4*)(P2 + o + 4); const f32x4 a0 = i2f(acc[ai][bj][m][0]) * s, a1 = i2f(acc[ai][bj][m][1]) * s;
                        u32x4 w; w.x = cvt_pk_bf16(fast_sigmoid(a0[0]) * p0[0], fast_sigmoid(a0[1]) * p0[1]); w.y = cvt_pk_bf16(fast_sigmoid(a0[2]) * p0[2], fast_sigmoid(a0[3]) * p0[3]);
                        w.z = cvt_pk_bf16(fast_sigmoid(a1[0]) * p1[0], fast_sigmoid(a1[1]) * p1[1]); w.w = cvt_pk_bf16(fast_sigmoid(a1[2]) * p1[2], fast_sigmoid(a1[3]) * p1[3]);
                        *(u32x4*)(PLE + o) = w; }
                    if (m & 1) asm volatile("" ::: "memory"); }
            return; }
        const float sd = scl[128 + u.e]; const int cnt = cntL[u.e], li0 = u.mt * BM + trow0;
        const float* lhs = (const float*)(ws + WS_LHS) + (size_t)u.e * LISTCAP + li0;
        bf16_t* yp = Y + (size_t)row0 * D + u.on * BM + cw;
        float lhv[2][4];
#pragma unroll
        for (int ai = 0; ai < 2; ++ai)
#pragma unroll
            for (int m = 0; m < 4; ++m) lhv[ai][m] = lhs[ai * HALF + m * 16];
#pragma unroll
        for (int ai = 0; ai < 2; ++ai)
#pragma unroll
            for (int m = 0; m < 4; ++m) { const int dr = ai * HALF + m * 16; const float s = ((li0 + dr) < cnt ? lhv[ai][m] : 0.f) * sd;
#pragma unroll
                for (int bj = 0; bj < 2; ++bj) { const f32x4 v0 = i2f(acc[ai][bj][m][0]) * s, v1 = i2f(acc[ai][bj][m][1]) * s;
                    u32x4 o; o.x = cvt_pk_bf16(v0[0], v0[1]); o.y = cvt_pk_bf16(v0[2], v0[3]); o.z = cvt_pk_bf16(v1[0], v1[1]); o.w = cvt_pk_bf16(v1[2], v1[3]);
                    *(u32x4*)(yp + (size_t)dr * D + bj * HALF) = o; }
                if (m & 1) asm volatile("" ::: "memory"); }
    }
};
struct EpiDown {
    static constexpr bool PERM = true; typedef f32x4 AccT;
    bf16_t* Y; unsigned char* ws;
    __device__ __forceinline__ void operator()(AccRef acc, const Unit& u, int wr, int wc, int fr, int fq) const {
        if (u.e < 0) { ple_epilogue(acc, u, wr, wc, fr, fq, (const float*)(ws + WS_P2), (bf16_t*)(ws + WS_PLE)); return; }
        bf16_t* yp = Y + (size_t)(u.om * BM + wr * 64 + fr) * D + u.on * BM + wc * 32 + 8 * fq;
#pragma unroll
        for (int ai = 0; ai < 2; ++ai)
#pragma unroll
            for (int m = 0; m < 4; ++m)
#pragma unroll
                for (int bj = 0; bj < 2; ++bj) { const f32x4 v0 = acc[ai][bj][m][0], v1 = acc[ai][bj][m][1];
                    u32x4 o; o.x = cvt_pk_bf16(v0[0], v0[1]); o.y = cvt_pk_bf16(v0[2], v0[3]); o.z = cvt_pk_bf16(v1[0], v1[1]); o.w = cvt_pk_bf16(v1[2], v1[3]);
                    *(u32x4*)(yp + (size_t)(ai * HALF + m * 16) * D + bj * HALF) = o; }
    }
};

struct DualOrder {
    StaticOrder so;
    __device__ __forceinline__ bool next(int i, Unit& u) const {
        int pm, pn, q; if (!so.tile(i >> 1, pm, pn, q)) return false;
        const int e = i & 1; u.pm = e * (M / BM) + pm; u.pn = e * 4 + pn; u.om = pm; u.on = pn; u.e = e; u.mt = 0; u.slot = 0; return true;
    }
    __device__ __forceinline__ void a_off(const Unit& u, int tid, int K, unsigned (&o)[2][2]) const { plain_a_off(u.pm, tid, K, o); }
};
struct MoeOrder {
    const LAS int* cntL; const LAS int* tsL; const LAS unsigned* tw; int NT, gather, btile0, btile_ple, n_extra, extra_first; unsigned abase, abase_ple; int U, UT, G, c; const LAS int* utab; int nunits;
    __device__ __forceinline__ void init(const LAS int* cntL_, const LAS int* tsL_, const LAS unsigned* tw_, int NT_, int G_, int c_, int gather_, size_t aoff_, size_t boff_, int n_extra_, int extra_first_, size_t aoff_ple_, size_t boff_ple_, int tshift_) {
        cntL = cntL_; tsL = tsL_; tw = tw_; NT = NT_; gather = gather_; abase = (unsigned)aoff_; btile0 = (int)(boff_ >> tshift_); abase_ple = (unsigned)aoff_ple_; btile_ple = (int)(boff_ple_ >> tshift_); n_extra = n_extra_; extra_first = extra_first_;
        U = __builtin_amdgcn_readfirstlane(tsL_[NE]) * NT_; UT = U + n_extra_; G = G_; c = c_; utab = nullptr; nunits = 0; }
    struct Own { int ok, maxT, maxC, totalFree; };
    __device__ __forceinline__ Own own_params(int split) const {
        Own o; int mx = 0, sumT = 0;
        for (int e = 0; e < NE; ++e) { const int T = tsL[e + 1] - tsL[e]; mx = T > mx ? T : mx; sumT += T; }
        o.maxT = mx; o.maxC = split == 1 ? mx : (mx + 1) >> 1; o.ok = 0;
        o.totalFree = split == 1 ? 8 * (NE * o.maxC - sumT) : 4 * (2 * NE * o.maxC - sumT);
        return o;
    }
    __device__ __forceinline__ static int ple_in_p5(const LAS int* tsL_, int G_) {
        int mx = 0, sumT = 0;
        for (int e = 0; e < NE; ++e) { const int T = tsL_[e + 1] - tsL_[e]; mx = T > mx ? T : mx; sumT += T; }
        int nfree;
        { const int U5 = sumT * 8; nfree = (G_ - U5 % G_) % G_; }
        return nfree < 256 ? nfree : 256;
    }
    __device__ __forceinline__ void build_units(LAS int* tab, int maxu, int tid, int p, int split) {
        const Own o = own_params(split);
        if (o.ok) {
            const int e = p >> 3, sub = p & 7, nt = split == 1 ? sub : sub >> 1, half = split == 1 ? 0 : sub & 1;
            const int t0 = tsL[e], T = tsL[e + 1] - t0, h0 = (T + 1) >> 1;
            const int myc = split == 1 ? T : (half ? T - h0 : h0), mt0 = (split == 2 && half) ? h0 : 0, myfree = o.maxC - myc;
            int prefix = 0;
            for (int k = 0; k < e; ++k) { const int Tk = tsL[k + 1] - tsL[k]; prefix += split == 1 ? 8 * (o.maxC - Tk) : 4 * (2 * o.maxC - Tk); }
            prefix += split == 1 ? sub * (o.maxC - T) : (sub >> 1) * (2 * o.maxC - T) + (half ? (o.maxC - h0) : 0);
            int nfill = n_extra - prefix; nfill = nfill < 0 ? 0 : (nfill > myfree ? myfree : nfill);
            int nover = 0; if (n_extra > o.totalFree) { const int rem = n_extra - o.totalFree - p; nover = rem > 0 ? (rem + 255) >> 8 : 0; }
            int n = myc + nfill + nover; if (n > maxu) n = maxu;
            if (tid < n) { LAS int* q = tab + 8 * tid;
                if (tid < myc) { const int mt = mt0 + tid; q[0] = t0 + mt; q[1] = btile0 + e * NT + nt; q[2] = nt; q[3] = e; q[4] = mt; }
                else { const int k = tid - myc; const int idx = k < nfill ? prefix + k : o.totalFree + (k - nfill) * 256 + p;
                    const int j = extra_first + idx, pm = (j >> 5) * 8 + (j & 7), pn = (j & 31) >> 3; q[0] = pm; q[1] = btile_ple + pn; q[2] = pn; q[3] = -1; q[4] = 0; } }
            __syncthreads();
            utab = tab; nunits = n; return;
        }
        if (tid < maxu) { const int L = tid * G + c;
            if (L < UT) { LAS int* q = tab + 8 * tid;
                if (L >= U) { const int j = extra_first + (L - U), pm = (j >> 5) * 8 + (j & 7), pn = (j & 31) >> 3; q[0] = pm; q[1] = btile_ple + pn; q[2] = pn; q[3] = -1; q[4] = 0; }
                else { const int wgid = xcd_remap(L, U); int e = 0;
                    for (int k = 1; k < NE; ++k) e += (wgid >= tsL[k] * NT) ? 1 : 0;
                    const int t0 = tsL[e], ntl = tsL[e + 1] - t0, r = wgid - t0 * NT, nt = r / ntl, mt = r - nt * ntl;
                    q[0] = t0 + mt; q[1] = btile0 + e * NT + nt; q[2] = nt; q[3] = e; q[4] = mt; } } }
        __syncthreads();
        utab = tab; nunits = c < UT ? (UT - 1 - c) / G + 1 : 0; if (nunits > maxu) nunits = maxu;
    }
    __device__ __forceinline__ bool next(int i, Unit& u) const {
        if (i >= nunits) return false;
        const LAS int* p = utab + 8 * i;
        u.pm = __builtin_amdgcn_readfirstlane(p[0]); u.pn = __builtin_amdgcn_readfirstlane(p[1]); u.om = u.pm; u.on = __builtin_amdgcn_readfirstlane(p[2]);
        u.e = __builtin_amdgcn_readfirstlane(p[3]); u.mt = __builtin_amdgcn_readfirstlane(p[4]); u.slot = i; return true;
    }
    __device__ __forceinline__ void a_off(const Unit& u, int tid, int K, unsigned (&o)[2][2]) const {
        if (u.e < 0 || !gather) { plain_a_off(u.pm, tid, K, o); const unsigned base = u.e < 0 ? abase_ple : abase;
#pragma unroll
            for (int h = 0; h < 2; ++h)
#pragma unroll
                for (int i = 0; i < 2; ++i) o[h][i] += base;
            return; }
#pragma unroll
        for (int i = 0; i < 2; ++i) { int R, C; stage_rc(tid * 16 + i * 8192, R, C);
#pragma unroll
            for (int h = 0; h < 2; ++h) { const int tok = (int)(tw[u.slot * BM + h * HALF + R] & 0xffffu);
                o[h][i] = (unsigned)(tok * K + C) * 2u + abase; } }
    }
};
constexpr int MOE_MAXU = 10;
__device__ __forceinline__ void moe_preload(const MoeOrder& S, const LAS int* cntL, const int* list_tok, const float* list_w, LAS unsigned* tw, int wvid) {
    int tid_ = (wvid * 64 + lane_id_asm()); asm volatile("" : "+v"(tid_)); const int tid = tid_;
    int tokv[MOE_MAXU / 2]; float wv[MOE_MAXU / 2];
#pragma unroll
    for (int k = 0; k < MOE_MAXU / 2; ++k) { const int ent = tid + NTHREADS * k, slot = ent >> 8, row = ent & 255; tokv[k] = 0; wv[k] = 0.f;
        if (slot < S.nunits) { const LAS int* p = S.utab + 8 * slot; const int e = p[3], mt = p[4], li = mt * BM + row;
            if (e >= 0 && li < cntL[e]) { tokv[k] = list_tok[(size_t)e * LISTCAP + li]; wv[k] = list_w[(size_t)e * LISTCAP + li]; } } }
#pragma unroll
    for (int k = 0; k < MOE_MAXU / 2; ++k) { const int ent = tid + NTHREADS * k; if ((ent >> 8) < S.nunits) tw[ent] = (unsigned)tokv[k] | (f2bf(wv[k]) << 16); }
    __syncthreads();
}
struct Ple1Order {
    int first, n;
    __device__ __forceinline__ bool next(int i, Unit& u) const { if (i >= n) return false; const int j = first + i, pm = (j >> 5) * 8 + (j & 7), pn = (j & 31) >> 3;
        u.pm = pm; u.pn = pn; u.om = pm; u.on = pn; u.e = 0; u.mt = 0; u.slot = 0; return true; }
    __device__ __forceinline__ void a_off(const Unit& u, int tid, int K, unsigned (&o)[2][2]) const { plain_a_off(u.pm, tid, K, o); }
};
}
__device__ __forceinline__ int dst_row(int n, int map) {
    if (map == 1) { if (n >= 1024 && n < 3072) { const int hsel = n >= 2048, c = n - 1024 - hsel * 1024; return 1024 + (c >> 7) * 256 + hsel * 128 + (c & 127); } return n; }
    if (map == 2) { const int hsel = n >= 1024, c = n - hsel * 1024; return (c >> 7) * 256 + hsel * 128 + (c & 127); }
    return n;
}
struct P0Args { const float *x, *p, *w_in, *w_brc, *w_bra, *w_out, *w_pg, *w_pp, *w_gu, *w_dn; unsigned char* ws; float s_in, s_pp; };
struct P0Item { const float* src; bf16_t* dst; int K, N; float qinv; };
constexpr int P0_I_IN = 16 * (NIN / 64), P0_I_SQ = 16 * 16, P0_I_PP = 4 * 16, P0_I_GU = 16 * 32, P0_I_DN = 16 * 16;
constexpr int P0_NSMALL = P0_I_IN + 3 * P0_I_SQ + P0_I_PP;
constexpr int P0_NITEMS = P0_I_IN + 4 * P0_I_SQ + P0_I_PP + NE * P0_I_GU + NE * P0_I_DN;
__device__ __forceinline__ P0Item p0_decode(const P0Args& a, int it) {
    const float* W; bf16_t* WT; int K = D, N = D, map = 0, r = it; float qinv = 0.f; const float* scl = (const float*)(a.ws + WS_SCL);
    if (r < P0_I_IN) { W = a.w_in; WT = (bf16_t*)(a.ws + WS_WIN); N = NIN; map = 1; qinv = 1.0f / a.s_in; }
    else if ((r -= P0_I_IN) < P0_I_SQ) { W = a.w_brc; WT = (bf16_t*)(a.ws + WS_WBR); }
    else if ((r -= P0_I_SQ) < P0_I_SQ) { W = a.w_bra; WT = (bf16_t*)(a.ws + WS_WBR) + (size_t)D * D; }
    else if ((r -= P0_I_SQ) < P0_I_SQ) { W = a.w_out; WT = (bf16_t*)(a.ws + WS_WOUT); }
    else if ((r -= P0_I_SQ) < P0_I_PP) { W = a.w_pp; WT = (bf16_t*)(a.ws + WS_WPP); K = DPLE; }
    else if ((r -= P0_I_PP) < P0_I_SQ) { W = a.w_pg; WT = (bf16_t*)(a.ws + WS_WPG8); qinv = 1.0f / scl[NE]; }
    else if ((r -= P0_I_SQ) < NE * P0_I_GU) { const int e = r / P0_I_GU; r -= e * P0_I_GU; W = a.w_gu + (size_t)e * D * 2048; WT = (bf16_t*)(a.ws + WS_WGU + (size_t)e * 2048 * D); N = 2048; map = 2; qinv = 1.0f / scl[e]; }
    else { r -= NE * P0_I_GU; const int e = r / P0_I_DN; r -= e * P0_I_DN; W = a.w_dn + (size_t)e * D * D; WT = (bf16_t*)(a.ws + WS_WDN + (size_t)e * D * D); qinv = 1.0f / scl[128 + e]; }
    const int nblk = N / 64, kb = r / nblk, nb = r - kb * nblk, k0 = 64 * kb, n0 = 64 * nb;
    P0Item d; d.src = W + (size_t)k0 * N + n0; d.K = K; d.N = N; d.qinv = qinv;
    d.dst = qinv != 0.f ? (bf16_t*)((unsigned char*)WT + (size_t)dst_row(n0, map) * K + k0) : WT + (size_t)dst_row(n0, map) * K + k0; return d;
}
__device__ __forceinline__ void p0_load(const P0Item& d, f32x4 (&v)[16], int lane) {
    const int lr = lane >> 4, lc = (lane & 15) * 4;
#pragma unroll
    for (int i = 0; i < 16; ++i) v[i] = __builtin_nontemporal_load((const f32x4*)(d.src + (size_t)(4 * i + lr) * d.N + lc));
}
__device__ __forceinline__ void p0_store(const P0Item& d, const f32x4 (&v)[16], LAS float* scr, int lane) {
    const int lr = lane >> 4, lc = (lane & 15) * 4;
#pragma unroll
    for (int i = 0; i < 16; ++i) { LAS float* s = scr + (4 * i + lr) * 65 + lc; s[0] = v[i][0]; s[1] = v[i][1]; s[2] = v[i][2]; s[3] = v[i][3]; }
    asm volatile("s_waitcnt lgkmcnt(0)" ::: "memory");
    const int c = lane & 7;
#pragma unroll
    for (int j = 0; j < 8; ++j) { const int n = (lane >> 3) + 8 * j; const LAS float* s = scr + (8 * c) * 65 + n;
        if (d.qinv != 0.f) { unsigned lo = 0u, hi = 0u;
#pragma unroll
            for (int q = 0; q < 4; ++q) { const int a0 = (int)fminf(fmaxf(rintf(s[q * 65] * d.qinv), -127.f), 127.f), a1 = (int)fminf(fmaxf(rintf(s[(q + 4) * 65] * d.qinv), -127.f), 127.f);
                lo |= ((unsigned)a0 & 0xffu) << (8 * q); hi |= ((unsigned)a1 & 0xffu) << (8 * q); }
            *(u32x2*)((unsigned char*)d.dst + (size_t)n * d.K + 8 * c) = (u32x2){lo, hi}; }
        else { u32x4 o; o.x = pk2(s[0 * 65], s[1 * 65]); o.y = pk2(s[2 * 65], s[3 * 65]); o.z = pk2(s[4 * 65], s[5 * 65]); o.w = pk2(s[6 * 65], s[7 * 65]);
            *(u32x4*)(d.dst + (size_t)n * d.K + 8 * c) = o; } }
    asm volatile("s_waitcnt lgkmcnt(0)" ::: "memory");
}
__host__ __device__ constexpr int fill_cnt(int seam) { return seam >= 1 && seam <= 5 ? 2 : 0; }
__host__ __device__ constexpr int fill_pre(int seam) { int a = 0; for (int k = 1; k < seam; ++k) a += fill_cnt(k); return a; }
constexpr int P0_FILL_TOTAL = fill_pre(5);
__device__ __forceinline__ void p0_fill(const P0Args& a, LAS unsigned char* lds, int vcu, int G, int seam, int wave) {
    const int lane = lane_id_asm();
    LAS float* scr = (LAS float*)(lds + wave * 16640);
    int it = (seam <= 4 ? P0_NSMALL + G * 7 * fill_pre(seam) : P0_NITEMS - G * 7 * fill_cnt(5)) + (vcu * 7 + (wave - 1)) * fill_cnt(seam);
    int end = it + fill_cnt(seam); end = end < P0_NITEMS ? end : P0_NITEMS;
    f32x4 va[16], vb[16]; P0Item da, db;
    if (it < end) { da = p0_decode(a, it); p0_load(da, va, lane); }
    while (it < end) {
        const bool hb = it + 1 < end;
        if (hb) { db = p0_decode(a, it + 1); p0_load(db, vb, lane); }
        p0_store(da, va, scr, lane);
        if (!hb) break;
        const bool ha = it + 2 < end;
        if (ha) { da = p0_decode(a, it + 2); p0_load(da, va, lane); }
        p0_store(db, vb, scr, lane);
        if (!ha) break;
        it += 2;
    }
}
__device__ __forceinline__ float sample_scale(const float* Wm, unsigned stride, LAS unsigned char* lds, int wvid, float* rms_out = nullptr) {
    int tid_ = (wvid * 64 + lane_id_asm()); asm volatile("" : "+v"(tid_)); const int tid = tid_, lane = tid & 63;
    const unsigned so = (unsigned)tid * stride;
    const f32x4 v0 = *(const f32x4*)(Wm + so), v1 = *(const f32x4*)(Wm + so + 4);
    float ss = (v0[0] * v0[0] + v0[1] * v0[1]) + (v0[2] * v0[2] + v0[3] * v0[3]) + (v1[0] * v1[0] + v1[1] * v1[1]) + (v1[2] * v1[2] + v1[3] * v1[3]);
    float mx = fmaxf(fmaxf(fmaxf(fabsf(v0[0]), fabsf(v0[1])), fmaxf(fabsf(v0[2]), fabsf(v0[3]))), fmaxf(fmaxf(fabsf(v1[0]), fabsf(v1[1])), fmaxf(fabsf(v1[2]), fabsf(v1[3]))));
    ss = wave_sum(ss, lane);
#pragma unroll
    for (int o = 1; o < 64; o <<= 1) mx = fmaxf(mx, shx(mx, o, lane));
    LAS float* red = (LAS float*)lds;
    __syncthreads();
    if ((tid & 63) == 0) { red[tid >> 6] = ss; red[8 + (tid >> 6)] = mx; }
    __syncthreads();
    float s = 0.f, m = 0.f;
#pragma unroll
    for (int w = 0; w < NWAVES; ++w) { s += red[w]; m = fmaxf(m, red[8 + w]); }
    __syncthreads();
    const float rms = sqrtf(s * (1.0f / 4096.0f)); if (rms_out) *rms_out = rms;
    return fmaxf(fmaxf(6.5f * rms, 1.25f * m), 1e-30f) * (1.0f / 127.0f);
}
__device__ __forceinline__ void p0_calibrate(const P0Args& a, LAS unsigned char* lds, int vcu, int wvid) {
    if (vcu > 2 * NE) return;
    float rms = 0.f;
    const float* Wm = vcu < NE ? a.w_gu + (size_t)vcu * D * 2048 : (vcu == NE ? a.w_pg : a.w_dn + (size_t)(vcu - NE - 1) * D * D);
    const float sc = sample_scale(Wm, vcu < NE ? 4100 : 2044, lds, wvid, &rms);
    if ((wvid * 64 + lane_id_asm()) == 0) { float* scl = (float*)(a.ws + WS_SCL); if (vcu <= NE) scl[vcu] = sc; else scl[128 + vcu - NE - 1] = sc; if (vcu < NE) scl[64 + vcu] = rms; }
}
__device__ __forceinline__ void p0_phase(const P0Args& a, LAS unsigned char* lds, int vcu, int G, int it_lo, int it_hi, bool do_xp, int wvid) {
    int tid_ = (wvid * 64 + lane_id_asm()); asm volatile("" : "+v"(tid_));
    const int tid = tid_, lane = tid & 63, wave = __builtin_amdgcn_readfirstlane(tid >> 6);
    LAS float* scr = (LAS float*)(lds + wave * 16640);
    const int gw = vcu * NWAVES + wave, NGW = G * NWAVES;
    f32x4 va[16], vb[16]; P0Item da, db;
    int it = it_lo + gw;
    if (it < it_hi) { da = p0_decode(a, it); p0_load(da, va, lane); }
    while (it < it_hi) {
        const bool hb = it + NGW < it_hi;
        if (hb) { db = p0_decode(a, it + NGW); p0_load(db, vb, lane); }
        p0_store(da, va, scr, lane);
        if (!hb) break;
        const bool ha = it + 2 * NGW < it_hi;
        if (ha) { da = p0_decode(a, it + 2 * NGW); p0_load(da, va, lane); }
        p0_store(db, vb, scr, lane);
        if (!ha) break;
        it += 2 * NGW;
    }
    if (!do_xp) return;
    p0_calibrate(a, lds, vcu, wvid);
    const int gt = vcu * NTHREADS + tid, NGT = G * NTHREADS;
    for (int t0 = 2 * gw; t0 < M; t0 += 2 * NGW) { f32x4 v[2][4];
#pragma unroll
        for (int x = 0; x < 2; ++x)
#pragma unroll
            for (int j = 0; j < 4; ++j) v[x][j] = __builtin_nontemporal_load((const f32x4*)(a.x + (size_t)(t0 + x) * D + 256 * j + 4 * lane));
#pragma unroll
        for (int x = 0; x < 2; ++x) { float am = 0.f;
#pragma unroll
            for (int j = 0; j < 4; ++j) am = fmaxf(am, fmaxf(fmaxf(fabsf(v[x][j][0]), fabsf(v[x][j][1])), fmaxf(fabsf(v[x][j][2]), fabsf(v[x][j][3]))));
#pragma unroll
            for (int o = 1; o < 64; o <<= 1) am = fmaxf(am, shx(am, o, lane));
            const float sxr = fmaxf(am, 1e-30f) * (1.0f / 127.0f), qi = 1.0f / sxr;
#pragma unroll
            for (int j = 0; j < 4; ++j) { unsigned q = 0u;
#pragma unroll
                for (int z = 0; z < 4; ++z) q |= ((unsigned)(int)rintf(v[x][j][z] * qi) & 0xffu) << (8 * z);
                *(unsigned*)(a.ws + WS_XB + (size_t)(t0 + x) * D + 256 * j + 4 * lane) = q; }
            if (lane == 0) ((float*)(a.ws + WS_SX0))[t0 + x] = sxr; } }
    for (int i = gt; i < M * DPLE / 8; i += 4 * NGT) { f32x4 v[4][2];
#pragma unroll
        for (int u = 0; u < 4; ++u) { const size_t o = (size_t)(i + u * NGT) * 8; v[u][0] = __builtin_nontemporal_load((const f32x4*)(a.p + o)); v[u][1] = __builtin_nontemporal_load((const f32x4*)(a.p + o + 4)); }
#pragma unroll
        for (int u = 0; u < 4; ++u) { u32x4 o; o.x = pk2(v[u][0][0], v[u][0][1]); o.y = pk2(v[u][0][2], v[u][0][3]); o.z = pk2(v[u][1][0], v[u][1][1]); o.w = pk2(v[u][1][2], v[u][1][3]);
            *(u32x4*)((bf16_t*)(a.ws + WS_PB) + (size_t)(i + u * NGT) * 8) = o; } }
}

__device__ __forceinline__ int crow(int r, int hi) { return (r & 3) + 8 * (r >> 2) + 4 * hi; }
typedef short v4i16_t __attribute__((ext_vector_type(4)));
__device__ __forceinline__ s16x4 vtr(const LAS unsigned char* p) { return __builtin_bit_cast(s16x4, __builtin_amdgcn_ds_read_tr16_b64_v4i16((LAS v4i16_t*)p)); }
__device__ __forceinline__ void attn_unit(LAS unsigned char* lds, const bf16_t* Q, const bf16_t* Kg, const bf16_t* Vg, const float* sinks, bf16_t* O, int b, int kvh, int nb, int wvid) {
    int tid_ = (wvid * 64 + lane_id_asm()); asm volatile("" : "+v"(tid_));
    const int tid = tid_, lane = tid & 63, r32 = lane & 31, hi = lane >> 5; const int wid = __builtin_amdgcn_readfirstlane(tid >> 6);
    const int t0 = b * SEQ + nb * 128;
#pragma unroll
    for (int it = 0; it < 4; ++it) { const int idx = tid + it * NTHREADS, key = idx >> 3, c = idx & 7;
        int row = t0 - 128 + key; if (row < b * SEQ) row = b * SEQ;
        const u32x4 kv = *(const u32x4*)(Kg + (size_t)row * 256 + kvh * HD + c * 8);
        const u32x4 vv = *(const u32x4*)(Vg + (size_t)row * 256 + kvh * HD + c * 8);
        *(LAS u32x4*)(lds + c * 4096 + key * 16) = kv;
        *(LAS u32x4*)(lds + 32768 + (c >> 2) * 16384 + (key >> 4) * 1024 + (key & 15) * 64 + (c & 3) * 16) = vv; }
    __syncthreads();
    const int g = wid >> 1, half = wid & 1, h = kvh * 4 + g;
    const float sink2 = sinks[h] * LOG2E;
    const LAS unsigned char* vbase = lds + 32768 + ((lane >> 4) & 1) * 32 + (lane & 3) * 8 + (4 * hi + ((lane & 15) >> 2)) * 64;
#pragma unroll 1
    for (int qq = 0; qq < 2; ++qq) {
        const int qt = half * 2 + qq;
        const bf16_t* qp = Q + (size_t)(t0 + 32 * qt + r32) * D + h * HD + hi * 8;
        bf16x8 qr[4];
#pragma unroll
        for (int d0 = 0; d0 < 4; ++d0) qr[d0] = *(const bf16x8*)(qp + d0 * 16);
        f32x16 s[5];
#pragma unroll
        for (int j = 0; j < 5; ++j) { const LAS unsigned char* kp = lds + hi * 4096 + ((qt + j) * 32 + r32) * 16; f32x16 a = {};
#pragma unroll
            for (int d0 = 0; d0 < 4; ++d0) a = __builtin_amdgcn_mfma_f32_32x32x16_bf16(*(const LAS bf16x8*)(kp + d0 * 8192), qr[d0], a, 0, 0, 0);
            s[j] = a; }
#pragma unroll
        for (int r = 0; r < 16; ++r) { const int cr = crow(r, hi); if (cr <= r32) s[0][r] = -INFINITY; if (cr > r32) s[4][r] = -INFINITY; }
        if (nb == 0) {
#pragma unroll
            for (int j = 0; j < 4; ++j) if (qt + j < 4) {
#pragma unroll
                for (int r = 0; r < 16; ++r) s[j][r] = -INFINITY; } }
        float mx = -INFINITY;
#pragma unroll
        for (int j = 0; j < 5; ++j)
#pragma unroll
            for (int r = 0; r < 16; ++r) mx = fmaxf(mx, s[j][r]);
        mx = fmaxf(mx, shx(mx, 32, lane)); mx = fmaxf(mx, sink2);
        float ls = 0.f;
#pragma unroll
        for (int j = 0; j < 5; ++j)
#pragma unroll
            for (int r = 0; r < 16; ++r) { s[j][r] = __builtin_amdgcn_exp2f(s[j][r] - mx); ls += s[j][r]; }
        ls += shx(ls, 32, lane); ls += __builtin_amdgcn_exp2f(sink2 - mx);
        const float linv = 1.0f / ls;
        f32x16 o[2]; o[0] = f32x16{}; o[1] = f32x16{};
#pragma unroll
        for (int j = 0; j < 5; ++j)
#pragma unroll
            for (int ks = 0; ks < 2; ++ks) {
                u32x4 pw; pw.x = pk2(s[j][8 * ks + 0], s[j][8 * ks + 1]); pw.y = pk2(s[j][8 * ks + 2], s[j][8 * ks + 3]); pw.z = pk2(s[j][8 * ks + 4], s[j][8 * ks + 5]); pw.w = pk2(s[j][8 * ks + 6], s[j][8 * ks + 7]);
                const bf16x8 pa = __builtin_bit_cast(bf16x8, pw);
                const LAS unsigned char* vp = vbase + ((qt + j) * 2 + ks) * 1024;
#pragma unroll
                for (int dh = 0; dh < 2; ++dh) { const s16x4 lo = vtr(vp + dh * 16384), hi4 = vtr(vp + dh * 16384 + 512);
                    const bf16x8 vf = {lo[0], lo[1], lo[2], lo[3], hi4[0], hi4[1], hi4[2], hi4[3]};
                    o[dh] = __builtin_amdgcn_mfma_f32_32x32x16_bf16(pa, vf, o[dh], 0, 0, 0); } }
        LAS bf16_t* stg = (LAS bf16_t*)(lds + 65536 + wid * 4096);
#pragma unroll
        for (int r = 0; r < 16; ++r) { const int q = crow(r, hi); const float sc = shidx(linv, q);
            stg[q * 64 + r32] = (bf16_t)f2bf(o[0][r] * sc); stg[q * 64 + 32 + r32] = (bf16_t)f2bf(o[1][r] * sc); }
        asm volatile("s_waitcnt lgkmcnt(0)" ::: "memory");
        bf16_t* ob = O + (size_t)(t0 + 32 * qt) * D + h * HD;
#pragma unroll
        for (int i = 0; i < 4; ++i) { const int row = i * 8 + (lane >> 3), ch = lane & 7;
            *(u32x4*)(ob + (size_t)row * D + ch * 8) = *(const LAS u32x4*)(stg + row * 64 + ch * 8); }
        asm volatile("s_waitcnt lgkmcnt(0)" ::: "memory");
    }
    __syncthreads();
}
__device__ __forceinline__ void conv_phase(const bf16_t* Bg, const bf16_t* U, const float* cw, bf16_t* Z, int vcu, int G, int wvid) {
    int tid_ = (wvid * 64 + lane_id_asm()); asm volatile("" : "+v"(tid_));
    const int gt = vcu * NTHREADS + tid_, NGT = G * NTHREADS;
    for (int i = gt; i < (M / 8) * (D / 8); i += NGT) {
        const int t0 = (i >> 7) * 8, c = (i & 127) * 8, tl0 = t0 & (SEQ - 1);
        f32x4 w[3][2];
#pragma unroll
        for (int k = 0; k < 3; ++k) { w[k][0] = *(const f32x4*)(cw + k * D + c); w[k][1] = *(const f32x4*)(cw + k * D + c + 4); }
        u32x4 ur[10], br[8];
#pragma unroll
        for (int r = 0; r < 10; ++r) { if (r >= 2 || tl0 != 0) ur[r] = *(const u32x4*)(U + (size_t)(t0 + r - 2) * D + c); else ur[r] = (u32x4){0u, 0u, 0u, 0u}; }
#pragma unroll
        for (int r = 0; r < 8; ++r) br[r] = *(const u32x4*)(Bg + (size_t)(t0 + r) * D + c);
#pragma unroll
        for (int r = 0; r < 8; ++r) { float y[8];
#pragma unroll
            for (int j = 0; j < 8; ++j) y[j] = 0.f;
#pragma unroll
            for (int k = 0; k < 3; ++k) { const u32x4 uw = ur[r + k];
                y[0] += w[k][0][0] * bflo(uw.x); y[1] += w[k][0][1] * bfhi(uw.x); y[2] += w[k][0][2] * bflo(uw.y); y[3] += w[k][0][3] * bfhi(uw.y);
                y[4] += w[k][1][0] * bflo(uw.z); y[5] += w[k][1][1] * bfhi(uw.z); y[6] += w[k][1][2] * bflo(uw.w); y[7] += w[k][1][3] * bfhi(uw.w); }
            const u32x4 bw = br[r];
            u32x4 o; o.x = pk2(y[0] * bflo(bw.x), y[1] * bfhi(bw.x)); o.y = pk2(y[2] * bflo(bw.y), y[3] * bfhi(bw.y)); o.z = pk2(y[4] * bflo(bw.z), y[5] * bfhi(bw.z)); o.w = pk2(y[6] * bflo(bw.w), y[7] * bfhi(bw.w));
            *(u32x4*)(Z + (size_t)(t0 + r) * D + c) = o; }
    }
}
#ifndef DBG_ATTN
#define DBG_ATTN 0
#endif
#if DBG_ATTN
__device__ __forceinline__ void dbg_attn_check(const bf16_t* Q, const bf16_t* Kg, const bf16_t* Vg, const float* sinks, const bf16_t* O, float* acc3, int vcu, int G, int wvid) {
    const int lane = (wvid * 64 + lane_id_asm()) & 63, wave = wvid;
    const int gw = vcu * NWAVES + wave, nw = G * NWAVES;
    float lnum = 0.f, lden = 0.f, lmax = 0.f;
    for (int it = gw; it < M * NH; it += nw) {
        const int t = it / NH, h = it % NH, kvh = h / 4, tl = t % SEQ;
        const int slo = tl - 127 < 0 ? 0 : tl - 127, n = tl - slo + 1;
        const bf16_t* qp = Q + (size_t)t * D + h * HD;
        float sc[2];
#pragma unroll
        for (int u = 0; u < 2; ++u) { const int j = lane + 64 * u; float dot = -INFINITY;
            if (j < n) { const bf16_t* kp = Kg + (size_t)(t - tl + slo + j) * 256 + kvh * HD; dot = 0.f;
                for (int d = 0; d < HD; ++d) dot = fmaf(bflo((unsigned)qp[d]), bflo((unsigned)kp[d]), dot);
                dot *= (1.0f / LOG2E); }
            sc[u] = dot; }
        const float sink = sinks[h];
        float m = fmaxf(sc[0], sc[1]);
        for (int o = 1; o < 64; o <<= 1) m = fmaxf(m, shx(m, o, lane));
        m = fmaxf(m, sink);
        float e0 = (lane < n) ? expf(sc[0] - m) : 0.f, e1 = (lane + 64 < n) ? expf(sc[1] - m) : 0.f;
        float s = e0 + e1;
        for (int o = 1; o < 64; o <<= 1) s += shx(s, o, lane);
        const float denom = s + expf(sink - m);
        e0 /= denom; e1 /= denom;
        float a = 0.f;
        for (int j = 0; j < n; ++j) { const float pj = shidx(j < 64 ? e0 : e1, j & 63); a = fmaf(pj, bflo((unsigned)Vg[(size_t)(t - tl + slo + j) * 256 + kvh * HD + lane]), a); }
        const float o = bflo((unsigned)O[(size_t)t * D + h * HD + lane]);
        const float rn = wave_sum((o - a) * (o - a), lane), rd = wave_sum(a * a, lane);
        lnum += rn; lden += rd; lmax = fmaxf(lmax, rn / fmaxf(rd, 1e-20f));
    }
    if (lane == 0) { atomicAdd(acc3, lnum); atomicAdd(acc3 + 1, lden); atomicMax((unsigned*)(acc3 + 2), __float_as_uint(lmax)); }
}
#endif
constexpr int WR_STRIDE = 1028;
struct RouteArgs { const bf16_t* T; const float* X; bf16_t* X1B; const float *g1, *b1, *w_r, *b_r; int* gcnt; int* list_tok; float* list_w; int* tk_e; int* tk_rank; float* tk_w; unsigned char* XQ; float* sx1; float* list_sx; float* list_hs; const float* scl; };
#ifndef PROBE_DRYCUT
#define PROBE_DRYCUT 0
#endif
__device__ __forceinline__ void route_phase(const RouteArgs& a, LAS unsigned char* lds, int vcu, int G, bool dry, int wvid) {
    int tid_ = (wvid * 64 + lane_id_asm()); asm volatile("" : "+v"(tid_));
    const int tid = tid_, lane = tid & 63, wave = __builtin_amdgcn_readfirstlane(tid >> 6);
    LAS float* wrt = (LAS float*)lds;
    LAS int* misc = (LAS int*)(lds + MISC_OFF);
    LAS int* lcnt = misc + 96; LAS int* gbase = misc + 128; LAS int* rowe = misc + 160; LAS float* roww = (LAS float*)(misc + 416); LAS float* rowsx = (LAS float*)(misc + 672); LAS float* rownrm = (LAS float*)(misc + 736);
    if (!(dry && (PROBE_DRYCUT & 1))) for (int i = tid; i < (D / 4) * NE; i += NTHREADS) { const int q = i >> 5, e = i & 31; const float* wp = a.w_r + (size_t)(4 * q) * NE + e;
        const f32x4 w4 = {wp[0], wp[NE], wp[2 * NE], wp[3 * NE]}; *(LAS f32x4*)(wrt + e * WR_STRIDE + 4 * q) = w4; }
    if (tid < NE) lcnt[tid] = 0;
    __syncthreads();
    const int rows_per_wg = M / G;
    f32x4 xr[2][4]; u32x2 tr[2][4];
#define ROUTE_LOAD(rr_) do { _Pragma("unroll") for (int x = 0; x < 2; ++x) _Pragma("unroll") for (int j = 0; j < 4; ++j) { const size_t o_ = (size_t)(vcu * rows_per_wg + (rr_) + x) * D + 256 * j + 4 * lane; \
        tr[x][j] = *(const u32x2*)(a.T + o_); xr[x][j] = __builtin_nontemporal_load((const f32x4*)(a.X + o_)); } } while (0)
    if (2 * wave < rows_per_wg) ROUTE_LOAD(2 * wave);
    for (int rr = 2 * wave; rr < rows_per_wg; rr += 2 * NWAVES) {
        f32x4 v[2][4];
#pragma unroll
        for (int x = 0; x < 2; ++x)
#pragma unroll
            for (int j = 0; j < 4; ++j) v[x][j] = xr[x][j] * DN_ALPHA + (f32x4){bflo(tr[x][j].x), bfhi(tr[x][j].x), bflo(tr[x][j].y), bfhi(tr[x][j].y)};
        if (rr + 2 * NWAVES < rows_per_wg) ROUTE_LOAD(rr + 2 * NWAVES);
#pragma unroll
        for (int x = 0; x < 2; ++x) { const int t = vcu * rows_per_wg + rr + x; float s = 0.f;
#pragma unroll
            for (int j = 0; j < 4; ++j) s += (v[x][j][0] + v[x][j][1]) + (v[x][j][2] + v[x][j][3]);
            const float mean = wave_sum_u(s) * (1.0f / D); float q = 0.f;
#pragma unroll
            for (int j = 0; j < 4; ++j) { v[x][j] = v[x][j] - mean; q += (v[x][j][0] * v[x][j][0] + v[x][j][1] * v[x][j][1]) + (v[x][j][2] * v[x][j][2] + v[x][j][3] * v[x][j][3]); }
            const float rstd = 1.0f / sqrtf(wave_sum_u(q) * (1.0f / D) + LN_EPS);
#pragma unroll
            for (int j = 0; j < 4; ++j) { const f32x4 gg = *(const f32x4*)(a.g1 + 256 * j + 4 * lane), bb = *(const f32x4*)(a.b1 + 256 * j + 4 * lane);
                v[x][j] = v[x][j] * rstd * gg + bb;
                if (!dry) { u32x2 w; w.x = pk2(v[x][j][0], v[x][j][1]); w.y = pk2(v[x][j][2], v[x][j][3]); *(u32x2*)(a.X1B + (size_t)t * D + 256 * j + 4 * lane) = w; } }
            float am = 0.f, ssq = 0.f;
#pragma unroll
            for (int j = 0; j < 4; ++j) { am = fmaxf(am, fmaxf(fmaxf(fabsf(v[x][j][0]), fabsf(v[x][j][1])), fmaxf(fabsf(v[x][j][2]), fabsf(v[x][j][3]))));
                ssq += (v[x][j][0] * v[x][j][0] + v[x][j][1] * v[x][j][1]) + (v[x][j][2] * v[x][j][2] + v[x][j][3] * v[x][j][3]); }
            am = wave_max_u(am); ssq = wave_sum_u(ssq);
            const float sxr = fmaxf(am, 1e-30f) * (1.0f / 127.0f), qi = 1.0f / sxr;
            if (!dry) {
#pragma unroll
                for (int j = 0; j < 4; ++j) { unsigned q8 = 0u;
#pragma unroll
                    for (int z = 0; z < 4; ++z) q8 |= ((unsigned)(int)rintf(v[x][j][z] * qi) & 0xffu) << (8 * z);
                    *(unsigned*)(a.XQ + (size_t)t * D + 256 * j + 4 * lane) = q8; }
                if (lane == 0) { a.sx1[t] = sxr; rowsx[rr + x] = sxr; } }
            if (lane == 0) rownrm[rr + x] = sqrtf(ssq); }
        float pl[2][32];
#pragma unroll
        for (int e = 0; e < 32; ++e) { float a0 = 0.f, a1 = 0.f;
            if (dry && (PROBE_DRYCUT & 2)) { a0 = v[0][e & 3][e >> 3]; a1 = v[1][e & 3][e >> 3]; } else
#pragma unroll
            for (int j = 0; j < 4; ++j) { const f32x4 w = *(const LAS f32x4*)(wrt + e * WR_STRIDE + 256 * j + 4 * lane);
                a0 += (v[0][j][0] * w[0] + v[0][j][1] * w[1]) + (v[0][j][2] * w[2] + v[0][j][3] * w[3]); a1 += (v[1][j][0] * w[0] + v[1][j][1] * w[1]) + (v[1][j][2] * w[2] + v[1][j][3] * w[3]); }
            pl[0][e] = a0; pl[1][e] = a1; }
        if (!(dry && (PROBE_DRYCUT & 4)))
#pragma unroll
        for (int o = 32, n = 16; o >= 2; o >>= 1, n >>= 1) { const bool up = (lane & o) != 0;
#pragma unroll
            for (int i = 0; i < 16; ++i) if (i < n) {
#pragma unroll
                for (int x = 0; x < 2; ++x) { const float send = up ? pl[x][i] : pl[x][i + n], keep = up ? pl[x][i + n] : pl[x][i]; pl[x][i] = keep + shx(send, o, lane); } } }
        const int myexp = lane >> 1; const float brv = a.b_r[myexp];
#pragma unroll
        for (int x = 0; x < 2; ++x) { float cur = pl[x][0] + shx(pl[x][0], 1, lane) + brv; float sv[4]; int se[4];
#pragma unroll
            for (int k = 0; k < 4; ++k) { const float m = wave_max_u(cur); const unsigned long long bal = __builtin_amdgcn_ballot_w64(cur == m);
                const int ek = __builtin_amdgcn_readfirstlane((int)__builtin_ctzll(bal)) >> 1; sv[k] = m; se[k] = ek; if (myexp == ek) cur = -INFINITY; }
            const float e1 = __expf(sv[1] - sv[0]), e2 = __expf(sv[2] - sv[0]), e3 = __expf(sv[3] - sv[0]); const float inv = 1.0f / (1.0f + e1 + e2 + e3);
            if (lane < 4) { const int e = lane == 0 ? se[0] : lane == 1 ? se[1] : lane == 2 ? se[2] : se[3];
                const float w = (lane == 0 ? 1.0f : lane == 1 ? e1 : lane == 2 ? e2 : e3) * inv;
                rowe[(rr + x) * 4 + lane] = e; roww[(rr + x) * 4 + lane] = w; } }
    }
#undef ROUTE_LOAD
    __syncthreads();
    if (dry) return;
    const int nent = rows_per_wg * 4;
    int my_e = 0, my_lr = 0;
    if (tid < nent) { my_e = rowe[tid]; my_lr = atomicAdd((int*)(lcnt + my_e), 1); }
    __syncthreads();
    if (tid < NE) gbase[tid] = atomicAdd(a.gcnt + tid, lcnt[tid]);
    __syncthreads();
    if (tid < nent) { const int t = vcu * rows_per_wg + (tid >> 2), rank = gbase[my_e] + my_lr;
        const float sig = rownrm[tid >> 2] * a.scl[64 + my_e], clip = fmaxf((1.0f + 3.5f * sig) * (3.5f * sig), 1e-20f);
        const float qh = bfhi(f2bf(127.0f / clip) << 16);
        a.list_tok[(size_t)my_e * LISTCAP + rank] = t; a.list_w[(size_t)my_e * LISTCAP + rank] = qh; a.list_sx[(size_t)my_e * LISTCAP + rank] = rowsx[tid >> 2];
        a.list_hs[(size_t)my_e * LISTCAP + rank] = roww[tid] / qh;
        a.tk_e[t * 4 + (tid & 3)] = my_e; a.tk_rank[t * 4 + (tid & 3)] = rank; a.tk_w[t * 4 + (tid & 3)] = roww[tid]; }
    __syncthreads();
}
__device__ __forceinline__ void build_tables(const int* gcnt, LAS unsigned char* lds, int wvid) {
    LAS int* misc = (LAS int*)(lds + MISC_OFF);
    const int tid = wvid * 64 + lane_id_asm();
    if (tid < NE) misc[tid] = __hip_atomic_load(gcnt + tid, __ATOMIC_RELAXED, __HIP_MEMORY_SCOPE_AGENT);
    __syncthreads();
    if (tid == 0) { int a = 0; for (int e = 0; e < NE; ++e) { misc[32 + e] = a; a += (misc[e] + 255) >> 8; } misc[32 + NE] = a; }
    __syncthreads();
}
struct FinalArgs { float dbg_scale; int pad_; const bf16_t* X1B; const bf16_t* PLE; const bf16_t* Y; const int* tk_e; const int* tk_rank; const float* tk_w; const float* b_down; const float *g2, *b2; float* out; };
__device__ __forceinline__ void final_phase(const FinalArgs& a, LAS unsigned char* lds, int vcu, int G, int wvid) {
    int tid_ = (wvid * 64 + lane_id_asm()); asm volatile("" : "+v"(tid_));
    const int tid = tid_, lane = tid & 63, wave = __builtin_amdgcn_readfirstlane(tid >> 6);
    const LAS int* ts = (const LAS int*)(lds + MISC_OFF) + 32;
    LAS float* bdl = (LAS float*)lds;
    for (int i = tid; i < NE * D / 4; i += NTHREADS) *(LAS f32x4*)(bdl + 4 * i) = *(const f32x4*)(a.b_down + 4 * i);
    __syncthreads();
    const int gw = vcu * NWAVES + wave, NGW = G * NWAVES;
    for (int t0 = 2 * gw; t0 < M; t0 += 2 * NGW) {
        size_t pos[2][4]; int ek[2][4]; float wk[2][4];
#pragma unroll
        for (int x = 0; x < 2; ++x)
#pragma unroll
            for (int k = 0; k < 4; ++k) { const int t = t0 + x, e = a.tk_e[t * 4 + k], rk = a.tk_rank[t * 4 + k]; pos[x][k] = ((size_t)ts[e] * 256 + rk) * D; ek[x][k] = e * D; wk[x][k] = a.tk_w[t * 4 + k]; }
        f32x4 v[2][4]; float s[2] = {0.f, 0.f};
#pragma unroll
        for (int x = 0; x < 2; ++x)
#pragma unroll
            for (int j = 0; j < 4; ++j) { const int c = 256 * j + 4 * lane; const size_t ro = (size_t)(t0 + x) * D + c;
                const u32x2 xw = *(const u32x2*)(a.X1B + ro), pw = *(const u32x2*)(a.PLE + ro);
                f32x4 xx = {bflo(xw.x) * DN_ALPHA + bflo(pw.x), bfhi(xw.x) * DN_ALPHA + bfhi(pw.x), bflo(xw.y) * DN_ALPHA + bflo(pw.y), bfhi(xw.y) * DN_ALPHA + bfhi(pw.y)};
#pragma unroll
                for (int k = 0; k < 4; ++k) { const u32x2 yw = *(const u32x2*)(a.Y + pos[x][k] + c); const f32x4 bd = *(const LAS f32x4*)(bdl + ek[x][k] + c);
                    xx[0] += bflo(yw.x) + wk[x][k] * bd[0]; xx[1] += bfhi(yw.x) + wk[x][k] * bd[1]; xx[2] += bflo(yw.y) + wk[x][k] * bd[2]; xx[3] += bfhi(yw.y) + wk[x][k] * bd[3]; }
                v[x][j] = xx; s[x] += (xx[0] + xx[1]) + (xx[2] + xx[3]); }
#pragma unroll
        for (int x = 0; x < 2; ++x) { const float mean = wave_sum_u(s[x]) * (1.0f / D); float q = 0.f;
#pragma unroll
            for (int j = 0; j < 4; ++j) { v[x][j] = v[x][j] - mean; q += (v[x][j][0] * v[x][j][0] + v[x][j][1] * v[x][j][1]) + (v[x][j][2] * v[x][j][2] + v[x][j][3] * v[x][j][3]); }
            const float rstd = 1.0f / sqrtf(wave_sum_u(q) * (1.0f / D) + LN_EPS);
#pragma unroll
            for (int j = 0; j < 4; ++j) { const int c = 256 * j + 4 * lane; const f32x4 gg = *(const f32x4*)(a.g2 + c), bb = *(const f32x4*)(a.b2 + c);
                *(f32x4*)(a.out + (size_t)(t0 + x) * D + c) = (v[x][j] * rstd * gg + bb) * a.dbg_scale; } }
    }
}

#define STAMP(k) do { if (PROBE_STAMP >= 0 && bx == 0 && (wvid * 64 + lane_id_asm()) == 0) __hip_atomic_store(WSP(unsigned long long, WS_CTL + 32768) + (k), (unsigned long long)__builtin_amdgcn_s_memrealtime(), __ATOMIC_RELAXED, __HIP_MEMORY_SCOPE_AGENT); } while (0)
#define PROBE_SCALE 5e-6f
#ifndef PROBE_REP
#define PROBE_REP 0
#endif
struct Args { const float* in[20]; float* out; unsigned char* ws; };
__global__ void __launch_bounds__(NTHREADS, 2) mega_fwd(Args args) {
    extern __shared__ __attribute__((aligned(16))) unsigned char lds_raw[];
    LAS unsigned char* lds = (LAS unsigned char*)lds_raw;
    cg::grid_group grid = cg::this_grid();
    const int G = gridDim.x, bx = blockIdx.x;
    const int wvid = __builtin_amdgcn_readfirstlane((int)threadIdx.x >> 6);
    const int vcu = (G % 8 == 0) ? (bx % 8) * (G / 8) + bx / 8 : bx;
    unsigned char* const ws = args.ws;
    const LAS int* cntL = (const LAS int*)(lds + MISC_OFF); const LAS int* tsL = cntL + 32;
    { volatile LAS unsigned* bst = (volatile LAS unsigned*)(lds + MISC_OFF) + BST_IDX;
      { int t_ = (wvid * 64 + lane_id_asm()); asm volatile("" : "+v"(t_)); if (t_ < 2) bst[t_] = 0u; }
      if (PROBE_STAMP >= 16 && (wvid * 64 + lane_id_asm()) == 0) { LAS int* m_ = (LAS int*)(lds + MISC_OFF); *(LAS unsigned long long*)(m_ + 68) = (unsigned long long)(args.ws + WS_CTL + 32768); m_[70] = 0; }
      __syncthreads();
    }
    if (bx == 0) { const int t0_ = wvid * 64 + lane_id_asm(); for (int i_ = t0_; i_ < (int)(CTL_ZERO_BYTES / 16); i_ += NTHREADS) ((u32x4*)(ws + WS_CTL))[i_] = (u32x4){0u, 0u, 0u, 0u}; }
#define GRID_BAR() do { XcdBarrier b_; b_.bar = (unsigned*)(ws + WS_BAR); b_.x = xb_xcc_id(); b_.st = (volatile LAS unsigned*)(lds + MISC_OFF) + BST_IDX; b_.lead = ((wvid * 64 + lane_id_asm()) == 0); xcd_barrier(b_); if (PROBE_REP & 0x80000) xcd_barrier(b_); } while (0)
#define WSP(T, off) ((T*)(ws + (off)))
#define P0ARGS_LATE P0Args a_{args.in[0], args.in[1], args.in[2], args.in[4], args.in[5], args.in[7], args.in[17], args.in[16], args.in[12], args.in[14], ws, 1.0f, 1.0f}
#define GRID_BAR_F(seam, pre) do { XcdBarrier b_; b_.bar = (unsigned*)(ws + WS_BAR); b_.x = xb_xcc_id(); b_.st = (volatile LAS unsigned*)(lds + MISC_OFF) + BST_IDX; b_.lead = ((wvid * 64 + lane_id_asm()) == 0); \
    asm volatile("s_waitcnt vmcnt(0)" ::: "memory"); __syncthreads(); \
    if (wvid == 0) xcd_barrier_lead(b_); \
    else if (!(pre) || !(vcu & 1)) { P0ARGS_LATE; p0_fill(a_, lds, vcu, G, seam, wvid); } \
    __syncthreads(); } while (0)
#ifndef PRE_MASK
#define PRE_MASK 24
#endif
#define PREFILL(seam) do { if (((PRE_MASK >> (seam)) & 1) && (vcu & 1)) { if (wvid != 0) { P0ARGS_LATE; p0_fill(a_, lds, vcu, G, seam, wvid); } __syncthreads(); } } while (0)

    STAMP(0);
    {
      const float s_in = __builtin_bit_cast(float, __builtin_amdgcn_readfirstlane(__builtin_bit_cast(int, sample_scale(args.in[2], 13308, lds, wvid))));
      if ((wvid * 64 + lane_id_asm()) == 0) WSP(float, WS_SCL)[161] = s_in;
    _Pragma("unroll 1") for (int rep_ = 0; rep_ < ((PROBE_REP & 1) ? 2 : 1); ++rep_) { P0Args a{args.in[0], args.in[1], args.in[2], args.in[4], args.in[5], args.in[7], args.in[17], args.in[16], args.in[12], args.in[14], ws, s_in, 0.0f}; p0_phase(a, lds, vcu, G, 0, P0_NSMALL, true, wvid); } }
#if (PROBE_REP & 0x200000)
    { u32x4* z_ = (u32x4*)(ws + WS_R); const int gt_ = vcu * NTHREADS + wvid * 64 + lane_id_asm(); for (size_t i_ = gt_; i_ < (176 * MiB) / 16; i_ += (size_t)G * NTHREADS) z_[i_] = (u32x4){0u, 0u, 0u, 0u}; }
#endif
    grid.sync();
    (void)xcd_barrier_post((unsigned*)(ws + WS_BAR), (volatile LAS unsigned*)(lds + MISC_OFF) + BST_IDX, (wvid * 64 + lane_id_asm()) == 0);
    STAMP(1);
    PREFILL(1);
    { constexpr int U1 = (M / 256) * (NIN / 256); const int R1 = U1 % G, nidle = R1 ? G - R1 : G, per = 256 / nidle;
      if (R1 == 0 || bx >= R1) {
        pg8::Gemm g{WSP(bf16_t, WS_PB), (const bf16_t*)(ws + WS_WPP), DPLE}; pg8::Ple1Order S{(bx - R1) * per, per};
        pg8::EpiF32 E{WSP(float, WS_P2)};
        pg8::gemm_phase<pg8::EpiF32, pg8::Ple1Order, false>(lds, g, S, E, wvid); } }
    _Pragma("unroll 1") for (int rep_ = 0; rep_ < ((PROBE_REP & 2) ? 2 : 1); ++rep_) { pg8::Gemm g{WSP(bf16_t, WS_XB), (const bf16_t*)(ws + WS_WIN), D / 2}; pg8::StaticOrder S; S.init(M / 256, NIN / 256, G, bx, 1);
      const float s_in1 = __builtin_bit_cast(float, __builtin_amdgcn_readfirstlane(__builtin_bit_cast(int, WSP(float, WS_SCL)[161])));
      pg8::EpiInProjI8 E{ws, s_in1};
      pg8::gemm_phase<pg8::EpiInProjI8, pg8::StaticOrder, true, 0, true>(lds, g, S, E, wvid);
#if (PROBE_REP & 0x1000000)
      pg8::gemm_phase<pg8::EpiInProjI8, pg8::StaticOrder, true, 1, true>(lds, g, S, E, wvid);
#endif
#if (PROBE_REP & 0x2000000)
      pg8::gemm_phase<pg8::EpiInProjI8, pg8::StaticOrder, true, 2, true>(lds, g, S, E, wvid);
#endif
      }
    GRID_BAR_F(1, (PRE_MASK >> 1) & 1);
    STAMP(2);
    if (PROBE_REP & 4096) { _Pragma("unroll 1") for (int k_ = 0; k_ < 8; ++k_) GRID_BAR(); }
    _Pragma("unroll 1") for (int rep_ = 0; rep_ < ((PROBE_REP & 4) ? 2 : 1); ++rep_) for (int it = vcu; it < BATCH * NKV * (SEQ / 128); it += G) { const int nb = it & 63, kvh = (it >> 6) & 3, b = it >> 8;
        attn_unit(lds, WSP(bf16_t, WS_Q), WSP(bf16_t, WS_K), WSP(bf16_t, WS_V), args.in[6], WSP(bf16_t, WS_ZO) + (size_t)M * D, b, kvh, nb, wvid); }
    _Pragma("unroll 1") for (int rep_ = 0; rep_ < ((PROBE_REP & 8) ? 2 : 1); ++rep_) conv_phase(WSP(bf16_t, WS_BG), WSP(bf16_t, WS_U), args.in[3], WSP(bf16_t, WS_ZO), vcu, G, wvid);
    GRID_BAR_F(2, 0);
    STAMP(3);
#if DBG_ATTN
    dbg_attn_check(WSP(bf16_t, WS_Q), WSP(bf16_t, WS_K), WSP(bf16_t, WS_V), args.in[6], WSP(bf16_t, WS_ZO) + (size_t)M * D, WSP(float, WS_CTL) + 64, vcu, G, wvid);
#endif
    PREFILL(3);
    _Pragma("unroll 1") for (int rep_ = 0; rep_ < ((PROBE_REP & 16) ? 2 : 1); ++rep_) { pg8::Gemm g{WSP(bf16_t, WS_ZO), (const bf16_t*)(ws + WS_WBR), D}; pg8::DualOrder S; S.so.init(M / 256, D / 256, G, bx);
      pg8::EpiDual E{ws};
      pg8::gemm_phase<pg8::EpiDual, pg8::DualOrder, true>(lds, g, S, E, wvid); }
    GRID_BAR_F(3, (PRE_MASK >> 3) & 1);
    STAMP(4);
    PREFILL(4);
    _Pragma("unroll 1") for (int rep_ = 0; rep_ < ((PROBE_REP & 32) ? 2 : 1); ++rep_) { pg8::Gemm g{WSP(bf16_t, WS_MG), (const bf16_t*)(ws + WS_WOUT), D}; pg8::StaticOrder S; S.init(M / 256, D / 256, G, bx);
      pg8::EpiResid E{WSP(bf16_t, WS_X1F)};
      pg8::gemm_phase<pg8::EpiResid, pg8::StaticOrder, false>(lds, g, S, E, wvid);
#if (PROBE_REP & 0x4000000)
      pg8::gemm_phase<pg8::EpiResid, pg8::StaticOrder, false, 1>(lds, g, S, E, wvid);
#endif
#if (PROBE_REP & 0x8000000)
      pg8::gemm_phase<pg8::EpiResid, pg8::StaticOrder, false, 2>(lds, g, S, E, wvid);
#endif
      }
    GRID_BAR_F(4, (PRE_MASK >> 4) & 1);
    STAMP(5);
    { P0Args a{args.in[0], args.in[1], args.in[2], args.in[4], args.in[5], args.in[7], args.in[17], args.in[16], args.in[12], args.in[14], ws, 1.0f, 1.0f}; p0_phase(a, lds, vcu, G, P0_NSMALL + P0_FILL_TOTAL * G * 7, P0_NITEMS - G * 7 * fill_cnt(5), false, wvid); __syncthreads();
      if (PROBE_REP & 0x40000) { p0_phase(a, lds, vcu, G, P0_NSMALL, P0_NITEMS, false, wvid); __syncthreads(); } }
    _Pragma("unroll 1") for (int rep_ = ((PROBE_REP & 64) ? 0 : 1); rep_ < 2; ++rep_) { RouteArgs a{WSP(bf16_t, WS_X1F), args.in[0], WSP(bf16_t, WS_X1B), args.in[8], args.in[9], args.in[10], args.in[11], WSP(int, WS_CTL), WSP(int, WS_LTOK), WSP(float, WS_LW), WSP(int, WS_TKE), WSP(int, WS_TKR), WSP(float, WS_TKW), ws + WS_XQ, WSP(float, WS_SX1), WSP(float, WS_LSX), WSP(float, WS_LHS), WSP(float, WS_SCL)}; route_phase(a, lds, vcu, G, rep_ == 0, wvid); }
    GRID_BAR_F(5, 0);
    STAMP(6);
    build_tables(WSP(int, WS_CTL), lds, wvid);
    { const int nx5_ = __builtin_amdgcn_readfirstlane(pg8::MoeOrder::ple_in_p5(tsL, G));
      pg8::MoeOrder S; S.init(cntL, tsL, (const LAS unsigned*)(lds + TW_OFF), 8, G, bx, 1, WS_XQ, WS_WGU, nx5_, 0, WS_XQ, WS_WPG8, 18); S.build_units((LAS int*)(lds + UTAB_OFF), 12, wvid * 64 + lane_id_asm(), vcu, 1);
      pg8::moe_preload(S, cntL, WSP(int, WS_LTOK), WSP(float, WS_LW), (LAS unsigned*)(lds + TW_OFF), wvid);
      _Pragma("unroll 1") for (int rep_ = 0; rep_ < ((PROBE_REP & 128) ? 2 : 1); ++rep_) { pg8::Gemm g{(const bf16_t*)ws, (const bf16_t*)ws, D / 2};
        pg8::EpiSwigluI8 E{WSP(bf16_t, WS_H), args.in[13], (const LAS unsigned*)(lds + TW_OFF), ws};
        pg8::gemm_phase<pg8::EpiSwigluI8, pg8::MoeOrder, true, 0, true>(lds, g, S, E, wvid);
#if (PROBE_REP & 0x400000)
        pg8::gemm_phase<pg8::EpiSwigluI8, pg8::MoeOrder, true, 1, true>(lds, g, S, E, wvid);
#endif
#if (PROBE_REP & 0x800000)
        pg8::gemm_phase<pg8::EpiSwigluI8, pg8::MoeOrder, true, 2, true>(lds, g, S, E, wvid);
#endif
        } }
    GRID_BAR();
    STAMP(7);
    _Pragma("unroll 1") for (int rep_ = 0; rep_ < ((PROBE_REP & 1024) ? 2 : 1); ++rep_) { pg8::Gemm g{(const bf16_t*)ws, (const bf16_t*)ws, D / 2};
      const int nx5_ = __builtin_amdgcn_readfirstlane(pg8::MoeOrder::ple_in_p5(tsL, G));
      pg8::MoeOrder S; S.init(cntL, tsL, (const LAS unsigned*)(lds + TW_OFF), 4, G, bx, 0, WS_H, WS_WDN, 256 - nx5_, nx5_, WS_XQ, WS_WPG8, 18); S.build_units((LAS int*)(lds + UTAB_OFF), 12, wvid * 64 + lane_id_asm(), vcu, 2);
      pg8::EpiDownI8 E{WSP(bf16_t, WS_Y), ws, cntL};
      pg8::gemm_phase<pg8::EpiDownI8, pg8::MoeOrder, true, 0, true>(lds, g, S, E, wvid); }
    STAMP(8);
    GRID_BAR();
    STAMP(9);
    _Pragma("unroll 1") for (int rep_ = 0; rep_ < ((PROBE_REP & 2048) ? 2 : 1); ++rep_) { float dbgs_ = 1.0f;
      if (PROBE_STAMP >= 0) { const unsigned long long* st_ = WSP(unsigned long long, WS_CTL + 32768); const float dt_us = (float)(long long)(__hip_atomic_load(st_ + PROBE_STAMP + 1, __ATOMIC_RELAXED, __HIP_MEMORY_SCOPE_AGENT) - __hip_atomic_load(st_ + PROBE_STAMP, __ATOMIC_RELAXED, __HIP_MEMORY_SCOPE_AGENT)) * 0.01f; dbgs_ = 1.0f + sqrtf(dt_us * PROBE_SCALE); }
#if DBG_ATTN
      { const float* a3 = WSP(float, WS_CTL) + 64; const float num = __hip_atomic_load(a3, __ATOMIC_RELAXED, __HIP_MEMORY_SCOPE_AGENT), den = __hip_atomic_load(a3 + 1, __ATOMIC_RELAXED, __HIP_MEMORY_SCOPE_AGENT), mx = __hip_atomic_load(a3 + 2, __ATOMIC_RELAXED, __HIP_MEMORY_SCOPE_AGENT);
        dbgs_ = 1.0f + sqrtf(100.0f * (DBG_ATTN == 1 ? num / den : mx)); }
#endif
      FinalArgs a{dbgs_, 0, WSP(bf16_t, WS_X1B), WSP(bf16_t, WS_PLE), WSP(bf16_t, WS_Y), WSP(int, WS_TKE), WSP(int, WS_TKR), WSP(float, WS_TKW), args.in[15], args.in[18], args.in[19], args.out}; final_phase(a, lds, vcu, G, wvid); }
}

extern "C" void kernel_launch(void* const* d_in, const int* in_sizes, int n_in, void* d_out, int out_size, void* d_ws, size_t ws_size, hipStream_t stream) {
    static int grid = 0;
    if (grid == 0) {
        if (n_in != 20 || out_size != M * D || ws_size < WS_END) { fprintf(stderr, "kernel_launch: unexpected sizes (n_in %d, out %d, ws %zu < %zu)\n", n_in, out_size, ws_size, (size_t)WS_END); grid = -1; return; }
        int dev = 0, cus = 0, per_cu = 0;
        if (hipGetDevice(&dev) != hipSuccess || hipDeviceGetAttribute(&cus, hipDeviceAttributeMultiprocessorCount, dev) != hipSuccess) { grid = -1; return; }
        if (hipFuncSetAttribute((const void*)mega_fwd, hipFuncAttributeMaxDynamicSharedMemorySize, LDS_BYTES) != hipSuccess) { fprintf(stderr, "kernel_launch: hipFuncSetAttribute failed\n"); grid = -1; return; }
        if (hipOccupancyMaxActiveBlocksPerMultiprocessor(&per_cu, (const void*)mega_fwd, NTHREADS, LDS_BYTES) != hipSuccess || per_cu < 1) { fprintf(stderr, "kernel_launch: occupancy query says %d blocks per CU\n", per_cu); grid = -1; return; }
        grid = cus;
        if (grid != 256) fprintf(stderr, "kernel_launch: note: %d CUs (built and tuned for 256)\n", grid);
    }
    if (grid < 0) return;
    Args a{};
    for (int i = 0; i < 20; ++i) a.in[i] = (const float*)d_in[i];
    a.out = (float*)d_out; a.ws = (unsigned char*)d_ws;
    void* kargs[] = {&a};
    const hipError_t e = hipLaunchCooperativeKernel((const void*)mega_fwd, dim3(grid), dim3(NTHREADS), kargs, LDS_BYTES, stream);
    if (e != hipSuccess) fprintf(stderr, "kernel_launch: cooperative launch failed: %s (grid %d)\n", hipGetErrorString(e), grid);
}
```
